# Optimizing an MI355X kernel written in HIP

```python
import jax
import jax.numpy as jnp
from jax import lax
import numpy as np

D_MODEL = 2048
BATCH = 1
SEQ = 8192
DEPTH = 4

A_HEADS = 16
A_KV_GROUPS = 4
A_HEADS_PER_GROUP = A_HEADS // A_KV_GROUPS
A_HEAD_DIM = D_MODEL // A_HEADS
A_WIDTH = A_HEADS * A_HEAD_DIM
A_KV_WIDTH = A_KV_GROUPS * A_HEAD_DIM
A_N_BRANCH = 3
CMP_BLOCK = 32
CMP_STRIDE = 16
CMP_HIDDEN = 256
SEL_BLOCK = 64
SEL_TOP_N = 16
SEL_Q_CHUNK = 64
WIN_SIZE = 512
WIN_Q_BLOCK = 128
B_HEADS = 4
B_KEY_WIDTH = D_MODEL // 2
B_VAL_WIDTH = D_MODEL
B_KEY_DIM = B_KEY_WIDTH // B_HEADS
B_VAL_DIM = B_VAL_WIDTH // B_HEADS
B_ALPHA_RANK = 16
B_GATE_TEMP = 16.0
B_CHUNK = 64
NORM_EPS = 1e-6

IN_SIZES = (A_WIDTH, A_KV_WIDTH, A_KV_WIDTH, A_KV_WIDTH, A_KV_WIDTH, A_KV_WIDTH, A_KV_WIDTH,
            A_HEADS * A_N_BRANCH, A_WIDTH,
            B_KEY_WIDTH, B_KEY_WIDTH, B_VAL_WIDTH, B_ALPHA_RANK, B_VAL_WIDTH,
            D_MODEL, D_MODEL)
IN_COLS = sum(IN_SIZES)

kernel_name = 'hybrid_nsa_gla_gated_block'


def rms_norm(x, w):
    xf = x.astype(jnp.float32)
    y = xf * lax.rsqrt(jnp.mean(xf * xf, axis=-1, keepdims=True) + NORM_EPS)
    return (y * w.astype(jnp.float32)).astype(x.dtype)


def masked_softmax(s, mask):
    s = jnp.where(mask, s.astype(jnp.float32), -jnp.inf)
    m = jnp.max(s, axis=-1, keepdims=True)
    m = jnp.where(jnp.isfinite(m), m, 0.0)
    p = jnp.exp(s - m)
    denom = jnp.sum(p, axis=-1, keepdims=True)
    return p / jnp.where(denom > 0, denom, 1.0)


def compress_tokens(kv, pe, w1, b1, w2, b2):
    B, T, G, DH = kv.shape
    ratio = CMP_BLOCK // CMP_STRIDE
    c = kv.reshape(B, T // CMP_STRIDE, CMP_STRIDE, G, DH)
    nc = T // CMP_STRIDE - ratio + 1
    blocks = jnp.concatenate([c[:, r:r + nc] for r in range(ratio)], axis=2)
    blocks = blocks + pe[None, None, :, None, :]
    flat = blocks.transpose(0, 1, 3, 2, 4).reshape(B, nc, G, CMP_BLOCK * DH)
    hid = jax.nn.gelu(flat @ w1 + b1)
    return hid @ w2 + b2


def selected_attention(q, k_sel, v_sel, idx):
    B, T, G, HG, DH = q.shape
    n = idx.shape[-1]
    nb = T // SEL_BLOCK
    kb = k_sel.reshape(B, nb, SEL_BLOCK, G, DH).transpose(0, 3, 1, 2, 4)
    vb = v_sel.reshape(B, nb, SEL_BLOCK, G, DH).transpose(0, 3, 1, 2, 4)
    nqc = T // SEL_Q_CHUNK
    q_c = jnp.moveaxis(q.reshape(B, nqc, SEL_Q_CHUNK, G, HG, DH), 1, 0)
    i_c = jnp.moveaxis(idx.reshape(B, nqc, SEL_Q_CHUNK, G, n), 1, 0)
    t_c = jnp.arange(T, dtype=jnp.int32).reshape(nqc, SEL_Q_CHUNK)
    b_ix = jnp.arange(B)[:, None, None, None]
    g_ix = jnp.arange(G)[None, None, :, None]
    offs = jnp.arange(SEL_BLOCK, dtype=jnp.int32)

    def one_chunk(args):
        qc, ic, tc = args
        kg = kb[b_ix, g_ix, ic]
        vg = vb[b_ix, g_ix, ic]
        kpos = ic[..., None] * SEL_BLOCK + offs
        mask = kpos <= tc[None, :, None, None, None]
        s = jnp.einsum('bcghd,bcgnld->bcghnl', qc, kg)
        s = s.reshape(B, SEL_Q_CHUNK, G, HG, n * SEL_BLOCK)
        p = masked_softmax(s, mask.reshape(B, SEL_Q_CHUNK, G, 1, n * SEL_BLOCK))
        return jnp.einsum('bcghk,bcgkd->bcghd', p.astype(vg.dtype),
                          vg.reshape(B, SEL_Q_CHUNK, G, n * SEL_BLOCK, DH))

    o = lax.map(one_chunk, (q_c, i_c, t_c))
    return jnp.moveaxis(o, 0, 1).reshape(B, T, G, HG, DH)


def window_attention(q, k_win, v_win):
    B, T, G, HG, DH = q.shape
    nq = T // WIN_Q_BLOCK
    r = WIN_SIZE // WIN_Q_BLOCK
    nk = (r + 1) * WIN_Q_BLOCK

    def band(u):
        up = jnp.pad(u, ((0, 0), (WIN_SIZE, 0), (0, 0), (0, 0)))
        up = up.reshape(B, (T + WIN_SIZE) // WIN_Q_BLOCK, WIN_Q_BLOCK, G, DH)
        return jnp.concatenate([up[:, i:i + nq] for i in range(r + 1)], axis=2)

    kw, vw = band(k_win), band(v_win)
    qb = q.reshape(B, nq, WIN_Q_BLOCK, G, HG, DH)
    a = jnp.arange(WIN_Q_BLOCK)[:, None]
    c = jnp.arange(nk)[None, :]
    rel = a - c + WIN_SIZE
    kpos = jnp.arange(nq)[:, None, None] * WIN_Q_BLOCK - WIN_SIZE + c[None]
    mask = (rel >= 0) & (rel < WIN_SIZE) & (kpos >= 0)
    s = jnp.einsum('bnqghd,bnkgd->bnghqk', qb, kw)
    p = masked_softmax(s, mask[None, :, None, None, :, :])
    o = jnp.einsum('bnghqk,bnkgd->bnqghd', p.astype(vw.dtype), vw)
    return o.reshape(B, T, G, HG, DH)


def nsa_mixer(q, k_cmp, v_cmp, k_sel, v_sel, k_win, v_win, g_br,
              cmp_pe, cmp_w1, cmp_b1, cmp_w2, cmp_b2):
    B, T = q.shape[:2]
    G, HG, DH = A_KV_GROUPS, A_HEADS_PER_GROUP, A_HEAD_DIM
    q = q.reshape(B, T, G, HG, DH) * (DH ** -0.5)
    kv = lambda u: u.reshape(B, T, G, DH)
    pos = jnp.arange(T, dtype=jnp.int32)
    kc = compress_tokens(kv(k_cmp), cmp_pe[0], cmp_w1[0], cmp_b1[0], cmp_w2[0], cmp_b2[0])
    vc = compress_tokens(kv(v_cmp), cmp_pe[1], cmp_w1[1], cmp_b1[1], cmp_w2[1], cmp_b2[1])
    nc = kc.shape[1]
    c_start = jnp.arange(nc, dtype=jnp.int32) * CMP_STRIDE
    c_mask = (c_start + CMP_BLOCK - 1)[None, :] <= pos[:, None]
    s_c = jnp.einsum('btghd,bngd->btghn', q, kc)
    p_c = masked_softmax(s_c, c_mask[None, :, None, None, :])
    o_cmp = jnp.einsum('btghn,bngd->btghd', p_c.astype(vc.dtype), vc)
    nb = T // SEL_BLOCK
    j = jnp.arange(nb, dtype=jnp.int32)
    overlap = ((c_start[:, None] <= j[None, :] * SEL_BLOCK + SEL_BLOCK - 1) &
               (c_start[:, None] + CMP_BLOCK - 1 >= j[None, :] * SEL_BLOCK)).astype(jnp.float32)
    p_slc = jnp.einsum('btgn,nj->btgj', jnp.sum(p_c, axis=3), overlap)
    cur = pos[:, None] // SEL_BLOCK
    valid = j[None, :] * SEL_BLOCK <= pos[:, None]
    forced = (j[None, :] == 0) | (j[None, :] == cur) | (j[None, :] == cur - 1)
    score = jnp.where(forced[None, :, None, :], jnp.inf,
                      jnp.where(valid[None, :, None, :], p_slc, -jnp.inf))
    n_sel = min(SEL_TOP_N, nb)
    _, idx = lax.top_k(score, n_sel)
    o_sel = selected_attention(q, kv(k_sel), kv(v_sel), idx.astype(jnp.int32))
    o_win = window_attention(q, kv(k_win), kv(v_win))
    g = jax.nn.sigmoid(g_br).reshape(B, T, G, HG, A_N_BRANCH)
    o = g[..., 0:1] * o_cmp + g[..., 1:2] * o_sel + g[..., 2:3] * o_win
    return o.reshape(B, T, A_WIDTH)


def gla_mixer(q, k, v, a_lr, alpha_w, alpha_b, norm_w):
    B, T = q.shape[:2]
    H, DK, DV, C = B_HEADS, B_KEY_DIM, B_VAL_DIM, B_CHUNK
    nck = T // C
    f32 = jnp.float32
    log_a = jax.nn.log_sigmoid((a_lr @ alpha_w + alpha_b).astype(f32)) / B_GATE_TEMP
    chunks = lambda u, d: u.astype(f32).reshape(B, nck, C, H, d)
    qc = chunks(q, DK) * (DK ** -0.5)
    kc = chunks(k, DK)
    vc = chunks(v, DV)
    cum = jnp.cumsum(chunks(log_a, DK), axis=2)
    last = cum[:, :, -1:]
    q_dec = qc * jnp.exp(cum)
    k_inv = kc * jnp.exp(-cum)
    k_state = kc * jnp.exp(last - cum)
    tril = jnp.tril(jnp.ones((C, C), dtype=bool))
    att = jnp.where(tril, jnp.einsum('bnthd,bnshd->bnhts', q_dec, k_inv), 0.0)
    o_intra = jnp.einsum('bnhts,bnshv->bnthv', att, vc)

    def step(S, xs):
        q_c, k_c, v_c, dec = xs
        o = jnp.einsum('bthd,bhdv->bthv', q_c, S)
        S = S * dec[..., None] + jnp.einsum('bshd,bshv->bhdv', k_c, v_c)
        return S, o

    S0 = jnp.zeros((B, H, DK, DV), f32)
    xs = (jnp.moveaxis(q_dec, 1, 0), jnp.moveaxis(k_state, 1, 0), jnp.moveaxis(vc, 1, 0),
          jnp.moveaxis(jnp.exp(last[:, :, 0]), 1, 0))
    _, o_inter = lax.scan(step, S0, xs)
    o = (o_intra + jnp.moveaxis(o_inter, 0, 1)).reshape(B, T, H, DV)
    o = o * lax.rsqrt(jnp.mean(o * o, axis=-1, keepdims=True) + NORM_EPS) * norm_w.astype(f32)
    return o.reshape(B, T, B_VAL_WIDTH).astype(q.dtype)


def setup_inputs(seed: int = 0) -> dict:
    key = jax.random.key(seed)
    ks = jax.random.split(key, 18)
    f32 = jnp.float32
    nrm = lambda k, shape, scale: jax.random.normal(k, shape, f32) * scale
    return {
        'x': nrm(ks[0], (BATCH, SEQ, D_MODEL), 1.0),
        'norm_w': 1.0 + nrm(ks[1], (DEPTH, D_MODEL), 0.02),
        'w_in': nrm(ks[2], (DEPTH, D_MODEL, IN_COLS), D_MODEL ** -0.5),
        'cmp_pe': nrm(ks[3], (DEPTH, 2, CMP_BLOCK, A_HEAD_DIM), 0.5),
        'cmp_w1': nrm(ks[4], (DEPTH, 2, CMP_BLOCK * A_HEAD_DIM, CMP_HIDDEN), (CMP_BLOCK * A_HEAD_DIM) ** -0.5),
        'cmp_b1': nrm(ks[5], (DEPTH, 2, CMP_HIDDEN), 0.01),
        'cmp_w2': nrm(ks[6], (DEPTH, 2, CMP_HIDDEN, A_HEAD_DIM), CMP_HIDDEN ** -0.5),
        'cmp_b2': nrm(ks[7], (DEPTH, 2, A_HEAD_DIM), 0.01),
        'gla_alpha_w': nrm(ks[8], (DEPTH, B_ALPHA_RANK, B_KEY_WIDTH), B_ALPHA_RANK ** -0.5),
        'gla_alpha_b': nrm(ks[9], (DEPTH, B_KEY_WIDTH), 0.1),
        'gla_norm_w': 1.0 + nrm(ks[10], (DEPTH, B_VAL_DIM), 0.02),
        'p_a': nrm(ks[11], (DEPTH, A_WIDTH, D_MODEL), A_WIDTH ** -0.5),
        'p_b': nrm(ks[12], (DEPTH, B_VAL_WIDTH, D_MODEL), B_VAL_WIDTH ** -0.5),
        'w_out': nrm(ks[13], (DEPTH, D_MODEL, D_MODEL), D_MODEL ** -0.5),
        'final_norm_w': 1.0 + nrm(ks[14], (D_MODEL,), 0.02),
    }


def reference(x, norm_w, w_in, cmp_pe, cmp_w1, cmp_b1, cmp_w2, cmp_b2,
              gla_alpha_w, gla_alpha_b, gla_norm_w, p_a, p_b, w_out, final_norm_w):
    split_points = np.cumsum(IN_SIZES)[:-1].tolist()
    for layer in range(DEPTH):
        h = rms_norm(x, norm_w[layer])
        cols = h @ w_in[layer]
        (q_a, k_cmp, v_cmp, k_sel, v_sel, k_win, v_win, g_br, z_a,
         q_b, k_b, v_b, a_lr, z_b, gate_a, gate_b) = jnp.split(cols, split_points, axis=-1)
        o_a = nsa_mixer(q_a, k_cmp, v_cmp, k_sel, v_sel, k_win, v_win, g_br,
                        cmp_pe[layer], cmp_w1[layer], cmp_b1[layer], cmp_w2[layer], cmp_b2[layer])
        y_a = (o_a * jax.nn.silu(z_a)) @ p_a[layer]
        o_b = gla_mixer(q_b, k_b, v_b, a_lr, gla_alpha_w[layer], gla_alpha_b[layer], gla_norm_w[layer])
        y_b = (o_b * jax.nn.silu(z_b)) @ p_b[layer]
        y = jax.nn.sigmoid(gate_a) * y_a + jax.nn.sigmoid(gate_b) * y_b
        x = x + y @ w_out[layer]
    return rms_norm(x, final_norm_w)
```

```cpp
#include <hip/hip_runtime.h>
#include <cstdio>
#include <cstdint>

#ifndef MK_PER_PHASE
#define MK_PER_PHASE 1
#endif

#define LAS __attribute__((address_space(3)))
#define GAS __attribute__((address_space(1)))
typedef unsigned short bf16_t;
typedef short bf16x8 __attribute__((ext_vector_type(8)));
typedef short s16x4 __attribute__((ext_vector_type(4)));
typedef float f32x4 __attribute__((ext_vector_type(4)));
typedef float f32x2 __attribute__((ext_vector_type(2)));
typedef unsigned u32x4 __attribute__((ext_vector_type(4)));
typedef unsigned u32x2 __attribute__((ext_vector_type(2)));
#define DI __device__ __forceinline__
#define MFMA16(a, b, c) __builtin_amdgcn_mfma_f32_16x16x32_bf16((a), (b), (c), 0, 0, 0)

constexpr int T = 8192, D = 2048, DEPTH = 4, NIN = 17472, NP = 17664;
constexpr int NCH = 128;
constexpr int C_QA = 0, C_KCMP = 2048, C_VCMP = 2560, C_KSEL = 3072, C_VSEL = 3584, C_KWIN = 4096, C_VWIN = 4608, C_ZA = 5120,
              C_QB = 7168, C_KB = 8192, C_VB = 9216, C_ZB = 11264, C_GA = 13312, C_GB = 15360, C_GBR = 17408, C_ALR = 17456;
constexpr float NORM_EPS = 1e-6f;
constexpr float ATT_C = 0.08838834764831845f * 1.4426950408889634f;

DI int map_col(int n) {
    if (n < 5120) return n;
    if (n < 5168) return C_GBR + (n - 5120);
    if (n < 11312) return n - 48;
    if (n < 11328) return C_ALR + (n - 11312);
    return n - 64;
}

constexpr size_t MiB = 1u << 20;
constexpr size_t al(size_t x) { return (x + MiB - 1) / MiB * MiB; }
constexpr size_t WS_CTL = 0, CTL_BYTES = MiB;
constexpr size_t WS_WIN = WS_CTL + CTL_BYTES;
constexpr size_t WS_WPA = WS_WIN + al((size_t)DEPTH * NP * D * 2);
constexpr size_t WS_WPB = WS_WPA + al((size_t)DEPTH * D * D * 2);
constexpr size_t WS_WOUT = WS_WPB + al((size_t)DEPTH * D * D * 2);
constexpr size_t WS_W1T = WS_WOUT + al((size_t)DEPTH * D * D * 2);
constexpr size_t WS_W2T = WS_W1T + al((size_t)DEPTH * 2 * 256 * 4096 * 2);
constexpr size_t WS_B1P = WS_W2T + al((size_t)DEPTH * 2 * 128 * 256 * 2);
constexpr size_t WS_X = WS_B1P + MiB;
constexpr size_t WS_H = WS_X + al((size_t)T * D * 4);
constexpr size_t WS_COLS = WS_H + al((size_t)T * D * 2);
constexpr size_t WS_CPART = WS_COLS + al((size_t)(T + 64) * NP * 2);
constexpr size_t WS_KC = WS_CPART + al((size_t)8 * 8 * 512 * 256 * 4);
constexpr size_t WS_VCT = WS_KC + MiB;
constexpr size_t WS_SELM = WS_VCT + MiB;
constexpr size_t WS_OCMP = WS_SELM + MiB;
constexpr size_t WS_OSEL = WS_OCMP + al((size_t)T * D * 2);
constexpr size_t WS_OWIN = WS_OSEL + al((size_t)T * D * 2);
constexpr size_t WS_VSELT = WS_OWIN + al((size_t)T * D * 2);
constexpr size_t WS_VWINT = WS_VSELT + al((size_t)4 * 128 * 128 * 64 * 2);
constexpr size_t WS_QDEC = WS_VWINT + al((size_t)4 * 128 * 128 * 64 * 2);
constexpr size_t WS_KST = WS_QDEC + al((size_t)T * 1024 * 2);
constexpr size_t WS_VT = WS_KST + al((size_t)T * 1024 * 2);
constexpr size_t WS_ATT = WS_VT + al((size_t)T * 2048 * 2);
constexpr size_t WS_DEC = WS_ATT + al((size_t)128 * 4 * 64 * 64 * 2);
constexpr size_t WS_OPART = WS_DEC + MiB;
constexpr size_t WS_A1 = WS_OPART + al((size_t)2 * T * 2048 * 4);
constexpr size_t WS_A2 = WS_A1 + al((size_t)T * D * 2);
constexpr size_t WS_TMP = WS_A2 + al((size_t)T * D * 2);
constexpr size_t WS_Y = WS_TMP + al((size_t)T * D * 4);
constexpr size_t WS_END = WS_Y + al((size_t)T * D * 2);

constexpr int LDS_MAIN = 131072;
constexpr int LDS_MISC = LDS_MAIN;
constexpr int LDS_BYTES = 147456;
constexpr int NWAVES = 8, NTHR = 512;

DI float bf2f(unsigned short b) { return __uint_as_float(((unsigned)b) << 16); }
DI unsigned f2bf(float f) { unsigned u = __float_as_uint(f); return (u + 0x7fffu + ((u >> 16) & 1u)) >> 16; }
DI unsigned pk2(float lo, float hi) { return f2bf(lo) | (f2bf(hi) << 16); }
DI unsigned cvt_pk_bf16(float lo, float hi) { unsigned r; asm volatile("v_cvt_pk_bf16_f32 %0, %1, %2" : "=v"(r) : "v"(lo), "v"(hi)); return r; }
DI float lo_bf(unsigned w) { return __uint_as_float(w << 16); }
DI float hi_bf(unsigned w) { return __uint_as_float(w & 0xffff0000u); }
DI float sigmoidf_(float x) { return 1.f / (1.f + __expf(-x)); }
DI float siluf_(float x) { return x / (1.f + __expf(-x)); }
DI float shx(float v, int off, int lane) { return __int_as_float(__builtin_amdgcn_ds_bpermute((lane ^ off) << 2, __float_as_int(v))); }
DI int shxi(int v, int off, int lane) { return __builtin_amdgcn_ds_bpermute((lane ^ off) << 2, v); }
DI float wave_sum(float v, int lane) {
#pragma unroll
    for (int o = 1; o < 64; o <<= 1) v += shx(v, o, lane);
    return v;
}
#define LDS_WAIT() asm volatile("s_waitcnt lgkmcnt(0)" ::: "memory")
#define VM_WAIT() asm volatile("s_waitcnt vmcnt(0)" ::: "memory")

namespace pg8 {
constexpr int BM = 256, BK = 64, HALF = 128, HTB = HALF * BK * 2, STAGE_BYTES = 8 * HTB, NXCD = 8, WGM = 8;
__host__ __device__ __forceinline__ int lds_byte(int r, int c) { const int st = (r >> 4) * 2 + (c >> 5), rr = r & 15, cc = c & 31, ob = rr * 64 + cc * 2; return st * 1024 + (ob ^ (((ob >> 9) & 1) << 5)); }
__host__ __device__ __forceinline__ void stage_rc(int b, int& R, int& C) { const int st = b / 1024, sb = b % 1024, swz = sb ^ (((sb >> 9) & 1) << 5); R = (st >> 1) * 16 + swz / 64; C = (st & 1) * 32 + (swz % 64) / 2; }
__host__ __device__ __forceinline__ int perm32(int rho) { const int n = rho >> 4, i = rho & 15; return 8 * (i >> 2) + 4 * n + (i & 3); }

struct Unit { int pm, pn, pk, pz; };
struct Gemm { const bf16_t* A; const bf16_t* Bt; int lda, ldb, K; };

struct OrderMN {
    int nM, nN, nwg, G, c;
    DI void init(int M, int N, int G_, int c_) { nM = M / BM; nN = N / BM; nwg = nM * nN; G = G_; c = c_; }
    DI bool next(int i, Unit& u) const {
        const long L = (long)i * G + c; if (L >= nwg) return false;
        int wgid = (int)L; { const int q = nwg / NXCD, r = nwg % NXCD, xcd = wgid % NXCD, off = wgid / NXCD; wgid = (xcd < r ? xcd * (q + 1) : r * (q + 1) + (xcd - r) * q) + off; }
        const int nig = WGM * nN, gid = wgid / nig, fm = gid * WGM, gsz = (nM - fm) < WGM ? (nM - fm) : WGM;
        u.pm = fm + ((wgid % nig) % gsz); u.pn = (wgid % nig) / gsz; u.pk = 0; u.pz = 0; return true;
    }
    DI const char* a_ptr(const Gemm& g, const Unit& u) const { return (const char*)g.A + (size_t)u.pm * BM * g.lda * 2; }
    DI const char* b_ptr(const Gemm& g, const Unit& u) const { return (const char*)g.Bt + (size_t)u.pn * BM * g.ldb * 2; }
};
struct OrderCmp {
    int G, c;
    DI void init(int G_, int c_) { G = G_; c = c_; }
    DI bool next(int i, Unit& u) const { const int L = i * G + c; if (L >= 128) return false; u.pk = L & 7; u.pm = (L >> 3) & 1; u.pz = L >> 4; u.pn = 0; return true; }
    DI const char* a_ptr(const Gemm& g, const Unit& u) const { const int kv = u.pz >> 2, gg = u.pz & 3;
        return (const char*)g.A + ((size_t)(u.pm * BM * 16 + u.pk * 4) * NP + (kv ? C_VCMP : C_KCMP) + gg * 128) * 2; }
    DI const char* b_ptr(const Gemm& g, const Unit& u) const { const int kv = u.pz >> 2; return (const char*)g.Bt + ((size_t)kv * 256 * 4096 + u.pk * 512) * 2; }
};

template <class Epi, class Sched, bool IM2COL = false>
DI void gemm_phase(LAS unsigned char* lds, const Gemm g, const Sched& S, const Epi& E, const int tid) {
    const int wid = __builtin_amdgcn_readfirstlane(tid >> 6), lane = tid & 63, wr = wid >> 2, wc = wid & 3, fr = lane & 15, fq = lane >> 4;
    const int nt = g.K / BK;
    unsigned voffA[2], voffB[2];
#pragma unroll
    for (int i = 0; i < 2; ++i) { int R, C; stage_rc(tid * 16 + i * 8192, R, C); const int Rb = Epi::PERM ? ((R & ~31) + perm32(R & 31)) : R;
        voffA[i] = (unsigned)(R * g.lda + C) * 2u; voffB[i] = (unsigned)(Rb * g.ldb + C) * 2u; }
    const size_t hstepA = (size_t)HALF * g.lda * 2, hstepB = (size_t)HALF * g.ldb * 2;
    const unsigned ldsw = (unsigned)wid * 1024u;
    const int aoff = lds_byte(wr * 64 + fr, fq * 8), boff = lds_byte(wc * 32 + fr, fq * 8);
#define PG8_KA(kt) (IM2COL ? ((size_t)((kt) >> 1) * (NP * 2) + (size_t)((kt) & 1) * 128) : (size_t)(kt) * 128)
#define PG8_KB(kt) ((size_t)(kt) * 128)
#define PG8_SA(b, h) (((b) * 2 + (h)) * HTB)
#define PG8_SB(b, h) ((4 + (b) * 2 + (h)) * HTB)
#define PG8_STAGE(bufoff, gbase, voff) do { _Pragma("unroll") for (int _i = 0; _i < 2; ++_i) \
        __builtin_amdgcn_global_load_lds((const unsigned*)((const char*)(gbase) + (voff)[_i]), (LAS unsigned*)(lds + (bufoff) + ldsw + _i * 8192), 16, 0, 0); } while (0)
#define PG8_LDA(dst, b, h) do { _Pragma("unroll") for (int m = 0; m < 4; ++m) _Pragma("unroll") for (int k = 0; k < 2; ++k) dst[m][k] = *(const LAS bf16x8*)(lds + PG8_SA(b, h) + aoff + m * 2048 + k * 1024); } while (0)
#define PG8_LDB(dst, b, h) do { _Pragma("unroll") for (int n = 0; n < 2; ++n) _Pragma("unroll") for (int k = 0; k < 2; ++k) dst[n][k] = *(const LAS bf16x8*)(lds + PG8_SB(b, h) + boff + n * 2048 + k * 1024); } while (0)
#define PG8_MMA(ai, bj, At, Bt) do { __builtin_amdgcn_s_setprio(1); _Pragma("unroll") for (int m = 0; m < 4; ++m) _Pragma("unroll") for (int n = 0; n < 2; ++n) _Pragma("unroll") for (int k = 0; k < 2; ++k) \
        acc[ai][bj][m][n] = __builtin_amdgcn_mfma_f32_16x16x32_bf16(Bt[n][k], At[m][k], acc[ai][bj][m][n], 0, 0, 0); __builtin_amdgcn_s_setprio(0); } while (0)
#define PG8_WAIT_V(n) asm volatile("s_waitcnt vmcnt(" #n ")" ::: "memory")
#define PG8_WAIT_L(n) asm volatile("s_waitcnt lgkmcnt(" #n ")" ::: "memory")
#define PG8_BAR __builtin_amdgcn_s_barrier()
#define PG8_SCHED __builtin_amdgcn_sched_barrier(0)
    Unit cur, nxt; int ui = 0;
    if (!S.next(0, cur)) return;
    f32x4 acc[2][2][4][2];
#pragma unroll
    for (int a = 0; a < 2; ++a)
#pragma unroll
        for (int b = 0; b < 2; ++b)
#pragma unroll
            for (int m = 0; m < 4; ++m)
#pragma unroll
                for (int n = 0; n < 2; ++n) acc[a][b][m][n] = (f32x4){0.f, 0.f, 0.f, 0.f};
    bf16x8 At[4][2], B0[2][2], B1[2][2];
    const char* cA = S.a_ptr(g, cur); const char* cB = S.b_ptr(g, cur);
    PG8_STAGE(PG8_SB(0, 0), cB, voffB); PG8_STAGE(PG8_SA(0, 0), cA, voffA); PG8_STAGE(PG8_SB(0, 1), cB + hstepB, voffB); PG8_STAGE(PG8_SA(0, 1), cA + hstepA, voffA);
    if (wr == 1) PG8_BAR;
    PG8_WAIT_V(4); PG8_BAR;
    PG8_STAGE(PG8_SB(1, 0), cB + PG8_KB(1), voffB); PG8_STAGE(PG8_SA(1, 0), cA + PG8_KA(1), voffA); PG8_STAGE(PG8_SB(1, 1), cB + hstepB + PG8_KB(1), voffB);
    PG8_WAIT_V(6); PG8_BAR;
    for (;;) {
        const bool has_next = S.next(ui + 1, nxt);
        const char* nA = has_next ? S.a_ptr(g, nxt) : cA; const char* nB = has_next ? S.b_ptr(g, nxt) : cB;
        for (int t = 0; t < nt; t += 2) {
            const bool last = (t == nt - 2);
            const char* a1 = cA + PG8_KA(t + 1);
            const char* a2 = last ? nA : cA + PG8_KA(t + 2); const char* b2 = last ? nB : cB + PG8_KB(t + 2);
            const char* a3 = last ? nA + PG8_KA(1) : cA + PG8_KA(t + 3); const char* b3 = b2 + 128;
            PG8_LDB(B0, 0, 0); PG8_SCHED; PG8_LDA(At, 0, 0); PG8_STAGE(PG8_SA(1, 1), a1 + hstepA, voffA);
            PG8_WAIT_L(8); PG8_BAR; PG8_WAIT_L(0); PG8_MMA(0, 0, At, B0); PG8_BAR; PG8_SCHED;
            PG8_LDB(B1, 0, 1); PG8_STAGE(PG8_SB(0, 0), b2, voffB);
            PG8_BAR; PG8_WAIT_L(0); PG8_MMA(0, 1, At, B1); PG8_BAR;
            PG8_LDA(At, 0, 1); PG8_STAGE(PG8_SA(0, 0), a2, voffA);
            PG8_BAR; PG8_WAIT_L(0); PG8_MMA(1, 0, At, B0); PG8_BAR; PG8_SCHED;
            PG8_STAGE(PG8_SB(0, 1), b2 + hstepB, voffB);
            PG8_WAIT_V(6); PG8_BAR; PG8_MMA(1, 1, At, B1); PG8_BAR;
            PG8_LDB(B0, 1, 0); PG8_SCHED; PG8_LDA(At, 1, 0); PG8_STAGE(PG8_SA(0, 1), a2 + hstepA, voffA);
            PG8_WAIT_L(8); PG8_BAR; PG8_WAIT_L(0); PG8_MMA(0, 0, At, B0); PG8_BAR; PG8_SCHED;
            PG8_LDB(B1, 1, 1); PG8_STAGE(PG8_SB(1, 0), b3, voffB);
            PG8_BAR; PG8_WAIT_L(0); PG8_MMA(0, 1, At, B1); PG8_BAR;
            PG8_LDA(At, 1, 1); PG8_STAGE(PG8_SA(1, 0), a3, voffA);
            PG8_BAR; PG8_WAIT_L(0); PG8_MMA(1, 0, At, B0); PG8_BAR; PG8_SCHED;
            PG8_STAGE(PG8_SB(1, 1), b3 + hstepB, voffB);
            PG8_WAIT_V(6); PG8_BAR; PG8_MMA(1, 1, At, B1); PG8_BAR;
        }
        E(acc, cur, wr, wc, fr, fq);
        if (!has_next) break;
#pragma unroll
        for (int a = 0; a < 2; ++a)
#pragma unroll
            for (int b = 0; b < 2; ++b)
#pragma unroll
                for (int m = 0; m < 4; ++m)
#pragma unroll
                    for (int n = 0; n < 2; ++n) acc[a][b][m][n] = (f32x4){0.f, 0.f, 0.f, 0.f};
        cur = nxt; cA = nA; cB = nB; ++ui;
    }
    PG8_WAIT_V(0);
    if (wr == 0) PG8_BAR;
    PG8_BAR;
#undef PG8_KA
#undef PG8_KB
#undef PG8_SA
#undef PG8_SB
#undef PG8_STAGE
#undef PG8_LDA
#undef PG8_LDB
#undef PG8_MMA
#undef PG8_WAIT_V
#undef PG8_WAIT_L
#undef PG8_BAR
#undef PG8_SCHED
}

struct EpiCols {
    static constexpr bool PERM = true;
    bf16_t* O; int ldc;
    DI void operator()(const f32x4 (&acc)[2][2][4][2], const Unit& u, int wr, int wc, int fr, int fq) const {
        const int row0 = u.pm * BM + wr * 64 + fr, col0 = u.pn * BM + wc * 32 + 8 * fq;
#pragma unroll
        for (int ai = 0; ai < 2; ++ai)
#pragma unroll
            for (int m = 0; m < 4; ++m) { bf16_t* rowp = O + (size_t)(row0 + ai * HALF + m * 16) * ldc + col0;
#pragma unroll
                for (int bj = 0; bj < 2; ++bj) { const f32x4 v0 = acc[ai][bj][m][0], v1 = acc[ai][bj][m][1];
                    u32x4 w; w.x = cvt_pk_bf16(v0[0], v0[1]); w.y = cvt_pk_bf16(v0[2], v0[3]); w.z = cvt_pk_bf16(v1[0], v1[1]); w.w = cvt_pk_bf16(v1[2], v1[3]);
                    *(u32x4*)(rowp + bj * HALF) = w; } }
    }
};
struct EpiPart {
    static constexpr bool PERM = false;
    float* P;
    DI void operator()(const f32x4 (&acc)[2][2][4][2], const Unit& u, int wr, int wc, int fr, int fq) const {
        float* base = P + ((size_t)(u.pk * 8 + u.pz) * 512 + u.pm * BM) * 256;
        const int row0 = wr * 64 + fr, col0 = wc * 32 + 4 * fq;
#pragma unroll
        for (int ai = 0; ai < 2; ++ai)
#pragma unroll
            for (int m = 0; m < 4; ++m) { float* rowp = base + (size_t)(row0 + ai * HALF + m * 16) * 256 + col0;
#pragma unroll
                for (int bj = 0; bj < 2; ++bj)
#pragma unroll
                    for (int n = 0; n < 2; ++n) *(f32x4*)(rowp + bj * HALF + n * 16) = acc[ai][bj][m][n]; }
    }
};
struct EpiGateTmp {
    static constexpr bool PERM = true;
    float* O; const bf16_t* gate;
    DI void operator()(const f32x4 (&acc)[2][2][4][2], const Unit& u, int wr, int wc, int fr, int fq) const {
        const int row0 = u.pm * BM + wr * 64 + fr, col0 = u.pn * BM + wc * 32 + 8 * fq;
#pragma unroll
        for (int ai = 0; ai < 2; ++ai)
#pragma unroll
            for (int m = 0; m < 4; ++m) { const int row = row0 + ai * HALF + m * 16;
#pragma unroll
                for (int bj = 0; bj < 2; ++bj) { const u32x4 gw = *(const u32x4*)(gate + (size_t)row * NP + col0 + bj * HALF);
                    const f32x4 v0 = acc[ai][bj][m][0], v1 = acc[ai][bj][m][1]; f32x4 o0, o1;
                    o0[0] = v0[0] * sigmoidf_(lo_bf(gw.x)); o0[1] = v0[1] * sigmoidf_(hi_bf(gw.x)); o0[2] = v0[2] * sigmoidf_(lo_bf(gw.y)); o0[3] = v0[3] * sigmoidf_(hi_bf(gw.y));
                    o1[0] = v1[0] * sigmoidf_(lo_bf(gw.z)); o1[1] = v1[1] * sigmoidf_(hi_bf(gw.z)); o1[2] = v1[2] * sigmoidf_(lo_bf(gw.w)); o1[3] = v1[3] * sigmoidf_(hi_bf(gw.w));
                    float* op = O + (size_t)row * D + col0 + bj * HALF; *(f32x4*)op = o0; *(f32x4*)(op + 4) = o1; }
                asm volatile("" ::: "memory"); }
    }
};
struct EpiGateAdd {
    static constexpr bool PERM = true;
    bf16_t* Y; const float* tmp; const bf16_t* gate;
    DI void operator()(const f32x4 (&acc)[2][2][4][2], const Unit& u, int wr, int wc, int fr, int fq) const {
        const int row0 = u.pm * BM + wr * 64 + fr, col0 = u.pn * BM + wc * 32 + 8 * fq;
#pragma unroll
        for (int ai = 0; ai < 2; ++ai)
#pragma unroll
            for (int m = 0; m < 4; ++m) { const int row = row0 + ai * HALF + m * 16;
#pragma unroll
                for (int bj = 0; bj < 2; ++bj) { const u32x4 gw = *(const u32x4*)(gate + (size_t)row * NP + col0 + bj * HALF);
                    const float* tp = tmp + (size_t)row * D + col0 + bj * HALF; const f32x4 t0 = *(const f32x4*)tp, t1 = *(const f32x4*)(tp + 4);
                    const f32x4 v0 = acc[ai][bj][m][0], v1 = acc[ai][bj][m][1]; f32x4 o0, o1;
                    o0[0] = t0[0] + v0[0] * sigmoidf_(lo_bf(gw.x)); o0[1] = t0[1] + v0[1] * sigmoidf_(hi_bf(gw.x)); o0[2] = t0[2] + v0[2] * sigmoidf_(lo_bf(gw.y)); o0[3] = t0[3] + v0[3] * sigmoidf_(hi_bf(gw.y));
                    o1[0] = t1[0] + v1[0] * sigmoidf_(lo_bf(gw.z)); o1[1] = t1[1] + v1[1] * sigmoidf_(hi_bf(gw.z)); o1[2] = t1[2] + v1[2] * sigmoidf_(lo_bf(gw.w)); o1[3] = t1[3] + v1[3] * sigmoidf_(hi_bf(gw.w));
                    u32x4 w; w.x = cvt_pk_bf16(o0[0], o0[1]); w.y = cvt_pk_bf16(o0[2], o0[3]); w.z = cvt_pk_bf16(o1[0], o1[1]); w.w = cvt_pk_bf16(o1[2], o1[3]);
                    *(u32x4*)(Y + (size_t)row * D + col0 + bj * HALF) = w; }
                asm volatile("" ::: "memory"); }
    }
};
struct EpiResid {
    static constexpr bool PERM = true;
    const float* xi; float* xo;
    DI void operator()(const f32x4 (&acc)[2][2][4][2], const Unit& u, int wr, int wc, int fr, int fq) const {
        const int row0 = u.pm * BM + wr * 64 + fr, col0 = u.pn * BM + wc * 32 + 8 * fq;
#pragma unroll
        for (int ai = 0; ai < 2; ++ai)
#pragma unroll
            for (int m = 0; m < 4; ++m) { const size_t off = (size_t)(row0 + ai * HALF + m * 16) * D + col0;
#pragma unroll
                for (int bj = 0; bj < 2; ++bj) { const f32x4 t0 = *(const f32x4*)(xi + off + bj * HALF), t1 = *(const f32x4*)(xi + off + bj * HALF + 4);
                    *(f32x4*)(xo + off + bj * HALF) = t0 + acc[ai][bj][m][0]; *(f32x4*)(xo + off + bj * HALF + 4) = t1 + acc[ai][bj][m][1]; }
                asm volatile("" ::: "memory"); }
    }
};
}

#define XB_TMO      128
#define XB_XCNT(j)  (256  + 64 * (j))
#define XB_XSUB(j)  (1280 + 64 * (j))
#define XB_XGEN(j)  (2304 + 64 * (j))
#define XB_TOP      3328
#define XB_TOPGEN   3392
#define XCD_BAR_WORDS 3456
#define XB_SPIN_CAP (1u << 18)
__device__ __forceinline__ unsigned xb_ld(unsigned* p)              { return __hip_atomic_load(p, __ATOMIC_RELAXED, __HIP_MEMORY_SCOPE_AGENT); }
__device__ __forceinline__ unsigned xb_add(unsigned* p, unsigned v) { return __hip_atomic_fetch_add(p, v, __ATOMIC_RELAXED, __HIP_MEMORY_SCOPE_AGENT); }
__device__ __forceinline__ unsigned xb_xcc_id() { return (unsigned)__builtin_amdgcn_s_getreg((3 << 11) | 20) & 0xFu; }
#define XB_SPIN(cond, bar) do { unsigned _sp = 0; while (cond) { __builtin_amdgcn_s_sleep(1); \
    if ((++_sp & 255u) == 0u) { if (xb_ld(&(bar)[XB_TMO])) break; if (_sp > XB_SPIN_CAP) { atomicAdd(&(bar)[XB_TMO], 1u); break; } } } } while (0)
struct XcdBarrier { unsigned* bar; unsigned x; volatile LAS unsigned* st; };
__device__ __forceinline__ XcdBarrier xcd_barrier_post(unsigned* bar, volatile LAS unsigned* st) {
    XcdBarrier b; b.bar = bar; b.x = xb_xcc_id(); b.st = st;
    if (threadIdx.x == 0) (void)xb_add(&bar[XB_XCNT(b.x)], 1u);
    return b;
}
__device__ __forceinline__ void xcd_barrier_complete(unsigned* bar, unsigned x, unsigned& nloc, unsigned& nx) {
    const unsigned G = gridDim.x * gridDim.y * gridDim.z;
    unsigned sum, cnt, mine, sp = 0u;
    for (;;) {
        sum = 0u; cnt = 0u; mine = 0u;
#pragma unroll
        for (unsigned j = 0; j < 16; ++j) { const unsigned c = xb_ld(&bar[XB_XCNT(j)]); sum += c; cnt += (c > 0u) ? 1u : 0u; mine = (j == x) ? c : mine; }
        if (sum == G) break;
        __builtin_amdgcn_s_sleep(1);
        if ((++sp & 255u) == 0u) { if (xb_ld(&bar[XB_TMO])) break; if (sp > XB_SPIN_CAP) { atomicAdd(&bar[XB_TMO], 1u); break; } }
    }
    nloc = mine > 0u ? mine : 1u; nx = cnt > 0u ? cnt : 1u;
}
__device__ __forceinline__ void xcd_barrier(const XcdBarrier& b) {
    asm volatile("s_waitcnt vmcnt(0)" ::: "memory");
    __syncthreads();
    if (threadIdx.x == 0) {
        unsigned* bar = b.bar;
        __builtin_amdgcn_s_waitcnt(0);
        unsigned nloc = b.st[0], nx = b.st[1];
        if (nloc == 0u) { xcd_barrier_complete(bar, b.x, nloc, nx); b.st[0] = nloc; b.st[1] = nx; }
        const unsigned old = xb_add(&bar[XB_XSUB(b.x)], 1u);
        const unsigned gen = old / nloc;
        if (old + 1u == (gen + 1u) * nloc) {
            __builtin_amdgcn_fence(__ATOMIC_RELEASE, "agent");
            asm volatile("s_waitcnt vmcnt(0)" ::: "memory");
            const unsigned og = xb_add(&bar[XB_TOP], 1u);
            const unsigned tg = og / nx;
            if (og + 1u == (tg + 1u) * nx) xb_add(&bar[XB_TOPGEN], 1u);
            else XB_SPIN(xb_ld(&bar[XB_TOPGEN]) == tg, bar);
            __builtin_amdgcn_fence(__ATOMIC_ACQUIRE, "agent");
            xb_add(&bar[XB_XGEN(b.x)], 1u);
            asm volatile("s_waitcnt vmcnt(0)" ::: "memory");
        } else {
            XB_SPIN(xb_ld(&bar[XB_XGEN(b.x)]) == gen, bar);
            __builtin_amdgcn_fence(__ATOMIC_ACQUIRE, "agent");
            asm volatile("s_waitcnt vmcnt(0)" ::: "memory");
        }
    }
    __syncthreads();
}

struct Args {
    const float *x, *norm_w, *w_in, *cmp_pe, *cmp_w1, *cmp_b1, *cmp_w2, *cmp_b2, *alpha_w, *alpha_b, *gla_norm_w, *p_a, *p_b, *w_out, *final_w;
    float* out; unsigned char* ws; int ph_lo, ph_hi;
};
typedef const __attribute__((address_space(4))) Args* KArgsP;
DI Args load_args(KArgsP p) { Args a; a.x = p->x; a.norm_w = p->norm_w; a.w_in = p->w_in; a.cmp_pe = p->cmp_pe; a.cmp_w1 = p->cmp_w1; a.cmp_b1 = p->cmp_b1; a.cmp_w2 = p->cmp_w2; a.cmp_b2 = p->cmp_b2;
    a.alpha_w = p->alpha_w; a.alpha_b = p->alpha_b; a.gla_norm_w = p->gla_norm_w; a.p_a = p->p_a; a.p_b = p->p_b; a.w_out = p->w_out; a.final_w = p->final_w; a.out = p->out; a.ws = p->ws; a.ph_lo = 0; a.ph_hi = 0; return a; }
struct Frame {
    LAS unsigned char* lds; int tid, lane, wave, G, bid, gw, NGW;
};

template <bool MAP>
DI void transpose_item(const float* W, int K, int N, bf16_t* WT, LAS float* scr, int item, int lane) {
    const int nblk = N / 32, kb = item / nblk, nb = item % nblk, k0 = 64 * kb, n0 = 32 * nb;
#pragma unroll 8
    for (int i = 0; i < 32; ++i) { const int kk = 2 * i + (lane >> 5); scr[kk * 33 + (lane & 31)] = W[(size_t)(k0 + kk) * N + n0 + (lane & 31)]; }
    LDS_WAIT(); asm volatile("" ::: "memory");
    const int c = lane & 7;
#pragma unroll
    for (int j = 0; j < 4; ++j) { const int n = (lane >> 3) + 8 * j; const LAS float* s = scr + (8 * c) * 33 + n;
        u32x4 o; o.x = pk2(s[0 * 33], s[1 * 33]); o.y = pk2(s[2 * 33], s[3 * 33]); o.z = pk2(s[4 * 33], s[5 * 33]); o.w = pk2(s[6 * 33], s[7 * 33]);
        const int drow = MAP ? map_col(n0 + n) : (n0 + n);
        *(u32x4*)(WT + (size_t)drow * K + k0 + 8 * c) = o; }
    LDS_WAIT(); asm volatile("" ::: "memory");
}
DI void p_prologue(const Frame& F, const Args& a) {
    LAS float* scr = (LAS float*)(F.lds + F.wave * 8704);
    constexpr int I_IN = (D / 64) * (NIN / 32), I_SQ = (D / 64) * (D / 32), I_W1 = (4096 / 64) * (256 / 32), I_W2 = (256 / 64) * (128 / 32);
    constexpr int PER_L = I_IN + 3 * I_SQ + 2 * I_W1 + 2 * I_W2;
    unsigned char* ws = a.ws;
    for (int it = F.gw; it < DEPTH * PER_L; it += F.NGW) {
        const int l = it / PER_L; int r = it % PER_L;
        if (r < I_IN) { transpose_item<true>(a.w_in + (size_t)l * D * NIN, D, NIN, (bf16_t*)(ws + WS_WIN) + (size_t)l * NP * D, scr, r, F.lane); continue; } r -= I_IN;
        if (r < I_SQ) { transpose_item<false>(a.p_a + (size_t)l * D * D, D, D, (bf16_t*)(ws + WS_WPA) + (size_t)l * D * D, scr, r, F.lane); continue; } r -= I_SQ;
        if (r < I_SQ) { transpose_item<false>(a.p_b + (size_t)l * D * D, D, D, (bf16_t*)(ws + WS_WPB) + (size_t)l * D * D, scr, r, F.lane); continue; } r -= I_SQ;
        if (r < I_SQ) { transpose_item<false>(a.w_out + (size_t)l * D * D, D, D, (bf16_t*)(ws + WS_WOUT) + (size_t)l * D * D, scr, r, F.lane); continue; } r -= I_SQ;
        if (r < 2 * I_W1) { const int kv = r / I_W1; transpose_item<false>(a.cmp_w1 + (size_t)(l * 2 + kv) * 4096 * 256, 4096, 256, (bf16_t*)(ws + WS_W1T) + (size_t)(l * 2 + kv) * 256 * 4096, scr, r % I_W1, F.lane); continue; } r -= 2 * I_W1;
        { const int kv = r / I_W2; transpose_item<false>(a.cmp_w2 + (size_t)(l * 2 + kv) * 256 * 128, 256, 128, (bf16_t*)(ws + WS_W2T) + (size_t)(l * 2 + kv) * 128 * 256, scr, r % I_W2, F.lane); }
    }
    __syncthreads();
    LAS float* red = (LAS float*)F.lds;
    for (int job = F.bid; job < DEPTH * 2; job += F.G) {
        const float* w1 = a.cmp_w1 + (size_t)job * 4096 * 256; const float* pe = a.cmp_pe + (size_t)job * 4096;
        f32x4 s = {0.f, 0.f, 0.f, 0.f};
        for (int k = F.wave * 512; k < F.wave * 512 + 512; ++k) { const f32x4 w = *(const f32x4*)(w1 + (size_t)k * 256 + 4 * F.lane); s += w * pe[k]; }
        *(LAS f32x4*)(red + F.wave * 256 + 4 * F.lane) = s;
        __syncthreads();
        if (F.tid < 256) { float t = a.cmp_b1[job * 256 + F.tid];
#pragma unroll
            for (int w = 0; w < 8; ++w) t += red[w * 256 + F.tid];
            ((float*)(ws + WS_B1P))[job * 256 + F.tid] = t; }
        __syncthreads();
    }
}

template <bool OUT_F32>
DI void p_rmsnorm(const Frame& F, const float* x, const float* w, void* out) {
    f32x4 wv[8];
#pragma unroll
    for (int j = 0; j < 8; ++j) wv[j] = *(const f32x4*)(w + 4 * F.lane + 256 * j);
    for (int row = F.gw; row < T; row += F.NGW) {
        const float* xr = x + (size_t)row * D + 4 * F.lane;
        f32x4 v[8]; float s = 0.f;
#pragma unroll
        for (int j = 0; j < 8; ++j) { v[j] = *(const f32x4*)(xr + 256 * j); s += (v[j].x * v[j].x + v[j].y * v[j].y) + (v[j].z * v[j].z + v[j].w * v[j].w); }
        const float rs = rsqrtf(wave_sum(s, F.lane) * (1.f / D) + NORM_EPS);
        if (OUT_F32) { float* o = (float*)out + (size_t)row * D + 4 * F.lane;
#pragma unroll
            for (int j = 0; j < 8; ++j) *(f32x4*)(o + 256 * j) = v[j] * rs * wv[j];
        } else { bf16_t* o = (bf16_t*)out + (size_t)row * D + 4 * F.lane;
#pragma unroll
            for (int j = 0; j < 8; ++j) { const f32x4 y = v[j] * rs * wv[j]; u32x2 p; p.x = pk2(y.x, y.y); p.y = pk2(y.z, y.w); *(u32x2*)(o + 256 * j) = p; } }
    }
}

DI void transpose64x64(const bf16_t* src, size_t pitch, bf16_t* dst, LAS unsigned char* scr, int lane) {
#pragma unroll
    for (int i = 0; i < 8; ++i) { const int id = i * 64 + lane, row = id >> 3, ch = id & 7;
        *(LAS u32x4*)(scr + row * 144 + ch * 16) = *(const u32x4*)(src + (size_t)row * pitch + ch * 8); }
    LDS_WAIT(); asm volatile("" ::: "memory");
#pragma unroll
    for (int i = 0; i < 8; ++i) { const int id = i * 64 + lane, col = id & 63, tg = id >> 6;
        const LAS unsigned short* s = (const LAS unsigned short*)(scr + (8 * tg) * 144 + col * 2);
        u32x4 o; o.x = (unsigned)s[0] | ((unsigned)s[72] << 16); o.y = (unsigned)s[144] | ((unsigned)s[216] << 16);
        o.z = (unsigned)s[288] | ((unsigned)s[360] << 16); o.w = (unsigned)s[432] | ((unsigned)s[504] << 16);
        *(u32x4*)(dst + (size_t)col * 64 + 8 * tg) = o; }
    LDS_WAIT(); asm volatile("" ::: "memory");
}

DI void gla_g1_unit(const Frame& F, const Args& a, int layer, int n, int h) {
    const bf16_t* cols = (const bf16_t*)(a.ws + WS_COLS);
    LAS float* alr = (LAS float*)(F.lds); LAS float* part = (LAS float*)(F.lds + 4096);
    LAS unsigned char* qd = F.lds + 8192; LAS unsigned char* ki = F.lds + 8192 + 33792;
    __syncthreads();
    if (F.tid < 256) { const int t = F.tid >> 2, k4 = (F.tid & 3) * 4; const u32x2 w = *(const u32x2*)(cols + (size_t)(64 * n + t) * NP + C_ALR + k4);
        alr[t * 16 + k4 + 0] = lo_bf(w.x); alr[t * 16 + k4 + 1] = hi_bf(w.x); alr[t * 16 + k4 + 2] = lo_bf(w.y); alr[t * 16 + k4 + 3] = hi_bf(w.y); }
    __syncthreads();
    const int d = F.tid & 255, half = F.tid >> 8, col = h * 256 + d;
    float w[16];
#pragma unroll
    for (int k = 0; k < 16; ++k) w[k] = a.alpha_w[(size_t)(layer * 16 + k) * 1024 + col];
    const float b = a.alpha_b[layer * 1024 + col];
    float cum[32]; float run = 0.f;
#pragma unroll
    for (int i = 0; i < 32; ++i) { const int t = half * 32 + i; float ga = b;
#pragma unroll
        for (int k4 = 0; k4 < 4; ++k4) { const f32x4 av = *(const LAS f32x4*)(alr + t * 16 + 4 * k4); ga += av.x * w[4 * k4] + av.y * w[4 * k4 + 1] + av.z * w[4 * k4 + 2] + av.w * w[4 * k4 + 3]; }
        const float ls = fminf(ga, 0.f) - log1pf(__expf(-fabsf(ga)));
        run += ls * 0.0625f; cum[i] = run; }
    part[half * 256 + d] = run;
    __syncthreads();
    const float p0 = part[d], last = p0 + part[256 + d];
    if (half) {
#pragma unroll
        for (int i = 0; i < 32; ++i) cum[i] += p0; }
    bf16_t* qdec = (bf16_t*)(a.ws + WS_QDEC); bf16_t* kst = (bf16_t*)(a.ws + WS_KST);
    unsigned ksw[16];
#pragma unroll
    for (int i = 0; i < 32; ++i) { const int t = half * 32 + i; const size_t row = (size_t)(64 * n + t);
        const float qv = bf2f(cols[row * NP + C_QB + col]), kv = bf2f(cols[row * NP + C_KB + col]);
        const unsigned qb = f2bf(qv * 0.0625f * __expf(cum[i])), kib = f2bf(kv * __expf(-cum[i])), ksb = f2bf(kv * __expf(last - cum[i]));
        *(LAS unsigned short*)(qd + t * 528 + d * 2) = (unsigned short)qb; *(LAS unsigned short*)(ki + t * 528 + d * 2) = (unsigned short)kib;
        qdec[row * 1024 + col] = (bf16_t)qb;
        if (i & 1) ksw[i >> 1] |= ksb << 16; else ksw[i >> 1] = ksb; }
    { bf16_t* kp = kst + ((size_t)((n * 4 + h) * 256 + d)) * 64 + half * 32;
#pragma unroll
        for (int j = 0; j < 4; ++j) { u32x4 o; o.x = ksw[4 * j]; o.y = ksw[4 * j + 1]; o.z = ksw[4 * j + 2]; o.w = ksw[4 * j + 3]; *(u32x4*)(kp + 8 * j) = o; } }
    if (half == 0) ((float*)(a.ws + WS_DEC))[(n * 4 + h) * 256 + d] = __expf(last);
    __syncthreads();
    bf16_t* att = (bf16_t*)(a.ws + WS_ATT) + (size_t)(n * 4 + h) * 4096;
    const int fr = F.lane & 15, fq = F.lane >> 4, ms = F.wave >> 1;
#pragma unroll
    for (int z = 0; z < 2; ++z) { const int nt = 2 * (F.wave & 1) + z; f32x4 acc = {0.f, 0.f, 0.f, 0.f};
#pragma unroll
        for (int ks = 0; ks < 8; ++ks) { const bf16x8 A = *(const LAS bf16x8*)(ki + (16 * ms + fr) * 528 + (32 * ks + 8 * fq) * 2);
            const bf16x8 B = *(const LAS bf16x8*)(qd + (16 * nt + fr) * 528 + (32 * ks + 8 * fq) * 2); acc = MFMA16(A, B, acc); }
        const int t = 16 * nt + fr, s0 = 16 * ms + 4 * fq;
        u32x2 o; o.x = pk2(s0 + 0 <= t ? acc[0] : 0.f, s0 + 1 <= t ? acc[1] : 0.f); o.y = pk2(s0 + 2 <= t ? acc[2] : 0.f, s0 + 3 <= t ? acc[3] : 0.f);
        *(u32x2*)(att + t * 64 + s0) = o; }
}

DI void p_thin(const Frame& F, const Args& a, int layer) {
    for (int u = F.bid; u < NCH * 4; u += F.G) gla_g1_unit(F, a, layer, u >> 2, u & 3);
    __syncthreads();
    const bf16_t* cols = (const bf16_t*)(a.ws + WS_COLS);
    LAS unsigned char* scr = F.lds + F.wave * 9216;
    for (int it = F.gw; it < 6144; it += F.NGW) {
        if (it < 4096) { const int n = it >> 5, cg = it & 31;
            transpose64x64(cols + (size_t)(64 * n) * NP + C_VB + 64 * cg, NP, (bf16_t*)(a.ws + WS_VT) + ((size_t)n * 2048 + 64 * cg) * 64, scr, F.lane); }
        else { const int r = (it - 4096) & 1023, win = (it - 4096) >> 10, j = r >> 3, g = (r >> 1) & 3, hf = r & 1;
            transpose64x64(cols + (size_t)(64 * j) * NP + (win ? C_VWIN : C_VSEL) + 128 * g + 64 * hf, NP,
                           (bf16_t*)(a.ws + (win ? WS_VWINT : WS_VSELT)) + ((size_t)(g * 128 + j) * 128 + 64 * hf) * 64, scr, F.lane); }
    }
}

DI float gelu_tanh(float x) { const float u = 0.7978845608028654f * (x + 0.044715f * x * x * x); const float t = __expf(2.f * u); return 0.5f * x * (2.f - 2.f / (t + 1.f)); }
DI void mlp2_unit(const Frame& F, const Args& a, int layer, int pz, int rt) {
    const float* cpart = (const float*)(a.ws + WS_CPART);
    LAS unsigned char* hid = F.lds;
    const int kv = pz >> 2, g = pz & 3;
    __syncthreads();
    { const int r = F.tid >> 3, c0 = (F.tid & 7) * 32; f32x4 s[8];
        const float* bp = (const float*)(a.ws + WS_B1P) + (layer * 2 + kv) * 256 + c0;
#pragma unroll
        for (int j = 0; j < 8; ++j) s[j] = *(const f32x4*)(bp + 4 * j);
        for (int pk = 0; pk < 8; ++pk) { const float* p = cpart + ((size_t)(pk * 8 + pz) * 512 + rt * 64 + r) * 256 + c0;
#pragma unroll
            for (int j = 0; j < 8; ++j) s[j] += *(const f32x4*)(p + 4 * j); }
#pragma unroll
        for (int j = 0; j < 4; ++j) { u32x4 o; const f32x4 x0 = s[2 * j], x1 = s[2 * j + 1];
            o.x = pk2(gelu_tanh(x0.x), gelu_tanh(x0.y)); o.y = pk2(gelu_tanh(x0.z), gelu_tanh(x0.w)); o.z = pk2(gelu_tanh(x1.x), gelu_tanh(x1.y)); o.w = pk2(gelu_tanh(x1.z), gelu_tanh(x1.w));
            *(LAS u32x4*)(hid + r * 528 + (c0 + 8 * j) * 2) = o; } }
    __syncthreads();
    const bf16_t* w2t = (const bf16_t*)(a.ws + WS_W2T) + (size_t)(layer * 2 + kv) * 128 * 256;
    const int fr = F.lane & 15, fq = F.lane >> 4, dt = F.wave;
    bf16x8 wf[8];
#pragma unroll
    for (int ks = 0; ks < 8; ++ks) wf[ks] = *(const bf16x8*)(w2t + (16 * dt + fr) * 256 + 32 * ks + 8 * fq);
    const float* b2 = a.cmp_b2 + (layer * 2 + kv) * 128;
#pragma unroll
    for (int nt = 0; nt < 4; ++nt) { f32x4 acc = {0.f, 0.f, 0.f, 0.f};
#pragma unroll
        for (int ks = 0; ks < 8; ++ks) { const bf16x8 hf = *(const LAS bf16x8*)(hid + (16 * nt + fr) * 528 + (32 * ks + 8 * fq) * 2);
            acc = kv ? MFMA16(hf, wf[ks], acc) : MFMA16(wf[ks], hf, acc); }
        if (!kv) { const int n = 64 * rt + 16 * nt + fr, dim = 16 * dt + 4 * fq; const f32x4 bb = *(const f32x4*)(b2 + dim); u32x2 o;
            if (n == 511) { o.x = 0u; o.y = 0u; } else { o.x = pk2(acc[0] + bb.x, acc[1] + bb.y); o.y = pk2(acc[2] + bb.z, acc[3] + bb.w); }
            *(u32x2*)((bf16_t*)(a.ws + WS_KC) + ((size_t)g * 512 + n) * 128 + dim) = o; }
        else { const int n0 = 64 * rt + 16 * nt + 4 * fq, dim = 16 * dt + fr; const float bb = b2[dim]; u32x2 o;
            o.x = pk2(acc[0] + bb, acc[1] + bb); o.y = pk2(acc[2] + bb, (n0 + 3 == 511) ? 0.f : acc[3] + bb);
            *(u32x2*)((bf16_t*)(a.ws + WS_VCT) + ((size_t)g * 128 + dim) * 512 + n0) = o; } }
}

constexpr int KSTR = 272, VSTR = 144, KTILE = 64 * KSTR, VTILE = 128 * VSTR, ABUF = KTILE + VTILE;
struct TileRegs { u32x4 k[2], v[2]; };
DI void tile_load_k(TileRegs& r, const bf16_t* kbase, size_t kpitch, int tid) {
#pragma unroll
    for (int i = 0; i < 2; ++i) { const int id = tid + 512 * i; r.k[i] = *(const u32x4*)(kbase + (size_t)(id >> 4) * kpitch + (id & 15) * 8); }
}
DI void tile_load_v(TileRegs& r, const bf16_t* vbase, size_t vpitch, int tid) {
#pragma unroll
    for (int i = 0; i < 2; ++i) { const int id = tid + 512 * i; r.v[i] = *(const u32x4*)(vbase + (size_t)(id >> 3) * vpitch + (id & 7) * 8); }
}
DI void tile_store_k(const TileRegs& r, LAS unsigned char* kb, int tid) {
#pragma unroll
    for (int i = 0; i < 2; ++i) { const int id = tid + 512 * i; *(LAS u32x4*)(kb + (id >> 4) * KSTR + (id & 15) * 16) = r.k[i]; }
}
DI void tile_store_v(const TileRegs& r, LAS unsigned char* vb, int tid) {
#pragma unroll
    for (int i = 0; i < 2; ++i) { const int id = tid + 512 * i; *(LAS u32x4*)(vb + (id >> 3) * VSTR + (id & 7) * 16) = r.v[i]; }
}
DI void qk_tile(f32x4 (&s)[4][2], const LAS unsigned char* kb, const bf16x8 (&qf)[2][4], int fr, int fq, bool act0, bool act1) {
#pragma unroll
    for (int kt = 0; kt < 4; ++kt) { bf16x8 kf[4];
#pragma unroll
        for (int ks = 0; ks < 4; ++ks) kf[ks] = *(const LAS bf16x8*)(kb + (16 * kt + fr) * KSTR + (32 * ks + 8 * fq) * 2);
        s[kt][0] = (f32x4){0.f, 0.f, 0.f, 0.f}; s[kt][1] = (f32x4){0.f, 0.f, 0.f, 0.f};
        if (act0) {
#pragma unroll
            for (int ks = 0; ks < 4; ++ks) s[kt][0] = MFMA16(kf[ks], qf[0][ks], s[kt][0]); }
        if (act1) {
#pragma unroll
            for (int ks = 0; ks < 4; ++ks) s[kt][1] = MFMA16(kf[ks], qf[1][ks], s[kt][1]); }
    }
}
DI void pv_tile(f32x4 (&O)[8][2], const LAS unsigned char* vb, const bf16x8 (&pf)[2][2], int fr, int fq, bool act0, bool act1) {
#pragma unroll
    for (int dt = 0; dt < 8; ++dt)
#pragma unroll
        for (int s2 = 0; s2 < 2; ++s2) {
            const s16x4 lo = *(const LAS s16x4*)(vb + (16 * dt + fr) * VSTR + (32 * s2 + 4 * fq) * 2), hi = *(const LAS s16x4*)(vb + (16 * dt + fr) * VSTR + (32 * s2 + 16 + 4 * fq) * 2);
            const bf16x8 vf = {lo[0], lo[1], lo[2], lo[3], hi[0], hi[1], hi[2], hi[3]};
            if (act0) O[dt][0] = MFMA16(vf, pf[s2][0], O[dt][0]);
            if (act1) O[dt][1] = MFMA16(vf, pf[s2][1], O[dt][1]);
        }
}
DI bf16x8 pack_p(const f32x4& a, const f32x4& b) { u32x4 w; w.x = cvt_pk_bf16(a[0], a[1]); w.y = cvt_pk_bf16(a[2], a[3]); w.z = cvt_pk_bf16(b[0], b[1]); w.w = cvt_pk_bf16(b[2], b[3]); return __builtin_bit_cast(bf16x8, w); }
DI float quad_max(float v, int lane) { v = fmaxf(v, shx(v, 16, lane)); return fmaxf(v, shx(v, 32, lane)); }
DI float quad_sum(float v, int lane) { v += shx(v, 16, lane); return v + shx(v, 32, lane); }
constexpr float NEG_INF = -__builtin_inff();

template <int MODE  >
DI void fa_chunk(const Frame& F, const Args& a, int c, int g) {
    const bf16_t* cols = (const bf16_t*)(a.ws + WS_COLS);
    const int fr = F.lane & 15, fq = F.lane >> 4, w = F.wave, tid = F.tid;
    LAS unsigned char* lds = F.lds;
    LAS int* list = (LAS int*)(lds + 2 * ABUF); LAS unsigned* maskw = (LAS unsigned*)(lds + 2 * ABUF + 1024);
    const bf16_t* kcol = cols + (MODE ? C_KWIN : C_KSEL) + 128 * g;
    const bf16_t* vT = (const bf16_t*)(a.ws + (MODE ? WS_VWINT : WS_VSELT)) + (size_t)g * 128 * 8192;
    __syncthreads();
    int ntile, j0 = 0;
    if (MODE == 0) {
        const unsigned* selm = (const unsigned*)(a.ws + WS_SELM);
        if (tid < 256) maskw[tid] = selm[((size_t)(64 * c + (tid >> 2)) * 4 + g) * 4 + (tid & 3)];
        __syncthreads();
        if (w == 0) { int base = 0;
#pragma unroll
            for (int hf = 0; hf < 2; ++hf) { const int j = hf * 64 + F.lane; unsigned orv = 0u;
                for (int tk = 0; tk < 64; ++tk) orv |= maskw[tk * 4 + (j >> 5)];
                const bool act = ((orv >> (j & 31)) & 1u) && (j <= c); const unsigned long long bl = __ballot(act);
                if (act) list[base + __popcll(bl & ((1ull << F.lane) - 1ull))] = j; base += __popcll(bl); }
            if (F.lane == 0) list[129] = base; }
        __syncthreads();
        ntile = list[129];
    } else { j0 = c > 8 ? c - 8 : 0; ntile = c - j0 + 1; }
    int tokl[2]; tokl[0] = 8 * w + (fr >> 2); tokl[1] = tokl[0] + 4;
    const int head = 4 * g + (fr & 3);
    bf16x8 qf[2][4];
#pragma unroll
    for (int ct = 0; ct < 2; ++ct)
#pragma unroll
        for (int ks = 0; ks < 4; ++ks) qf[ct][ks] = *(const bf16x8*)(cols + (size_t)(64 * c + tokl[ct]) * NP + C_QA + head * 128 + 32 * ks + 8 * fq);
    f32x4 O[8][2]; float m[2] = {-1e30f, -1e30f}, l[2] = {0.f, 0.f};
#pragma unroll
    for (int dt = 0; dt < 8; ++dt) { O[dt][0] = (f32x4){0.f, 0.f, 0.f, 0.f}; O[dt][1] = (f32x4){0.f, 0.f, 0.f, 0.f}; }
    TileRegs tr;
    { const int j = MODE ? j0 : list[0]; tile_load_k(tr, kcol + (size_t)(64 * j) * NP, NP, tid); tile_load_v(tr, vT + (size_t)j * 8192, 64, tid);
      tile_store_k(tr, lds, tid); tile_store_v(tr, lds + KTILE, tid); }
    __syncthreads();
    for (int idx = 0; idx < ntile; ++idx) {
        const int j = MODE ? j0 + idx : list[idx];
        const bool more = idx + 1 < ntile;
        if (more) { const int jn = MODE ? j + 1 : list[idx + 1]; tile_load_k(tr, kcol + (size_t)(64 * jn) * NP, NP, tid); tile_load_v(tr, vT + (size_t)jn * 8192, 64, tid); }
        const LAS unsigned char* kb = lds + (idx & 1) * ABUF; const LAS unsigned char* vb = kb + KTILE;
        bool bit[2] = {true, true}, act[2] = {true, true};
        if (MODE == 0) {
#pragma unroll
            for (int ct = 0; ct < 2; ++ct) { bit[ct] = (maskw[tokl[ct] * 4 + (j >> 5)] >> (j & 31)) & 1u; act[ct] = __ballot(bit[ct]) != 0ull; } }
        if (act[0] || act[1]) {
            f32x4 s[4][2];
            qk_tile(s, kb, qf, fr, fq, act[0], act[1]);
            const bool diag = (j == c), left = (MODE == 1) && (j == c - 8);
            bf16x8 pf[2][2];
#pragma unroll
            for (int ct = 0; ct < 2; ++ct) {
                if (!act[ct]) { pf[0][ct] = (bf16x8){0, 0, 0, 0, 0, 0, 0, 0}; pf[1][ct] = pf[0][ct]; continue; }
                if (MODE == 0 || diag || left) {
                    const int thr_hi = !bit[ct] ? -1 : (diag ? tokl[ct] : 63), thr_lo = left ? tokl[ct] : -1;
#pragma unroll
                    for (int kt = 0; kt < 4; ++kt)
#pragma unroll
                        for (int r = 0; r < 4; ++r) { const int kl = 16 * kt + 4 * fq + r;
                            s[kt][ct][r] = (kl <= thr_hi && kl > thr_lo) ? s[kt][ct][r] : NEG_INF; } }
                float mx = NEG_INF;
#pragma unroll
                for (int kt = 0; kt < 4; ++kt) mx = fmaxf(mx, fmaxf(fmaxf(s[kt][ct][0], s[kt][ct][1]), fmaxf(s[kt][ct][2], s[kt][ct][3])));
                mx = quad_max(mx, F.lane);
                const float mn = fmaxf(m[ct], mx), alpha = __builtin_amdgcn_exp2f((m[ct] - mn) * ATT_C), mc = mn * ATT_C; m[ct] = mn;
                float rs = 0.f;
#pragma unroll
                for (int kt = 0; kt < 4; ++kt)
#pragma unroll
                    for (int r = 0; r < 4; ++r) { const float p = __builtin_amdgcn_exp2f(s[kt][ct][r] * ATT_C - mc); s[kt][ct][r] = p; rs += p; }
                rs = quad_sum(rs, F.lane);
                l[ct] = l[ct] * alpha + rs;
#pragma unroll
                for (int dt = 0; dt < 8; ++dt) O[dt][ct] *= alpha;
                pf[0][ct] = pack_p(s[0][ct], s[1][ct]); pf[1][ct] = pack_p(s[2][ct], s[3][ct]);
            }
            pv_tile(O, vb, pf, fr, fq, act[0], act[1]);
        }
        if (more) { LAS unsigned char* nb = lds + ((idx + 1) & 1) * ABUF; tile_store_k(tr, nb, tid); tile_store_v(tr, nb + KTILE, tid); }
        __syncthreads();
    }
    bf16_t* out = (bf16_t*)(a.ws + (MODE ? WS_OWIN : WS_OSEL));
#pragma unroll
    for (int ct = 0; ct < 2; ++ct) { const float inv = 1.f / l[ct]; bf16_t* op = out + (size_t)(64 * c + tokl[ct]) * D + head * 128 + 4 * fq;
#pragma unroll
        for (int dt = 0; dt < 8; ++dt) { u32x2 o; o.x = pk2(O[dt][ct][0] * inv, O[dt][ct][1] * inv); o.y = pk2(O[dt][ct][2] * inv, O[dt][ct][3] * inv); *(u32x2*)(op + 16 * dt) = o; } }
}

DI void ca_chunk(const Frame& F, const Args& a, int c, int g) {
    const bf16_t* cols = (const bf16_t*)(a.ws + WS_COLS);
    const int fr = F.lane & 15, fq = F.lane >> 4, w = F.wave, tid = F.tid;
    LAS unsigned char* lds = F.lds;
    LAS float* pslc = (LAS float*)(lds + ABUF); LAS float* p3 = (LAS float*)(lds + ABUF + 32768);
    const bf16_t* kc = (const bf16_t*)(a.ws + WS_KC) + (size_t)g * 512 * 128;
    const bf16_t* vct = (const bf16_t*)(a.ws + WS_VCT) + (size_t)g * 128 * 512;
    const int ntile = ((4 * c + 2) >> 6) + 1;
    int tokl[2]; tokl[0] = 8 * w + (fr >> 2); tokl[1] = tokl[0] + 4;
    const int head = 4 * g + (fr & 3);
    int nlim[2];
#pragma unroll
    for (int ct = 0; ct < 2; ++ct) { const int t = 64 * c + tokl[ct]; nlim[ct] = t >= 31 ? ((t - 31) >> 4) : -1; }
    bf16x8 qf[2][4];
#pragma unroll
    for (int ct = 0; ct < 2; ++ct)
#pragma unroll
        for (int ks = 0; ks < 4; ++ks) qf[ct][ks] = *(const bf16x8*)(cols + (size_t)(64 * c + tokl[ct]) * NP + C_QA + head * 128 + 32 * ks + 8 * fq);
    float m[2] = {-1e30f, -1e30f}, l[2] = {0.f, 0.f};
    TileRegs tr;
    for (int jt = 0; jt < ntile; ++jt) {
        __syncthreads();
        tile_load_k(tr, kc + (size_t)(64 * jt) * 128, 128, tid); tile_store_k(tr, lds, tid);
        __syncthreads();
        f32x4 s[4][2];
        qk_tile(s, lds, qf, fr, fq, true, true);
#pragma unroll
        for (int ct = 0; ct < 2; ++ct) {
            float mx = NEG_INF;
#pragma unroll
            for (int kt = 0; kt < 4; ++kt)
#pragma unroll
                for (int r = 0; r < 4; ++r) { const int n = 64 * jt + 16 * kt + 4 * fq + r; const float v = (n <= nlim[ct]) ? s[kt][ct][r] : NEG_INF; s[kt][ct][r] = v; mx = fmaxf(mx, v); }
            mx = quad_max(mx, F.lane);
            const float mn = fmaxf(m[ct], mx), alpha = __builtin_amdgcn_exp2f((m[ct] - mn) * ATT_C), mc = mn * ATT_C; m[ct] = mn;
            float rs = 0.f;
#pragma unroll
            for (int kt = 0; kt < 4; ++kt)
#pragma unroll
                for (int r = 0; r < 4; ++r) rs += __builtin_amdgcn_exp2f(s[kt][ct][r] * ATT_C - mc);
            l[ct] = l[ct] * alpha + quad_sum(rs, F.lane);
        }
    }
    f32x4 O[8][2];
#pragma unroll
    for (int dt = 0; dt < 8; ++dt) { O[dt][0] = (f32x4){0.f, 0.f, 0.f, 0.f}; O[dt][1] = (f32x4){0.f, 0.f, 0.f, 0.f}; }
    float mc[2], inv[2];
#pragma unroll
    for (int ct = 0; ct < 2; ++ct) { mc[ct] = m[ct] * ATT_C; inv[ct] = l[ct] > 0.f ? 1.f / l[ct] : 0.f; }
    for (int jt = 0; jt < ntile; ++jt) {
        __syncthreads();
        tile_load_k(tr, kc + (size_t)(64 * jt) * 128, 128, tid); tile_load_v(tr, vct + 64 * jt, 512, tid);
        tile_store_k(tr, lds, tid); tile_store_v(tr, lds + KTILE, tid);
        __syncthreads();
        f32x4 s[4][2];
        qk_tile(s, lds, qf, fr, fq, true, true);
        bf16x8 pf[2][2];
#pragma unroll
        for (int ct = 0; ct < 2; ++ct) {
#pragma unroll
            for (int kt = 0; kt < 4; ++kt) {
#pragma unroll
                for (int r = 0; r < 4; ++r) { const int n = 64 * jt + 16 * kt + 4 * fq + r;
                    s[kt][ct][r] = (n <= nlim[ct]) ? __builtin_amdgcn_exp2f(s[kt][ct][r] * ATT_C - mc[ct]) * inv[ct] : 0.f; }
                float h3 = s[kt][ct][3], hs = (s[kt][ct][0] + s[kt][ct][1]) + (s[kt][ct][2] + h3);
                hs += shx(hs, 1, F.lane); hs += shx(hs, 2, F.lane); h3 += shx(h3, 1, F.lane); h3 += shx(h3, 2, F.lane);
                if ((fr & 3) == 0) { const int jj = 16 * jt + 4 * kt + fq; pslc[tokl[ct] * 128 + jj] = hs; p3[tokl[ct] * 128 + jj] = h3; }
            }
            pf[0][ct] = pack_p(s[0][ct], s[1][ct]); pf[1][ct] = pack_p(s[2][ct], s[3][ct]);
        }
        pv_tile(O, lds + KTILE, pf, fr, fq, true, true);
    }
    bf16_t* out = (bf16_t*)(a.ws + WS_OCMP);
#pragma unroll
    for (int ct = 0; ct < 2; ++ct) { bf16_t* op = out + (size_t)(64 * c + tokl[ct]) * D + head * 128 + 4 * fq;
#pragma unroll
        for (int dt = 0; dt < 8; ++dt) { u32x2 o; o.x = pk2(O[dt][ct][0], O[dt][ct][1]); o.y = pk2(O[dt][ct][2], O[dt][ct][3]); *(u32x2*)(op + 16 * dt) = o; } }
    LDS_WAIT(); asm volatile("" ::: "memory");
    unsigned* selm = (unsigned*)(a.ws + WS_SELM);
    for (int tl = 0; tl < 8; ++tl) {
        const int tok = 8 * w + tl;
        unsigned mw0 = 0u, mw1 = 0u, mw2 = 0u, mw3 = 0u;
#define SETBIT(j) do { const int _j = (j); const unsigned _b = 1u << (_j & 31); const int _w = _j >> 5; mw0 |= (_w == 0) ? _b : 0u; mw1 |= (_w == 1) ? _b : 0u; mw2 |= (_w == 2) ? _b : 0u; mw3 |= (_w == 3) ? _b : 0u; } while (0)
        if (c <= 15) { for (int j = 0; j <= c; ++j) SETBIT(j); }
        else {
            SETBIT(0); SETBIT(c - 1); SETBIT(c);
            const int j0 = F.lane, j1 = F.lane + 64;
            float v0 = (j0 >= 1 && j0 <= c - 2) ? pslc[tok * 128 + j0] + p3[tok * 128 + j0 - 1] : NEG_INF;
            float v1 = (j1 <= c - 2) ? pslc[tok * 128 + j1] + p3[tok * 128 + j1 - 1] : NEG_INF;
            for (int round = 0; round < 13; ++round) {
                float bv; int bi; if (v0 >= v1) { bv = v0; bi = j0; } else { bv = v1; bi = j1; }
#pragma unroll
                for (int off = 32; off >= 1; off >>= 1) { const float ov = shx(bv, off, F.lane); const int oi = shxi(bi, off, F.lane);
                    if (ov > bv || (ov == bv && oi < bi)) { bv = ov; bi = oi; } }
                SETBIT(bi);
                if (bi == j0) v0 = NEG_INF; if (bi == j1) v1 = NEG_INF;
            }
        }
#undef SETBIT
        if (F.lane == 0) { u32x4 o; o.x = mw0; o.y = mw1; o.z = mw2; o.w = mw3; *(u32x4*)(selm + ((size_t)(64 * c + tok) * 4 + g) * 4) = o; }
    }
}

struct ScanRegs { bf16x8 q[4]; bf16x8 at; bf16x8 ks[2]; bf16x8 v[2]; f32x4 dc; };
DI void scan_load(ScanRegs& r, const Args& a, int n, int h, int sl, int kh, int w, int fr, int fq) {
    const bf16_t* qdec = (const bf16_t*)(a.ws + WS_QDEC); const bf16_t* kst = (const bf16_t*)(a.ws + WS_KST);
    const bf16_t* vt = (const bf16_t*)(a.ws + WS_VT); const bf16_t* att = (const bf16_t*)(a.ws + WS_ATT); const float* dec = (const float*)(a.ws + WS_DEC);
    if (w < 4) { const size_t row = (size_t)(64 * n + 16 * w + fr);
#pragma unroll
        for (int ks = 0; ks < 4; ++ks) r.q[ks] = *(const bf16x8*)(qdec + row * 1024 + h * 256 + kh * 128 + 32 * ks + 8 * fq);
        r.at = *(const bf16x8*)(att + ((size_t)(n * 4 + h) * 64 + 16 * w + fr) * 64 + 32 * kh + 8 * fq); }
#pragma unroll
    for (int ks = 0; ks < 2; ++ks) { r.ks[ks] = *(const bf16x8*)(kst + ((size_t)(n * 4 + h) * 256 + kh * 128 + 16 * w + fr) * 64 + 32 * ks + 8 * fq);
        r.v[ks] = *(const bf16x8*)(vt + ((size_t)n * 2048 + h * 512 + 16 * sl + fr) * 64 + 32 * ks + 8 * fq); }
    r.dc = *(const f32x4*)(dec + (n * 4 + h) * 256 + kh * 128 + 16 * w + 4 * fq);
}
DI void gla_scan_unit(const Frame& F, const Args& a, int h, int sl, int kh) {
    constexpr int SROW = 272, SBUF = 16 * SROW;
    LAS unsigned char* st = F.lds;
    const int fr = F.lane & 15, fq = F.lane >> 4, w = F.wave;
    float* opart = (float*)(a.ws + WS_OPART) + (size_t)kh * T * 2048;
    __syncthreads();
    for (int i = F.tid; i < SBUF / 4; i += NTHR) ((LAS unsigned*)st)[i] = 0u;
    __syncthreads();
    f32x4 S = {0.f, 0.f, 0.f, 0.f};
    ScanRegs cur, nxt;
    scan_load(cur, a, 0, h, sl, kh, w, fr, fq);
    for (int n = 0; n < NCH; ++n) {
        if (n + 1 < NCH) scan_load(nxt, a, n + 1, h, sl, kh, w, fr, fq);
        const LAS unsigned char* sc = st + (n & 1) * SBUF;
        if (w < 4) { f32x4 acc = {0.f, 0.f, 0.f, 0.f};
#pragma unroll
            for (int ks = 0; ks < 4; ++ks) { const bf16x8 A = *(const LAS bf16x8*)(sc + fr * SROW + (32 * ks + 8 * fq) * 2); acc = MFMA16(A, cur.q[ks], acc); }
            acc = MFMA16(kh ? cur.v[1] : cur.v[0], cur.at, acc);
            *(f32x4*)(opart + (size_t)(64 * n + 16 * w + fr) * 2048 + h * 512 + 16 * sl + 4 * fq) = acc; }
        S = S * cur.dc;
        S = MFMA16(cur.ks[0], cur.v[0], S); S = MFMA16(cur.ks[1], cur.v[1], S);
        { u32x2 o; o.x = pk2(S[0], S[1]); o.y = pk2(S[2], S[3]); *(LAS u32x2*)(st + ((n + 1) & 1) * SBUF + fr * SROW + (16 * w + 4 * fq) * 2) = o; }
        __syncthreads();
        cur = nxt;
    }
}

DI void unpack8(const u32x4& w, float (&f)[8]) { f[0] = lo_bf(w.x); f[1] = hi_bf(w.x); f[2] = lo_bf(w.y); f[3] = hi_bf(w.y); f[4] = lo_bf(w.z); f[5] = hi_bf(w.z); f[6] = lo_bf(w.w); f[7] = hi_bf(w.w); }
DI void p_combine(const Frame& F, const Args& a, int layer) {
    const bf16_t* cols = (const bf16_t*)(a.ws + WS_COLS);
    const bf16_t* ocmp = (const bf16_t*)(a.ws + WS_OCMP); const bf16_t* osel = (const bf16_t*)(a.ws + WS_OSEL); const bf16_t* owin = (const bf16_t*)(a.ws + WS_OWIN);
    const float* op0 = (const float*)(a.ws + WS_OPART); const float* op1 = op0 + (size_t)T * 2048;
    bf16_t* A1 = (bf16_t*)(a.ws + WS_A1); bf16_t* A2 = (bf16_t*)(a.ws + WS_A2);
    const int c0 = 32 * F.lane;
    f32x4 nw[8];
#pragma unroll
    for (int j = 0; j < 8; ++j) nw[j] = *(const f32x4*)(a.gla_norm_w + layer * 512 + (c0 & 511) + 4 * j);
    for (int row = F.gw; row < T; row += F.NGW) {
        const bf16_t* cr = cols + (size_t)row * NP;
        { const int head = F.lane >> 2;
          const float g0 = sigmoidf_(bf2f(cr[C_GBR + head * 3 + 0])), g1 = sigmoidf_(bf2f(cr[C_GBR + head * 3 + 1])), g2 = sigmoidf_(bf2f(cr[C_GBR + head * 3 + 2]));
#pragma unroll
          for (int j = 0; j < 4; ++j) { float oc[8], os[8], ow[8], za[8];
              unpack8(*(const u32x4*)(ocmp + (size_t)row * D + c0 + 8 * j), oc); unpack8(*(const u32x4*)(osel + (size_t)row * D + c0 + 8 * j), os);
              unpack8(*(const u32x4*)(owin + (size_t)row * D + c0 + 8 * j), ow); unpack8(*(const u32x4*)(cr + C_ZA + c0 + 8 * j), za);
              float r[8];
#pragma unroll
              for (int e = 0; e < 8; ++e) r[e] = (g0 * oc[e] + g1 * os[e] + g2 * ow[e]) * siluf_(za[e]);
              u32x4 o; o.x = pk2(r[0], r[1]); o.y = pk2(r[2], r[3]); o.z = pk2(r[4], r[5]); o.w = pk2(r[6], r[7]);
              *(u32x4*)(A1 + (size_t)row * D + c0 + 8 * j) = o; } }
        { f32x4 o[8]; float ss = 0.f;
#pragma unroll
          for (int j = 0; j < 8; ++j) { o[j] = *(const f32x4*)(op0 + (size_t)row * 2048 + c0 + 4 * j) + *(const f32x4*)(op1 + (size_t)row * 2048 + c0 + 4 * j);
              ss += (o[j].x * o[j].x + o[j].y * o[j].y) + (o[j].z * o[j].z + o[j].w * o[j].w); }
          ss += shx(ss, 1, F.lane); ss += shx(ss, 2, F.lane); ss += shx(ss, 4, F.lane); ss += shx(ss, 8, F.lane);
          const float rs = rsqrtf(ss * (1.f / 512.f) + NORM_EPS);
#pragma unroll
          for (int j = 0; j < 4; ++j) { float zb[8]; unpack8(*(const u32x4*)(cr + C_ZB + c0 + 8 * j), zb);
              const f32x4 y0 = o[2 * j] * rs * nw[2 * j], y1 = o[2 * j + 1] * rs * nw[2 * j + 1];
              u32x4 q; q.x = pk2(y0.x * siluf_(zb[0]), y0.y * siluf_(zb[1])); q.y = pk2(y0.z * siluf_(zb[2]), y0.w * siluf_(zb[3]));
              q.z = pk2(y1.x * siluf_(zb[4]), y1.y * siluf_(zb[5])); q.w = pk2(y1.z * siluf_(zb[6]), y1.w * siluf_(zb[7]));
              *(u32x4*)(A2 + (size_t)row * D + c0 + 8 * j) = q; } }
    }
}

constexpr int PH_PER_LAYER = 12, N_PHASES = 2 + DEPTH * PH_PER_LAYER;
__global__ void __launch_bounds__(NTHR, 2) mk_fwd(Args a_in, int li) {
    KArgsP ap = (KArgsP)__builtin_amdgcn_kernarg_segment_ptr();
    const int ph_lo = a_in.ph_lo, ph_hi = a_in.ph_hi;
    extern __shared__ __attribute__((aligned(16))) unsigned char lds_raw[];
    Frame F;
    F.lds = (LAS unsigned char*)lds_raw;
    F.tid = threadIdx.x; F.lane = F.tid & 63; F.wave = __builtin_amdgcn_readfirstlane(F.tid >> 6);
    const int wave_s = F.wave;
    F.G = gridDim.x; F.bid = blockIdx.x; F.gw = F.bid * NWAVES + F.wave; F.NGW = F.G * NWAVES;
    volatile LAS unsigned* misc = (volatile LAS unsigned*)(F.lds + LDS_MISC);
    if (F.tid < 64) misc[F.tid] = 0u;
    __syncthreads();
    unsigned* ctl = (unsigned*)(a_in.ws + WS_CTL);
    XcdBarrier bar = xcd_barrier_post(ctl + (size_t)li * XCD_BAR_WORDS, misc);
#ifndef PHASE_SET
#define PHASE_SET 0xFFFF
#endif
#define HAS(k) ((PHASE_SET >> (k)) & 1)
#define IN(k) (ph_lo <= (k) && (k) < ph_hi)
#define SEAM(k) do { if (IN(k) && IN((k) + 1)) xcd_barrier(bar); } while (0)
#define FRESH() do { int _l = __builtin_amdgcn_mbcnt_hi(~0u, __builtin_amdgcn_mbcnt_lo(~0u, 0u)); asm volatile("" : "+v"(_l)); int _w = wave_s; asm volatile("" : "+s"(_w)); F.lane = _l; F.wave = _w; F.tid = _w * 64 + _l; F.gw = F.bid * NWAVES + F.wave; { KArgsP _k = (KArgsP)__builtin_amdgcn_kernarg_segment_ptr(); asm volatile("" : "+s"(_k)); ap = _k; } } while (0)
    if (HAS(12) && IN(0)) { FRESH(); const Args a = load_args(ap); p_prologue(F, a); SEAM(0); }
    for (int L = 0; L < DEPTH; ++L) {
        const int pb = 1 + PH_PER_LAYER * L;
        if (HAS(0) && IN(pb + 0)) { FRESH(); const Args a = load_args(ap); unsigned char* ws = a.ws; bf16_t* cols = (bf16_t*)(ws + WS_COLS); const float* xin = L == 0 ? a.x : (const float*)(ws + WS_X); float* xw = (float*)(ws + WS_X); (void)cols; (void)xin; (void)xw; p_rmsnorm<false>(F, xin, a.norm_w + L * D, ws + WS_H); SEAM(pb + 0); }
        if (HAS(1) && IN(pb + 1)) { FRESH(); const Args a = load_args(ap); unsigned char* ws = a.ws; bf16_t* cols = (bf16_t*)(ws + WS_COLS); const float* xin = L == 0 ? a.x : (const float*)(ws + WS_X); float* xw = (float*)(ws + WS_X); (void)cols; (void)xin; (void)xw;
            pg8::Gemm g{(const bf16_t*)(ws + WS_H), (const bf16_t*)(ws + WS_WIN) + (size_t)L * NP * D, D, D, D};
            pg8::OrderMN S; S.init(T, NP, F.G, F.bid); pg8::EpiCols E{cols, NP};
            pg8::gemm_phase<pg8::EpiCols, pg8::OrderMN, false>(F.lds, g, S, E, F.tid);
            SEAM(pb + 1); }
        if (HAS(2) && IN(pb + 2)) { FRESH(); const Args a = load_args(ap); unsigned char* ws = a.ws; bf16_t* cols = (bf16_t*)(ws + WS_COLS); const float* xin = L == 0 ? a.x : (const float*)(ws + WS_X); float* xw = (float*)(ws + WS_X); (void)cols; (void)xin; (void)xw; p_thin(F, a, L); SEAM(pb + 2); }
        if (HAS(3) && IN(pb + 3)) { FRESH(); const Args a = load_args(ap); unsigned char* ws = a.ws; bf16_t* cols = (bf16_t*)(ws + WS_COLS); const float* xin = L == 0 ? a.x : (const float*)(ws + WS_X); float* xw = (float*)(ws + WS_X); (void)cols; (void)xin; (void)xw;
            pg8::Gemm g{cols, (const bf16_t*)(ws + WS_W1T) + (size_t)L * 2 * 256 * 4096, 16 * NP, 4096, 512};
            pg8::OrderCmp S; S.init(F.G, F.bid); pg8::EpiPart E{(float*)(ws + WS_CPART)};
            pg8::gemm_phase<pg8::EpiPart, pg8::OrderCmp, true>(F.lds, g, S, E, F.tid);
            SEAM(pb + 3); }
        if (HAS(4) && IN(pb + 4)) { FRESH(); const Args a = load_args(ap); unsigned char* ws = a.ws; bf16_t* cols = (bf16_t*)(ws + WS_COLS); const float* xin = L == 0 ? a.x : (const float*)(ws + WS_X); float* xw = (float*)(ws + WS_X); (void)cols; (void)xin; (void)xw; for (int u = F.bid; u < 64; u += F.G) mlp2_unit(F, a, L, u >> 3, u & 7); SEAM(pb + 4); }
        if (HAS(5) && IN(pb + 5)) { FRESH(); const Args a = load_args(ap); unsigned char* ws = a.ws; bf16_t* cols = (bf16_t*)(ws + WS_COLS); const float* xin = L == 0 ? a.x : (const float*)(ws + WS_X); float* xw = (float*)(ws + WS_X); (void)cols; (void)xin; (void)xw; for (int u = F.bid; u < 256; u += F.G) { const int p = u >> 2, g = u & 3; ca_chunk(F, a, p, g); ca_chunk(F, a, 127 - p, g); } SEAM(pb + 5); }
        if (HAS(6) && IN(pb + 6)) { FRESH(); const Args a = load_args(ap); unsigned char* ws = a.ws; bf16_t* cols = (bf16_t*)(ws + WS_COLS); const float* xin = L == 0 ? a.x : (const float*)(ws + WS_X); float* xw = (float*)(ws + WS_X); (void)cols; (void)xin; (void)xw; for (int u = F.bid; u < 256; u += F.G) gla_scan_unit(F, a, u >> 6, (u >> 1) & 31, u & 1); SEAM(pb + 6); }
        if (HAS(7) && IN(pb + 7)) { FRESH(); const Args a = load_args(ap); unsigned char* ws = a.ws; bf16_t* cols = (bf16_t*)(ws + WS_COLS); const float* xin = L == 0 ? a.x : (const float*)(ws + WS_X); float* xw = (float*)(ws + WS_X); (void)cols; (void)xin; (void)xw;
            for (int u = F.bid; u < 256; u += F.G) { const int p = u >> 2, g = u & 3; fa_chunk<0>(F, a, p, g); fa_chunk<0>(F, a, 127 - p, g); }
            for (int u = F.bid; u < 256; u += F.G) { const int p = u >> 2, g = u & 3; fa_chunk<1>(F, a, p, g); fa_chunk<1>(F, a, 127 - p, g); }
            SEAM(pb + 7); }
        if (HAS(8) && IN(pb + 8)) { FRESH(); const Args a = load_args(ap); unsigned char* ws = a.ws; bf16_t* cols = (bf16_t*)(ws + WS_COLS); const float* xin = L == 0 ? a.x : (const float*)(ws + WS_X); float* xw = (float*)(ws + WS_X); (void)cols; (void)xin; (void)xw; p_combine(F, a, L); SEAM(pb + 8); }
        if (HAS(9) && IN(pb + 9)) { FRESH(); const Args a = load_args(ap); unsigned char* ws = a.ws; bf16_t* cols = (bf16_t*)(ws + WS_COLS); const float* xin = L == 0 ? a.x : (const float*)(ws + WS_X); float* xw = (float*)(ws + WS_X); (void)cols; (void)xin; (void)xw;
            pg8::Gemm g{(const bf16_t*)(ws + WS_A1), (const bf16_t*)(ws + WS_WPA) + (size_t)L * D * D, D, D, D};
            pg8::OrderMN S; S.init(T, D, F.G, F.bid); pg8::EpiGateTmp E{(float*)(ws + WS_TMP), cols + C_GA};
            pg8::gemm_phase<pg8::EpiGateTmp, pg8::OrderMN, false>(F.lds, g, S, E, F.tid);
            SEAM(pb + 9); }
        if (HAS(10) && IN(pb + 10)) { FRESH(); const Args a = load_args(ap); unsigned char* ws = a.ws; bf16_t* cols = (bf16_t*)(ws + WS_COLS); const float* xin = L == 0 ? a.x : (const float*)(ws + WS_X); float* xw = (float*)(ws + WS_X); (void)cols; (void)xin; (void)xw;
            pg8::Gemm g{(const bf16_t*)(ws + WS_A2), (const bf16_t*)(ws + WS_WPB) + (size_t)L * D * D, D, D, D};
            pg8::OrderMN S; S.init(T, D, F.G, F.bid); pg8::EpiGateAdd E{(bf16_t*)(ws + WS_Y), (const float*)(ws + WS_TMP), cols + C_GB};
            pg8::gemm_phase<pg8::EpiGateAdd, pg8::OrderMN, false>(F.lds, g, S, E, F.tid);
            SEAM(pb + 10); }
        if (HAS(11) && IN(pb + 11)) { FRESH(); const Args a = load_args(ap); unsigned char* ws = a.ws; bf16_t* cols = (bf16_t*)(ws + WS_COLS); const float* xin = L == 0 ? a.x : (const float*)(ws + WS_X); float* xw = (float*)(ws + WS_X); (void)cols; (void)xin; (void)xw;
            pg8::Gemm g{(const bf16_t*)(ws + WS_Y), (const bf16_t*)(ws + WS_WOUT) + (size_t)L * D * D, D, D, D};
            pg8::OrderMN S; S.init(T, D, F.G, F.bid); pg8::EpiResid E{xin, xw};
            pg8::gemm_phase<pg8::EpiResid, pg8::OrderMN, false>(F.lds, g, S, E, F.tid);
            SEAM(pb + 11); }
    }
    if (HAS(13) && IN(N_PHASES - 1)) { FRESH(); const Args a = load_args(ap); p_rmsnorm<true>(F, (const float*)(a.ws + WS_X), a.final_w, a.out); }
#undef IN
#undef SEAM
}

extern "C" void kernel_launch(void* const* d_in, const int* in_sizes, int n_in, void* d_out, int out_size, void* d_ws, size_t ws_size, hipStream_t stream) {
    static int grid = 0;
    if (grid == 0) {
        if (n_in != 15 || ws_size < WS_END) { fprintf(stderr, "kernel_launch: unexpected inputs (n_in %d, ws %zu, need %zu)\n", n_in, ws_size, (size_t)WS_END); grid = -1; return; }
        int dev = 0, cus = 0;
        if (hipGetDevice(&dev) != hipSuccess || hipDeviceGetAttribute(&cus, hipDeviceAttributeMultiprocessorCount, dev) != hipSuccess) { grid = -1; return; }
        if (hipFuncSetAttribute((const void*)mk_fwd, hipFuncAttributeMaxDynamicSharedMemorySize, LDS_BYTES) != hipSuccess) { fprintf(stderr, "kernel_launch: hipFuncSetAttribute failed\n"); grid = -1; return; }
        int per_cu = 0;
        if (hipOccupancyMaxActiveBlocksPerMultiprocessor(&per_cu, (const void*)mk_fwd, NTHR, LDS_BYTES) != hipSuccess || per_cu < 1) fprintf(stderr, "kernel_launch: occupancy query reports %d\n", per_cu);
        (void)hipGetLastError();
        grid = cus;
    }
    if (grid < 0) return;
    (void)hipMemsetAsync((char*)d_ws + WS_CTL, 0, CTL_BYTES, stream);
    Args a{};
    a.x = (const float*)d_in[0]; a.norm_w = (const float*)d_in[1]; a.w_in = (const float*)d_in[2]; a.cmp_pe = (const float*)d_in[3]; a.cmp_w1 = (const float*)d_in[4];
    a.cmp_b1 = (const float*)d_in[5]; a.cmp_w2 = (const float*)d_in[6]; a.cmp_b2 = (const float*)d_in[7]; a.alpha_w = (const float*)d_in[8]; a.alpha_b = (const float*)d_in[9];
    a.gla_norm_w = (const float*)d_in[10]; a.p_a = (const float*)d_in[11]; a.p_b = (const float*)d_in[12]; a.w_out = (const float*)d_in[13]; a.final_w = (const float*)d_in[14];
    a.out = (float*)d_out; a.ws = (unsigned char*)d_ws;
#if MK_PER_PHASE
    for (int k = 0; k < N_PHASES; ++k) { a.ph_lo = k; a.ph_hi = k + 1; hipLaunchKernelGGL(mk_fwd, dim3(grid), dim3(NTHR), LDS_BYTES, stream, a, k); }
#else
    a.ph_lo = 0; a.ph_hi = N_PHASES; hipLaunchKernelGGL(mk_fwd, dim3(grid), dim3(NTHR), LDS_BYTES, stream, a, 0);
#endif
}
```

```cpp
#include <hip/hip_runtime.h>
#include <cstdio>
#include <cstdint>

#ifndef MK_PER_PHASE
#define MK_PER_PHASE 0
#endif

#define LAS __attribute__((address_space(3)))
#define GAS __attribute__((address_space(1)))
typedef unsigned short bf16_t;
typedef short bf16x8 __attribute__((ext_vector_type(8)));
typedef short s16x4 __attribute__((ext_vector_type(4)));
typedef float f32x4 __attribute__((ext_vector_type(4)));
typedef float f32x2 __attribute__((ext_vector_type(2)));
typedef unsigned u32x4 __attribute__((ext_vector_type(4)));
typedef unsigned u32x2 __attribute__((ext_vector_type(2)));
#define DI __device__ __forceinline__
#define MFMA16(a, b, c) __builtin_amdgcn_mfma_f32_16x16x32_bf16((a), (b), (c), 0, 0, 0)

constexpr int T = 8192, D = 2048, DEPTH = 4, NIN = 17472, NP = 17664;
constexpr int NCH = 128;
constexpr int C_QA = 0, C_KCMP = 2048, C_VCMP = 2560, C_KSEL = 3072, C_VSEL = 3584, C_KWIN = 4096, C_VWIN = 4608, C_ZA = 5120,
              C_QB = 7168, C_KB = 8192, C_VB = 9216, C_ZB = 11264, C_GA = 13312, C_GB = 15360, C_GBR = 17408, C_ALR = 17456;
constexpr float NORM_EPS = 1e-6f;
constexpr float ATT_C = 0.08838834764831845f * 1.4426950408889634f;

DI int map_col(int n) {
    if (n < 5120) return n;
    if (n < 5168) return C_GBR + (n - 5120);
    if (n < 11312) return n - 48;
    if (n < 11328) return C_ALR + (n - 11312);
    return n - 64;
}

constexpr size_t MiB = 1u << 20;
constexpr size_t al(size_t x) { return (x + MiB - 1) / MiB * MiB; }
constexpr size_t WS_CTL = 0, CTL_BYTES = MiB;
constexpr size_t WS_WIN = WS_CTL + CTL_BYTES;
constexpr size_t WS_WPA = WS_WIN + al((size_t)DEPTH * NP * D * 2);
constexpr size_t WS_WPB = WS_WPA + al((size_t)DEPTH * D * D * 2);
constexpr size_t WS_WOUT = WS_WPB + al((size_t)DEPTH * D * D * 2);
constexpr size_t WS_W1T = WS_WOUT + al((size_t)DEPTH * D * D * 2);
constexpr size_t WS_W2T = WS_W1T + al((size_t)DEPTH * 2 * 256 * 4096 * 2);
constexpr size_t WS_B1P = WS_W2T + al((size_t)DEPTH * 2 * 128 * 256 * 2);
constexpr size_t WS_X = WS_B1P + MiB;
constexpr size_t WS_H = WS_X + al((size_t)T * D * 4);
constexpr size_t WS_COLS = WS_H + al((size_t)T * D * 2);
constexpr size_t WS_CPART = WS_COLS + al((size_t)(T + 64) * NP * 2);
constexpr size_t WS_KC = WS_CPART + al((size_t)8 * 8 * 512 * 256 * 4);
constexpr size_t WS_VCT = WS_KC + MiB;
constexpr size_t WS_SELM = WS_VCT + MiB;
constexpr size_t WS_OCMP = WS_SELM + MiB;
constexpr size_t WS_OSEL = WS_OCMP + al((size_t)T * D * 2);
constexpr size_t WS_OWIN = WS_OSEL + al((size_t)T * D * 2);
constexpr size_t WS_VSELT = WS_OWIN + al((size_t)T * D * 2);
constexpr size_t WS_VWINT = WS_VSELT + al((size_t)4 * 128 * 128 * 64 * 2);
constexpr size_t WS_QDEC = WS_VWINT + al((size_t)4 * 128 * 128 * 64 * 2);
constexpr size_t WS_KST = WS_QDEC + al((size_t)T * 1024 * 2);
constexpr size_t WS_VT = WS_KST + al((size_t)T * 1024 * 2);
constexpr size_t WS_ATT = WS_VT + al((size_t)T * 2048 * 2);
constexpr size_t WS_DEC = WS_ATT + al((size_t)128 * 4 * 64 * 64 * 2);
constexpr size_t WS_OPART = WS_DEC + MiB;
constexpr size_t WS_A1 = WS_OPART + al((size_t)2 * T * 2048 * 4);
constexpr size_t WS_A2 = WS_A1 + al((size_t)T * D * 2);
constexpr size_t WS_TMP = WS_A2 + al((size_t)T * D * 2);
constexpr size_t WS_Y = WS_TMP + al((size_t)T * D * 4);
constexpr size_t WS_END = WS_Y + al((size_t)T * D * 2);

constexpr int LDS_MAIN = 131072;
constexpr int LDS_BYTES = 147456;
constexpr int LDS_MISC = LDS_BYTES - 256;
constexpr int NWAVES = 8, NTHR = 512;

DI float bf2f(unsigned short b) { return __uint_as_float(((unsigned)b) << 16); }
DI unsigned f2bf(float f) { unsigned u = __float_as_uint(f); return (u + 0x7fffu + ((u >> 16) & 1u)) >> 16; }
DI unsigned pk2_sw(float lo, float hi) { return f2bf(lo) | (f2bf(hi) << 16); }
typedef __bf16 bf16x2_t __attribute__((ext_vector_type(2)));
DI unsigned cvt_pk_bf16(float lo, float hi) { const f32x2 v = {lo, hi}; const bf16x2_t b = __builtin_convertvector(v, bf16x2_t); return __builtin_bit_cast(unsigned, b); }
DI unsigned pk2(float lo, float hi) { return cvt_pk_bf16(lo, hi); }
DI float lo_bf(unsigned w) { return __uint_as_float(w << 16); }
DI float hi_bf(unsigned w) { return __uint_as_float(w & 0xffff0000u); }
DI float sigmoidf_(float x) { return 1.f / (1.f + __expf(-x)); }
DI float siluf_(float x) { return x / (1.f + __expf(-x)); }
DI float shx(float v, int off, int lane) { return __int_as_float(__builtin_amdgcn_ds_bpermute((lane ^ off) << 2, __float_as_int(v))); }
DI int shxi(int v, int off, int lane) { return __builtin_amdgcn_ds_bpermute((lane ^ off) << 2, v); }
DI float wave_sum(float v, int lane) {
#pragma unroll
    for (int o = 1; o < 64; o <<= 1) v += shx(v, o, lane);
    return v;
}
#define LDS_WAIT() asm volatile("s_waitcnt lgkmcnt(0)" ::: "memory")
#define VM_WAIT() asm volatile("s_waitcnt vmcnt(0)" ::: "memory")

namespace pg8 {
constexpr int BM = 256, BK = 64, HALF = 128, HTB = HALF * BK * 2, STAGE_BYTES = 8 * HTB, NXCD = 8, WGM = 4;
__host__ __device__ __forceinline__ int lds_byte(int r, int c) { const int st = (r >> 4) * 2 + (c >> 5), rr = r & 15, cc = c & 31, ob = rr * 64 + cc * 2; return st * 1024 + (ob ^ (((ob >> 9) & 1) << 5)); }
__host__ __device__ __forceinline__ void stage_rc(int b, int& R, int& C) { const int st = b / 1024, sb = b % 1024, swz = sb ^ (((sb >> 9) & 1) << 5); R = (st >> 1) * 16 + swz / 64; C = (st & 1) * 32 + (swz % 64) / 2; }
__host__ __device__ __forceinline__ int perm32(int rho) { const int n = rho >> 4, i = rho & 15; return 8 * (i >> 2) + 4 * n + (i & 3); }

struct Unit { int pm, pn, pk, pz; };
struct Gemm { const bf16_t* A; const bf16_t* Bt; int lda, ldb, K; };

struct OrderMN {
    int nM, nN, nwg, G, c, rep;
    DI void init(int M, int N, int G_, int c_, int rep_ = 1) { nM = M / BM; nN = N / BM; nwg = nM * nN; G = G_; c = c_; rep = rep_; }
    DI bool next(int i, Unit& u) const {
        long L = (long)i * G + c; if (L >= (long)nwg * rep) return false;
        if (L >= nwg) L -= nwg;
        int wgid = (int)L; { const int q = nwg / NXCD, r = nwg % NXCD, xcd = wgid % NXCD, off = wgid / NXCD; wgid = (xcd < r ? xcd * (q + 1) : r * (q + 1) + (xcd - r) * q) + off; }
        const int nig = WGM * nN, gid = wgid / nig, fm = gid * WGM, gsz = (nM - fm) < WGM ? (nM - fm) : WGM;
        u.pm = fm + ((wgid % nig) % gsz); u.pn = (wgid % nig) / gsz; u.pk = 0; u.pz = 0; return true;
    }
    DI const char* a_ptr(const Gemm& g, const Unit& u) const { return (const char*)g.A + (size_t)u.pm * BM * g.lda * 2; }
    DI const char* b_ptr(const Gemm& g, const Unit& u) const { return (const char*)g.Bt + (size_t)u.pn * BM * g.ldb * 2; }
};
struct OrderCmp {
    int G, c;
    DI void init(int G_, int c_) { G = G_; c = c_; }
    DI bool next(int i, Unit& u) const { const int L = i * G + c; if (L >= 128) return false; u.pk = L & 7; u.pm = (L >> 3) & 1; u.pz = L >> 4; u.pn = 0; return true; }
    DI const char* a_ptr(const Gemm& g, const Unit& u) const { const int kv = u.pz >> 2, gg = u.pz & 3;
        return (const char*)g.A + ((size_t)(u.pm * BM * 16 + u.pk * 4) * NP + (kv ? C_VCMP : C_KCMP) + gg * 128) * 2; }
    DI const char* b_ptr(const Gemm& g, const Unit& u) const { const int kv = u.pz >> 2; return (const char*)g.Bt + ((size_t)kv * 256 * 4096 + u.pk * 512) * 2; }
};

template <class Epi, class Sched, bool IM2COL = false, bool ALIGN_EPI = false, bool SP2 = false>
DI void gemm_phase(LAS unsigned char* lds, const Gemm g, const Sched& S, const Epi& E, const int tid) {
    const int wid = __builtin_amdgcn_readfirstlane(tid >> 6), lane = tid & 63, wr = wid >> 2, wc = wid & 3, fr = lane & 15, fq = lane >> 4;
    const int nt = g.K / BK;
    unsigned voffA[2], voffB[2];
#pragma unroll
    for (int i = 0; i < 2; ++i) { int R, C; stage_rc(tid * 16 + i * 8192, R, C); const int Rb = Epi::PERM ? ((R & ~31) + perm32(R & 31)) : R;
        voffA[i] = (unsigned)(R * g.lda + C) * 2u; voffB[i] = (unsigned)(Rb * g.ldb + C) * 2u; }
    const size_t hstepA = (size_t)HALF * g.lda * 2, hstepB = (size_t)HALF * g.ldb * 2;
    const unsigned ldsw = (unsigned)wid * 1024u;
    const int aoff = lds_byte(wr * 64 + fr, fq * 8), boff = lds_byte(wc * 32 + fr, fq * 8);
#define PG8_KA(kt) (IM2COL ? ((size_t)((kt) >> 1) * (NP * 2) + (size_t)((kt) & 1) * 128) : (size_t)(kt) * 128)
#define PG8_KB(kt) ((size_t)(kt) * 128)
#define PG8_SA(b, h) (((b) * 2 + (h)) * HTB)
#define PG8_SB(b, h) ((4 + (b) * 2 + (h)) * HTB)
#define PG8_STAGE(bufoff, gbase, voff) do { _Pragma("unroll") for (int _i = 0; _i < 2; ++_i) \
        __builtin_amdgcn_global_load_lds((const unsigned*)((const char*)(gbase) + (voff)[_i]), (LAS unsigned*)(lds + (bufoff) + ldsw + _i * 8192), 16, 0, 0); } while (0)
#define PG8_LDA(dst, b, h) do { _Pragma("unroll") for (int m = 0; m < 4; ++m) _Pragma("unroll") for (int k = 0; k < 2; ++k) dst[m][k] = *(const LAS bf16x8*)(lds + PG8_SA(b, h) + aoff + m * 2048 + k * 1024); } while (0)
#define PG8_LDB(dst, b, h) do { _Pragma("unroll") for (int n = 0; n < 2; ++n) _Pragma("unroll") for (int k = 0; k < 2; ++k) dst[n][k] = *(const LAS bf16x8*)(lds + PG8_SB(b, h) + boff + n * 2048 + k * 1024); } while (0)
#define PG8_MMA(ai, bj, At, Bt) do { __builtin_amdgcn_s_setprio(1); _Pragma("unroll") for (int m = 0; m < 4; ++m) _Pragma("unroll") for (int n = 0; n < 2; ++n) _Pragma("unroll") for (int k = 0; k < 2; ++k) \
        acc[ai][bj][m][n] = __builtin_amdgcn_mfma_f32_16x16x32_bf16(Bt[n][k], At[m][k], acc[ai][bj][m][n], 0, 0, 0); __builtin_amdgcn_s_setprio(0); } while (0)
#define PG8_WAIT_V(n) asm volatile("s_waitcnt vmcnt(" #n ")" ::: "memory")
#define PG8_WAIT_L(n) asm volatile("s_waitcnt lgkmcnt(" #n ")" ::: "memory")
#define PG8_BAR __builtin_amdgcn_s_barrier()
#define PG8_SCHED __builtin_amdgcn_sched_barrier(0)
    Unit cur, nxt; int ui = 0;
    if (!S.next(0, cur)) return;
    f32x4 acc[2][2][4][2];
#pragma unroll
    for (int a = 0; a < 2; ++a)
#pragma unroll
        for (int b = 0; b < 2; ++b)
#pragma unroll
            for (int m = 0; m < 4; ++m)
#pragma unroll
                for (int n = 0; n < 2; ++n) acc[a][b][m][n] = (f32x4){0.f, 0.f, 0.f, 0.f};
    bf16x8 At[4][2], B0[2][2], B1[2][2];
    const char* cA = S.a_ptr(g, cur); const char* cB = S.b_ptr(g, cur);
    if constexpr (SP2) {
        PG8_STAGE(PG8_SB(0, 0), cB, voffB); PG8_STAGE(PG8_SB(0, 1), cB + hstepB, voffB); PG8_STAGE(PG8_SA(0, 0), cA, voffA); PG8_STAGE(PG8_SA(0, 1), cA + hstepA, voffA);
        if (wr == 1) PG8_BAR;
        PG8_WAIT_V(2); PG8_BAR;
        PG8_STAGE(PG8_SB(1, 0), cB + PG8_KB(1), voffB); PG8_STAGE(PG8_SA(1, 0), cA + PG8_KA(1), voffA); PG8_STAGE(PG8_SB(1, 1), cB + hstepB + PG8_KB(1), voffB);
        PG8_WAIT_V(6); PG8_BAR;
    } else {
    PG8_STAGE(PG8_SB(0, 0), cB, voffB); PG8_STAGE(PG8_SA(0, 0), cA, voffA); PG8_STAGE(PG8_SB(0, 1), cB + hstepB, voffB); PG8_STAGE(PG8_SA(0, 1), cA + hstepA, voffA);
    if (wr == 1) PG8_BAR;
    PG8_WAIT_V(4); PG8_BAR;
    PG8_STAGE(PG8_SB(1, 0), cB + PG8_KB(1), voffB); PG8_STAGE(PG8_SA(1, 0), cA + PG8_KA(1), voffA); PG8_STAGE(PG8_SB(1, 1), cB + hstepB + PG8_KB(1), voffB);
    PG8_WAIT_V(6); PG8_BAR;
    }
    for (;;) {
        const bool has_next = S.next(ui + 1, nxt);
        const char* nA = has_next ? S.a_ptr(g, nxt) : cA; const char* nB = has_next ? S.b_ptr(g, nxt) : cB;
        for (int t = 0; t < nt; t += 2) {
            const bool last = (t == nt - 2);
            const char* a1 = cA + PG8_KA(t + 1);
            const char* a2 = last ? nA : cA + PG8_KA(t + 2); const char* b2 = last ? nB : cB + PG8_KB(t + 2);
            const char* a3 = last ? nA + PG8_KA(1) : cA + PG8_KA(t + 3); const char* b3 = b2 + 128;
            if constexpr (SP2) {
            PG8_LDB(B0, 0, 0); PG8_LDB(B1, 0, 1); PG8_SCHED; PG8_LDA(At, 0, 0); PG8_STAGE(PG8_SA(1, 1), a1 + hstepA, voffA);
            PG8_WAIT_V(8); PG8_WAIT_L(0); PG8_BAR; PG8_MMA(0, 0, At, B0); PG8_MMA(0, 1, At, B1); PG8_BAR; PG8_SCHED;
            PG8_LDA(At, 0, 1); PG8_STAGE(PG8_SB(0, 0), b2, voffB); PG8_STAGE(PG8_SB(0, 1), b2 + hstepB, voffB); PG8_STAGE(PG8_SA(0, 0), a2, voffA);
            PG8_WAIT_V(8); PG8_WAIT_L(0); PG8_BAR; PG8_MMA(1, 0, At, B0); PG8_MMA(1, 1, At, B1); PG8_BAR; PG8_SCHED;
            PG8_LDB(B0, 1, 0); PG8_LDB(B1, 1, 1); PG8_SCHED; PG8_LDA(At, 1, 0); PG8_STAGE(PG8_SA(0, 1), a2 + hstepA, voffA);
            PG8_WAIT_V(8); PG8_WAIT_L(0); PG8_BAR; PG8_MMA(0, 0, At, B0); PG8_MMA(0, 1, At, B1); PG8_BAR; PG8_SCHED;
            PG8_LDA(At, 1, 1); PG8_STAGE(PG8_SB(1, 0), b3, voffB); PG8_STAGE(PG8_SB(1, 1), b3 + hstepB, voffB); PG8_STAGE(PG8_SA(1, 0), a3, voffA);
            PG8_WAIT_V(8); PG8_WAIT_L(0); PG8_BAR; PG8_MMA(1, 0, At, B0); PG8_MMA(1, 1, At, B1); PG8_BAR; PG8_SCHED;
            } else {
            PG8_LDB(B0, 0, 0); PG8_SCHED; PG8_LDA(At, 0, 0); PG8_STAGE(PG8_SA(1, 1), a1 + hstepA, voffA);
            PG8_WAIT_L(8); PG8_BAR; PG8_WAIT_L(0); PG8_MMA(0, 0, At, B0); PG8_BAR; PG8_SCHED;
            PG8_LDB(B1, 0, 1); PG8_STAGE(PG8_SB(0, 0), b2, voffB);
            PG8_BAR; PG8_WAIT_L(0); PG8_MMA(0, 1, At, B1); PG8_BAR;
            PG8_LDA(At, 0, 1); PG8_STAGE(PG8_SA(0, 0), a2, voffA);
            PG8_BAR; PG8_WAIT_L(0); PG8_MMA(1, 0, At, B0); PG8_BAR; PG8_SCHED;
            PG8_STAGE(PG8_SB(0, 1), b2 + hstepB, voffB);
            PG8_WAIT_V(6); PG8_BAR; PG8_MMA(1, 1, At, B1); PG8_BAR;
            PG8_LDB(B0, 1, 0); PG8_SCHED; PG8_LDA(At, 1, 0); PG8_STAGE(PG8_SA(0, 1), a2 + hstepA, voffA);
            PG8_WAIT_L(8); PG8_BAR; PG8_WAIT_L(0); PG8_MMA(0, 0, At, B0); PG8_BAR; PG8_SCHED;
            PG8_LDB(B1, 1, 1); PG8_STAGE(PG8_SB(1, 0), b3, voffB);
            PG8_BAR; PG8_WAIT_L(0); PG8_MMA(0, 1, At, B1); PG8_BAR;
            PG8_LDA(At, 1, 1); PG8_STAGE(PG8_SA(1, 0), a3, voffA);
            PG8_BAR; PG8_WAIT_L(0); PG8_MMA(1, 0, At, B0); PG8_BAR; PG8_SCHED;
            PG8_STAGE(PG8_SB(1, 1), b3 + hstepB, voffB);
            PG8_WAIT_V(6); PG8_BAR; PG8_MMA(1, 1, At, B1); PG8_BAR;
            }
        }
        if constexpr (ALIGN_EPI) { if (wr == 0) PG8_BAR; }
        E(acc, cur, wr, wc, fr, fq);
        if (!has_next) break;
#pragma unroll
        for (int a = 0; a < 2; ++a)
#pragma unroll
            for (int b = 0; b < 2; ++b)
#pragma unroll
                for (int m = 0; m < 4; ++m)
#pragma unroll
                    for (int n = 0; n < 2; ++n) acc[a][b][m][n] = (f32x4){0.f, 0.f, 0.f, 0.f};
        cur = nxt; cA = nA; cB = nB; ++ui;
        if constexpr (ALIGN_EPI) { if (wr == 1) PG8_BAR; }
    }
    PG8_WAIT_V(0);
    if constexpr (!ALIGN_EPI) { if (wr == 0) PG8_BAR; }
    PG8_BAR;
#undef PG8_KA
#undef PG8_KB
#undef PG8_SA
#undef PG8_SB
#undef PG8_STAGE
#undef PG8_LDA
#undef PG8_LDB
#undef PG8_MMA
#undef PG8_WAIT_V
#undef PG8_WAIT_L
#undef PG8_BAR
#undef PG8_SCHED
}

struct EpiCols {
    static constexpr bool PERM = true;
    bf16_t* O; int ldc;
    DI void operator()(const f32x4 (&acc)[2][2][4][2], const Unit& u, int wr, int wc, int fr, int fq) const {
        const int row0 = u.pm * BM + wr * 64 + fr, col0 = u.pn * BM + wc * 32 + 8 * fq;
#pragma unroll
        for (int ai = 0; ai < 2; ++ai)
#pragma unroll
            for (int m = 0; m < 4; ++m) { bf16_t* rowp = O + (size_t)(row0 + ai * HALF + m * 16) * ldc + col0;
#pragma unroll
                for (int bj = 0; bj < 2; ++bj) { const f32x4 v0 = acc[ai][bj][m][0], v1 = acc[ai][bj][m][1];
                    u32x4 w; w.x = cvt_pk_bf16(v0[0], v0[1]); w.y = cvt_pk_bf16(v0[2], v0[3]); w.z = cvt_pk_bf16(v1[0], v1[1]); w.w = cvt_pk_bf16(v1[2], v1[3]);
                    *(u32x4*)(rowp + bj * HALF) = w; } }
    }
};
struct EpiPart {
    static constexpr bool PERM = false;
    float* P;
    DI void operator()(const f32x4 (&acc)[2][2][4][2], const Unit& u, int wr, int wc, int fr, int fq) const {
        float* base = P + ((size_t)(u.pk * 8 + u.pz) * 512 + u.pm * BM) * 256;
        const int row0 = wr * 64 + fr, col0 = wc * 32 + 4 * fq;
#pragma unroll
        for (int ai = 0; ai < 2; ++ai)
#pragma unroll
            for (int m = 0; m < 4; ++m) { float* rowp = base + (size_t)(row0 + ai * HALF + m * 16) * 256 + col0;
#pragma unroll
                for (int bj = 0; bj < 2; ++bj)
#pragma unroll
                    for (int n = 0; n < 2; ++n) *(f32x4*)(rowp + bj * HALF + n * 16) = acc[ai][bj][m][n]; }
    }
};
struct EpiGateTmp {
    static constexpr bool PERM = true;
    float* O; const bf16_t* gate;
    DI void operator()(const f32x4 (&acc)[2][2][4][2], const Unit& u, int wr, int wc, int fr, int fq) const {
        const int row0 = u.pm * BM + wr * 64 + fr, col0 = u.pn * BM + wc * 32 + 8 * fq;
#pragma unroll
        for (int ai = 0; ai < 2; ++ai)
#pragma unroll
            for (int m = 0; m < 4; ++m) { const int row = row0 + ai * HALF + m * 16;
#pragma unroll
                for (int bj = 0; bj < 2; ++bj) { const u32x4 gw = *(const u32x4*)(gate + (size_t)row * NP + col0 + bj * HALF);
                    const f32x4 v0 = acc[ai][bj][m][0], v1 = acc[ai][bj][m][1]; f32x4 o0, o1;
                    o0[0] = v0[0] * sigmoidf_(lo_bf(gw.x)); o0[1] = v0[1] * sigmoidf_(hi_bf(gw.x)); o0[2] = v0[2] * sigmoidf_(lo_bf(gw.y)); o0[3] = v0[3] * sigmoidf_(hi_bf(gw.y));
                    o1[0] = v1[0] * sigmoidf_(lo_bf(gw.z)); o1[1] = v1[1] * sigmoidf_(hi_bf(gw.z)); o1[2] = v1[2] * sigmoidf_(lo_bf(gw.w)); o1[3] = v1[3] * sigmoidf_(hi_bf(gw.w));
                    float* op = O + (size_t)row * D + col0 + bj * HALF; *(f32x4*)op = o0; *(f32x4*)(op + 4) = o1; }
                asm volatile("" ::: "memory"); }
    }
};
struct EpiGateAdd {
    static constexpr bool PERM = true;
    bf16_t* Y; const float* tmp; const bf16_t* gate;
    DI void operator()(const f32x4 (&acc)[2][2][4][2], const Unit& u, int wr, int wc, int fr, int fq) const {
        const int row0 = u.pm * BM + wr * 64 + fr, col0 = u.pn * BM + wc * 32 + 8 * fq;
#pragma unroll
        for (int ai = 0; ai < 2; ++ai)
#pragma unroll
            for (int m = 0; m < 4; ++m) { const int row = row0 + ai * HALF + m * 16;
#pragma unroll
                for (int bj = 0; bj < 2; ++bj) { const u32x4 gw = *(const u32x4*)(gate + (size_t)row * NP + col0 + bj * HALF);
                    const float* tp = tmp + (size_t)row * D + col0 + bj * HALF; const f32x4 t0 = *(const f32x4*)tp, t1 = *(const f32x4*)(tp + 4);
                    const f32x4 v0 = acc[ai][bj][m][0], v1 = acc[ai][bj][m][1]; f32x4 o0, o1;
                    o0[0] = t0[0] + v0[0] * sigmoidf_(lo_bf(gw.x)); o0[1] = t0[1] + v0[1] * sigmoidf_(hi_bf(gw.x)); o0[2] = t0[2] + v0[2] * sigmoidf_(lo_bf(gw.y)); o0[3] = t0[3] + v0[3] * sigmoidf_(hi_bf(gw.y));
                    o1[0] = t1[0] + v1[0] * sigmoidf_(lo_bf(gw.z)); o1[1] = t1[1] + v1[1] * sigmoidf_(hi_bf(gw.z)); o1[2] = t1[2] + v1[2] * sigmoidf_(lo_bf(gw.w)); o1[3] = t1[3] + v1[3] * sigmoidf_(hi_bf(gw.w));
                    u32x4 w; w.x = cvt_pk_bf16(o0[0], o0[1]); w.y = cvt_pk_bf16(o0[2], o0[3]); w.z = cvt_pk_bf16(o1[0], o1[1]); w.w = cvt_pk_bf16(o1[2], o1[3]);
                    *(u32x4*)(Y + (size_t)row * D + col0 + bj * HALF) = w; }
                asm volatile("" ::: "memory"); }
    }
};
struct EpiResid {
    static constexpr bool PERM = true;
    const float* xi; float* xo;
    DI void operator()(const f32x4 (&acc)[2][2][4][2], const Unit& u, int wr, int wc, int fr, int fq) const {
        const int row0 = u.pm * BM + wr * 64 + fr, col0 = u.pn * BM + wc * 32 + 8 * fq;
#pragma unroll
        for (int ai = 0; ai < 2; ++ai) { f32x4 t[4][2][2];
#pragma unroll
            for (int m = 0; m < 4; ++m) { const size_t off = (size_t)(row0 + ai * HALF + m * 16) * D + col0;
#pragma unroll
                for (int bj = 0; bj < 2; ++bj) { t[m][bj][0] = *(const f32x4*)(xi + off + bj * HALF); t[m][bj][1] = *(const f32x4*)(xi + off + bj * HALF + 4); } }
#pragma unroll
            for (int m = 0; m < 4; ++m) { const size_t off = (size_t)(row0 + ai * HALF + m * 16) * D + col0;
#pragma unroll
                for (int bj = 0; bj < 2; ++bj) { *(f32x4*)(xo + off + bj * HALF) = t[m][bj][0] + acc[ai][bj][m][0]; *(f32x4*)(xo + off + bj * HALF + 4) = t[m][bj][1] + acc[ai][bj][m][1]; } }
            asm volatile("" ::: "memory"); }
    }
};
struct OrderAB {
    OrderMN mn; const bf16_t* A2; const bf16_t* B2;
    DI bool next(int i, Unit& u) const { if (!mn.next(i >> 1, u)) return false; u.pz = i & 1; return true; }
    DI const char* a_ptr(const Gemm& g, const Unit& u) const { return (const char*)(u.pz ? A2 : g.A) + (size_t)u.pm * BM * g.lda * 2; }
    DI const char* b_ptr(const Gemm& g, const Unit& u) const { return (const char*)(u.pz ? B2 : g.Bt) + (size_t)u.pn * BM * g.ldb * 2; }
};
struct EpiGateAB {
    static constexpr bool PERM = true;
    bf16_t* Y; bf16_t* tmp; const bf16_t* gate_a; const bf16_t* gate_b;
    DI void operator()(const f32x4 (&acc)[2][2][4][2], const Unit& u, int wr, int wc, int fr, int fq) const {
        const int row0 = u.pm * BM + wr * 64 + fr, col0 = u.pn * BM + wc * 32 + 8 * fq;
        const bf16_t* gate = u.pz ? gate_b : gate_a; bf16_t* dst = u.pz ? Y : tmp;
#pragma unroll
        for (int ai = 0; ai < 2; ++ai) { u32x4 gw[4][2], tw[4][2];
#pragma unroll
            for (int m = 0; m < 4; ++m) { const int row = row0 + ai * HALF + m * 16;
#pragma unroll
                for (int bj = 0; bj < 2; ++bj) { gw[m][bj] = *(const u32x4*)(gate + (size_t)row * NP + col0 + bj * HALF);
                    tw[m][bj] = (u32x4){0u, 0u, 0u, 0u}; if (u.pz) tw[m][bj] = *(const u32x4*)(tmp + (size_t)row * D + col0 + bj * HALF); } }
#pragma unroll
            for (int m = 0; m < 4; ++m) { const int row = row0 + ai * HALF + m * 16;
#pragma unroll
                for (int bj = 0; bj < 2; ++bj) { const u32x4 g_ = gw[m][bj], t_ = tw[m][bj];
                    const f32x4 v0 = acc[ai][bj][m][0], v1 = acc[ai][bj][m][1]; f32x4 o0, o1;
                    o0[0] = lo_bf(t_.x) + v0[0] * sigmoidf_(lo_bf(g_.x)); o0[1] = hi_bf(t_.x) + v0[1] * sigmoidf_(hi_bf(g_.x)); o0[2] = lo_bf(t_.y) + v0[2] * sigmoidf_(lo_bf(g_.y)); o0[3] = hi_bf(t_.y) + v0[3] * sigmoidf_(hi_bf(g_.y));
                    o1[0] = lo_bf(t_.z) + v1[0] * sigmoidf_(lo_bf(g_.z)); o1[1] = hi_bf(t_.z) + v1[1] * sigmoidf_(hi_bf(g_.z)); o1[2] = lo_bf(t_.w) + v1[2] * sigmoidf_(lo_bf(g_.w)); o1[3] = hi_bf(t_.w) + v1[3] * sigmoidf_(hi_bf(g_.w));
                    u32x4 w; w.x = cvt_pk_bf16(o0[0], o0[1]); w.y = cvt_pk_bf16(o0[2], o0[3]); w.z = cvt_pk_bf16(o1[0], o1[1]); w.w = cvt_pk_bf16(o1[2], o1[3]);
                    *(u32x4*)(dst + (size_t)row * D + col0 + bj * HALF) = w; } }
            asm volatile("" ::: "memory"); }
    }
};
}

#define XB_TMO      128
#define XB_XCNT(j)  (256  + 64 * (j))
#define XB_XSUB(j)  (1280 + 64 * (j))
#define XB_XGEN(j)  (2304 + 64 * (j))
#define XB_TOP      3328
#define XB_TOPGEN   3392
#define XCD_BAR_WORDS 3456
#define XB_SPIN_CAP (1u << 18)
__device__ __forceinline__ unsigned xb_ld(unsigned* p)              { return __hip_atomic_load(p, __ATOMIC_RELAXED, __HIP_MEMORY_SCOPE_AGENT); }
__device__ __forceinline__ unsigned xb_add(unsigned* p, unsigned v) { return __hip_atomic_fetch_add(p, v, __ATOMIC_RELAXED, __HIP_MEMORY_SCOPE_AGENT); }
__device__ __forceinline__ unsigned xb_xcc_id() { return (unsigned)__builtin_amdgcn_s_getreg((3 << 11) | 20) & 0xFu; }
#define XB_SPIN(cond, bar) do { unsigned _sp = 0; while (cond) { __builtin_amdgcn_s_sleep(1); \
    if ((++_sp & 255u) == 0u) { if (xb_ld(&(bar)[XB_TMO])) break; if (_sp > XB_SPIN_CAP) { atomicAdd(&(bar)[XB_TMO], 1u); break; } } } } while (0)
struct XcdBarrier { unsigned* bar; unsigned x; volatile LAS unsigned* st; };
__device__ __forceinline__ XcdBarrier xcd_barrier_post(unsigned* bar, volatile LAS unsigned* st) {
    XcdBarrier b; b.bar = bar; b.x = xb_xcc_id(); b.st = st;
    if (threadIdx.x == 0) (void)xb_add(&bar[XB_XCNT(b.x)], 1u);
    return b;
}
__device__ __forceinline__ void xcd_barrier_complete(unsigned* bar, unsigned x, unsigned& nloc, unsigned& nx) {
    const unsigned G = gridDim.x * gridDim.y * gridDim.z;
    unsigned sum, cnt, mine, sp = 0u;
    for (;;) {
        sum = 0u; cnt = 0u; mine = 0u;
#pragma unroll
        for (unsigned j = 0; j < 16; ++j) { const unsigned c = xb_ld(&bar[XB_XCNT(j)]); sum += c; cnt += (c > 0u) ? 1u : 0u; mine = (j == x) ? c : mine; }
        if (sum == G) break;
        __builtin_amdgcn_s_sleep(1);
        if ((++sp & 255u) == 0u) { if (xb_ld(&bar[XB_TMO])) break; if (sp > XB_SPIN_CAP) { atomicAdd(&bar[XB_TMO], 1u); break; } }
    }
    nloc = mine > 0u ? mine : 1u; nx = cnt > 0u ? cnt : 1u;
}
__device__ __forceinline__ void xcd_barrier(const XcdBarrier& b) {
    asm volatile("s_waitcnt vmcnt(0)" ::: "memory");
    __syncthreads();
    if (threadIdx.x == 0) {
        unsigned* bar = b.bar;
        __builtin_amdgcn_s_waitcnt(0);
        unsigned nloc = b.st[0], nx = b.st[1];
        if (nloc == 0u) { xcd_barrier_complete(bar, b.x, nloc, nx); b.st[0] = nloc; b.st[1] = nx; }
        const unsigned old = xb_add(&bar[XB_XSUB(b.x)], 1u);
        const unsigned gen = old / nloc;
        if (old + 1u == (gen + 1u) * nloc) {
            __builtin_amdgcn_fence(__ATOMIC_RELEASE, "agent");
            asm volatile("s_waitcnt vmcnt(0)" ::: "memory");
            const unsigned og = xb_add(&bar[XB_TOP], 1u);
            const unsigned tg = og / nx;
            if (og + 1u == (tg + 1u) * nx) xb_add(&bar[XB_TOPGEN], 1u);
            else XB_SPIN(xb_ld(&bar[XB_TOPGEN]) == tg, bar);
            __builtin_amdgcn_fence(__ATOMIC_ACQUIRE, "agent");
            xb_add(&bar[XB_XGEN(b.x)], 1u);
            asm volatile("s_waitcnt vmcnt(0)" ::: "memory");
        } else {
            XB_SPIN(xb_ld(&bar[XB_XGEN(b.x)]) == gen, bar);
            __builtin_amdgcn_fence(__ATOMIC_ACQUIRE, "agent");
            asm volatile("s_waitcnt vmcnt(0)" ::: "memory");
        }
    }
    __syncthreads();
}

struct Args {
    const float *x, *norm_w, *w_in, *cmp_pe, *cmp_w1, *cmp_b1, *cmp_w2, *cmp_b2, *alpha_w, *alpha_b, *gla_norm_w, *p_a, *p_b, *w_out, *final_w;
    float* out; unsigned char* ws; int ph_lo, ph_hi;
};
typedef const __attribute__((address_space(4))) Args* KArgsP;
DI Args load_args(KArgsP p) { Args a; a.x = p->x; a.norm_w = p->norm_w; a.w_in = p->w_in; a.cmp_pe = p->cmp_pe; a.cmp_w1 = p->cmp_w1; a.cmp_b1 = p->cmp_b1; a.cmp_w2 = p->cmp_w2; a.cmp_b2 = p->cmp_b2;
    a.alpha_w = p->alpha_w; a.alpha_b = p->alpha_b; a.gla_norm_w = p->gla_norm_w; a.p_a = p->p_a; a.p_b = p->p_b; a.w_out = p->w_out; a.final_w = p->final_w; a.out = p->out; a.ws = p->ws; a.ph_lo = 0; a.ph_hi = 0; return a; }
struct Frame {
    LAS unsigned char* lds; int tid, lane, wave, G, bid, gw, NGW;
};

struct CvItem { const float* W; bf16_t* WT; int K, N, item; bool map; };
DI void cv_load(f32x4 (&v)[16], const CvItem& c, int lane) {
    const int nblk = c.N / 64, kb = c.item / nblk, nb = c.item % nblk, k0 = 64 * kb, n0 = 64 * nb;
#pragma unroll
    for (int i = 0; i < 16; ++i) v[i] = *(const f32x4*)(c.W + (size_t)(k0 + 4 * i + (lane >> 4)) * c.N + n0 + 4 * (lane & 15));
}
DI void cv_store(const f32x4 (&v)[16], const CvItem& c, LAS float* scr, int lane) {
    const int nblk = c.N / 64, kb = c.item / nblk, nb = c.item % nblk, k0 = 64 * kb, n0 = 64 * nb;
#pragma unroll
    for (int i = 0; i < 16; ++i) { LAS float* d = scr + (4 * i + (lane >> 4)) * 65 + 4 * (lane & 15); d[0] = v[i].x; d[1] = v[i].y; d[2] = v[i].z; d[3] = v[i].w; }
    LDS_WAIT(); asm volatile("" ::: "memory");
    const int ch = lane & 7;
#pragma unroll
    for (int j = 0; j < 8; ++j) { const int n = (lane >> 3) + 8 * j; const LAS float* s = scr + (8 * ch) * 65 + n;
        u32x4 o; o.x = pk2(s[0 * 65], s[1 * 65]); o.y = pk2(s[2 * 65], s[3 * 65]); o.z = pk2(s[4 * 65], s[5 * 65]); o.w = pk2(s[6 * 65], s[7 * 65]);
        const int drow = c.map ? map_col(n0 + n) : (n0 + n);
        *(u32x4*)(c.WT + (size_t)drow * c.K + k0 + 8 * ch) = o; }
    LDS_WAIT(); asm volatile("" ::: "memory");
}
constexpr int CV_IN = (D / 64) * (NIN / 64), CV_SQ = (D / 64) * (D / 64), CV_W1 = (4096 / 64) * (256 / 64), CV_W2 = (256 / 64) * (128 / 64);
constexpr int CV_PER_L = CV_IN + 3 * CV_SQ + 2 * CV_W1 + 2 * CV_W2;
DI CvItem cv_item(const Args& a, int it) {
    unsigned char* ws = a.ws; const int l = it / CV_PER_L; int r = it % CV_PER_L; CvItem c;
    if (r < CV_IN) { c.W = a.w_in + (size_t)l * D * NIN; c.WT = (bf16_t*)(ws + WS_WIN) + (size_t)l * NP * D; c.K = D; c.N = NIN; c.item = r; c.map = true; return c; } r -= CV_IN;
    c.map = false;
    if (r < CV_SQ) { c.W = a.p_a + (size_t)l * D * D; c.WT = (bf16_t*)(ws + WS_WPA) + (size_t)l * D * D; c.K = D; c.N = D; c.item = r; return c; } r -= CV_SQ;
    if (r < CV_SQ) { c.W = a.p_b + (size_t)l * D * D; c.WT = (bf16_t*)(ws + WS_WPB) + (size_t)l * D * D; c.K = D; c.N = D; c.item = r; return c; } r -= CV_SQ;
    if (r < CV_SQ) { c.W = a.w_out + (size_t)l * D * D; c.WT = (bf16_t*)(ws + WS_WOUT) + (size_t)l * D * D; c.K = D; c.N = D; c.item = r; return c; } r -= CV_SQ;
    if (r < 2 * CV_W1) { const int kv = r / CV_W1; c.W = a.cmp_w1 + (size_t)(l * 2 + kv) * 4096 * 256; c.WT = (bf16_t*)(ws + WS_W1T) + (size_t)(l * 2 + kv) * 256 * 4096; c.K = 4096; c.N = 256; c.item = r % CV_W1; return c; } r -= 2 * CV_W1;
    { const int kv = r / CV_W2; c.W = a.cmp_w2 + (size_t)(l * 2 + kv) * 256 * 128; c.WT = (bf16_t*)(ws + WS_W2T) + (size_t)(l * 2 + kv) * 128 * 256; c.K = 256; c.N = 128; c.item = r % CV_W2; }
    return c;
}
DI void p_prologue(const Frame& F, const Args& a) {
    LAS float* scr = (LAS float*)(F.lds + F.wave * 16640);
    unsigned char* ws = a.ws;
    constexpr int TOT = DEPTH * CV_PER_L;
    f32x4 va[16], vb[16];
    int it = F.gw;
    if (it < TOT) { CvItem ca = cv_item(a, it); cv_load(va, ca, F.lane);
        for (;;) {
            const int itb = it + F.NGW; CvItem cb; const bool hb = itb < TOT; if (hb) { cb = cv_item(a, itb); cv_load(vb, cb, F.lane); }
            cv_store(va, ca, scr, F.lane);
            if (!hb) break;
            const int itc = itb + F.NGW; const bool hc = itc < TOT; if (hc) { ca = cv_item(a, itc); cv_load(va, ca, F.lane); }
            cv_store(vb, cb, scr, F.lane);
            if (!hc) break;
            it = itc;
        } }
    __syncthreads();
    LAS float* red = (LAS float*)F.lds;
    for (int job = F.bid; job < DEPTH * 2; job += F.G) {
        const float* w1 = a.cmp_w1 + (size_t)job * 4096 * 256; const float* pe = a.cmp_pe + (size_t)job * 4096;
        f32x4 s = {0.f, 0.f, 0.f, 0.f};
        for (int k = F.wave * 512; k < F.wave * 512 + 512; ++k) { const f32x4 w = *(const f32x4*)(w1 + (size_t)k * 256 + 4 * F.lane); s += w * pe[k]; }
        *(LAS f32x4*)(red + F.wave * 256 + 4 * F.lane) = s;
        __syncthreads();
        if (F.tid < 256) { float t = a.cmp_b1[job * 256 + F.tid];
#pragma unroll
            for (int w = 0; w < 8; ++w) t += red[w * 256 + F.tid];
            ((float*)(ws + WS_B1P))[job * 256 + F.tid] = t; }
        __syncthreads();
    }
}

template <bool OUT_F32>
DI void p_rmsnorm(const Frame& F, const float* x, const float* w, void* out) {
    f32x4 wv[8];
#pragma unroll
    for (int j = 0; j < 8; ++j) wv[j] = *(const f32x4*)(w + 4 * F.lane + 256 * j);
    for (int row = F.gw; row < T; row += F.NGW) {
        const float* xr = x + (size_t)row * D + 4 * F.lane;
        f32x4 v[8]; float s = 0.f;
#pragma unroll
        for (int j = 0; j < 8; ++j) { v[j] = *(const f32x4*)(xr + 256 * j); s += (v[j].x * v[j].x + v[j].y * v[j].y) + (v[j].z * v[j].z + v[j].w * v[j].w); }
        const float rs = rsqrtf(wave_sum(s, F.lane) * (1.f / D) + NORM_EPS);
        if (OUT_F32) { float* o = (float*)out + (size_t)row * D + 4 * F.lane;
#pragma unroll
            for (int j = 0; j < 8; ++j) *(f32x4*)(o + 256 * j) = v[j] * rs * wv[j];
        } else { bf16_t* o = (bf16_t*)out + (size_t)row * D + 4 * F.lane;
#pragma unroll
            for (int j = 0; j < 8; ++j) { const f32x4 y = v[j] * rs * wv[j]; u32x2 p; p.x = pk2(y.x, y.y); p.y = pk2(y.z, y.w); *(u32x2*)(o + 256 * j) = p; } }
    }
}

constexpr int KTILE = 16384, VTILE = 16384, ABUF = KTILE + VTILE;
DI void glds16(const void* gsrc, LAS unsigned char* dst) { unsigned keep; const unsigned lds_dst = (unsigned)(uintptr_t)dst;
    asm volatile("s_mov_b32 %0, m0\n\ts_mov_b32 m0, %2\n\ts_nop 0\n\tglobal_load_lds_dwordx4 %1, off\n\ts_mov_b32 m0, %0" : "=&s"(keep) : "v"(gsrc), "s"(lds_dst) : "memory"); }
DI void dma_k(LAS unsigned char* kb, const bf16_t* kbase, size_t kpitch, int w, int lane) {
#pragma unroll
    for (int i = 0; i < 2; ++i) { const int b = w + 8 * i, row = 4 * b + (lane >> 4), c = (lane & 15) ^ (row & 15);
        glds16(kbase + (size_t)row * kpitch + c * 8, kb + b * 1024); }
}
DI void dma_v(LAS unsigned char* vb, const bf16_t* vbase, size_t vpitch, int w, int lane) {
#pragma unroll
    for (int i = 0; i < 2; ++i) { const int b = w + 8 * i, row = 8 * b + (lane >> 3), c = (lane & 7) ^ ((row >> 1) & 7);
        glds16(vbase + (size_t)row * vpitch + c * 8, vb + b * 1024); }
}
#define VMCNT(n) asm volatile("s_waitcnt vmcnt(" #n ")" ::: "memory")
#define RAW_BARRIER() do { asm volatile("" ::: "memory"); __builtin_amdgcn_s_barrier(); asm volatile("" ::: "memory"); } while (0)

template <bool PERMK>
DI void transpose64x64(const bf16_t* src, size_t pitch, bf16_t* dst, LAS unsigned char* scr, int lane) {
    u32x4 v[8];
#pragma unroll
    for (int i = 0; i < 8; ++i) { const int id = i * 64 + lane, row = id >> 3, ch = id & 7; v[i] = *(const u32x4*)(src + (size_t)row * pitch + ch * 8); }
#pragma unroll
    for (int i = 0; i < 8; ++i) { const int id = i * 64 + lane, row = id >> 3, ch = id & 7;
        const int pos = PERMK ? ((row & 32) | (((row >> 2) & 3) << 3) | (((row >> 4) & 1) << 2) | (row & 3)) : row;
        LAS unsigned char* d = scr + (8 * ch) * 136 + pos * 2;
        *(LAS unsigned short*)(d + 0 * 136) = (unsigned short)(v[i].x & 0xffffu); *(LAS unsigned short*)(d + 1 * 136) = (unsigned short)(v[i].x >> 16);
        *(LAS unsigned short*)(d + 2 * 136) = (unsigned short)(v[i].y & 0xffffu); *(LAS unsigned short*)(d + 3 * 136) = (unsigned short)(v[i].y >> 16);
        *(LAS unsigned short*)(d + 4 * 136) = (unsigned short)(v[i].z & 0xffffu); *(LAS unsigned short*)(d + 5 * 136) = (unsigned short)(v[i].z >> 16);
        *(LAS unsigned short*)(d + 6 * 136) = (unsigned short)(v[i].w & 0xffffu); *(LAS unsigned short*)(d + 7 * 136) = (unsigned short)(v[i].w >> 16); }
    LDS_WAIT(); asm volatile("" ::: "memory");
#pragma unroll
    for (int i = 0; i < 8; ++i) { const int id = i * 64 + lane, col = id >> 3, tg = id & 7;
        const u32x2 lo = *(const LAS u32x2*)(scr + col * 136 + tg * 16), hi = *(const LAS u32x2*)(scr + col * 136 + tg * 16 + 8);
        u32x4 o; o.x = lo.x; o.y = lo.y; o.z = hi.x; o.w = hi.y;
        *(u32x4*)(dst + (size_t)col * 64 + 8 * tg) = o; }
    LDS_WAIT(); asm volatile("" ::: "memory");
}

DI void gla_g1_unit(const Frame& F, const Args& a, int layer, int n, int h) {
    const bf16_t* cols = (const bf16_t*)(a.ws + WS_COLS);
    LAS float* alr = (LAS float*)(F.lds); LAS float* part = (LAS float*)(F.lds + 4096);
    LAS unsigned char* QR = F.lds + 8192; LAS unsigned char* KR = F.lds + 8192 + 32768;
    __syncthreads();
#pragma unroll
    for (int hf = 0; hf < 2; ++hf) { dma_k(QR + hf * 16384, cols + (size_t)(64 * n) * NP + C_QB + h * 256 + hf * 128, NP, F.wave, F.lane);
        dma_k(KR + hf * 16384, cols + (size_t)(64 * n) * NP + C_KB + h * 256 + hf * 128, NP, F.wave, F.lane); }
    if (F.tid < 256) { const int t = F.tid >> 2, k4 = (F.tid & 3) * 4; const u32x2 w = *(const u32x2*)(cols + (size_t)(64 * n + t) * NP + C_ALR + k4);
        alr[t * 16 + k4 + 0] = lo_bf(w.x); alr[t * 16 + k4 + 1] = hi_bf(w.x); alr[t * 16 + k4 + 2] = lo_bf(w.y); alr[t * 16 + k4 + 3] = hi_bf(w.y); }
    __syncthreads();
    const int d = F.tid & 255, half = F.tid >> 8, col = h * 256 + d;
    float w[16];
#pragma unroll
    for (int k = 0; k < 16; ++k) w[k] = a.alpha_w[(size_t)(layer * 16 + k) * 1024 + col];
    const float b = a.alpha_b[layer * 1024 + col];
    float cum[32]; float run = 0.f;
#pragma unroll
    for (int i = 0; i < 32; ++i) { const int t = half * 32 + i; float ga = b;
#pragma unroll
        for (int k4 = 0; k4 < 4; ++k4) { const f32x4 av = *(const LAS f32x4*)(alr + t * 16 + 4 * k4); ga += av.x * w[4 * k4] + av.y * w[4 * k4 + 1] + av.z * w[4 * k4 + 2] + av.w * w[4 * k4 + 3]; }
        const float ls = fminf(ga, 0.f) - __logf(1.f + __expf(-fabsf(ga)));
        run += ls * 0.0625f; cum[i] = run; }
    part[half * 256 + d] = run;
    VMCNT(0);
    __syncthreads();
    const float p0 = part[d], last = p0 + part[256 + d], elast = __expf(last);
    if (half) {
#pragma unroll
        for (int i = 0; i < 32; ++i) cum[i] += p0; }
    bf16_t* kst = (bf16_t*)(a.ws + WS_KST);
    const int eoff = (d >> 7) * 16384 + (d & 7) * 2, ech = (d & 127) >> 3;
    unsigned ksw[16];
#pragma unroll
    for (int i = 0; i < 32; ++i) { const int t = half * 32 + i; const int off = eoff + t * 256 + ((ech ^ (t & 15)) << 4);
        const float qv = bf2f(*(const LAS unsigned short*)(QR + off)), kv = bf2f(*(const LAS unsigned short*)(KR + off));
        const float ec = __expf(cum[i]), kin = kv * __expf(-cum[i]);
        const unsigned qb = f2bf(qv * 0.0625f * ec), kib = f2bf(kin), ksb = f2bf(kin * elast);
        *(LAS unsigned short*)(QR + off) = (unsigned short)qb; *(LAS unsigned short*)(KR + off) = (unsigned short)kib;
        if (i & 1) ksw[i >> 1] |= ksb << 16; else ksw[i >> 1] = ksb; }
    { bf16_t* kp = kst + ((size_t)((n * 4 + h) * 256 + d)) * 64 + half * 32;
#pragma unroll
        for (int j = 0; j < 4; ++j) { u32x4 o; o.x = ksw[4 * j]; o.y = ksw[4 * j + 1]; o.z = ksw[4 * j + 2]; o.w = ksw[4 * j + 3]; *(u32x4*)(kp + 8 * j) = o; } }
    if (half == 0) ((float*)(a.ws + WS_DEC))[(n * 4 + h) * 256 + d] = elast;
    __syncthreads();
    { bf16_t* qdec = (bf16_t*)(a.ws + WS_QDEC);
#pragma unroll
        for (int i = 0; i < 4; ++i) { const int id = F.tid + 512 * i, t = id >> 5, c32 = id & 31, hf = c32 >> 4, c = c32 & 15;
            *(u32x4*)(qdec + (size_t)(64 * n + t) * 1024 + h * 256 + c32 * 8) = *(const LAS u32x4*)(QR + hf * 16384 + t * 256 + ((c ^ (t & 15)) << 4)); } }
    bf16_t* att = (bf16_t*)(a.ws + WS_ATT) + (size_t)(n * 4 + h) * 4096;
    const int fr = F.lane & 15, fq = F.lane >> 4, ms = F.wave >> 1;
#pragma unroll
    for (int z = 0; z < 2; ++z) { const int nt = 2 * (F.wave & 1) + z; f32x4 acc = {0.f, 0.f, 0.f, 0.f};
#pragma unroll
        for (int ks = 0; ks < 8; ++ks) { const int fo = (ks >> 2) * 16384 + (((4 * (ks & 3) + fq) ^ fr) << 4);
            const bf16x8 A = *(const LAS bf16x8*)(KR + fo + (16 * ms + fr) * 256);
            const bf16x8 B = *(const LAS bf16x8*)(QR + fo + (16 * nt + fr) * 256); acc = MFMA16(A, B, acc); }
        const int t = 16 * nt + fr, s0 = 16 * ms + 4 * fq;
        u32x2 o; o.x = pk2(s0 + 0 <= t ? acc[0] : 0.f, s0 + 1 <= t ? acc[1] : 0.f); o.y = pk2(s0 + 2 <= t ? acc[2] : 0.f, s0 + 3 <= t ? acc[3] : 0.f);
        *(u32x2*)(att + t * 64 + s0) = o; }
}

DI void transpose_unit(const Frame& F, const Args& a, int tu) {
    __syncthreads();
    const bf16_t* cols = (const bf16_t*)(a.ws + WS_COLS);
    LAS unsigned char* scr = F.lds + F.wave * 9216;
#pragma unroll 1
    for (int rep = 0; rep < 3; ++rep) { const int it = (tu * 3 + rep) * 8 + F.wave;
    if (it < 4096) { const int n = it >> 5, cg = it & 31;
        transpose64x64<false>(cols + (size_t)(64 * n) * NP + C_VB + 64 * cg, NP, (bf16_t*)(a.ws + WS_VT) + ((size_t)n * 2048 + 64 * cg) * 64, scr, F.lane); }
    else { const int r = (it - 4096) & 1023, win = (it - 4096) >> 10, j = r >> 3, g = (r >> 1) & 3, hf = r & 1;
        transpose64x64<true>(cols + (size_t)(64 * j) * NP + (win ? C_VWIN : C_VSEL) + 128 * g + 64 * hf, NP,
                             (bf16_t*)(a.ws + (win ? WS_VWINT : WS_VSELT)) + ((size_t)(g * 128 + j) * 128 + 64 * hf) * 64, scr, F.lane); } }
}

DI float gelu_tanh(float x) { const float u = 0.7978845608028654f * (x + 0.044715f * x * x * x); const float t = __expf(2.f * u); return 0.5f * x * (2.f - 2.f / (t + 1.f)); }
DI void mlp2_unit(const Frame& F, const Args& a, int layer, int pz, int rt) {
    const float* cpart = (const float*)(a.ws + WS_CPART);
    LAS unsigned char* hid = F.lds;
    const int kv = pz >> 2, g = pz & 3;
    __syncthreads();
    { const int r = F.tid >> 5, c0 = (F.tid & 31) * 8; f32x4 s0, s1;
        const float* bp = (const float*)(a.ws + WS_B1P) + (layer * 2 + kv) * 256 + c0;
        s0 = *(const f32x4*)bp; s1 = *(const f32x4*)(bp + 4);
#pragma unroll
        for (int pk = 0; pk < 8; ++pk) { const float* p = cpart + ((size_t)(pk * 8 + pz) * 512 + rt * 16 + r) * 256 + c0; s0 += *(const f32x4*)p; s1 += *(const f32x4*)(p + 4); }
        u32x4 o; o.x = pk2(gelu_tanh(s0.x), gelu_tanh(s0.y)); o.y = pk2(gelu_tanh(s0.z), gelu_tanh(s0.w)); o.z = pk2(gelu_tanh(s1.x), gelu_tanh(s1.y)); o.w = pk2(gelu_tanh(s1.z), gelu_tanh(s1.w));
        *(LAS u32x4*)(hid + r * 528 + c0 * 2) = o; }
    __syncthreads();
    const bf16_t* w2t = (const bf16_t*)(a.ws + WS_W2T) + (size_t)(layer * 2 + kv) * 128 * 256;
    const int fr = F.lane & 15, fq = F.lane >> 4, dt = F.wave;
    const float* b2 = a.cmp_b2 + (layer * 2 + kv) * 128;
    f32x4 acc = {0.f, 0.f, 0.f, 0.f};
#pragma unroll
    for (int ks = 0; ks < 8; ++ks) { const bf16x8 wf = *(const bf16x8*)(w2t + (16 * dt + fr) * 256 + 32 * ks + 8 * fq);
        const bf16x8 hf = *(const LAS bf16x8*)(hid + fr * 528 + (32 * ks + 8 * fq) * 2);
        acc = kv ? MFMA16(hf, wf, acc) : MFMA16(wf, hf, acc); }
    if (!kv) { const int n = 16 * rt + fr, dim = 16 * dt + 4 * fq; const f32x4 bb = *(const f32x4*)(b2 + dim); u32x2 o;
        if (n == 511) { o.x = 0u; o.y = 0u; } else { o.x = pk2(acc[0] + bb.x, acc[1] + bb.y); o.y = pk2(acc[2] + bb.z, acc[3] + bb.w); }
        *(u32x2*)((bf16_t*)(a.ws + WS_KC) + ((size_t)g * 512 + n) * 128 + dim) = o; }
    else { const int n0 = 16 * rt + 4 * fq, dim = 16 * dt + fr; const float bb = b2[dim]; u32x2 o;
        o.x = pk2(acc[0] + bb, acc[1] + bb); o.y = pk2(acc[2] + bb, (n0 + 3 == 511) ? 0.f : acc[3] + bb);
        const int pos = 64 * (rt >> 2) + 32 * ((rt & 3) >> 1) + 8 * fq + 4 * (rt & 1);
        *(u32x2*)((bf16_t*)(a.ws + WS_VCT) + ((size_t)g * 128 + dim) * 512 + pos) = o; }
}

template <int ACT>
DI void qk_tile(f32x4 (&s)[4][2], const LAS unsigned char* kb, const bf16x8 (&qf)[2][4], int fr, int fq) {
    const LAS unsigned char* kr = kb + fr * 256; const int x0 = (fq ^ fr) << 4, x1 = ((4 + fq) ^ fr) << 4, x2 = ((8 + fq) ^ fr) << 4, x3 = ((12 + fq) ^ fr) << 4;
    const f32x4 zero = {0.f, 0.f, 0.f, 0.f};
#pragma unroll
    for (int kt = 0; kt < 4; ++kt) { const LAS unsigned char* kn = kr + kt * 4096; bf16x8 kf[4];
        kf[0] = *(const LAS bf16x8*)(kn + x0); kf[1] = *(const LAS bf16x8*)(kn + x1); kf[2] = *(const LAS bf16x8*)(kn + x2); kf[3] = *(const LAS bf16x8*)(kn + x3);
        if (ACT & 1) { s[kt][0] = MFMA16(kf[0], qf[0][0], zero); } if (ACT & 2) { s[kt][1] = MFMA16(kf[0], qf[1][0], zero); }
#pragma unroll
        for (int ks = 1; ks < 4; ++ks) { if (ACT & 1) s[kt][0] = MFMA16(kf[ks], qf[0][ks], s[kt][0]); if (ACT & 2) s[kt][1] = MFMA16(kf[ks], qf[1][ks], s[kt][1]); }
    }
}
template <int ACT, bool WITH_L = true>
DI void pv_tile(f32x4 (&O)[8][2], f32x4 (&L)[2], const LAS unsigned char* vb, const bf16x8 (&pf)[2][2], int fr, int fq) {
    const LAS unsigned char* vr = vb + fr * 128; const int x = (fr >> 1) & 7, y0 = (fq ^ x) << 4, y1 = ((4 + fq) ^ x) << 4;
    const bf16x8 ones = {0x3f80, 0x3f80, 0x3f80, 0x3f80, 0x3f80, 0x3f80, 0x3f80, 0x3f80};
    if (WITH_L && (ACT & 1)) { L[0] = MFMA16(ones, pf[0][0], L[0]); L[0] = MFMA16(ones, pf[1][0], L[0]); }
    if (WITH_L && (ACT & 2)) { L[1] = MFMA16(ones, pf[0][1], L[1]); L[1] = MFMA16(ones, pf[1][1], L[1]); }
#pragma unroll
    for (int dt = 0; dt < 8; ++dt) {
        const bf16x8 v0 = *(const LAS bf16x8*)(vr + dt * 2048 + y0), v1 = *(const LAS bf16x8*)(vr + dt * 2048 + y1);
        if (ACT & 1) O[dt][0] = MFMA16(v0, pf[0][0], O[dt][0]); if (ACT & 2) O[dt][1] = MFMA16(v0, pf[0][1], O[dt][1]);
        if (ACT & 1) O[dt][0] = MFMA16(v1, pf[1][0], O[dt][0]); if (ACT & 2) O[dt][1] = MFMA16(v1, pf[1][1], O[dt][1]);
    }
}
DI float max3f(float a, float b, float c) { return fmaxf(fmaxf(a, b), c); }
DI bf16x8 pack_p(const f32x4& a, const f32x4& b) { u32x4 w; w.x = cvt_pk_bf16(a[0], a[1]); w.y = cvt_pk_bf16(a[2], a[3]); w.z = cvt_pk_bf16(b[0], b[1]); w.w = cvt_pk_bf16(b[2], b[3]); return __builtin_bit_cast(bf16x8, w); }
DI float quad_max(float v, int lane) {
    auto r = __builtin_amdgcn_permlane16_swap(__float_as_uint(v), __float_as_uint(v), false, false); v = fmaxf(__uint_as_float(r[0]), __uint_as_float(r[1]));
    r = __builtin_amdgcn_permlane32_swap(__float_as_uint(v), __float_as_uint(v), false, false); return fmaxf(__uint_as_float(r[0]), __uint_as_float(r[1])); }
DI float quad_sum(float v, int lane) {
    auto r = __builtin_amdgcn_permlane16_swap(__float_as_uint(v), __float_as_uint(v), false, false); v = __uint_as_float(r[0]) + __uint_as_float(r[1]);
    r = __builtin_amdgcn_permlane32_swap(__float_as_uint(v), __float_as_uint(v), false, false); return __uint_as_float(r[0]) + __uint_as_float(r[1]); }
constexpr float NEG_INF = -__builtin_inff();

template <int MODE, int ACT>
DI void fa_tile(f32x4 (&O)[8][2], f32x4 (&L)[2], float (&m)[2], const bf16x8 (&qf)[2][4], const LAS unsigned char* kb, const LAS unsigned char* vb,
                const bool (&bit)[2], const int (&tokl)[2], bool diag, bool left, int fr, int fq, int lane) {
    f32x4 s[4][2];
    qk_tile<ACT>(s, kb, qf, fr, fq);
    bf16x8 pf[2][2];
#pragma unroll
    for (int ct = 0; ct < 2; ++ct) {
        if (!((ACT >> ct) & 1)) continue;
        if (diag || left) {
            const int thr_hi = diag ? tokl[ct] : 63, thr_lo = left ? tokl[ct] : -1;
            int kq = 4 * fq; asm volatile("" : "+v"(kq));
#pragma unroll
            for (int kt = 0; kt < 4; ++kt)
#pragma unroll
                for (int r = 0; r < 4; ++r) { const int kl = 16 * kt + kq + r;
                    s[kt][ct][r] = (kl <= thr_hi && kl > thr_lo) ? s[kt][ct][r] : NEG_INF; } }
        float mx = max3f(s[0][ct][0], s[0][ct][1], s[0][ct][2]);
        mx = max3f(mx, s[0][ct][3], s[1][ct][0]); mx = max3f(mx, s[1][ct][1], s[1][ct][2]); mx = max3f(mx, s[1][ct][3], s[2][ct][0]); mx = max3f(mx, s[2][ct][1], s[2][ct][2]);
        mx = max3f(mx, s[2][ct][3], s[3][ct][0]); mx = max3f(mx, s[3][ct][1], s[3][ct][2]); mx = fmaxf(mx, s[3][ct][3]);
        mx = quad_max(mx, lane);
        if (MODE == 0 && !bit[ct]) mx = NEG_INF;
        if (__ballot((mx - m[ct]) * ATT_C > 8.f) != 0ull) {
            const float mn = fmaxf(m[ct], mx), alpha = __builtin_amdgcn_exp2f((m[ct] - mn) * ATT_C); m[ct] = mn; L[ct] *= alpha;
#pragma unroll
            for (int dt = 0; dt < 8; ++dt) O[dt][ct] *= alpha; }
        const float mc = (MODE == 0 && !bit[ct]) ? __builtin_inff() : m[ct] * ATT_C;
#pragma unroll
        for (int kt = 0; kt < 4; ++kt)
#pragma unroll
            for (int r = 0; r < 4; ++r) s[kt][ct][r] = __builtin_amdgcn_exp2f(s[kt][ct][r] * ATT_C - mc);
        pf[0][ct] = pack_p(s[0][ct], s[1][ct]); pf[1][ct] = pack_p(s[2][ct], s[3][ct]);
    }
    pv_tile<ACT>(O, L, vb, pf, fr, fq);
}

template <int MODE>
DI bool fa_rowmax(float (&m)[2], float (&mc)[2], float (&alpha)[2], f32x4 (&s)[4][2], const bool (&bit)[2], const int (&tokl)[2], bool diag, bool left, int fq, int lane) {
    bool need = false;
#pragma unroll
    for (int ct = 0; ct < 2; ++ct) {
        if (diag || left) {
            const int thr_hi = diag ? tokl[ct] : 63, thr_lo = left ? tokl[ct] : -1;
            int kq = 4 * fq; asm volatile("" : "+v"(kq));
#pragma unroll
            for (int kt = 0; kt < 4; ++kt)
#pragma unroll
                for (int r = 0; r < 4; ++r) { const int kl = 16 * kt + kq + r; s[kt][ct][r] = (kl <= thr_hi && kl > thr_lo) ? s[kt][ct][r] : NEG_INF; } }
        float mx = max3f(s[0][ct][0], s[0][ct][1], s[0][ct][2]);
        mx = max3f(mx, s[0][ct][3], s[1][ct][0]); mx = max3f(mx, s[1][ct][1], s[1][ct][2]); mx = max3f(mx, s[1][ct][3], s[2][ct][0]); mx = max3f(mx, s[2][ct][1], s[2][ct][2]);
        mx = max3f(mx, s[2][ct][3], s[3][ct][0]); mx = max3f(mx, s[3][ct][1], s[3][ct][2]); mx = fmaxf(mx, s[3][ct][3]);
        mx = quad_max(mx, lane);
        if (MODE == 0 && !bit[ct]) mx = NEG_INF;
        alpha[ct] = 1.f;
        if (__ballot((mx - m[ct]) * ATT_C > 8.f) != 0ull) { const float mn = fmaxf(m[ct], mx); alpha[ct] = __builtin_amdgcn_exp2f((m[ct] - mn) * ATT_C); m[ct] = mn; need = true; }
        mc[ct] = (MODE == 0 && !bit[ct]) ? __builtin_inff() : m[ct] * ATT_C;
    }
    return need;
}
template <bool HAS_PREV>
DI void fa_exp_pv(f32x4 (&s)[4][2], const float (&mc)[2], bf16x8 (&pfc)[2][2], f32x4 (&O)[8][2], f32x4 (&L)[2], const bf16x8 (&pfp)[2][2], const LAS unsigned char* vbp, int fr, int fq) {
#define FA_EXP1(e) do { if ((e) < 32) { const int _ct = (e) >> 4, _kt = ((e) >> 2) & 3, _r = (e) & 3; s[_kt][_ct][_r] = __builtin_amdgcn_exp2f(s[_kt][_ct][_r] * ATT_C - mc[_ct]); } \
        if ((e) == 8) pfc[0][0] = pack_p(s[0][0], s[1][0]); if ((e) == 16) pfc[1][0] = pack_p(s[2][0], s[3][0]); \
        if ((e) == 24) pfc[0][1] = pack_p(s[0][1], s[1][1]); if ((e) == 32) pfc[1][1] = pack_p(s[2][1], s[3][1]); } while (0)
    if (!HAS_PREV) {
#pragma unroll
        for (int e = 0; e <= 32; ++e) FA_EXP1(e);
    } else {
        const LAS unsigned char* vr = vbp + fr * 128; const int x = (fr >> 1) & 7, y0 = (fq ^ x) << 4, y1 = ((4 + fq) ^ x) << 4;
        const bf16x8 ones = {0x3f80, 0x3f80, 0x3f80, 0x3f80, 0x3f80, 0x3f80, 0x3f80, 0x3f80};
        bf16x8 vf[2][2];
        vf[0][0] = *(const LAS bf16x8*)(vr + y0); vf[0][1] = *(const LAS bf16x8*)(vr + y1);
#define FA_SLOT(mfma_stmt, e) do { mfma_stmt; FA_EXP1(e); __builtin_amdgcn_sched_barrier(0); } while (0)
        FA_SLOT(L[0] = MFMA16(ones, pfp[0][0], L[0]), 0); FA_SLOT(L[1] = MFMA16(ones, pfp[0][1], L[1]), 1);
        FA_SLOT(L[0] = MFMA16(ones, pfp[1][0], L[0]), 2); FA_SLOT(L[1] = MFMA16(ones, pfp[1][1], L[1]), 3);
#pragma unroll
        for (int dt = 0; dt < 8; ++dt) { const int cb = dt & 1, nb = cb ^ 1;
            if (dt < 7) { vf[nb][0] = *(const LAS bf16x8*)(vr + (dt + 1) * 2048 + y0); vf[nb][1] = *(const LAS bf16x8*)(vr + (dt + 1) * 2048 + y1); }
            FA_SLOT(O[dt][0] = MFMA16(vf[cb][0], pfp[0][0], O[dt][0]), 4 + 4 * dt); FA_SLOT(O[dt][1] = MFMA16(vf[cb][0], pfp[0][1], O[dt][1]), 5 + 4 * dt);
            FA_SLOT(O[dt][0] = MFMA16(vf[cb][1], pfp[1][0], O[dt][0]), 6 + 4 * dt); FA_SLOT(O[dt][1] = MFMA16(vf[cb][1], pfp[1][1], O[dt][1]), 7 + 4 * dt); }
#undef FA_SLOT
    }
#undef FA_EXP1
}

template <int MODE  >
DI void fa_chunk(const Frame& F, const Args& a, int c, int g) {
    const bf16_t* cols = (const bf16_t*)(a.ws + WS_COLS);
    const int fr = F.lane & 15, fq = F.lane >> 4, w = F.wave, tid = F.tid;
    LAS unsigned char* lds = F.lds;
    LAS int* list = (LAS int*)(lds + 4 * ABUF); LAS unsigned* maskw = (LAS unsigned*)(lds + 4 * ABUF + 1024);
    const bf16_t* kcol = cols + (MODE ? C_KWIN : C_KSEL) + 128 * g;
    const bf16_t* vT = (const bf16_t*)(a.ws + (MODE ? WS_VWINT : WS_VSELT)) + (size_t)g * 128 * 8192;
    __syncthreads();
    int ntile, j0 = 0;
    if (MODE == 0) {
        const unsigned* selm = (const unsigned*)(a.ws + WS_SELM);
        if (tid < 256) maskw[tid] = selm[((size_t)(64 * c + (tid >> 2)) * 4 + g) * 4 + (tid & 3)];
        __syncthreads();
        if (w == 0) { int base = 0;
#pragma unroll
            for (int hf = 0; hf < 2; ++hf) { const int j = hf * 64 + F.lane; unsigned orv = 0u;
                for (int tk = 0; tk < 64; ++tk) orv |= maskw[tk * 4 + (j >> 5)];
                const bool act = ((orv >> (j & 31)) & 1u) && (j <= c); const unsigned long long bl = __ballot(act);
                if (act) list[base + __popcll(bl & ((1ull << F.lane) - 1ull))] = j; base += __popcll(bl); }
            if (F.lane == 0) list[129] = base; }
        __syncthreads();
        ntile = list[129];
    } else { j0 = c > 8 ? c - 8 : 0; ntile = c - j0 + 1; }
    int tokl[2]; tokl[0] = 8 * w + (fr >> 2); tokl[1] = tokl[0] + 4;
    const int head = 4 * g + (fr & 3);
    bf16x8 qf[2][4];
#pragma unroll
    for (int ct = 0; ct < 2; ++ct)
#pragma unroll
        for (int ks = 0; ks < 4; ++ks) qf[ct][ks] = *(const bf16x8*)(cols + (size_t)(64 * c + tokl[ct]) * NP + C_QA + head * 128 + 32 * ks + 8 * fq);
    f32x4 O[8][2], L[2]; float m[2] = {-1e30f, -1e30f};
    L[0] = (f32x4){0.f, 0.f, 0.f, 0.f}; L[1] = L[0];
#pragma unroll
    for (int dt = 0; dt < 8; ++dt) { O[dt][0] = (f32x4){0.f, 0.f, 0.f, 0.f}; O[dt][1] = (f32x4){0.f, 0.f, 0.f, 0.f}; }
#define FA_TILE(t) (MODE ? j0 + (t) : list[(t)])
#define FA_ISSUE(t) do { const int _j = FA_TILE(t); LAS unsigned char* _b = lds + ((t) & 3) * ABUF; \
        dma_k(_b, kcol + (size_t)(64 * _j) * NP, NP, w, F.lane); dma_v(_b + KTILE, vT + (size_t)_j * 8192, 64, w, F.lane); } while (0)
    FA_ISSUE(0); if (ntile > 1) FA_ISSUE(1);
    f32x4 s[4][2]; bf16x8 pfp[2][2], pfc[2][2]; float mc[2], alpha[2]; bool bit[2] = {true, true};
    for (int t = 0; t < ntile; ++t) {
        if (t + 1 < ntile) VMCNT(4); else VMCNT(0);
        RAW_BARRIER();
        if (t + 2 < ntile) FA_ISSUE(t + 2);
        const int j = FA_TILE(t);
        qk_tile<3>(s, lds + (t & 3) * ABUF, qf, fr, fq);
        if (MODE == 0) {
#pragma unroll
            for (int ct = 0; ct < 2; ++ct) bit[ct] = (maskw[tokl[ct] * 4 + (j >> 5)] >> (j & 31)) & 1u; }
        const bool need = fa_rowmax<MODE>(m, mc, alpha, s, bit, tokl, j == c, (MODE == 1) && (j == c - 8), fq, F.lane);
        __builtin_amdgcn_sched_barrier(0);
        if (t > 0) fa_exp_pv<true>(s, mc, pfc, O, L, pfp, lds + ((t - 1) & 3) * ABUF + KTILE, fr, fq); else fa_exp_pv<false>(s, mc, pfc, O, L, pfp, lds, fr, fq);
        __builtin_amdgcn_sched_barrier(0);
        if (need) {
#pragma unroll
            for (int ct = 0; ct < 2; ++ct) { L[ct] *= alpha[ct];
#pragma unroll
                for (int dt = 0; dt < 8; ++dt) O[dt][ct] *= alpha[ct]; } }
#pragma unroll
        for (int ct = 0; ct < 2; ++ct) { pfp[0][ct] = pfc[0][ct]; pfp[1][ct] = pfc[1][ct]; }
    }
    pv_tile<3>(O, L, lds + ((ntile - 1) & 3) * ABUF + KTILE, pfp, fr, fq);
#undef FA_ISSUE
#undef FA_TILE
    bf16_t* out = (bf16_t*)(a.ws + (MODE ? WS_OWIN : WS_OSEL));
#pragma unroll
    for (int ct = 0; ct < 2; ++ct) { const float inv = 1.f / L[ct][0]; bf16_t* op = out + (size_t)(64 * c + tokl[ct]) * D + head * 128 + 4 * fq;
#pragma unroll
        for (int dt = 0; dt < 8; ++dt) { u32x2 o; o.x = pk2(O[dt][ct][0] * inv, O[dt][ct][1] * inv); o.y = pk2(O[dt][ct][2] * inv, O[dt][ct][3] * inv); *(u32x2*)(op + 16 * dt) = o; } }
}

DI void ca_chunk(const Frame& F, const Args& a, int c, int g) {
    const bf16_t* cols = (const bf16_t*)(a.ws + WS_COLS);
    const int fr = F.lane & 15, fq = F.lane >> 4, w = F.wave, tid = F.tid;
    LAS unsigned char* lds = F.lds;
    LAS float* pslc = (LAS float*)(lds + 2 * ABUF); LAS float* p3 = (LAS float*)(lds + 2 * ABUF + 32768);
    const bf16_t* kc = (const bf16_t*)(a.ws + WS_KC) + (size_t)g * 512 * 128;
    const bf16_t* vct = (const bf16_t*)(a.ws + WS_VCT) + (size_t)g * 128 * 512;
    const int ntile = ((4 * c + 2) >> 6) + 1;
    int tokl[2]; tokl[0] = 8 * w + (fr >> 2); tokl[1] = tokl[0] + 4;
    const int head = 4 * g + (fr & 3);
    int nlim[2];
#pragma unroll
    for (int ct = 0; ct < 2; ++ct) { const int t = 64 * c + tokl[ct]; nlim[ct] = t >= 31 ? ((t - 31) >> 4) : -1; }
    bf16x8 qf[2][4];
#pragma unroll
    for (int ct = 0; ct < 2; ++ct)
#pragma unroll
        for (int ks = 0; ks < 4; ++ks) qf[ct][ks] = *(const bf16x8*)(cols + (size_t)(64 * c + tokl[ct]) * NP + C_QA + head * 128 + 32 * ks + 8 * fq);
    float m[2] = {-1e30f, -1e30f}, l[2] = {0.f, 0.f};
    __syncthreads();
    dma_k(lds, kc, 128, w, F.lane);
    for (int jt = 0; jt < ntile; ++jt) {
        VMCNT(0); RAW_BARRIER();
        if (jt + 1 < ntile) dma_k(lds + ((jt + 1) & 1) * ABUF, kc + (size_t)(64 * (jt + 1)) * 128, 128, w, F.lane);
        const LAS unsigned char* kb = lds + (jt & 1) * ABUF;
        f32x4 s[4][2];
        qk_tile<3>(s, kb, qf, fr, fq);
        const bool edge = jt >= ntile - 2;
        int kq = 4 * fq; asm volatile("" : "+v"(kq));
#pragma unroll
        for (int ct = 0; ct < 2; ++ct) {
            float mx = NEG_INF;
#pragma unroll
            for (int kt = 0; kt < 4; ++kt)
#pragma unroll
                for (int r = 0; r < 4; ++r) { float v = s[kt][ct][r]; if (edge) { const int n = 64 * jt + 16 * kt + kq + r; v = (n <= nlim[ct]) ? v : NEG_INF; s[kt][ct][r] = v; } mx = fmaxf(mx, v); }
            mx = quad_max(mx, F.lane);
            if (__ballot((mx - m[ct]) * ATT_C > 8.f) != 0ull) { const float mn = fmaxf(m[ct], mx); l[ct] *= __builtin_amdgcn_exp2f((m[ct] - mn) * ATT_C); m[ct] = mn; }
            const float mc = m[ct] * ATT_C;
            float rs = 0.f;
#pragma unroll
            for (int kt = 0; kt < 4; ++kt)
#pragma unroll
                for (int r = 0; r < 4; ++r) rs += __builtin_amdgcn_exp2f(s[kt][ct][r] * ATT_C - mc);
            l[ct] += quad_sum(rs, F.lane);
        }
    }
    f32x4 O[8][2];
#pragma unroll
    for (int dt = 0; dt < 8; ++dt) { O[dt][0] = (f32x4){0.f, 0.f, 0.f, 0.f}; O[dt][1] = (f32x4){0.f, 0.f, 0.f, 0.f}; }
    float mc[2], inv[2];
#pragma unroll
    for (int ct = 0; ct < 2; ++ct) { mc[ct] = m[ct] * ATT_C; inv[ct] = l[ct] > 0.f ? 1.f / l[ct] : 0.f; }
    RAW_BARRIER();
    dma_k(lds, kc, 128, w, F.lane); dma_v(lds + KTILE, vct, 512, w, F.lane);
    for (int jt = 0; jt < ntile; ++jt) {
        VMCNT(0); RAW_BARRIER();
        if (jt + 1 < ntile) { LAS unsigned char* nb = lds + ((jt + 1) & 1) * ABUF; dma_k(nb, kc + (size_t)(64 * (jt + 1)) * 128, 128, w, F.lane); dma_v(nb + KTILE, vct + 64 * (jt + 1), 512, w, F.lane); }
        const LAS unsigned char* kb = lds + (jt & 1) * ABUF;
        f32x4 s[4][2];
        qk_tile<3>(s, kb, qf, fr, fq);
        const bool edge = jt >= ntile - 2;
        int kq = 4 * fq; asm volatile("" : "+v"(kq));
        bf16x8 pf[2][2];
#pragma unroll
        for (int ct = 0; ct < 2; ++ct) {
#pragma unroll
            for (int kt = 0; kt < 4; ++kt) {
#pragma unroll
                for (int r = 0; r < 4; ++r) { float p = __builtin_amdgcn_exp2f(s[kt][ct][r] * ATT_C - mc[ct]) * inv[ct];
                    if (edge) { const int n = 64 * jt + 16 * kt + kq + r; p = (n <= nlim[ct]) ? p : 0.f; }
                    s[kt][ct][r] = p; }
                float h3 = s[kt][ct][3], hs = (s[kt][ct][0] + s[kt][ct][1]) + (s[kt][ct][2] + h3);
                hs += shx(hs, 1, F.lane); hs += shx(hs, 2, F.lane); h3 += shx(h3, 1, F.lane); h3 += shx(h3, 2, F.lane);
                if ((fr & 3) == 0) { const int jj = 16 * jt + 4 * kt + fq; pslc[tokl[ct] * 128 + jj] = hs; p3[tokl[ct] * 128 + jj] = h3; }
            }
            pf[0][ct] = pack_p(s[0][ct], s[1][ct]); pf[1][ct] = pack_p(s[2][ct], s[3][ct]);
        }
        { f32x4 Ldummy[2]; pv_tile<3, false>(O, Ldummy, kb + KTILE, pf, fr, fq); }
    }
    bf16_t* out = (bf16_t*)(a.ws + WS_OCMP);
#pragma unroll
    for (int ct = 0; ct < 2; ++ct) { bf16_t* op = out + (size_t)(64 * c + tokl[ct]) * D + head * 128 + 4 * fq;
#pragma unroll
        for (int dt = 0; dt < 8; ++dt) { u32x2 o; o.x = pk2(O[dt][ct][0], O[dt][ct][1]); o.y = pk2(O[dt][ct][2], O[dt][ct][3]); *(u32x2*)(op + 16 * dt) = o; } }
    LDS_WAIT(); asm volatile("" ::: "memory");
    unsigned* selm = (unsigned*)(a.ws + WS_SELM);
    {
        int li = F.lane & 15, tq = F.lane >> 4; asm volatile("" : "+v"(li), "+v"(tq));
        unsigned mw[2][4];
        if (c <= 15) {
            const unsigned all = (c == 31) ? 0xffffffffu : ((2u << c) - 1u);
#pragma unroll
            for (int b = 0; b < 2; ++b) { mw[b][0] = all; mw[b][1] = 0u; mw[b][2] = 0u; mw[b][3] = 0u; }
        } else {
            unsigned long long key[2][8];
#pragma unroll
            for (int b = 0; b < 2; ++b) { const int tok = 8 * w + 4 * b + tq;
#pragma unroll
                for (int e = 0; e < 8; ++e) { const int jj = li + 16 * e; const bool ok = (jj >= 1) && (jj <= c - 2);
                    const float sc = ok ? pslc[tok * 128 + jj] + p3[tok * 128 + jj - 1] : 0.f;
                    key[b][e] = ok ? (((unsigned long long)__float_as_uint(sc) << 32) | (unsigned)(127 - jj)) : 0ull; }
#pragma unroll
                for (int q = 0; q < 4; ++q) mw[b][q] = 0u;
                { const int f0 = 0, f1 = c - 1, f2 = c;
#pragma unroll
                  for (int q = 0; q < 4; ++q) mw[b][q] |= ((f0 >> 5) == q ? 1u << (f0 & 31) : 0u) | ((f1 >> 5) == q ? 1u << (f1 & 31) : 0u) | ((f2 >> 5) == q ? 1u << (f2 & 31) : 0u); } }
#define ROR64(v, n) ((((unsigned long long)(unsigned)__builtin_amdgcn_update_dpp(0, (int)(unsigned)((v) >> 32), 0x120 + (n), 0xf, 0xf, false)) << 32) | (unsigned)__builtin_amdgcn_update_dpp(0, (int)(unsigned)(v), 0x120 + (n), 0xf, 0xf, false))
#pragma unroll 1
            for (int round = 0; round < 13; ++round) {
#pragma unroll
                for (int b = 0; b < 2; ++b) {
                    unsigned long long best = key[b][0];
#pragma unroll
                    for (int e = 1; e < 8; ++e) best = key[b][e] > best ? key[b][e] : best;
                    { unsigned long long o; o = ROR64(best, 1); best = o > best ? o : best; o = ROR64(best, 2); best = o > best ? o : best;
                      o = ROR64(best, 4); best = o > best ? o : best; o = ROR64(best, 8); best = o > best ? o : best; }
                    if (best != 0ull) { const int jb = 127 - (int)(unsigned)best;
#pragma unroll
                        for (int q = 0; q < 4; ++q) mw[b][q] |= ((jb >> 5) == q) ? (1u << (jb & 31)) : 0u;
#pragma unroll
                        for (int e = 0; e < 8; ++e) key[b][e] = (key[b][e] == best) ? 0ull : key[b][e]; }
                }
            }
#undef ROR64
        }
        if (li == 0) {
#pragma unroll
            for (int b = 0; b < 2; ++b) { const int tok = 8 * w + 4 * b + tq; u32x4 o; o.x = mw[b][0]; o.y = mw[b][1]; o.z = mw[b][2]; o.w = mw[b][3];
                *(u32x4*)(selm + ((size_t)(64 * c + tok) * 4 + g) * 4) = o; } }
    }
}

struct ScanRegs { bf16x8 ks[2]; bf16x8 at; f32x4 dc; };
DI void dma_v8(LAS unsigned char* vb, const bf16_t* vbase, int w, int lane) {
    const int row = 8 * w + (lane >> 3), c = (lane & 7) ^ ((row >> 1) & 7);
    glds16(vbase + (size_t)row * 64 + c * 8, vb + w * 1024);
}
constexpr int SC_SROW = 272, SC_SBUF = 64 * SC_SROW, SC_Q = 0, SC_V = 4 * 16384, SC_S = SC_V + 4 * 8192;
static_assert(SC_S + 2 * SC_SBUF <= LDS_MISC, "scan LDS map");
DI void scan_issue(ScanRegs& r, LAS unsigned char* lds, const Args& a, int n, int h, int sl, int kh, int w, int lane, int fr, int fq) {
    const bf16_t* qdec = (const bf16_t*)(a.ws + WS_QDEC); const bf16_t* kst = (const bf16_t*)(a.ws + WS_KST);
    const bf16_t* vt = (const bf16_t*)(a.ws + WS_VT); const bf16_t* att = (const bf16_t*)(a.ws + WS_ATT); const float* dec = (const float*)(a.ws + WS_DEC);
    dma_k(lds + SC_Q + (n & 3) * 16384, qdec + (size_t)(64 * n) * 1024 + h * 256 + kh * 128, 1024, w, lane);
    dma_v8(lds + SC_V + (n & 3) * 8192, vt + ((size_t)n * 2048 + h * 512 + 64 * sl) * 64, w, lane);
    { const bf16_t* kp = kst + ((size_t)(n * 4 + h) * 256 + kh * 128 + 16 * w + fr) * 64 + 8 * fq;
      asm volatile("global_load_dwordx4 %0, %1, off" : "=v"(r.ks[0]) : "v"(kp) : "memory");
      asm volatile("global_load_dwordx4 %0, %1, off offset:64" : "=v"(r.ks[1]) : "v"(kp) : "memory"); }
    { const bf16_t* ap_ = att + ((size_t)(n * 4 + h) * 64 + 16 * (w & 3) + fr) * 64 + 32 * kh + 8 * fq; asm volatile("global_load_dwordx4 %0, %1, off" : "=v"(r.at) : "v"(ap_) : "memory"); }
    { const float* dp = dec + (n * 4 + h) * 256 + kh * 128 + 16 * w + 4 * fq; asm volatile("global_load_dwordx4 %0, %1, off" : "=v"(r.dc) : "v"(dp) : "memory"); }
}
DI void scan_step(const ScanRegs& cur, f32x4 (&S)[4], LAS unsigned char* lds, bf16_t* opart, int n, int h, int sl, int kh, int w, int fr, int fq) {
    const LAS unsigned char* sc = lds + SC_S + (n & 1) * SC_SBUF; const LAS unsigned char* qb = lds + SC_Q + (n & 3) * 16384; const LAS unsigned char* vb = lds + SC_V + (n & 3) * 8192;
    const int tt = w & 3, vt0 = 2 * (w >> 2), xv = (fr >> 1) & 7;
    const LAS unsigned char* vr = vb + fr * 128; const int y0 = (fq ^ xv) << 4, y1 = ((4 + fq) ^ xv) << 4;
    bf16x8 qf[4], sf[2][4];
#pragma unroll
    for (int ks = 0; ks < 4; ++ks) qf[ks] = *(const LAS bf16x8*)(qb + (16 * tt + fr) * 256 + (((4 * ks + fq) ^ fr) << 4));
#pragma unroll
    for (int z = 0; z < 2; ++z)
#pragma unroll
        for (int ks = 0; ks < 4; ++ks) sf[z][ks] = *(const LAS bf16x8*)(sc + (16 * (vt0 + z) + fr) * SC_SROW + (32 * ks + 8 * fq) * 2);
    LDS_WAIT(); __builtin_amdgcn_sched_barrier(0);
    f32x4 acc[2];
#pragma unroll
    for (int z = 0; z < 2; ++z) { acc[z] = (f32x4){0.f, 0.f, 0.f, 0.f};
#pragma unroll
        for (int ks = 0; ks < 4; ++ks) acc[z] = MFMA16(sf[z][ks], qf[ks], acc[z]); }
    bf16x8 vf[4][2];
#pragma unroll
    for (int vt = 0; vt < 4; ++vt) { vf[vt][0] = *(const LAS bf16x8*)(vr + vt * 2048 + y0); vf[vt][1] = *(const LAS bf16x8*)(vr + vt * 2048 + y1); }
    LDS_WAIT(); __builtin_amdgcn_sched_barrier(0);
    { const bf16x8 va0 = vt0 ? (kh ? vf[2][1] : vf[2][0]) : (kh ? vf[0][1] : vf[0][0]), va1 = vt0 ? (kh ? vf[3][1] : vf[3][0]) : (kh ? vf[1][1] : vf[1][0]);
      acc[0] = MFMA16(va0, cur.at, acc[0]); acc[1] = MFMA16(va1, cur.at, acc[1]); }
    LAS unsigned char* sn = lds + SC_S + ((n + 1) & 1) * SC_SBUF;
#pragma unroll
    for (int vt = 0; vt < 4; ++vt) { S[vt] = S[vt] * cur.dc; S[vt] = MFMA16(cur.ks[0], vf[vt][0], S[vt]); S[vt] = MFMA16(cur.ks[1], vf[vt][1], S[vt]); }
#pragma unroll
    for (int z = 0; z < 2; ++z) { u32x2 o; o.x = pk2(acc[z][0], acc[z][1]); o.y = pk2(acc[z][2], acc[z][3]);
        *(u32x2*)(opart + (size_t)(64 * n + 16 * tt + fr) * 2048 + h * 512 + 64 * sl + 16 * (vt0 + z) + 4 * fq) = o; }
#pragma unroll
    for (int vt = 0; vt < 4; ++vt) { u32x2 o; o.x = pk2(S[vt][0], S[vt][1]); o.y = pk2(S[vt][2], S[vt][3]); *(LAS u32x2*)(sn + (16 * vt + fr) * SC_SROW + (16 * w + 4 * fq) * 2) = o; }
}
DI void gla_scan_unit(const Frame& F, const Args& a, int h, int sl, int kh) {
    LAS unsigned char* lds = F.lds;
    const int fr = F.lane & 15, fq = F.lane >> 4, w = F.wave;
    bf16_t* opart = (bf16_t*)(a.ws + WS_OPART) + (size_t)kh * T * 2048;
    __syncthreads();
    for (int i = F.tid; i < SC_SBUF / 4; i += NTHR) ((LAS unsigned*)(lds + SC_S))[i] = 0u;
    f32x4 S[4];
#pragma unroll
    for (int vt = 0; vt < 4; ++vt) S[vt] = (f32x4){0.f, 0.f, 0.f, 0.f};
    ScanRegs r0, r1, r2, r3;
    scan_issue(r0, lds, a, 0, h, sl, kh, w, F.lane, fr, fq); scan_issue(r1, lds, a, 1, h, sl, kh, w, F.lane, fr, fq); scan_issue(r2, lds, a, 2, h, sl, kh, w, F.lane, fr, fq);
#define SC_STEP(rn, rc, n) do { if ((n) < 3) asm volatile("s_waitcnt vmcnt(14)" ::: "memory"); else asm volatile("s_waitcnt vmcnt(20)" ::: "memory"); LDS_WAIT(); RAW_BARRIER(); \
        scan_issue(rn, lds, a, ((n) + 3 < NCH) ? (n) + 3 : NCH - 1, h, sl, kh, w, F.lane, fr, fq); scan_step(rc, S, lds, opart, (n), h, sl, kh, w, fr, fq); } while (0)
    for (int n = 0; n < NCH; n += 4) { SC_STEP(r3, r0, n); SC_STEP(r0, r1, n + 1); SC_STEP(r1, r2, n + 2); SC_STEP(r2, r3, n + 3); }
#undef SC_STEP
    VM_WAIT();
}

DI void unpack8(const u32x4& w, float (&f)[8]) { f[0] = lo_bf(w.x); f[1] = hi_bf(w.x); f[2] = lo_bf(w.y); f[3] = hi_bf(w.y); f[4] = lo_bf(w.z); f[5] = hi_bf(w.z); f[6] = lo_bf(w.w); f[7] = hi_bf(w.w); }
DI void p_combine(const Frame& F, const Args& a, int layer) {
    const bf16_t* cols = (const bf16_t*)(a.ws + WS_COLS);
    const bf16_t* ocmp = (const bf16_t*)(a.ws + WS_OCMP); const bf16_t* osel = (const bf16_t*)(a.ws + WS_OSEL); const bf16_t* owin = (const bf16_t*)(a.ws + WS_OWIN);
    const bf16_t* op0 = (const bf16_t*)(a.ws + WS_OPART); const bf16_t* op1 = op0 + (size_t)T * 2048;
    bf16_t* A1 = (bf16_t*)(a.ws + WS_A1); bf16_t* A2 = (bf16_t*)(a.ws + WS_A2);
    const int c8 = 8 * F.lane;
    f32x4 nw[2]; nw[0] = *(const f32x4*)(a.gla_norm_w + layer * 512 + c8); nw[1] = *(const f32x4*)(a.gla_norm_w + layer * 512 + c8 + 4);
    for (int row = F.gw; row < T; row += F.NGW) {
        const bf16_t* cr = cols + (size_t)row * NP; const size_t ro = (size_t)row * D;
#pragma unroll
        for (int j = 0; j < 4; ++j) { const int c0 = 512 * j + c8, head = 4 * j + (F.lane >> 4);
            const float g0 = sigmoidf_(bf2f(cr[C_GBR + head * 3 + 0])), g1 = sigmoidf_(bf2f(cr[C_GBR + head * 3 + 1])), g2 = sigmoidf_(bf2f(cr[C_GBR + head * 3 + 2]));
            float oc[8], os[8], ow[8], za[8], p0[8], p1[8], zb[8];
            unpack8(*(const u32x4*)(ocmp + ro + c0), oc); unpack8(*(const u32x4*)(osel + ro + c0), os); unpack8(*(const u32x4*)(owin + ro + c0), ow); unpack8(*(const u32x4*)(cr + C_ZA + c0), za);
            unpack8(*(const u32x4*)(op0 + ro + c0), p0); unpack8(*(const u32x4*)(op1 + ro + c0), p1); unpack8(*(const u32x4*)(cr + C_ZB + c0), zb);
            float r[8], o[8], ss = 0.f;
#pragma unroll
            for (int e = 0; e < 8; ++e) { r[e] = (g0 * oc[e] + g1 * os[e] + g2 * ow[e]) * siluf_(za[e]); o[e] = p0[e] + p1[e]; ss += o[e] * o[e]; }
            { u32x4 q; q.x = pk2(r[0], r[1]); q.y = pk2(r[2], r[3]); q.z = pk2(r[4], r[5]); q.w = pk2(r[6], r[7]); *(u32x4*)(A1 + ro + c0) = q; }
            const float rs = rsqrtf(wave_sum(ss, F.lane) * (1.f / 512.f) + NORM_EPS);
            float y[8];
#pragma unroll
            for (int e = 0; e < 8; ++e) y[e] = o[e] * rs * nw[e >> 2][e & 3] * siluf_(zb[e]);
            { u32x4 q; q.x = pk2(y[0], y[1]); q.y = pk2(y[2], y[3]); q.z = pk2(y[4], y[5]); q.w = pk2(y[6], y[7]); *(u32x4*)(A2 + ro + c0) = q; } }
    }
}

constexpr int PH_PER_LAYER = 10, N_PHASES = 2 + DEPTH * PH_PER_LAYER;
constexpr int WQ_WORD0 = 16384;
DI int wq_pull(unsigned* cnt, volatile LAS unsigned* slot, int tid) {
    __syncthreads();
    if (tid == 0) *slot = __hip_atomic_fetch_add(cnt, 1u, __ATOMIC_RELAXED, __HIP_MEMORY_SCOPE_AGENT);
    __syncthreads();
    return (int)*slot;
}
__global__ void __launch_bounds__(NTHR, 2) mk_fwd(Args a_in, int li) {
    KArgsP ap = (KArgsP)__builtin_amdgcn_kernarg_segment_ptr();
    const int ph_lo = a_in.ph_lo, ph_hi = a_in.ph_hi;
    extern __shared__ __attribute__((aligned(16))) unsigned char lds_raw[];
    Frame F;
    F.lds = (LAS unsigned char*)lds_raw;
    F.tid = threadIdx.x; F.lane = F.tid & 63; F.wave = __builtin_amdgcn_readfirstlane(F.tid >> 6);
    const int wave_s = F.wave;
    F.G = gridDim.x; F.bid = blockIdx.x; F.gw = F.bid * NWAVES + F.wave; F.NGW = F.G * NWAVES;
    volatile LAS unsigned* misc = (volatile LAS unsigned*)(F.lds + LDS_MISC);
    if (F.tid < 64) misc[F.tid] = 0u;
    __syncthreads();
    unsigned* ctl = (unsigned*)(a_in.ws + WS_CTL);
    XcdBarrier bar = xcd_barrier_post(ctl + (size_t)li * XCD_BAR_WORDS, misc);
#ifndef PHASE_SET
#define PHASE_SET 0xFFFF
#endif
#define HAS(k) ((PHASE_SET >> (k)) & 1)
#ifndef REPEAT_PHASE
#define REPEAT_PHASE -1
#endif
#define REP(k) for (int _r = 0; _r < ((REPEAT_PHASE == (k)) ? 2 : 1); ++_r)
#define IN(k) (ph_lo <= (k) && (k) < ph_hi)
#define SEAM(k) do { if (IN(k) && IN((k) + 1)) xcd_barrier(bar); } while (0)
#define FRESH() do { int _l = __builtin_amdgcn_mbcnt_hi(~0u, __builtin_amdgcn_mbcnt_lo(~0u, 0u)); asm volatile("" : "+v"(_l)); int _w = wave_s; asm volatile("" : "+s"(_w)); F.lane = _l; F.wave = _w; F.tid = _w * 64 + _l; F.gw = F.bid * NWAVES + F.wave; { KArgsP _k = (KArgsP)__builtin_amdgcn_kernarg_segment_ptr(); asm volatile("" : "+s"(_k)); ap = _k; } } while (0)
    if (HAS(12) && IN(0)) { FRESH(); const Args a = load_args(ap); REP(12) { p_prologue(F, a); } SEAM(0); }
#define PHASE_ENTER() FRESH(); const Args a = load_args(ap); unsigned char* ws = a.ws; bf16_t* cols = (bf16_t*)(ws + WS_COLS); (void)cols
#define UNIT_FRAME(Fu) Frame Fu = F; { int _l = F.lane; asm volatile("" : "+v"(_l)); Fu.lane = _l; Fu.tid = F.wave * 64 + _l; }
    for (int L = 0; L < DEPTH; ++L) {
        const int pb = 1 + PH_PER_LAYER * L;
        if (HAS(0) && IN(pb + 0)) { PHASE_ENTER(); const float* xin = L == 0 ? a.x : (const float*)(ws + WS_X);
            p_rmsnorm<false>(F, xin, a.norm_w + L * D, ws + WS_H); SEAM(pb + 0); }
        if (HAS(1) && IN(pb + 1)) { PHASE_ENTER();
            pg8::Gemm g{(const bf16_t*)(ws + WS_H), (const bf16_t*)(ws + WS_WIN) + (size_t)L * NP * D, D, D, D};
            pg8::OrderMN S; S.init(T, NP, F.G, F.bid); pg8::EpiCols E{cols, NP};
            pg8::gemm_phase<pg8::EpiCols, pg8::OrderMN, false, true, true>(F.lds, g, S, E, F.tid);
            SEAM(pb + 1); }
        if (HAS(2) && IN(pb + 2)) { PHASE_ENTER();
            unsigned* cnt = (unsigned*)(ws + WS_CTL) + WQ_WORD0 + 8192 + 64 * L;
            for (;;) { const int u = wq_pull(cnt, misc + 16, F.tid); if (u >= 128 + 512 + 256) break;
                UNIT_FRAME(Fu);
                if (u < 128) { pg8::Gemm g{cols, (const bf16_t*)(ws + WS_W1T) + (size_t)L * 2 * 256 * 4096, 16 * NP, 4096, 512};
                    pg8::OrderCmp S; S.init(1 << 20, u); pg8::EpiPart E{(float*)(ws + WS_CPART)};
                    __syncthreads();
                    pg8::gemm_phase<pg8::EpiPart, pg8::OrderCmp, true, false, true>(Fu.lds, g, S, E, Fu.tid); }
                else if (u < 640) { const int v = u - 128; gla_g1_unit(Fu, a, L, v >> 2, v & 3); }
                else transpose_unit(Fu, a, u - 640); }
            SEAM(pb + 2); }
        if (HAS(3) && IN(pb + 3)) { PHASE_ENTER(); for (int u = F.bid; u < 256; u += F.G) mlp2_unit(F, a, L, u >> 5, u & 31); SEAM(pb + 3); }
        if (HAS(4) && IN(pb + 4)) { PHASE_ENTER();
            REP(4) { unsigned* cnt = (unsigned*)(ws + WS_CTL) + WQ_WORD0 + 64 * (2 * L + 16 * _r);
            for (;;) { const int u = wq_pull(cnt, misc + 16, F.tid); if (u >= 512 + 512) break;
                UNIT_FRAME(Fu);
                if (u < 512) ca_chunk(Fu, a, 127 - (u >> 2), u & 3);
                else { const int v = u - 512; fa_chunk<1>(Fu, a, 127 - (v >> 2), v & 3); } } }
            SEAM(pb + 4); }
        if (HAS(5) && IN(pb + 5)) { PHASE_ENTER();
            REP(5) { unsigned* cnt = (unsigned*)(ws + WS_CTL) + WQ_WORD0 + 64 * (2 * L + 1 + 16 * _r);
            unsigned* grp = (unsigned*)(ws + WS_CTL) + WQ_WORD0 + 4096 + 64 * (8 * L + 32 * _r);
            unsigned* claimed = (unsigned*)(ws + WS_CTL) + WQ_WORD0 + 32768 + 64 * (L + 4 * _r);
            { const unsigned x = xb_xcc_id() & 7u;
              __syncthreads();
              if (F.tid == 0) { unsigned r = __hip_atomic_fetch_add(grp + 64 * x, 1u, __ATOMIC_RELAXED, __HIP_MEMORY_SCOPE_AGENT); unsigned got = 0xffffffffu;
                  if (r < 8u && __hip_atomic_exchange(claimed + 8 * x + r, 1u, __ATOMIC_RELAXED, __HIP_MEMORY_SCOPE_AGENT) == 0u) got = 8u * x + r;
                  misc[16] = got; }
              __syncthreads();
              const unsigned su = misc[16];
              if (su != 0xffffffffu) { UNIT_FRAME(Fu); gla_scan_unit(Fu, a, (int)(su >> 4), (int)(su & 7u), (int)((su >> 3) & 1u)); } }
            for (;;) { const int u = wq_pull(cnt, misc + 16, F.tid); if (u >= 64) break;
                UNIT_FRAME(Fu);
                __syncthreads(); if (F.tid == 0) misc[17] = __hip_atomic_exchange(claimed + u, 1u, __ATOMIC_RELAXED, __HIP_MEMORY_SCOPE_AGENT); __syncthreads();
                if (misc[17] == 0u) gla_scan_unit(Fu, a, u >> 4, u & 7, (u >> 3) & 1); }
            { const int g0 = (int)(xb_xcc_id() & 3u);
              for (int gi = 0; gi < 4; ++gi) { const int gq = (g0 + gi) & 3; unsigned* qcnt = (unsigned*)(ws + WS_CTL) + WQ_WORD0 + 12288 + 64 * (4 * L + gq + 32 * _r);
                  for (;;) { const int u = wq_pull(qcnt, misc + 16, F.tid); if (u >= 128) break;
                      UNIT_FRAME(Fu);
                      fa_chunk<0>(Fu, a, 127 - u, gq); } } } }
            SEAM(pb + 5); }
        if (HAS(6) && IN(pb + 6)) { PHASE_ENTER(); p_combine(F, a, L); SEAM(pb + 6); }
        if (HAS(7) && IN(pb + 7)) { PHASE_ENTER();
            pg8::Gemm g{(const bf16_t*)(ws + WS_A1), (const bf16_t*)(ws + WS_WPA) + (size_t)L * D * D, D, D, D};
            pg8::OrderAB S; S.mn.init(T, D, F.G, F.bid); S.A2 = (const bf16_t*)(ws + WS_A2); S.B2 = (const bf16_t*)(ws + WS_WPB) + (size_t)L * D * D;
            pg8::EpiGateAB E{(bf16_t*)(ws + WS_Y), (bf16_t*)(ws + WS_TMP), cols + C_GA, cols + C_GB};
            pg8::gemm_phase<pg8::EpiGateAB, pg8::OrderAB, false, true, true>(F.lds, g, S, E, F.tid);
            SEAM(pb + 7); }
        if (HAS(8) && IN(pb + 8)) { PHASE_ENTER(); }
        if (HAS(9) && IN(pb + 9)) { PHASE_ENTER(); const float* xin = L == 0 ? a.x : (const float*)(ws + WS_X);
            pg8::Gemm g{(const bf16_t*)(ws + WS_Y), (const bf16_t*)(ws + WS_WOUT) + (size_t)L * D * D, D, D, D};
            pg8::OrderMN S; S.init(T, D, F.G, F.bid); pg8::EpiResid E{xin, (float*)(ws + WS_X)};
            pg8::gemm_phase<pg8::EpiResid, pg8::OrderMN, false, false, true>(F.lds, g, S, E, F.tid);
            SEAM(pb + 9); }
    }
    if (HAS(13) && IN(N_PHASES - 1)) { FRESH(); const Args a = load_args(ap); p_rmsnorm<true>(F, (const float*)(a.ws + WS_X), a.final_w, a.out); }
#undef IN
#undef SEAM
}

extern "C" void kernel_launch(void* const* d_in, const int* in_sizes, int n_in, void* d_out, int out_size, void* d_ws, size_t ws_size, hipStream_t stream) {
    static int grid = 0;
    if (grid == 0) {
        if (n_in != 15 || ws_size < WS_END) { fprintf(stderr, "kernel_launch: unexpected inputs (n_in %d, ws %zu, need %zu)\n", n_in, ws_size, (size_t)WS_END); grid = -1; return; }
        int dev = 0, cus = 0;
        if (hipGetDevice(&dev) != hipSuccess || hipDeviceGetAttribute(&cus, hipDeviceAttributeMultiprocessorCount, dev) != hipSuccess) { grid = -1; return; }
        if (hipFuncSetAttribute((const void*)mk_fwd, hipFuncAttributeMaxDynamicSharedMemorySize, LDS_BYTES) != hipSuccess) { fprintf(stderr, "kernel_launch: hipFuncSetAttribute failed\n"); grid = -1; return; }
        int per_cu = 0;
        if (hipOccupancyMaxActiveBlocksPerMultiprocessor(&per_cu, (const void*)mk_fwd, NTHR, LDS_BYTES) != hipSuccess || per_cu < 1) fprintf(stderr, "kernel_launch: occupancy query reports %d\n", per_cu);
        (void)hipGetLastError();
        grid = cus;
    }
    if (grid < 0) return;
    (void)hipMemsetAsync((char*)d_ws + WS_CTL, 0, CTL_BYTES, stream);
    Args a{};
    a.x = (const float*)d_in[0]; a.norm_w = (const float*)d_in[1]; a.w_in = (const float*)d_in[2]; a.cmp_pe = (const float*)d_in[3]; a.cmp_w1 = (const float*)d_in[4];
    a.cmp_b1 = (const float*)d_in[5]; a.cmp_w2 = (const float*)d_in[6]; a.cmp_b2 = (const float*)d_in[7]; a.alpha_w = (const float*)d_in[8]; a.alpha_b = (const float*)d_in[9];
    a.gla_norm_w = (const float*)d_in[10]; a.p_a = (const float*)d_in[11]; a.p_b = (const float*)d_in[12]; a.w_out = (const float*)d_in[13]; a.final_w = (const float*)d_in[14];
    a.out = (float*)d_out; a.ws = (unsigned char*)d_ws;
#if MK_PER_PHASE
    for (int k = 0; k < N_PHASES; ++k) { a.ph_lo = k; a.ph_hi = k + 1; hipLaunchKernelGGL(mk_fwd, dim3(grid), dim3(NTHR), LDS_BYTES, stream, a, k); }
#else
    a.ph_lo = 0; a.ph_hi = N_PHASES; hipLaunchKernelGGL(mk_fwd, dim3(grid), dim3(NTHR), LDS_BYTES, stream, a, 0);
#endif
}
```

```cpp
#include <hip/hip_runtime.h>
#include <cstdio>
#include <cstdint>

#ifndef MK_PER_PHASE
#define MK_PER_PHASE 0
#endif

#define LAS __attribute__((address_space(3)))
#define GAS __attribute__((address_space(1)))
typedef unsigned short bf16_t;
typedef short bf16x8 __attribute__((ext_vector_type(8)));
typedef short s16x4 __attribute__((ext_vector_type(4)));
typedef float f32x4 __attribute__((ext_vector_type(4)));
typedef float f32x2 __attribute__((ext_vector_type(2)));
typedef unsigned u32x4 __attribute__((ext_vector_type(4)));
typedef unsigned u32x2 __attribute__((ext_vector_type(2)));
#define DI __device__ __forceinline__
#define MFMA16(a, b, c) __builtin_amdgcn_mfma_f32_16x16x32_bf16((a), (b), (c), 0, 0, 0)

constexpr int T = 8192, D = 2048, DEPTH = 4, NIN = 17472, NP = 17664;
constexpr int NCH = 128;
constexpr int C_QA = 0, C_KCMP = 2048, C_VCMP = 2560, C_KSEL = 3072, C_VSEL = 3584, C_KWIN = 4096, C_VWIN = 4608, C_ZA = 5120,
              C_QB = 7168, C_KB = 8192, C_VB = 9216, C_ZB = 11264, C_GA = 13312, C_GB = 15360, C_GBR = 17408, C_ALR = 17456;
constexpr float NORM_EPS = 1e-6f;
constexpr float ATT_C = 0.08838834764831845f * 1.4426950408889634f;

DI int map_col(int n) {
    if (n < 5120) return n;
    if (n < 5168) return C_GBR + (n - 5120);
    if (n < 11312) return n - 48;
    if (n < 11328) return C_ALR + (n - 11312);
    return n - 64;
}

constexpr size_t MiB = 1u << 20;
constexpr size_t al(size_t x) { return (x + MiB - 1) / MiB * MiB; }
constexpr size_t WS_CTL = 0, CTL_BYTES = MiB;
constexpr size_t WS_WIN = WS_CTL + CTL_BYTES;
constexpr size_t WS_WPA = WS_WIN + al((size_t)DEPTH * NP * D * 2);
constexpr size_t WS_WPB = WS_WPA + al((size_t)DEPTH * D * D * 2);
constexpr size_t WS_WOUT = WS_WPB + al((size_t)DEPTH * D * D * 2);
constexpr size_t WS_W1T = WS_WOUT + al((size_t)DEPTH * D * D * 2);
constexpr size_t WS_W2T = WS_W1T + al((size_t)DEPTH * 2 * 256 * 4096 * 2);
constexpr size_t WS_B1P = WS_W2T + al((size_t)DEPTH * 2 * 128 * 256 * 2);
constexpr size_t WS_X = WS_B1P + MiB;
constexpr size_t WS_H = WS_X + al((size_t)T * D * 4);
constexpr size_t WS_COLS = WS_H + al((size_t)T * D * 2);
constexpr size_t WS_CPART = WS_COLS + al((size_t)(T + 64) * NP * 2);
constexpr size_t WS_KC = WS_CPART + al((size_t)8 * 8 * 512 * 256 * 4);
constexpr size_t WS_VCT = WS_KC + MiB;
constexpr size_t WS_SELM = WS_VCT + MiB;
constexpr size_t WS_OCMP = WS_SELM + MiB;
constexpr size_t WS_OSEL = WS_OCMP + al((size_t)T * D * 2);
constexpr size_t WS_OWIN = WS_OSEL + al((size_t)T * D * 2);
constexpr size_t WS_VSELT = WS_OWIN + al((size_t)T * D * 2);
constexpr size_t WS_VWINT = WS_VSELT + al((size_t)4 * 128 * 128 * 64 * 2);
constexpr size_t WS_QDEC = WS_VWINT + al((size_t)4 * 128 * 128 * 64 * 2);
constexpr size_t WS_KST = WS_QDEC + al((size_t)T * 1024 * 2);
constexpr size_t WS_VT = WS_KST + al((size_t)T * 1024 * 2);
constexpr size_t WS_ATT = WS_VT + al((size_t)T * 2048 * 2);
constexpr size_t WS_DEC = WS_ATT + al((size_t)128 * 4 * 64 * 64 * 2);
constexpr size_t WS_OPART = WS_DEC + MiB;
constexpr size_t WS_A1 = WS_OPART + al((size_t)2 * T * 2048 * 4);
constexpr size_t WS_A2 = WS_A1 + al((size_t)T * D * 2);
constexpr size_t WS_TMP = WS_A2 + al((size_t)T * D * 2);
constexpr size_t WS_Y = WS_TMP + al((size_t)T * D * 4);
constexpr size_t WS_END = WS_Y + al((size_t)T * D * 2);

constexpr int LDS_MAIN = 131072;
constexpr int LDS_BYTES = 147456;
constexpr int LDS_MISC = LDS_BYTES - 256;
constexpr int NWAVES = 8, NTHR = 512;

DI float bf2f(unsigned short b) { return __uint_as_float(((unsigned)b) << 16); }
DI unsigned f2bf(float f) { unsigned u = __float_as_uint(f); return (u + 0x7fffu + ((u >> 16) & 1u)) >> 16; }
DI unsigned pk2_sw(float lo, float hi) { return f2bf(lo) | (f2bf(hi) << 16); }
typedef __bf16 bf16x2_t __attribute__((ext_vector_type(2)));
DI unsigned cvt_pk_bf16(float lo, float hi) { const f32x2 v = {lo, hi}; const bf16x2_t b = __builtin_convertvector(v, bf16x2_t); return __builtin_bit_cast(unsigned, b); }
DI unsigned pk2(float lo, float hi) { return cvt_pk_bf16(lo, hi); }
DI float lo_bf(unsigned w) { return __uint_as_float(w << 16); }
DI float hi_bf(unsigned w) { return __uint_as_float(w & 0xffff0000u); }
DI float sigmoidf_(float x) { return 1.f / (1.f + __expf(-x)); }
DI float siluf_(float x) { return x / (1.f + __expf(-x)); }
DI float shx(float v, int off, int lane) { return __int_as_float(__builtin_amdgcn_ds_bpermute((lane ^ off) << 2, __float_as_int(v))); }
DI int shxi(int v, int off, int lane) { return __builtin_amdgcn_ds_bpermute((lane ^ off) << 2, v); }
DI float wave_sum(float v, int lane) {
#pragma unroll
    for (int o = 1; o < 64; o <<= 1) v += shx(v, o, lane);
    return v;
}
#define LDS_WAIT() asm volatile("s_waitcnt lgkmcnt(0)" ::: "memory")
#define VM_WAIT() asm volatile("s_waitcnt vmcnt(0)" ::: "memory")

namespace pg8 {
constexpr int BM = 256, BK = 64, HALF = 128, HTB = HALF * BK * 2, STAGE_BYTES = 8 * HTB, NXCD = 8, WGM = 8;
__host__ __device__ __forceinline__ int lds_byte(int r, int c) { const int st = (r >> 4) * 2 + (c >> 5), rr = r & 15, cc = c & 31, ob = rr * 64 + cc * 2; return st * 1024 + (ob ^ (((ob >> 9) & 1) << 5)); }
__host__ __device__ __forceinline__ void stage_rc(int b, int& R, int& C) { const int st = b / 1024, sb = b % 1024, swz = sb ^ (((sb >> 9) & 1) << 5); R = (st >> 1) * 16 + swz / 64; C = (st & 1) * 32 + (swz % 64) / 2; }
__host__ __device__ __forceinline__ int perm32(int rho) { const int n = rho >> 4, i = rho & 15; return 8 * (i >> 2) + 4 * n + (i & 3); }

struct Unit { int pm, pn, pk, pz; };
struct Gemm { const bf16_t* A; const bf16_t* Bt; int lda, ldb, K; };

struct OrderMN {
    int nM, nN, nwg, G, c, rep;
    DI void init(int M, int N, int G_, int c_, int rep_ = 1) { nM = M / BM; nN = N / BM; nwg = nM * nN; G = G_; c = c_; rep = rep_; }
    DI bool next(int i, Unit& u) const {
        long L = (long)i * G + c; if (L >= (long)nwg * rep) return false;
        if (L >= nwg) L -= nwg;
        int wgid = (int)L; { const int q = nwg / NXCD, r = nwg % NXCD, xcd = wgid % NXCD, off = wgid / NXCD; wgid = (xcd < r ? xcd * (q + 1) : r * (q + 1) + (xcd - r) * q) + off; }
        const int nig = WGM * nN, gid = wgid / nig, fm = gid * WGM, gsz = (nM - fm) < WGM ? (nM - fm) : WGM;
        u.pm = fm + ((wgid % nig) % gsz); u.pn = (wgid % nig) / gsz; u.pk = 0; u.pz = 0; return true;
    }
    DI const char* a_ptr(const Gemm& g, const Unit& u) const { return (const char*)g.A + (size_t)u.pm * BM * g.lda * 2; }
    DI const char* b_ptr(const Gemm& g, const Unit& u) const { return (const char*)g.Bt + (size_t)u.pn * BM * g.ldb * 2; }
};
struct OrderCmp {
    int G, c;
    DI void init(int G_, int c_) { G = G_; c = c_; }
    DI bool next(int i, Unit& u) const { const int L = i * G + c; if (L >= 128) return false; u.pk = L & 7; u.pm = (L >> 3) & 1; u.pz = L >> 4; u.pn = 0; return true; }
    DI const char* a_ptr(const Gemm& g, const Unit& u) const { const int kv = u.pz >> 2, gg = u.pz & 3;
        return (const char*)g.A + ((size_t)(u.pm * BM * 16 + u.pk * 4) * NP + (kv ? C_VCMP : C_KCMP) + gg * 128) * 2; }
    DI const char* b_ptr(const Gemm& g, const Unit& u) const { const int kv = u.pz >> 2; return (const char*)g.Bt + ((size_t)kv * 256 * 4096 + u.pk * 512) * 2; }
};

template <class Epi, class Sched, bool IM2COL = false, bool ALIGN_EPI = false, bool SP2 = false>
DI void gemm_phase(LAS unsigned char* lds, const Gemm g, const Sched& S, const Epi& E, const int tid) {
    const int wid = __builtin_amdgcn_readfirstlane(tid >> 6), lane = tid & 63, wr = wid >> 2, wc = wid & 3, fr = lane & 15, fq = lane >> 4;
    const int nt = g.K / BK;
    unsigned voffA[2], voffB[2];
#pragma unroll
    for (int i = 0; i < 2; ++i) { int R, C; stage_rc(tid * 16 + i * 8192, R, C); const int Rb = Epi::PERM ? ((R & ~31) + perm32(R & 31)) : R;
        voffA[i] = (unsigned)(R * g.lda + C) * 2u; voffB[i] = (unsigned)(Rb * g.ldb + C) * 2u; }
    const size_t hstepA = (size_t)HALF * g.lda * 2, hstepB = (size_t)HALF * g.ldb * 2;
    const unsigned ldsw = (unsigned)wid * 1024u;
    const int aoff = lds_byte(wr * 64 + fr, fq * 8), boff = lds_byte(wc * 32 + fr, fq * 8);
#define PG8_KA(kt) (IM2COL ? ((size_t)((kt) >> 1) * (NP * 2) + (size_t)((kt) & 1) * 128) : (size_t)(kt) * 128)
#define PG8_KB(kt) ((size_t)(kt) * 128)
#define PG8_SA(b, h) (((b) * 2 + (h)) * HTB)
#define PG8_SB(b, h) ((4 + (b) * 2 + (h)) * HTB)
#define PG8_STAGE(bufoff, gbase, voff) do { _Pragma("unroll") for (int _i = 0; _i < 2; ++_i) \
        __builtin_amdgcn_global_load_lds((const unsigned*)((const char*)(gbase) + (voff)[_i]), (LAS unsigned*)(lds + (bufoff) + ldsw + _i * 8192), 16, 0, 0); } while (0)
#define PG8_LDA(dst, b, h) do { _Pragma("unroll") for (int m = 0; m < 4; ++m) _Pragma("unroll") for (int k = 0; k < 2; ++k) dst[m][k] = *(const LAS bf16x8*)(lds + PG8_SA(b, h) + aoff + m * 2048 + k * 1024); } while (0)
#define PG8_LDB(dst, b, h) do { _Pragma("unroll") for (int n = 0; n < 2; ++n) _Pragma("unroll") for (int k = 0; k < 2; ++k) dst[n][k] = *(const LAS bf16x8*)(lds + PG8_SB(b, h) + boff + n * 2048 + k * 1024); } while (0)
#define PG8_MMA(ai, bj, At, Bt) do { __builtin_amdgcn_s_setprio(1); _Pragma("unroll") for (int m = 0; m < 4; ++m) _Pragma("unroll") for (int n = 0; n < 2; ++n) _Pragma("unroll") for (int k = 0; k < 2; ++k) \
        acc[ai][bj][m][n] = __builtin_amdgcn_mfma_f32_16x16x32_bf16(Bt[n][k], At[m][k], acc[ai][bj][m][n], 0, 0, 0); __builtin_amdgcn_s_setprio(0); } while (0)
#define PG8_WAIT_V(n) asm volatile("s_waitcnt vmcnt(" #n ")" ::: "memory")
#define PG8_WAIT_L(n) asm volatile("s_waitcnt lgkmcnt(" #n ")" ::: "memory")
#define PG8_BAR __builtin_amdgcn_s_barrier()
#define PG8_SCHED __builtin_amdgcn_sched_barrier(0)
    Unit cur, nxt; int ui = 0;
    if (!S.next(0, cur)) return;
    f32x4 acc[2][2][4][2];
#pragma unroll
    for (int a = 0; a < 2; ++a)
#pragma unroll
        for (int b = 0; b < 2; ++b)
#pragma unroll
            for (int m = 0; m < 4; ++m)
#pragma unroll
                for (int n = 0; n < 2; ++n) acc[a][b][m][n] = (f32x4){0.f, 0.f, 0.f, 0.f};
    bf16x8 At[4][2], B0[2][2], B1[2][2];
    const char* cA = S.a_ptr(g, cur); const char* cB = S.b_ptr(g, cur);
    if constexpr (SP2) {
        PG8_STAGE(PG8_SB(0, 0), cB, voffB); PG8_STAGE(PG8_SB(0, 1), cB + hstepB, voffB); PG8_STAGE(PG8_SA(0, 0), cA, voffA); PG8_STAGE(PG8_SA(0, 1), cA + hstepA, voffA);
        if (wr == 1) PG8_BAR;
        PG8_WAIT_V(2); PG8_BAR;
        PG8_STAGE(PG8_SB(1, 0), cB + PG8_KB(1), voffB); PG8_STAGE(PG8_SA(1, 0), cA + PG8_KA(1), voffA); PG8_STAGE(PG8_SB(1, 1), cB + hstepB + PG8_KB(1), voffB);
        PG8_WAIT_V(6); PG8_BAR;
    } else {
    PG8_STAGE(PG8_SB(0, 0), cB, voffB); PG8_STAGE(PG8_SA(0, 0), cA, voffA); PG8_STAGE(PG8_SB(0, 1), cB + hstepB, voffB); PG8_STAGE(PG8_SA(0, 1), cA + hstepA, voffA);
    if (wr == 1) PG8_BAR;
    PG8_WAIT_V(4); PG8_BAR;
    PG8_STAGE(PG8_SB(1, 0), cB + PG8_KB(1), voffB); PG8_STAGE(PG8_SA(1, 0), cA + PG8_KA(1), voffA); PG8_STAGE(PG8_SB(1, 1), cB + hstepB + PG8_KB(1), voffB);
    PG8_WAIT_V(6); PG8_BAR;
    }
    for (;;) {
        const bool has_next = S.next(ui + 1, nxt);
        const char* nA = has_next ? S.a_ptr(g, nxt) : cA; const char* nB = has_next ? S.b_ptr(g, nxt) : cB;
        for (int t = 0; t < nt; t += 2) {
            const bool last = (t == nt - 2);
            const char* a1 = cA + PG8_KA(t + 1);
            const char* a2 = last ? nA : cA + PG8_KA(t + 2); const char* b2 = last ? nB : cB + PG8_KB(t + 2);
            const char* a3 = last ? nA + PG8_KA(1) : cA + PG8_KA(t + 3); const char* b3 = b2 + 128;
            if constexpr (SP2) {
            PG8_LDB(B0, 0, 0); PG8_LDB(B1, 0, 1); PG8_SCHED; PG8_LDA(At, 0, 0); PG8_STAGE(PG8_SA(1, 1), a1 + hstepA, voffA);
            PG8_WAIT_V(8); PG8_WAIT_L(0); PG8_BAR; PG8_MMA(0, 0, At, B0); PG8_MMA(0, 1, At, B1); PG8_BAR; PG8_SCHED;
            PG8_LDA(At, 0, 1); PG8_STAGE(PG8_SB(0, 0), b2, voffB); PG8_STAGE(PG8_SB(0, 1), b2 + hstepB, voffB); PG8_STAGE(PG8_SA(0, 0), a2, voffA);
            PG8_WAIT_V(8); PG8_WAIT_L(0); PG8_BAR; PG8_MMA(1, 0, At, B0); PG8_MMA(1, 1, At, B1); PG8_BAR; PG8_SCHED;
            PG8_LDB(B0, 1, 0); PG8_LDB(B1, 1, 1); PG8_SCHED; PG8_LDA(At, 1, 0); PG8_STAGE(PG8_SA(0, 1), a2 + hstepA, voffA);
            PG8_WAIT_V(8); PG8_WAIT_L(0); PG8_BAR; PG8_MMA(0, 0, At, B0); PG8_MMA(0, 1, At, B1); PG8_BAR; PG8_SCHED;
            PG8_LDA(At, 1, 1); PG8_STAGE(PG8_SB(1, 0), b3, voffB); PG8_STAGE(PG8_SB(1, 1), b3 + hstepB, voffB); PG8_STAGE(PG8_SA(1, 0), a3, voffA);
            PG8_WAIT_V(8); PG8_WAIT_L(0); PG8_BAR; PG8_MMA(1, 0, At, B0); PG8_MMA(1, 1, At, B1); PG8_BAR; PG8_SCHED;
            } else {
            PG8_LDB(B0, 0, 0); PG8_SCHED; PG8_LDA(At, 0, 0); PG8_STAGE(PG8_SA(1, 1), a1 + hstepA, voffA);
            PG8_WAIT_L(8); PG8_BAR; PG8_WAIT_L(0); PG8_MMA(0, 0, At, B0); PG8_BAR; PG8_SCHED;
            PG8_LDB(B1, 0, 1); PG8_STAGE(PG8_SB(0, 0), b2, voffB);
            PG8_BAR; PG8_WAIT_L(0); PG8_MMA(0, 1, At, B1); PG8_BAR;
            PG8_LDA(At, 0, 1); PG8_STAGE(PG8_SA(0, 0), a2, voffA);
            PG8_BAR; PG8_WAIT_L(0); PG8_MMA(1, 0, At, B0); PG8_BAR; PG8_SCHED;
            PG8_STAGE(PG8_SB(0, 1), b2 + hstepB, voffB);
            PG8_WAIT_V(6); PG8_BAR; PG8_MMA(1, 1, At, B1); PG8_BAR;
            PG8_LDB(B0, 1, 0); PG8_SCHED; PG8_LDA(At, 1, 0); PG8_STAGE(PG8_SA(0, 1), a2 + hstepA, voffA);
            PG8_WAIT_L(8); PG8_BAR; PG8_WAIT_L(0); PG8_MMA(0, 0, At, B0); PG8_BAR; PG8_SCHED;
            PG8_LDB(B1, 1, 1); PG8_STAGE(PG8_SB(1, 0), b3, voffB);
            PG8_BAR; PG8_WAIT_L(0); PG8_MMA(0, 1, At, B1); PG8_BAR;
            PG8_LDA(At, 1, 1); PG8_STAGE(PG8_SA(1, 0), a3, voffA);
            PG8_BAR; PG8_WAIT_L(0); PG8_MMA(1, 0, At, B0); PG8_BAR; PG8_SCHED;
            PG8_STAGE(PG8_SB(1, 1), b3 + hstepB, voffB);
            PG8_WAIT_V(6); PG8_BAR; PG8_MMA(1, 1, At, B1); PG8_BAR;
            }
        }
        if constexpr (ALIGN_EPI) { if (wr == 0) PG8_BAR; }
        E(acc, cur, wr, wc, fr, fq);
        if (!has_next) break;
#pragma unroll
        for (int a = 0; a < 2; ++a)
#pragma unroll
            for (int b = 0; b < 2; ++b)
#pragma unroll
                for (int m = 0; m < 4; ++m)
#pragma unroll
                    for (int n = 0; n < 2; ++n) acc[a][b][m][n] = (f32x4){0.f, 0.f, 0.f, 0.f};
        cur = nxt; cA = nA; cB = nB; ++ui;
        if constexpr (ALIGN_EPI) { if (wr == 1) PG8_BAR; }
    }
    PG8_WAIT_V(0);
    if constexpr (!ALIGN_EPI) { if (wr == 0) PG8_BAR; }
    PG8_BAR;
#undef PG8_KA
#undef PG8_KB
#undef PG8_SA
#undef PG8_SB
#undef PG8_STAGE
#undef PG8_LDA
#undef PG8_LDB
#undef PG8_MMA
#undef PG8_WAIT_V
#undef PG8_WAIT_L
#undef PG8_BAR
#undef PG8_SCHED
}

struct EpiCols {
    static constexpr bool PERM = true;
    bf16_t* O; int ldc;
    DI void operator()(const f32x4 (&acc)[2][2][4][2], const Unit& u, int wr, int wc, int fr, int fq) const {
        const int row0 = u.pm * BM + wr * 64 + fr, col0 = u.pn * BM + wc * 32 + 8 * fq;
#pragma unroll
        for (int ai = 0; ai < 2; ++ai)
#pragma unroll
            for (int m = 0; m < 4; ++m) { bf16_t* rowp = O + (size_t)(row0 + ai * HALF + m * 16) * ldc + col0;
#pragma unroll
                for (int bj = 0; bj < 2; ++bj) { const f32x4 v0 = acc[ai][bj][m][0], v1 = acc[ai][bj][m][1];
                    u32x4 w; w.x = cvt_pk_bf16(v0[0], v0[1]); w.y = cvt_pk_bf16(v0[2], v0[3]); w.z = cvt_pk_bf16(v1[0], v1[1]); w.w = cvt_pk_bf16(v1[2], v1[3]);
                    *(u32x4*)(rowp + bj * HALF) = w; } }
    }
};
struct EpiPart {
    static constexpr bool PERM = false;
    float* P;
    DI void operator()(const f32x4 (&acc)[2][2][4][2], const Unit& u, int wr, int wc, int fr, int fq) const {
        float* base = P + ((size_t)(u.pk * 8 + u.pz) * 512 + u.pm * BM) * 256;
        const int row0 = wr * 64 + fr, col0 = wc * 32 + 4 * fq;
#pragma unroll
        for (int ai = 0; ai < 2; ++ai)
#pragma unroll
            for (int m = 0; m < 4; ++m) { float* rowp = base + (size_t)(row0 + ai * HALF + m * 16) * 256 + col0;
#pragma unroll
                for (int bj = 0; bj < 2; ++bj)
#pragma unroll
                    for (int n = 0; n < 2; ++n) *(f32x4*)(rowp + bj * HALF + n * 16) = acc[ai][bj][m][n]; }
    }
};
struct EpiGateTmp {
    static constexpr bool PERM = true;
    float* O; const bf16_t* gate;
    DI void operator()(const f32x4 (&acc)[2][2][4][2], const Unit& u, int wr, int wc, int fr, int fq) const {
        const int row0 = u.pm * BM + wr * 64 + fr, col0 = u.pn * BM + wc * 32 + 8 * fq;
#pragma unroll
        for (int ai = 0; ai < 2; ++ai)
#pragma unroll
            for (int m = 0; m < 4; ++m) { const int row = row0 + ai * HALF + m * 16;
#pragma unroll
                for (int bj = 0; bj < 2; ++bj) { const u32x4 gw = *(const u32x4*)(gate + (size_t)row * NP + col0 + bj * HALF);
                    const f32x4 v0 = acc[ai][bj][m][0], v1 = acc[ai][bj][m][1]; f32x4 o0, o1;
                    o0[0] = v0[0] * sigmoidf_(lo_bf(gw.x)); o0[1] = v0[1] * sigmoidf_(hi_bf(gw.x)); o0[2] = v0[2] * sigmoidf_(lo_bf(gw.y)); o0[3] = v0[3] * sigmoidf_(hi_bf(gw.y));
                    o1[0] = v1[0] * sigmoidf_(lo_bf(gw.z)); o1[1] = v1[1] * sigmoidf_(hi_bf(gw.z)); o1[2] = v1[2] * sigmoidf_(lo_bf(gw.w)); o1[3] = v1[3] * sigmoidf_(hi_bf(gw.w));
                    float* op = O + (size_t)row * D + col0 + bj * HALF; *(f32x4*)op = o0; *(f32x4*)(op + 4) = o1; }
                asm volatile("" ::: "memory"); }
    }
};
struct EpiGateAdd {
    static constexpr bool PERM = true;
    bf16_t* Y; const float* tmp; const bf16_t* gate;
    DI void operator()(const f32x4 (&acc)[2][2][4][2], const Unit& u, int wr, int wc, int fr, int fq) const {
        const int row0 = u.pm * BM + wr * 64 + fr, col0 = u.pn * BM + wc * 32 + 8 * fq;
#pragma unroll
        for (int ai = 0; ai < 2; ++ai)
#pragma unroll
            for (int m = 0; m < 4; ++m) { const int row = row0 + ai * HALF + m * 16;
#pragma unroll
                for (int bj = 0; bj < 2; ++bj) { const u32x4 gw = *(const u32x4*)(gate + (size_t)row * NP + col0 + bj * HALF);
                    const float* tp = tmp + (size_t)row * D + col0 + bj * HALF; const f32x4 t0 = *(const f32x4*)tp, t1 = *(const f32x4*)(tp + 4);
                    const f32x4 v0 = acc[ai][bj][m][0], v1 = acc[ai][bj][m][1]; f32x4 o0, o1;
                    o0[0] = t0[0] + v0[0] * sigmoidf_(lo_bf(gw.x)); o0[1] = t0[1] + v0[1] * sigmoidf_(hi_bf(gw.x)); o0[2] = t0[2] + v0[2] * sigmoidf_(lo_bf(gw.y)); o0[3] = t0[3] + v0[3] * sigmoidf_(hi_bf(gw.y));
                    o1[0] = t1[0] + v1[0] * sigmoidf_(lo_bf(gw.z)); o1[1] = t1[1] + v1[1] * sigmoidf_(hi_bf(gw.z)); o1[2] = t1[2] + v1[2] * sigmoidf_(lo_bf(gw.w)); o1[3] = t1[3] + v1[3] * sigmoidf_(hi_bf(gw.w));
                    u32x4 w; w.x = cvt_pk_bf16(o0[0], o0[1]); w.y = cvt_pk_bf16(o0[2], o0[3]); w.z = cvt_pk_bf16(o1[0], o1[1]); w.w = cvt_pk_bf16(o1[2], o1[3]);
                    *(u32x4*)(Y + (size_t)row * D + col0 + bj * HALF) = w; }
                asm volatile("" ::: "memory"); }
    }
};
struct EpiResid {
    static constexpr bool PERM = true;
    const float* xi; float* xo;
    DI void operator()(const f32x4 (&acc)[2][2][4][2], const Unit& u, int wr, int wc, int fr, int fq) const {
        const int row0 = u.pm * BM + wr * 64 + fr, col0 = u.pn * BM + wc * 32 + 8 * fq;
#pragma unroll
        for (int ai = 0; ai < 2; ++ai) { f32x4 t[4][2][2];
#pragma unroll
            for (int m = 0; m < 4; ++m) { const size_t off = (size_t)(row0 + ai * HALF + m * 16) * D + col0;
#pragma unroll
                for (int bj = 0; bj < 2; ++bj) { t[m][bj][0] = *(const f32x4*)(xi + off + bj * HALF); t[m][bj][1] = *(const f32x4*)(xi + off + bj * HALF + 4); } }
#pragma unroll
            for (int m = 0; m < 4; ++m) { const size_t off = (size_t)(row0 + ai * HALF + m * 16) * D + col0;
#pragma unroll
                for (int bj = 0; bj < 2; ++bj) { *(f32x4*)(xo + off + bj * HALF) = t[m][bj][0] + acc[ai][bj][m][0]; *(f32x4*)(xo + off + bj * HALF + 4) = t[m][bj][1] + acc[ai][bj][m][1]; } }
            asm volatile("" ::: "memory"); }
    }
};
struct OrderAB {
    OrderMN mn; const bf16_t* A2; const bf16_t* B2;
    DI bool next(int i, Unit& u) const { if (!mn.next(i >> 1, u)) return false; u.pz = i & 1; return true; }
    DI const char* a_ptr(const Gemm& g, const Unit& u) const { return (const char*)(u.pz ? A2 : g.A) + (size_t)u.pm * BM * g.lda * 2; }
    DI const char* b_ptr(const Gemm& g, const Unit& u) const { return (const char*)(u.pz ? B2 : g.Bt) + (size_t)u.pn * BM * g.ldb * 2; }
};
struct EpiGateAB {
    static constexpr bool PERM = true;
    bf16_t* Y; bf16_t* tmp; const bf16_t* gate_a; const bf16_t* gate_b;
    DI void operator()(const f32x4 (&acc)[2][2][4][2], const Unit& u, int wr, int wc, int fr, int fq) const {
        const int row0 = u.pm * BM + wr * 64 + fr, col0 = u.pn * BM + wc * 32 + 8 * fq;
        const bf16_t* gate = u.pz ? gate_b : gate_a; bf16_t* dst = u.pz ? Y : tmp;
#pragma unroll
        for (int ai = 0; ai < 2; ++ai) { u32x4 gw[4][2], tw[4][2];
#pragma unroll
            for (int m = 0; m < 4; ++m) { const int row = row0 + ai * HALF + m * 16;
#pragma unroll
                for (int bj = 0; bj < 2; ++bj) { gw[m][bj] = *(const u32x4*)(gate + (size_t)row * NP + col0 + bj * HALF);
                    tw[m][bj] = (u32x4){0u, 0u, 0u, 0u}; if (u.pz) tw[m][bj] = *(const u32x4*)(tmp + (size_t)row * D + col0 + bj * HALF); } }
#pragma unroll
            for (int m = 0; m < 4; ++m) { const int row = row0 + ai * HALF + m * 16;
#pragma unroll
                for (int bj = 0; bj < 2; ++bj) { const u32x4 g_ = gw[m][bj], t_ = tw[m][bj];
                    const f32x4 v0 = acc[ai][bj][m][0], v1 = acc[ai][bj][m][1]; f32x4 o0, o1;
                    o0[0] = lo_bf(t_.x) + v0[0] * sigmoidf_(lo_bf(g_.x)); o0[1] = hi_bf(t_.x) + v0[1] * sigmoidf_(hi_bf(g_.x)); o0[2] = lo_bf(t_.y) + v0[2] * sigmoidf_(lo_bf(g_.y)); o0[3] = hi_bf(t_.y) + v0[3] * sigmoidf_(hi_bf(g_.y));
                    o1[0] = lo_bf(t_.z) + v1[0] * sigmoidf_(lo_bf(g_.z)); o1[1] = hi_bf(t_.z) + v1[1] * sigmoidf_(hi_bf(g_.z)); o1[2] = lo_bf(t_.w) + v1[2] * sigmoidf_(lo_bf(g_.w)); o1[3] = hi_bf(t_.w) + v1[3] * sigmoidf_(hi_bf(g_.w));
                    u32x4 w; w.x = cvt_pk_bf16(o0[0], o0[1]); w.y = cvt_pk_bf16(o0[2], o0[3]); w.z = cvt_pk_bf16(o1[0], o1[1]); w.w = cvt_pk_bf16(o1[2], o1[3]);
                    *(u32x4*)(dst + (size_t)row * D + col0 + bj * HALF) = w; } }
            asm volatile("" ::: "memory"); }
    }
};
}

#define XB_TMO      128
#define XB_XCNT(j)  (256  + 64 * (j))
#define XB_XSUB(j)  (1280 + 64 * (j))
#define XB_XGEN(j)  (2304 + 64 * (j))
#define XB_TOP      3328
#define XB_TOPGEN   3392
#define XCD_BAR_WORDS 3456
#define XB_SPIN_CAP (1u << 18)
__device__ __forceinline__ unsigned xb_ld(unsigned* p)              { return __hip_atomic_load(p, __ATOMIC_RELAXED, __HIP_MEMORY_SCOPE_AGENT); }
__device__ __forceinline__ unsigned xb_add(unsigned* p, unsigned v) { return __hip_atomic_fetch_add(p, v, __ATOMIC_RELAXED, __HIP_MEMORY_SCOPE_AGENT); }
__device__ __forceinline__ unsigned xb_xcc_id() { return (unsigned)__builtin_amdgcn_s_getreg((3 << 11) | 20) & 0xFu; }
#define XB_SPIN(cond, bar) do { unsigned _sp = 0; while (cond) { __builtin_amdgcn_s_sleep(1); \
    if ((++_sp & 255u) == 0u) { if (xb_ld(&(bar)[XB_TMO])) break; if (_sp > XB_SPIN_CAP) { atomicAdd(&(bar)[XB_TMO], 1u); break; } } } } while (0)
struct XcdBarrier { unsigned* bar; unsigned x; volatile LAS unsigned* st; };
__device__ __forceinline__ XcdBarrier xcd_barrier_post(unsigned* bar, volatile LAS unsigned* st) {
    XcdBarrier b; b.bar = bar; b.x = xb_xcc_id(); b.st = st;
    if (threadIdx.x == 0) (void)xb_add(&bar[XB_XCNT(b.x)], 1u);
    return b;
}
__device__ __forceinline__ void xcd_barrier_complete(unsigned* bar, unsigned x, unsigned& nloc, unsigned& nx) {
    const unsigned G = gridDim.x * gridDim.y * gridDim.z;
    unsigned sum, cnt, mine, sp = 0u;
    for (;;) {
        sum = 0u; cnt = 0u; mine = 0u;
#pragma unroll
        for (unsigned j = 0; j < 16; ++j) { const unsigned c = xb_ld(&bar[XB_XCNT(j)]); sum += c; cnt += (c > 0u) ? 1u : 0u; mine = (j == x) ? c : mine; }
        if (sum == G) break;
        __builtin_amdgcn_s_sleep(1);
        if ((++sp & 255u) == 0u) { if (xb_ld(&bar[XB_TMO])) break; if (sp > XB_SPIN_CAP) { atomicAdd(&bar[XB_TMO], 1u); break; } }
    }
    nloc = mine > 0u ? mine : 1u; nx = cnt > 0u ? cnt : 1u;
}
__device__ __forceinline__ void xcd_barrier(const XcdBarrier& b) {
    asm volatile("s_waitcnt vmcnt(0)" ::: "memory");
    __syncthreads();
    if (threadIdx.x == 0) {
        unsigned* bar = b.bar;
        __builtin_amdgcn_s_waitcnt(0);
        unsigned nloc = b.st[0], nx = b.st[1];
        if (nloc == 0u) { xcd_barrier_complete(bar, b.x, nloc, nx); b.st[0] = nloc; b.st[1] = nx; }
        const unsigned old = xb_add(&bar[XB_XSUB(b.x)], 1u);
        const unsigned gen = old / nloc;
        if (old + 1u == (gen + 1u) * nloc) {
            __builtin_amdgcn_fence(__ATOMIC_RELEASE, "agent");
            asm volatile("s_waitcnt vmcnt(0)" ::: "memory");
            const unsigned og = xb_add(&bar[XB_TOP], 1u);
            const unsigned tg = og / nx;
            if (og + 1u == (tg + 1u) * nx) xb_add(&bar[XB_TOPGEN], 1u);
            else XB_SPIN(xb_ld(&bar[XB_TOPGEN]) == tg, bar);
            __builtin_amdgcn_fence(__ATOMIC_ACQUIRE, "agent");
            xb_add(&bar[XB_XGEN(b.x)], 1u);
            asm volatile("s_waitcnt vmcnt(0)" ::: "memory");
        } else {
            XB_SPIN(xb_ld(&bar[XB_XGEN(b.x)]) == gen, bar);
            __builtin_amdgcn_fence(__ATOMIC_ACQUIRE, "agent");
            asm volatile("s_waitcnt vmcnt(0)" ::: "memory");
        }
    }
    __syncthreads();
}

struct Args {
    const float *x, *norm_w, *w_in, *cmp_pe, *cmp_w1, *cmp_b1, *cmp_w2, *cmp_b2, *alpha_w, *alpha_b, *gla_norm_w, *p_a, *p_b, *w_out, *final_w;
    float* out; unsigned char* ws; int ph_lo, ph_hi;
};
typedef const __attribute__((address_space(4))) Args* KArgsP;
DI Args load_args(KArgsP p) { Args a; a.x = p->x; a.norm_w = p->norm_w; a.w_in = p->w_in; a.cmp_pe = p->cmp_pe; a.cmp_w1 = p->cmp_w1; a.cmp_b1 = p->cmp_b1; a.cmp_w2 = p->cmp_w2; a.cmp_b2 = p->cmp_b2;
    a.alpha_w = p->alpha_w; a.alpha_b = p->alpha_b; a.gla_norm_w = p->gla_norm_w; a.p_a = p->p_a; a.p_b = p->p_b; a.w_out = p->w_out; a.final_w = p->final_w; a.out = p->out; a.ws = p->ws; a.ph_lo = 0; a.ph_hi = 0; return a; }
struct Frame {
    LAS unsigned char* lds; int tid, lane, wave, G, bid, gw, NGW;
};

struct CvItem { const float* W; bf16_t* WT; int K, N, item; bool map; };
DI void cv_load(f32x4 (&v)[16], const CvItem& c, int lane) {
    const int nblk = c.N / 64, kb = c.item / nblk, nb = c.item % nblk, k0 = 64 * kb, n0 = 64 * nb;
#pragma unroll
    for (int i = 0; i < 16; ++i) v[i] = *(const f32x4*)(c.W + (size_t)(k0 + 4 * i + (lane >> 4)) * c.N + n0 + 4 * (lane & 15));
}
DI void cv_store(const f32x4 (&v)[16], const CvItem& c, LAS float* scr, int lane) {
    const int nblk = c.N / 64, kb = c.item / nblk, nb = c.item % nblk, k0 = 64 * kb, n0 = 64 * nb;
#pragma unroll
    for (int i = 0; i < 16; ++i) { LAS float* d = scr + (4 * i + (lane >> 4)) * 65 + 4 * (lane & 15); d[0] = v[i].x; d[1] = v[i].y; d[2] = v[i].z; d[3] = v[i].w; }
    LDS_WAIT(); asm volatile("" ::: "memory");
    const int ch = lane & 7;
#pragma unroll
    for (int j = 0; j < 8; ++j) { const int n = (lane >> 3) + 8 * j; const LAS float* s = scr + (8 * ch) * 65 + n;
        u32x4 o; o.x = pk2(s[0 * 65], s[1 * 65]); o.y = pk2(s[2 * 65], s[3 * 65]); o.z = pk2(s[4 * 65], s[5 * 65]); o.w = pk2(s[6 * 65], s[7 * 65]);
        const int drow = c.map ? map_col(n0 + n) : (n0 + n);
        *(u32x4*)(c.WT + (size_t)drow * c.K + k0 + 8 * ch) = o; }
    LDS_WAIT(); asm volatile("" ::: "memory");
}
constexpr int CV_IN = (D / 64) * (NIN / 64), CV_SQ = (D / 64) * (D / 64), CV_W1 = (4096 / 64) * (256 / 64), CV_W2 = (256 / 64) * (128 / 64);
constexpr int CV_PER_L = CV_IN + 3 * CV_SQ + 2 * CV_W1 + 2 * CV_W2;
DI CvItem cv_item(const Args& a, int it) {
    unsigned char* ws = a.ws; const int l = it / CV_PER_L; int r = it % CV_PER_L; CvItem c;
    if (r < CV_IN) { c.W = a.w_in + (size_t)l * D * NIN; c.WT = (bf16_t*)(ws + WS_WIN) + (size_t)l * NP * D; c.K = D; c.N = NIN; c.item = r; c.map = true; return c; } r -= CV_IN;
    c.map = false;
    if (r < CV_SQ) { c.W = a.p_a + (size_t)l * D * D; c.WT = (bf16_t*)(ws + WS_WPA) + (size_t)l * D * D; c.K = D; c.N = D; c.item = r; return c; } r -= CV_SQ;
    if (r < CV_SQ) { c.W = a.p_b + (size_t)l * D * D; c.WT = (bf16_t*)(ws + WS_WPB) + (size_t)l * D * D; c.K = D; c.N = D; c.item = r; return c; } r -= CV_SQ;
    if (r < CV_SQ) { c.W = a.w_out + (size_t)l * D * D; c.WT = (bf16_t*)(ws + WS_WOUT) + (size_t)l * D * D; c.K = D; c.N = D; c.item = r; return c; } r -= CV_SQ;
    if (r < 2 * CV_W1) { const int kv = r / CV_W1; c.W = a.cmp_w1 + (size_t)(l * 2 + kv) * 4096 * 256; c.WT = (bf16_t*)(ws + WS_W1T) + (size_t)(l * 2 + kv) * 256 * 4096; c.K = 4096; c.N = 256; c.item = r % CV_W1; return c; } r -= 2 * CV_W1;
    { const int kv = r / CV_W2; c.W = a.cmp_w2 + (size_t)(l * 2 + kv) * 256 * 128; c.WT = (bf16_t*)(ws + WS_W2T) + (size_t)(l * 2 + kv) * 128 * 256; c.K = 256; c.N = 128; c.item = r % CV_W2; }
    return c;
}
DI void p_prologue(const Frame& F, const Args& a) {
    LAS float* scr = (LAS float*)(F.lds + F.wave * 16640);
    unsigned char* ws = a.ws;
    constexpr int TOT = DEPTH * CV_PER_L;
    f32x4 va[16], vb[16];
    int it = F.gw;
    if (it < TOT) { CvItem ca = cv_item(a, it); cv_load(va, ca, F.lane);
        for (;;) {
            const int itb = it + F.NGW; CvItem cb; const bool hb = itb < TOT; if (hb) { cb = cv_item(a, itb); cv_load(vb, cb, F.lane); }
            cv_store(va, ca, scr, F.lane);
            if (!hb) break;
            const int itc = itb + F.NGW; const bool hc = itc < TOT; if (hc) { ca = cv_item(a, itc); cv_load(va, ca, F.lane); }
            cv_store(vb, cb, scr, F.lane);
            if (!hc) break;
            it = itc;
        } }
    __syncthreads();
    LAS float* red = (LAS float*)F.lds;
    for (int job = F.bid; job < DEPTH * 2; job += F.G) {
        const float* w1 = a.cmp_w1 + (size_t)job * 4096 * 256; const float* pe = a.cmp_pe + (size_t)job * 4096;
        f32x4 s = {0.f, 0.f, 0.f, 0.f};
        for (int k = F.wave * 512; k < F.wave * 512 + 512; ++k) { const f32x4 w = *(const f32x4*)(w1 + (size_t)k * 256 + 4 * F.lane); s += w * pe[k]; }
        *(LAS f32x4*)(red + F.wave * 256 + 4 * F.lane) = s;
        __syncthreads();
        if (F.tid < 256) { float t = a.cmp_b1[job * 256 + F.tid];
#pragma unroll
            for (int w = 0; w < 8; ++w) t += red[w * 256 + F.tid];
            ((float*)(ws + WS_B1P))[job * 256 + F.tid] = t; }
        __syncthreads();
    }
}

template <bool OUT_F32>
DI void p_rmsnorm(const Frame& F, const float* x, const float* w, void* out) {
    f32x4 wv[8];
#pragma unroll
    for (int j = 0; j < 8; ++j) wv[j] = *(const f32x4*)(w + 4 * F.lane + 256 * j);
    for (int row = F.gw; row < T; row += F.NGW) {
        const float* xr = x + (size_t)row * D + 4 * F.lane;
        f32x4 v[8]; float s = 0.f;
#pragma unroll
        for (int j = 0; j < 8; ++j) { v[j] = *(const f32x4*)(xr + 256 * j); s += (v[j].x * v[j].x + v[j].y * v[j].y) + (v[j].z * v[j].z + v[j].w * v[j].w); }
        const float rs = rsqrtf(wave_sum(s, F.lane) * (1.f / D) + NORM_EPS);
        if (OUT_F32) { float* o = (float*)out + (size_t)row * D + 4 * F.lane;
#pragma unroll
            for (int j = 0; j < 8; ++j) *(f32x4*)(o + 256 * j) = v[j] * rs * wv[j];
        } else { bf16_t* o = (bf16_t*)out + (size_t)row * D + 4 * F.lane;
#pragma unroll
            for (int j = 0; j < 8; ++j) { const f32x4 y = v[j] * rs * wv[j]; u32x2 p; p.x = pk2(y.x, y.y); p.y = pk2(y.z, y.w); *(u32x2*)(o + 256 * j) = p; } }
    }
}

constexpr int KTILE = 16384, VTILE = 16384, ABUF = KTILE + VTILE;
DI void glds16(const void* gsrc, LAS unsigned char* dst) { unsigned keep; const unsigned lds_dst = (unsigned)(uintptr_t)dst;
    asm volatile("s_mov_b32 %0, m0\n\ts_mov_b32 m0, %2\n\ts_nop 0\n\tglobal_load_lds_dwordx4 %1, off\n\ts_mov_b32 m0, %0" : "=&s"(keep) : "v"(gsrc), "s"(lds_dst) : "memory"); }
DI void dma_k(LAS unsigned char* kb, const bf16_t* kbase, size_t kpitch, int w, int lane) {
#pragma unroll
    for (int i = 0; i < 2; ++i) { const int b = w + 8 * i, row = 4 * b + (lane >> 4), c = (lane & 15) ^ (row & 15);
        glds16(kbase + (size_t)row * kpitch + c * 8, kb + b * 1024); }
}
DI void dma_v(LAS unsigned char* vb, const bf16_t* vbase, size_t vpitch, int w, int lane) {
#pragma unroll
    for (int i = 0; i < 2; ++i) { const int b = w + 8 * i, row = 8 * b + (lane >> 3), c = (lane & 7) ^ ((row >> 1) & 7);
        glds16(vbase + (size_t)row * vpitch + c * 8, vb + b * 1024); }
}
#define VMCNT(n) asm volatile("s_waitcnt vmcnt(" #n ")" ::: "memory")
#define RAW_BARRIER() do { asm volatile("" ::: "memory"); __builtin_amdgcn_s_barrier(); asm volatile("" ::: "memory"); } while (0)

template <bool PERMK>
DI void transpose64x64(const bf16_t* src, size_t pitch, bf16_t* dst, LAS unsigned char* scr, int lane) {
    u32x4 v[8];
#pragma unroll
    for (int i = 0; i < 8; ++i) { const int id = i * 64 + lane, row = id >> 3, ch = id & 7; v[i] = *(const u32x4*)(src + (size_t)row * pitch + ch * 8); }
#pragma unroll
    for (int i = 0; i < 8; ++i) { const int id = i * 64 + lane, row = id >> 3, ch = id & 7;
        const int pos = PERMK ? ((row & 32) | (((row >> 2) & 3) << 3) | (((row >> 4) & 1) << 2) | (row & 3)) : row;
        LAS unsigned char* d = scr + (8 * ch) * 136 + pos * 2;
        *(LAS unsigned short*)(d + 0 * 136) = (unsigned short)(v[i].x & 0xffffu); *(LAS unsigned short*)(d + 1 * 136) = (unsigned short)(v[i].x >> 16);
        *(LAS unsigned short*)(d + 2 * 136) = (unsigned short)(v[i].y & 0xffffu); *(LAS unsigned short*)(d + 3 * 136) = (unsigned short)(v[i].y >> 16);
        *(LAS unsigned short*)(d + 4 * 136) = (unsigned short)(v[i].z & 0xffffu); *(LAS unsigned short*)(d + 5 * 136) = (unsigned short)(v[i].z >> 16);
        *(LAS unsigned short*)(d + 6 * 136) = (unsigned short)(v[i].w & 0xffffu); *(LAS unsigned short*)(d + 7 * 136) = (unsigned short)(v[i].w >> 16); }
    LDS_WAIT(); asm volatile("" ::: "memory");
#pragma unroll
    for (int i = 0; i < 8; ++i) { const int id = i * 64 + lane, col = id >> 3, tg = id & 7;
        const u32x2 lo = *(const LAS u32x2*)(scr + col * 136 + tg * 16), hi = *(const LAS u32x2*)(scr + col * 136 + tg * 16 + 8);
        u32x4 o; o.x = lo.x; o.y = lo.y; o.z = hi.x; o.w = hi.y;
        *(u32x4*)(dst + (size_t)col * 64 + 8 * tg) = o; }
    LDS_WAIT(); asm volatile("" ::: "memory");
}

DI void gla_g1_unit(const Frame& F, const Args& a, int layer, int n, int h) {
    const bf16_t* cols = (const bf16_t*)(a.ws + WS_COLS);
    LAS float* alr = (LAS float*)(F.lds); LAS float* part = (LAS float*)(F.lds + 4096);
    LAS unsigned char* QR = F.lds + 8192; LAS unsigned char* KR = F.lds + 8192 + 32768;
    __syncthreads();
#pragma unroll
    for (int hf = 0; hf < 2; ++hf) { dma_k(QR + hf * 16384, cols + (size_t)(64 * n) * NP + C_QB + h * 256 + hf * 128, NP, F.wave, F.lane);
        dma_k(KR + hf * 16384, cols + (size_t)(64 * n) * NP + C_KB + h * 256 + hf * 128, NP, F.wave, F.lane); }
    if (F.tid < 256) { const int t = F.tid >> 2, k4 = (F.tid & 3) * 4; const u32x2 w = *(const u32x2*)(cols + (size_t)(64 * n + t) * NP + C_ALR + k4);
        alr[t * 16 + k4 + 0] = lo_bf(w.x); alr[t * 16 + k4 + 1] = hi_bf(w.x); alr[t * 16 + k4 + 2] = lo_bf(w.y); alr[t * 16 + k4 + 3] = hi_bf(w.y); }
    __syncthreads();
    const int d = F.tid & 255, half = F.tid >> 8, col = h * 256 + d;
    float w[16];
#pragma unroll
    for (int k = 0; k < 16; ++k) w[k] = a.alpha_w[(size_t)(layer * 16 + k) * 1024 + col];
    const float b = a.alpha_b[layer * 1024 + col];
    float cum[32]; float run = 0.f;
#pragma unroll
    for (int i = 0; i < 32; ++i) { const int t = half * 32 + i; float ga = b;
#pragma unroll
        for (int k4 = 0; k4 < 4; ++k4) { const f32x4 av = *(const LAS f32x4*)(alr + t * 16 + 4 * k4); ga += av.x * w[4 * k4] + av.y * w[4 * k4 + 1] + av.z * w[4 * k4 + 2] + av.w * w[4 * k4 + 3]; }
        const float ls = fminf(ga, 0.f) - __logf(1.f + __expf(-fabsf(ga)));
        run += ls * 0.0625f; cum[i] = run; }
    part[half * 256 + d] = run;
    VMCNT(0);
    __syncthreads();
    const float p0 = part[d], last = p0 + part[256 + d], elast = __expf(last);
    if (half) {
#pragma unroll
        for (int i = 0; i < 32; ++i) cum[i] += p0; }
    bf16_t* kst = (bf16_t*)(a.ws + WS_KST);
    const int eoff = (d >> 7) * 16384 + (d & 7) * 2, ech = (d & 127) >> 3;
    unsigned ksw[16];
#pragma unroll
    for (int i = 0; i < 32; ++i) { const int t = half * 32 + i; const int off = eoff + t * 256 + ((ech ^ (t & 15)) << 4);
        const float qv = bf2f(*(const LAS unsigned short*)(QR + off)), kv = bf2f(*(const LAS unsigned short*)(KR + off));
        const float ec = __expf(cum[i]), kin = kv * __expf(-cum[i]);
        const unsigned qb = f2bf(qv * 0.0625f * ec), kib = f2bf(kin), ksb = f2bf(kin * elast);
        *(LAS unsigned short*)(QR + off) = (unsigned short)qb; *(LAS unsigned short*)(KR + off) = (unsigned short)kib;
        if (i & 1) ksw[i >> 1] |= ksb << 16; else ksw[i >> 1] = ksb; }
    { bf16_t* kp = kst + ((size_t)((n * 4 + h) * 256 + d)) * 64 + half * 32;
#pragma unroll
        for (int j = 0; j < 4; ++j) { u32x4 o; o.x = ksw[4 * j]; o.y = ksw[4 * j + 1]; o.z = ksw[4 * j + 2]; o.w = ksw[4 * j + 3]; *(u32x4*)(kp + 8 * j) = o; } }
    if (half == 0) ((float*)(a.ws + WS_DEC))[(n * 4 + h) * 256 + d] = elast;
    __syncthreads();
    { bf16_t* qdec = (bf16_t*)(a.ws + WS_QDEC);
#pragma unroll
        for (int i = 0; i < 4; ++i) { const int id = F.tid + 512 * i, t = id >> 5, c32 = id & 31, hf = c32 >> 4, c = c32 & 15;
            *(u32x4*)(qdec + (size_t)(64 * n + t) * 1024 + h * 256 + c32 * 8) = *(const LAS u32x4*)(QR + hf * 16384 + t * 256 + ((c ^ (t & 15)) << 4)); } }
    bf16_t* att = (bf16_t*)(a.ws + WS_ATT) + (size_t)(n * 4 + h) * 4096;
    const int fr = F.lane & 15, fq = F.lane >> 4, ms = F.wave >> 1;
#pragma unroll
    for (int z = 0; z < 2; ++z) { const int nt = 2 * (F.wave & 1) + z; f32x4 acc = {0.f, 0.f, 0.f, 0.f};
#pragma unroll
        for (int ks = 0; ks < 8; ++ks) { const int fo = (ks >> 2) * 16384 + (((4 * (ks & 3) + fq) ^ fr) << 4);
            const bf16x8 A = *(const LAS bf16x8*)(KR + fo + (16 * ms + fr) * 256);
            const bf16x8 B = *(const LAS bf16x8*)(QR + fo + (16 * nt + fr) * 256); acc = MFMA16(A, B, acc); }
        const int t = 16 * nt + fr, s0 = 16 * ms + 4 * fq;
        u32x2 o; o.x = pk2(s0 + 0 <= t ? acc[0] : 0.f, s0 + 1 <= t ? acc[1] : 0.f); o.y = pk2(s0 + 2 <= t ? acc[2] : 0.f, s0 + 3 <= t ? acc[3] : 0.f);
        *(u32x2*)(att + t * 64 + s0) = o; }
}

DI void transpose_unit(const Frame& F, const Args& a, int tu) {
    __syncthreads();
    const bf16_t* cols = (const bf16_t*)(a.ws + WS_COLS);
    LAS unsigned char* scr = F.lds + F.wave * 9216;
#pragma unroll 1
    for (int rep = 0; rep < 3; ++rep) { const int it = (tu * 3 + rep) * 8 + F.wave;
    if (it < 4096) { const int n = it >> 5, cg = it & 31;
        transpose64x64<false>(cols + (size_t)(64 * n) * NP + C_VB + 64 * cg, NP, (bf16_t*)(a.ws + WS_VT) + ((size_t)n * 2048 + 64 * cg) * 64, scr, F.lane); }
    else { const int r = (it - 4096) & 1023, win = (it - 4096) >> 10, j = r >> 3, g = (r >> 1) & 3, hf = r & 1;
        transpose64x64<true>(cols + (size_t)(64 * j) * NP + (win ? C_VWIN : C_VSEL) + 128 * g + 64 * hf, NP,
                             (bf16_t*)(a.ws + (win ? WS_VWINT : WS_VSELT)) + ((size_t)(g * 128 + j) * 128 + 64 * hf) * 64, scr, F.lane); } }
}

DI float gelu_tanh(float x) { const float u = 0.7978845608028654f * (x + 0.044715f * x * x * x); const float t = __expf(2.f * u); return 0.5f * x * (2.f - 2.f / (t + 1.f)); }
DI void mlp2_unit(const Frame& F, const Args& a, int layer, int pz, int rt) {
    const float* cpart = (const float*)(a.ws + WS_CPART);
    LAS unsigned char* hid = F.lds;
    const int kv = pz >> 2, g = pz & 3;
    __syncthreads();
    { const int r = F.tid >> 5, c0 = (F.tid & 31) * 8; f32x4 s0, s1;
        const float* bp = (const float*)(a.ws + WS_B1P) + (layer * 2 + kv) * 256 + c0;
        s0 = *(const f32x4*)bp; s1 = *(const f32x4*)(bp + 4);
#pragma unroll
        for (int pk = 0; pk < 8; ++pk) { const float* p = cpart + ((size_t)(pk * 8 + pz) * 512 + rt * 16 + r) * 256 + c0; s0 += *(const f32x4*)p; s1 += *(const f32x4*)(p + 4); }
        u32x4 o; o.x = pk2(gelu_tanh(s0.x), gelu_tanh(s0.y)); o.y = pk2(gelu_tanh(s0.z), gelu_tanh(s0.w)); o.z = pk2(gelu_tanh(s1.x), gelu_tanh(s1.y)); o.w = pk2(gelu_tanh(s1.z), gelu_tanh(s1.w));
        *(LAS u32x4*)(hid + r * 528 + c0 * 2) = o; }
    __syncthreads();
    const bf16_t* w2t = (const bf16_t*)(a.ws + WS_W2T) + (size_t)(layer * 2 + kv) * 128 * 256;
    const int fr = F.lane & 15, fq = F.lane >> 4, dt = F.wave;
    const float* b2 = a.cmp_b2 + (layer * 2 + kv) * 128;
    f32x4 acc = {0.f, 0.f, 0.f, 0.f};
#pragma unroll
    for (int ks = 0; ks < 8; ++ks) { const bf16x8 wf = *(const bf16x8*)(w2t + (16 * dt + fr) * 256 + 32 * ks + 8 * fq);
        const bf16x8 hf = *(const LAS bf16x8*)(hid + fr * 528 + (32 * ks + 8 * fq) * 2);
        acc = kv ? MFMA16(hf, wf, acc) : MFMA16(wf, hf, acc); }
    if (!kv) { const int n = 16 * rt + fr, dim = 16 * dt + 4 * fq; const f32x4 bb = *(const f32x4*)(b2 + dim); u32x2 o;
        if (n == 511) { o.x = 0u; o.y = 0u; } else { o.x = pk2(acc[0] + bb.x, acc[1] + bb.y); o.y = pk2(acc[2] + bb.z, acc[3] + bb.w); }
        *(u32x2*)((bf16_t*)(a.ws + WS_KC) + ((size_t)g * 512 + n) * 128 + dim) = o; }
    else { const int n0 = 16 * rt + 4 * fq, dim = 16 * dt + fr; const float bb = b2[dim]; u32x2 o;
        o.x = pk2(acc[0] + bb, acc[1] + bb); o.y = pk2(acc[2] + bb, (n0 + 3 == 511) ? 0.f : acc[3] + bb);
        const int pos = 64 * (rt >> 2) + 32 * ((rt & 3) >> 1) + 8 * fq + 4 * (rt & 1);
        *(u32x2*)((bf16_t*)(a.ws + WS_VCT) + ((size_t)g * 128 + dim) * 512 + pos) = o; }
}

template <int ACT>
DI void qk_tile(f32x4 (&s)[4][2], const LAS unsigned char* kb, const bf16x8 (&qf)[2][4], int fr, int fq) {
    const LAS unsigned char* kr = kb + fr * 256; const int x0 = (fq ^ fr) << 4, x1 = ((4 + fq) ^ fr) << 4, x2 = ((8 + fq) ^ fr) << 4, x3 = ((12 + fq) ^ fr) << 4;
    const f32x4 zero = {0.f, 0.f, 0.f, 0.f};
#pragma unroll
    for (int kt = 0; kt < 4; ++kt) { const LAS unsigned char* kn = kr + kt * 4096; bf16x8 kf[4];
        kf[0] = *(const LAS bf16x8*)(kn + x0); kf[1] = *(const LAS bf16x8*)(kn + x1); kf[2] = *(const LAS bf16x8*)(kn + x2); kf[3] = *(const LAS bf16x8*)(kn + x3);
        if (ACT & 1) { s[kt][0] = MFMA16(kf[0], qf[0][0], zero); } if (ACT & 2) { s[kt][1] = MFMA16(kf[0], qf[1][0], zero); }
#pragma unroll
        for (int ks = 1; ks < 4; ++ks) { if (ACT & 1) s[kt][0] = MFMA16(kf[ks], qf[0][ks], s[kt][0]); if (ACT & 2) s[kt][1] = MFMA16(kf[ks], qf[1][ks], s[kt][1]); }
    }
}
template <int ACT, bool WITH_L = true>
DI void pv_tile(f32x4 (&O)[8][2], f32x4 (&L)[2], const LAS unsigned char* vb, const bf16x8 (&pf)[2][2], int fr, int fq) {
    const LAS unsigned char* vr = vb + fr * 128; const int x = (fr >> 1) & 7, y0 = (fq ^ x) << 4, y1 = ((4 + fq) ^ x) << 4;
    const bf16x8 ones = {0x3f80, 0x3f80, 0x3f80, 0x3f80, 0x3f80, 0x3f80, 0x3f80, 0x3f80};
    if (WITH_L && (ACT & 1)) { L[0] = MFMA16(ones, pf[0][0], L[0]); L[0] = MFMA16(ones, pf[1][0], L[0]); }
    if (WITH_L && (ACT & 2)) { L[1] = MFMA16(ones, pf[0][1], L[1]); L[1] = MFMA16(ones, pf[1][1], L[1]); }
#pragma unroll
    for (int dt = 0; dt < 8; ++dt) {
        const bf16x8 v0 = *(const LAS bf16x8*)(vr + dt * 2048 + y0), v1 = *(const LAS bf16x8*)(vr + dt * 2048 + y1);
        if (ACT & 1) O[dt][0] = MFMA16(v0, pf[0][0], O[dt][0]); if (ACT & 2) O[dt][1] = MFMA16(v0, pf[0][1], O[dt][1]);
        if (ACT & 1) O[dt][0] = MFMA16(v1, pf[1][0], O[dt][0]); if (ACT & 2) O[dt][1] = MFMA16(v1, pf[1][1], O[dt][1]);
    }
}
DI float max3f(float a, float b, float c) { return fmaxf(fmaxf(a, b), c); }
DI bf16x8 pack_p(const f32x4& a, const f32x4& b) { u32x4 w; w.x = cvt_pk_bf16(a[0], a[1]); w.y = cvt_pk_bf16(a[2], a[3]); w.z = cvt_pk_bf16(b[0], b[1]); w.w = cvt_pk_bf16(b[2], b[3]); return __builtin_bit_cast(bf16x8, w); }
DI float quad_max(float v, int lane) {
    auto r = __builtin_amdgcn_permlane16_swap(__float_as_uint(v), __float_as_uint(v), false, false); v = fmaxf(__uint_as_float(r[0]), __uint_as_float(r[1]));
    r = __builtin_amdgcn_permlane32_swap(__float_as_uint(v), __float_as_uint(v), false, false); return fmaxf(__uint_as_float(r[0]), __uint_as_float(r[1])); }
DI float quad_sum(float v, int lane) {
    auto r = __builtin_amdgcn_permlane16_swap(__float_as_uint(v), __float_as_uint(v), false, false); v = __uint_as_float(r[0]) + __uint_as_float(r[1]);
    r = __builtin_amdgcn_permlane32_swap(__float_as_uint(v), __float_as_uint(v), false, false); return __uint_as_float(r[0]) + __uint_as_float(r[1]); }
constexpr float NEG_INF = -__builtin_inff();

template <int MODE, int ACT>
DI void fa_tile(f32x4 (&O)[8][2], f32x4 (&L)[2], float (&m)[2], const bf16x8 (&qf)[2][4], const LAS unsigned char* kb, const LAS unsigned char* vb,
                const bool (&bit)[2], const int (&tokl)[2], bool diag, bool left, int fr, int fq, int lane) {
    f32x4 s[4][2];
    qk_tile<ACT>(s, kb, qf, fr, fq);
    bf16x8 pf[2][2];
#pragma unroll
    for (int ct = 0; ct < 2; ++ct) {
        if (!((ACT >> ct) & 1)) continue;
        if (diag || left) {
            const int thr_hi = diag ? tokl[ct] : 63, thr_lo = left ? tokl[ct] : -1;
            int kq = 4 * fq; asm volatile("" : "+v"(kq));
#pragma unroll
            for (int kt = 0; kt < 4; ++kt)
#pragma unroll
                for (int r = 0; r < 4; ++r) { const int kl = 16 * kt + kq + r;
                    s[kt][ct][r] = (kl <= thr_hi && kl > thr_lo) ? s[kt][ct][r] : NEG_INF; } }
        float mx = max3f(s[0][ct][0], s[0][ct][1], s[0][ct][2]);
        mx = max3f(mx, s[0][ct][3], s[1][ct][0]); mx = max3f(mx, s[1][ct][1], s[1][ct][2]); mx = max3f(mx, s[1][ct][3], s[2][ct][0]); mx = max3f(mx, s[2][ct][1], s[2][ct][2]);
        mx = max3f(mx, s[2][ct][3], s[3][ct][0]); mx = max3f(mx, s[3][ct][1], s[3][ct][2]); mx = fmaxf(mx, s[3][ct][3]);
        mx = quad_max(mx, lane);
        if (MODE == 0 && !bit[ct]) mx = NEG_INF;
        if (__ballot((mx - m[ct]) * ATT_C > 8.f) != 0ull) {
            const float mn = fmaxf(m[ct], mx), alpha = __builtin_amdgcn_exp2f((m[ct] - mn) * ATT_C); m[ct] = mn; L[ct] *= alpha;
#pragma unroll
            for (int dt = 0; dt < 8; ++dt) O[dt][ct] *= alpha; }
        const float mc = (MODE == 0 && !bit[ct]) ? __builtin_inff() : m[ct] * ATT_C;
#pragma unroll
        for (int kt = 0; kt < 4; ++kt)
#pragma unroll
            for (int r = 0; r < 4; ++r) s[kt][ct][r] = __builtin_amdgcn_exp2f(s[kt][ct][r] * ATT_C - mc);
        pf[0][ct] = pack_p(s[0][ct], s[1][ct]); pf[1][ct] = pack_p(s[2][ct], s[3][ct]);
    }
    pv_tile<ACT>(O, L, vb, pf, fr, fq);
}

template <int MODE>
DI bool fa_rowmax(float (&m)[2], float (&mc)[2], float (&alpha)[2], f32x4 (&s)[4][2], const bool (&bit)[2], const int (&tokl)[2], bool diag, bool left, int fq, int lane) {
    bool need = false;
#pragma unroll
    for (int ct = 0; ct < 2; ++ct) {
        if (diag || left) {
            const int thr_hi = diag ? tokl[ct] : 63, thr_lo = left ? tokl[ct] : -1;
            int kq = 4 * fq; asm volatile("" : "+v"(kq));
#pragma unroll
            for (int kt = 0; kt < 4; ++kt)
#pragma unroll
                for (int r = 0; r < 4; ++r) { const int kl = 16 * kt + kq + r; s[kt][ct][r] = (kl <= thr_hi && kl > thr_lo) ? s[kt][ct][r] : NEG_INF; } }
        float mx = max3f(s[0][ct][0], s[0][ct][1], s[0][ct][2]);
        mx = max3f(mx, s[0][ct][3], s[1][ct][0]); mx = max3f(mx, s[1][ct][1], s[1][ct][2]); mx = max3f(mx, s[1][ct][3], s[2][ct][0]); mx = max3f(mx, s[2][ct][1], s[2][ct][2]);
        mx = max3f(mx, s[2][ct][3], s[3][ct][0]); mx = max3f(mx, s[3][ct][1], s[3][ct][2]); mx = fmaxf(mx, s[3][ct][3]);
        mx = quad_max(mx, lane);
        if (MODE == 0 && !bit[ct]) mx = NEG_INF;
        alpha[ct] = 1.f;
        if (__ballot((mx - m[ct]) * ATT_C > 8.f) != 0ull) { const float mn = fmaxf(m[ct], mx); alpha[ct] = __builtin_amdgcn_exp2f((m[ct] - mn) * ATT_C); m[ct] = mn; need = true; }
        mc[ct] = (MODE == 0 && !bit[ct]) ? __builtin_inff() : m[ct] * ATT_C;
    }
    return need;
}
template <bool HAS_PREV>
DI void fa_exp_pv(f32x4 (&s)[4][2], const float (&mc)[2], bf16x8 (&pfc)[2][2], f32x4 (&O)[8][2], f32x4 (&L)[2], const bf16x8 (&pfp)[2][2], const LAS unsigned char* vbp, int fr, int fq) {
#define FA_EXP1(e) do { if ((e) < 32) { const int _ct = (e) >> 4, _kt = ((e) >> 2) & 3, _r = (e) & 3; s[_kt][_ct][_r] = __builtin_amdgcn_exp2f(s[_kt][_ct][_r] * ATT_C - mc[_ct]); } \
        if ((e) == 8) pfc[0][0] = pack_p(s[0][0], s[1][0]); if ((e) == 16) pfc[1][0] = pack_p(s[2][0], s[3][0]); \
        if ((e) == 24) pfc[0][1] = pack_p(s[0][1], s[1][1]); if ((e) == 32) pfc[1][1] = pack_p(s[2][1], s[3][1]); } while (0)
    if (!HAS_PREV) {
#pragma unroll
        for (int e = 0; e <= 32; ++e) FA_EXP1(e);
    } else {
        const LAS unsigned char* vr = vbp + fr * 128; const int x = (fr >> 1) & 7, y0 = (fq ^ x) << 4, y1 = ((4 + fq) ^ x) << 4;
        const bf16x8 ones = {0x3f80, 0x3f80, 0x3f80, 0x3f80, 0x3f80, 0x3f80, 0x3f80, 0x3f80};
        bf16x8 vf[2][2];
        vf[0][0] = *(const LAS bf16x8*)(vr + y0); vf[0][1] = *(const LAS bf16x8*)(vr + y1);
#define FA_SLOT(mfma_stmt, e) do { mfma_stmt; FA_EXP1(e); __builtin_amdgcn_sched_barrier(0); } while (0)
        FA_SLOT(L[0] = MFMA16(ones, pfp[0][0], L[0]), 0); FA_SLOT(L[1] = MFMA16(ones, pfp[0][1], L[1]), 1);
        FA_SLOT(L[0] = MFMA16(ones, pfp[1][0], L[0]), 2); FA_SLOT(L[1] = MFMA16(ones, pfp[1][1], L[1]), 3);
#pragma unroll
        for (int dt = 0; dt < 8; ++dt) { const int cb = dt & 1, nb = cb ^ 1;
            if (dt < 7) { vf[nb][0] = *(const LAS bf16x8*)(vr + (dt + 1) * 2048 + y0); vf[nb][1] = *(const LAS bf16x8*)(vr + (dt + 1) * 2048 + y1); }
            FA_SLOT(O[dt][0] = MFMA16(vf[cb][0], pfp[0][0], O[dt][0]), 4 + 4 * dt); FA_SLOT(O[dt][1] = MFMA16(vf[cb][0], pfp[0][1], O[dt][1]), 5 + 4 * dt);
            FA_SLOT(O[dt][0] = MFMA16(vf[cb][1], pfp[1][0], O[dt][0]), 6 + 4 * dt); FA_SLOT(O[dt][1] = MFMA16(vf[cb][1], pfp[1][1], O[dt][1]), 7 + 4 * dt); }
#undef FA_SLOT
    }
#undef FA_EXP1
}

template <int MODE  >
DI void fa_chunk(const Frame& F, const Args& a, int c, int g) {
    const bf16_t* cols = (const bf16_t*)(a.ws + WS_COLS);
    const int fr = F.lane & 15, fq = F.lane >> 4, w = F.wave, tid = F.tid;
    LAS unsigned char* lds = F.lds;
    LAS int* list = (LAS int*)(lds + 4 * ABUF); LAS unsigned* maskw = (LAS unsigned*)(lds + 4 * ABUF + 1024);
    const bf16_t* kcol = cols + (MODE ? C_KWIN : C_KSEL) + 128 * g;
    const bf16_t* vT = (const bf16_t*)(a.ws + (MODE ? WS_VWINT : WS_VSELT)) + (size_t)g * 128 * 8192;
    __syncthreads();
    int ntile, j0 = 0;
    if (MODE == 0) {
        const unsigned* selm = (const unsigned*)(a.ws + WS_SELM);
        if (tid < 256) maskw[tid] = selm[((size_t)(64 * c + (tid >> 2)) * 4 + g) * 4 + (tid & 3)];
        __syncthreads();
        if (w == 0) { int base = 0;
#pragma unroll
            for (int hf = 0; hf < 2; ++hf) { const int j = hf * 64 + F.lane; unsigned orv = 0u;
                for (int tk = 0; tk < 64; ++tk) orv |= maskw[tk * 4 + (j >> 5)];
                const bool act = ((orv >> (j & 31)) & 1u) && (j <= c); const unsigned long long bl = __ballot(act);
                if (act) list[base + __popcll(bl & ((1ull << F.lane) - 1ull))] = j; base += __popcll(bl); }
            if (F.lane == 0) list[129] = base; }
        __syncthreads();
        ntile = list[129];
    } else { j0 = c > 8 ? c - 8 : 0; ntile = c - j0 + 1; }
    int tokl[2]; tokl[0] = 8 * w + (fr >> 2); tokl[1] = tokl[0] + 4;
    const int head = 4 * g + (fr & 3);
    bf16x8 qf[2][4];
#pragma unroll
    for (int ct = 0; ct < 2; ++ct)
#pragma unroll
        for (int ks = 0; ks < 4; ++ks) qf[ct][ks] = *(const bf16x8*)(cols + (size_t)(64 * c + tokl[ct]) * NP + C_QA + head * 128 + 32 * ks + 8 * fq);
    f32x4 O[8][2], L[2]; float m[2] = {-1e30f, -1e30f};
    L[0] = (f32x4){0.f, 0.f, 0.f, 0.f}; L[1] = L[0];
#pragma unroll
    for (int dt = 0; dt < 8; ++dt) { O[dt][0] = (f32x4){0.f, 0.f, 0.f, 0.f}; O[dt][1] = (f32x4){0.f, 0.f, 0.f, 0.f}; }
#define FA_TILE(t) (MODE ? j0 + (t) : list[(t)])
#define FA_ISSUE(t) do { const int _j = FA_TILE(t); LAS unsigned char* _b = lds + ((t) & 3) * ABUF; \
        dma_k(_b, kcol + (size_t)(64 * _j) * NP, NP, w, F.lane); dma_v(_b + KTILE, vT + (size_t)_j * 8192, 64, w, F.lane); } while (0)
    FA_ISSUE(0); if (ntile > 1) FA_ISSUE(1);
    f32x4 s[4][2]; bf16x8 pfp[2][2], pfc[2][2]; float mc[2], alpha[2]; bool bit[2] = {true, true};
    for (int t = 0; t < ntile; ++t) {
        if (t + 1 < ntile) VMCNT(4); else VMCNT(0);
        RAW_BARRIER();
        if (t + 2 < ntile) FA_ISSUE(t + 2);
        const int j = FA_TILE(t);
        qk_tile<3>(s, lds + (t & 3) * ABUF, qf, fr, fq);
        if (MODE == 0) {
#pragma unroll
            for (int ct = 0; ct < 2; ++ct) bit[ct] = (maskw[tokl[ct] * 4 + (j >> 5)] >> (j & 31)) & 1u; }
        const bool need = fa_rowmax<MODE>(m, mc, alpha, s, bit, tokl, j == c, (MODE == 1) && (j == c - 8), fq, F.lane);
        __builtin_amdgcn_sched_barrier(0);
        if (t > 0) fa_exp_pv<true>(s, mc, pfc, O, L, pfp, lds + ((t - 1) & 3) * ABUF + KTILE, fr, fq); else fa_exp_pv<false>(s, mc, pfc, O, L, pfp, lds, fr, fq);
        __builtin_amdgcn_sched_barrier(0);
        if (need) {
#pragma unroll
            for (int ct = 0; ct < 2; ++ct) { L[ct] *= alpha[ct];
#pragma unroll
                for (int dt = 0; dt < 8; ++dt) O[dt][ct] *= alpha[ct]; } }
#pragma unroll
        for (int ct = 0; ct < 2; ++ct) { pfp[0][ct] = pfc[0][ct]; pfp[1][ct] = pfc[1][ct]; }
    }
    pv_tile<3>(O, L, lds + ((ntile - 1) & 3) * ABUF + KTILE, pfp, fr, fq);
#undef FA_ISSUE
#undef FA_TILE
    bf16_t* out = (bf16_t*)(a.ws + (MODE ? WS_OWIN : WS_OSEL));
#pragma unroll
    for (int ct = 0; ct < 2; ++ct) { const float inv = 1.f / L[ct][0]; bf16_t* op = out + (size_t)(64 * c + tokl[ct]) * D + head * 128 + 4 * fq;
#pragma unroll
        for (int dt = 0; dt < 8; ++dt) { u32x2 o; o.x = pk2(O[dt][ct][0] * inv, O[dt][ct][1] * inv); o.y = pk2(O[dt][ct][2] * inv, O[dt][ct][3] * inv); *(u32x2*)(op + 16 * dt) = o; } }
}

DI void ca_chunk(const Frame& F, const Args& a, int c, int g) {
    const bf16_t* cols = (const bf16_t*)(a.ws + WS_COLS);
    const int fr = F.lane & 15, fq = F.lane >> 4, w = F.wave, tid = F.tid;
    LAS unsigned char* lds = F.lds;
    LAS float* pslc = (LAS float*)(lds + 2 * ABUF); LAS float* p3 = (LAS float*)(lds + 2 * ABUF + 32768);
    const bf16_t* kc = (const bf16_t*)(a.ws + WS_KC) + (size_t)g * 512 * 128;
    const bf16_t* vct = (const bf16_t*)(a.ws + WS_VCT) + (size_t)g * 128 * 512;
    const int ntile = ((4 * c + 2) >> 6) + 1;
    int tokl[2]; tokl[0] = 8 * w + (fr >> 2); tokl[1] = tokl[0] + 4;
    const int head = 4 * g + (fr & 3);
    int nlim[2];
#pragma unroll
    for (int ct = 0; ct < 2; ++ct) { const int t = 64 * c + tokl[ct]; nlim[ct] = t >= 31 ? ((t - 31) >> 4) : -1; }
    bf16x8 qf[2][4];
#pragma unroll
    for (int ct = 0; ct < 2; ++ct)
#pragma unroll
        for (int ks = 0; ks < 4; ++ks) qf[ct][ks] = *(const bf16x8*)(cols + (size_t)(64 * c + tokl[ct]) * NP + C_QA + head * 128 + 32 * ks + 8 * fq);
    float m[2] = {-1e30f, -1e30f}, l[2] = {0.f, 0.f};
    __syncthreads();
    dma_k(lds, kc, 128, w, F.lane);
    for (int jt = 0; jt < ntile; ++jt) {
        VMCNT(0); RAW_BARRIER();
        if (jt + 1 < ntile) dma_k(lds + ((jt + 1) & 1) * ABUF, kc + (size_t)(64 * (jt + 1)) * 128, 128, w, F.lane);
        const LAS unsigned char* kb = lds + (jt & 1) * ABUF;
        f32x4 s[4][2];
        qk_tile<3>(s, kb, qf, fr, fq);
        const bool edge = jt >= ntile - 2;
        int kq = 4 * fq; asm volatile("" : "+v"(kq));
#pragma unroll
        for (int ct = 0; ct < 2; ++ct) {
            float mx = NEG_INF;
#pragma unroll
            for (int kt = 0; kt < 4; ++kt)
#pragma unroll
                for (int r = 0; r < 4; ++r) { float v = s[kt][ct][r]; if (edge) { const int n = 64 * jt + 16 * kt + kq + r; v = (n <= nlim[ct]) ? v : NEG_INF; s[kt][ct][r] = v; } mx = fmaxf(mx, v); }
            mx = quad_max(mx, F.lane);
            if (__ballot((mx - m[ct]) * ATT_C > 8.f) != 0ull) { const float mn = fmaxf(m[ct], mx); l[ct] *= __builtin_amdgcn_exp2f((m[ct] - mn) * ATT_C); m[ct] = mn; }
            const float mc = m[ct] * ATT_C;
            float rs = 0.f;
#pragma unroll
            for (int kt = 0; kt < 4; ++kt)
#pragma unroll
                for (int r = 0; r < 4; ++r) rs += __builtin_amdgcn_exp2f(s[kt][ct][r] * ATT_C - mc);
            l[ct] += quad_sum(rs, F.lane);
        }
    }
    f32x4 O[8][2];
#pragma unroll
    for (int dt = 0; dt < 8; ++dt) { O[dt][0] = (f32x4){0.f, 0.f, 0.f, 0.f}; O[dt][1] = (f32x4){0.f, 0.f, 0.f, 0.f}; }
    float mc[2], inv[2];
#pragma unroll
    for (int ct = 0; ct < 2; ++ct) { mc[ct] = m[ct] * ATT_C; inv[ct] = l[ct] > 0.f ? 1.f / l[ct] : 0.f; }
    RAW_BARRIER();
    dma_k(lds, kc, 128, w, F.lane); dma_v(lds + KTILE, vct, 512, w, F.lane);
    for (int jt = 0; jt < ntile; ++jt) {
        VMCNT(0); RAW_BARRIER();
        if (jt + 1 < ntile) { LAS unsigned char* nb = lds + ((jt + 1) & 1) * ABUF; dma_k(nb, kc + (size_t)(64 * (jt + 1)) * 128, 128, w, F.lane); dma_v(nb + KTILE, vct + 64 * (jt + 1), 512, w, F.lane); }
        const LAS unsigned char* kb = lds + (jt & 1) * ABUF;
        f32x4 s[4][2];
        qk_tile<3>(s, kb, qf, fr, fq);
        const bool edge = jt >= ntile - 2;
        int kq = 4 * fq; asm volatile("" : "+v"(kq));
        bf16x8 pf[2][2];
#pragma unroll
        for (int ct = 0; ct < 2; ++ct) {
#pragma unroll
            for (int kt = 0; kt < 4; ++kt) {
#pragma unroll
                for (int r = 0; r < 4; ++r) { float p = __builtin_amdgcn_exp2f(s[kt][ct][r] * ATT_C - mc[ct]) * inv[ct];
                    if (edge) { const int n = 64 * jt + 16 * kt + kq + r; p = (n <= nlim[ct]) ? p : 0.f; }
                    s[kt][ct][r] = p; }
                float h3 = s[kt][ct][3], hs = (s[kt][ct][0] + s[kt][ct][1]) + (s[kt][ct][2] + h3);
                hs += shx(hs, 1, F.lane); hs += shx(hs, 2, F.lane); h3 += shx(h3, 1, F.lane); h3 += shx(h3, 2, F.lane);
                if ((fr & 3) == 0) { const int jj = 16 * jt + 4 * kt + fq; pslc[tokl[ct] * 128 + jj] = hs; p3[tokl[ct] * 128 + jj] = h3; }
            }
            pf[0][ct] = pack_p(s[0][ct], s[1][ct]); pf[1][ct] = pack_p(s[2][ct], s[3][ct]);
        }
        { f32x4 Ldummy[2]; pv_tile<3, false>(O, Ldummy, kb + KTILE, pf, fr, fq); }
    }
    bf16_t* out = (bf16_t*)(a.ws + WS_OCMP);
#pragma unroll
    for (int ct = 0; ct < 2; ++ct) { bf16_t* op = out + (size_t)(64 * c + tokl[ct]) * D + head * 128 + 4 * fq;
#pragma unroll
        for (int dt = 0; dt < 8; ++dt) { u32x2 o; o.x = pk2(O[dt][ct][0], O[dt][ct][1]); o.y = pk2(O[dt][ct][2], O[dt][ct][3]); *(u32x2*)(op + 16 * dt) = o; } }
    LDS_WAIT(); asm volatile("" ::: "memory");
    unsigned* selm = (unsigned*)(a.ws + WS_SELM);
    {
        int li = F.lane & 15, tq = F.lane >> 4; asm volatile("" : "+v"(li), "+v"(tq));
        unsigned mw[2][4];
        if (c <= 15) {
            const unsigned all = (c == 31) ? 0xffffffffu : ((2u << c) - 1u);
#pragma unroll
            for (int b = 0; b < 2; ++b) { mw[b][0] = all; mw[b][1] = 0u; mw[b][2] = 0u; mw[b][3] = 0u; }
        } else {
            unsigned long long key[2][8];
#pragma unroll
            for (int b = 0; b < 2; ++b) { const int tok = 8 * w + 4 * b + tq;
#pragma unroll
                for (int e = 0; e < 8; ++e) { const int jj = li + 16 * e; const bool ok = (jj >= 1) && (jj <= c - 2);
                    const float sc = ok ? pslc[tok * 128 + jj] + p3[tok * 128 + jj - 1] : 0.f;
                    key[b][e] = ok ? (((unsigned long long)__float_as_uint(sc) << 32) | (unsigned)(127 - jj)) : 0ull; }
#pragma unroll
                for (int q = 0; q < 4; ++q) mw[b][q] = 0u;
                { const int f0 = 0, f1 = c - 1, f2 = c;
#pragma unroll
                  for (int q = 0; q < 4; ++q) mw[b][q] |= ((f0 >> 5) == q ? 1u << (f0 & 31) : 0u) | ((f1 >> 5) == q ? 1u << (f1 & 31) : 0u) | ((f2 >> 5) == q ? 1u << (f2 & 31) : 0u); } }
#define ROR64(v, n) ((((unsigned long long)(unsigned)__builtin_amdgcn_update_dpp(0, (int)(unsigned)((v) >> 32), 0x120 + (n), 0xf, 0xf, false)) << 32) | (unsigned)__builtin_amdgcn_update_dpp(0, (int)(unsigned)(v), 0x120 + (n), 0xf, 0xf, false))
#pragma unroll 1
            for (int round = 0; round < 13; ++round) {
#pragma unroll
                for (int b = 0; b < 2; ++b) {
                    unsigned long long best = key[b][0];
#pragma unroll
                    for (int e = 1; e < 8; ++e) best = key[b][e] > best ? key[b][e] : best;
                    { unsigned long long o; o = ROR64(best, 1); best = o > best ? o : best; o = ROR64(best, 2); best = o > best ? o : best;
                      o = ROR64(best, 4); best = o > best ? o : best; o = ROR64(best, 8); best = o > best ? o : best; }
                    if (best != 0ull) { const int jb = 127 - (int)(unsigned)best;
#pragma unroll
                        for (int q = 0; q < 4; ++q) mw[b][q] |= ((jb >> 5) == q) ? (1u << (jb & 31)) : 0u;
#pragma unroll
                        for (int e = 0; e < 8; ++e) key[b][e] = (key[b][e] == best) ? 0ull : key[b][e]; }
                }
            }
#undef ROR64
        }
        if (li == 0) {
#pragma unroll
            for (int b = 0; b < 2; ++b) { const int tok = 8 * w + 4 * b + tq; u32x4 o; o.x = mw[b][0]; o.y = mw[b][1]; o.z = mw[b][2]; o.w = mw[b][3];
                *(u32x4*)(selm + ((size_t)(64 * c + tok) * 4 + g) * 4) = o; } }
    }
}

struct ScanRegs { bf16x8 ks[2]; bf16x8 at; f32x4 dc; };
DI void dma_v8(LAS unsigned char* vb, const bf16_t* vbase, int w, int lane) {
    const int row = 8 * w + (lane >> 3), c = (lane & 7) ^ ((row >> 1) & 7);
    glds16(vbase + (size_t)row * 64 + c * 8, vb + w * 1024);
}
constexpr int SC_SROW = 272, SC_SBUF = 64 * SC_SROW, SC_Q = 0, SC_V = 4 * 16384, SC_S = SC_V + 4 * 8192;
static_assert(SC_S + 2 * SC_SBUF <= LDS_MISC, "scan LDS map");
DI void scan_issue(ScanRegs& r, LAS unsigned char* lds, const Args& a, int n, int h, int sl, int kh, int w, int lane, int fr, int fq) {
    const bf16_t* qdec = (const bf16_t*)(a.ws + WS_QDEC); const bf16_t* kst = (const bf16_t*)(a.ws + WS_KST);
    const bf16_t* vt = (const bf16_t*)(a.ws + WS_VT); const bf16_t* att = (const bf16_t*)(a.ws + WS_ATT); const float* dec = (const float*)(a.ws + WS_DEC);
    dma_k(lds + SC_Q + (n & 3) * 16384, qdec + (size_t)(64 * n) * 1024 + h * 256 + kh * 128, 1024, w, lane);
    dma_v8(lds + SC_V + (n & 3) * 8192, vt + ((size_t)n * 2048 + h * 512 + 64 * sl) * 64, w, lane);
    { const bf16_t* kp = kst + ((size_t)(n * 4 + h) * 256 + kh * 128 + 16 * w + fr) * 64 + 8 * fq;
      asm volatile("global_load_dwordx4 %0, %1, off" : "=v"(r.ks[0]) : "v"(kp) : "memory");
      asm volatile("global_load_dwordx4 %0, %1, off offset:64" : "=v"(r.ks[1]) : "v"(kp) : "memory"); }
    { const bf16_t* ap_ = att + ((size_t)(n * 4 + h) * 64 + 16 * (w & 3) + fr) * 64 + 32 * kh + 8 * fq; asm volatile("global_load_dwordx4 %0, %1, off" : "=v"(r.at) : "v"(ap_) : "memory"); }
    { const float* dp = dec + (n * 4 + h) * 256 + kh * 128 + 16 * w + 4 * fq; asm volatile("global_load_dwordx4 %0, %1, off" : "=v"(r.dc) : "v"(dp) : "memory"); }
}
DI void scan_step(const ScanRegs& cur, f32x4 (&S)[4], LAS unsigned char* lds, bf16_t* opart, int n, int h, int sl, int kh, int w, int fr, int fq) {
    const LAS unsigned char* sc = lds + SC_S + (n & 1) * SC_SBUF; const LAS unsigned char* qb = lds + SC_Q + (n & 3) * 16384; const LAS unsigned char* vb = lds + SC_V + (n & 3) * 8192;
    const int tt = w & 3, vt0 = 2 * (w >> 2), xv = (fr >> 1) & 7;
    const LAS unsigned char* vr = vb + fr * 128; const int y0 = (fq ^ xv) << 4, y1 = ((4 + fq) ^ xv) << 4;
    bf16x8 qf[4], sf[2][4];
#pragma unroll
    for (int ks = 0; ks < 4; ++ks) qf[ks] = *(const LAS bf16x8*)(qb + (16 * tt + fr) * 256 + (((4 * ks + fq) ^ fr) << 4));
#pragma unroll
    for (int z = 0; z < 2; ++z)
#pragma unroll
        for (int ks = 0; ks < 4; ++ks) sf[z][ks] = *(const LAS bf16x8*)(sc + (16 * (vt0 + z) + fr) * SC_SROW + (32 * ks + 8 * fq) * 2);
    LDS_WAIT(); __builtin_amdgcn_sched_barrier(0);
    f32x4 acc[2];
#pragma unroll
    for (int z = 0; z < 2; ++z) { acc[z] = (f32x4){0.f, 0.f, 0.f, 0.f};
#pragma unroll
        for (int ks = 0; ks < 4; ++ks) acc[z] = MFMA16(sf[z][ks], qf[ks], acc[z]); }
    bf16x8 vf[4][2];
#pragma unroll
    for (int vt = 0; vt < 4; ++vt) { vf[vt][0] = *(const LAS bf16x8*)(vr + vt * 2048 + y0); vf[vt][1] = *(const LAS bf16x8*)(vr + vt * 2048 + y1); }
    LDS_WAIT(); __builtin_amdgcn_sched_barrier(0);
    { const bf16x8 va0 = vt0 ? (kh ? vf[2][1] : vf[2][0]) : (kh ? vf[0][1] : vf[0][0]), va1 = vt0 ? (kh ? vf[3][1] : vf[3][0]) : (kh ? vf[1][1] : vf[1][0]);
      acc[0] = MFMA16(va0, cur.at, acc[0]); acc[1] = MFMA16(va1, cur.at, acc[1]); }
    LAS unsigned char* sn = lds + SC_S + ((n + 1) & 1) * SC_SBUF;
#pragma unroll
    for (int vt = 0; vt < 4; ++vt) { S[vt] = S[vt] * cur.dc; S[vt] = MFMA16(cur.ks[0], vf[vt][0], S[vt]); S[vt] = MFMA16(cur.ks[1], vf[vt][1], S[vt]); }
#pragma unroll
    for (int z = 0; z < 2; ++z) { u32x2 o; o.x = pk2(acc[z][0], acc[z][1]); o.y = pk2(acc[z][2], acc[z][3]);
        *(u32x2*)(opart + (size_t)(64 * n + 16 * tt + fr) * 2048 + h * 512 + 64 * sl + 16 * (vt0 + z) + 4 * fq) = o; }
#pragma unroll
    for (int vt = 0; vt < 4; ++vt) { u32x2 o; o.x = pk2(S[vt][0], S[vt][1]); o.y = pk2(S[vt][2], S[vt][3]); *(LAS u32x2*)(sn + (16 * vt + fr) * SC_SROW + (16 * w + 4 * fq) * 2) = o; }
}
DI void gla_scan_unit(const Frame& F, const Args& a, int h, int sl, int kh) {
    LAS unsigned char* lds = F.lds;
    const int fr = F.lane & 15, fq = F.lane >> 4, w = F.wave;
    bf16_t* opart = (bf16_t*)(a.ws + WS_OPART) + (size_t)kh * T * 2048;
    __syncthreads();
    for (int i = F.tid; i < SC_SBUF / 4; i += NTHR) ((LAS unsigned*)(lds + SC_S))[i] = 0u;
    f32x4 S[4];
#pragma unroll
    for (int vt = 0; vt < 4; ++vt) S[vt] = (f32x4){0.f, 0.f, 0.f, 0.f};
    ScanRegs r0, r1, r2, r3;
    scan_issue(r0, lds, a, 0, h, sl, kh, w, F.lane, fr, fq); scan_issue(r1, lds, a, 1, h, sl, kh, w, F.lane, fr, fq); scan_issue(r2, lds, a, 2, h, sl, kh, w, F.lane, fr, fq);
#define SC_STEP(rn, rc, n) do { if ((n) < 3) asm volatile("s_waitcnt vmcnt(14)" ::: "memory"); else asm volatile("s_waitcnt vmcnt(20)" ::: "memory"); LDS_WAIT(); RAW_BARRIER(); \
        scan_issue(rn, lds, a, ((n) + 3 < NCH) ? (n) + 3 : NCH - 1, h, sl, kh, w, F.lane, fr, fq); scan_step(rc, S, lds, opart, (n), h, sl, kh, w, fr, fq); } while (0)
    for (int n = 0; n < NCH; n += 4) { SC_STEP(r3, r0, n); SC_STEP(r0, r1, n + 1); SC_STEP(r1, r2, n + 2); SC_STEP(r2, r3, n + 3); }
#undef SC_STEP
    VM_WAIT();
}

DI void unpack8(const u32x4& w, float (&f)[8]) { f[0] = lo_bf(w.x); f[1] = hi_bf(w.x); f[2] = lo_bf(w.y); f[3] = hi_bf(w.y); f[4] = lo_bf(w.z); f[5] = hi_bf(w.z); f[6] = lo_bf(w.w); f[7] = hi_bf(w.w); }
DI void p_combine(const Frame& F, const Args& a, int layer) {
    const bf16_t* cols = (const bf16_t*)(a.ws + WS_COLS);
    const bf16_t* ocmp = (const bf16_t*)(a.ws + WS_OCMP); const bf16_t* osel = (const bf16_t*)(a.ws + WS_OSEL); const bf16_t* owin = (const bf16_t*)(a.ws + WS_OWIN);
    const bf16_t* op0 = (const bf16_t*)(a.ws + WS_OPART); const bf16_t* op1 = op0 + (size_t)T * 2048;
    bf16_t* A1 = (bf16_t*)(a.ws + WS_A1); bf16_t* A2 = (bf16_t*)(a.ws + WS_A2);
    const int c8 = 8 * F.lane;
    f32x4 nw[2]; nw[0] = *(const f32x4*)(a.gla_norm_w + layer * 512 + c8); nw[1] = *(const f32x4*)(a.gla_norm_w + layer * 512 + c8 + 4);
    for (int row = F.gw; row < T; row += F.NGW) {
        const bf16_t* cr = cols + (size_t)row * NP; const size_t ro = (size_t)row * D;
#pragma unroll
        for (int j = 0; j < 4; ++j) { const int c0 = 512 * j + c8, head = 4 * j + (F.lane >> 4);
            const float g0 = sigmoidf_(bf2f(cr[C_GBR + head * 3 + 0])), g1 = sigmoidf_(bf2f(cr[C_GBR + head * 3 + 1])), g2 = sigmoidf_(bf2f(cr[C_GBR + head * 3 + 2]));
            float oc[8], os[8], ow[8], za[8], p0[8], p1[8], zb[8];
            unpack8(*(const u32x4*)(ocmp + ro + c0), oc); unpack8(*(const u32x4*)(osel + ro + c0), os); unpack8(*(const u32x4*)(owin + ro + c0), ow); unpack8(*(const u32x4*)(cr + C_ZA + c0), za);
            unpack8(*(const u32x4*)(op0 + ro + c0), p0); unpack8(*(const u32x4*)(op1 + ro + c0), p1); unpack8(*(const u32x4*)(cr + C_ZB + c0), zb);
            float r[8], o[8], ss = 0.f;
#pragma unroll
            for (int e = 0; e < 8; ++e) { r[e] = (g0 * oc[e] + g1 * os[e] + g2 * ow[e]) * siluf_(za[e]); o[e] = p0[e] + p1[e]; ss += o[e] * o[e]; }
            { u32x4 q; q.x = pk2(r[0], r[1]); q.y = pk2(r[2], r[3]); q.z = pk2(r[4], r[5]); q.w = pk2(r[6], r[7]); *(u32x4*)(A1 + ro + c0) = q; }
            const float rs = rsqrtf(wave_sum(ss, F.lane) * (1.f / 512.f) + NORM_EPS);
            float y[8];
#pragma unroll
            for (int e = 0; e < 8; ++e) y[e] = o[e] * rs * nw[e >> 2][e & 3] * siluf_(zb[e]);
            { u32x4 q; q.x = pk2(y[0], y[1]); q.y = pk2(y[2], y[3]); q.z = pk2(y[4], y[5]); q.w = pk2(y[6], y[7]); *(u32x4*)(A2 + ro + c0) = q; } }
    }
}

constexpr int PH_PER_LAYER = 10, N_PHASES = 2 + DEPTH * PH_PER_LAYER;
constexpr int WQ_WORD0 = 16384;
DI int wq_pull(unsigned* cnt, volatile LAS unsigned* slot, int tid) {
    __syncthreads();
    if (tid == 0) *slot = __hip_atomic_fetch_add(cnt, 1u, __ATOMIC_RELAXED, __HIP_MEMORY_SCOPE_AGENT);
    __syncthreads();
    return (int)*slot;
}
__global__ void __launch_bounds__(NTHR, 2) mk_fwd(Args a_in, int li) {
    KArgsP ap = (KArgsP)__builtin_amdgcn_kernarg_segment_ptr();
    const int ph_lo = a_in.ph_lo, ph_hi = a_in.ph_hi;
    extern __shared__ __attribute__((aligned(16))) unsigned char lds_raw[];
    Frame F;
    F.lds = (LAS unsigned char*)lds_raw;
    F.tid = threadIdx.x; F.lane = F.tid & 63; F.wave = __builtin_amdgcn_readfirstlane(F.tid >> 6);
    const int wave_s = F.wave;
    F.G = gridDim.x; F.bid = blockIdx.x; F.gw = F.bid * NWAVES + F.wave; F.NGW = F.G * NWAVES;
    volatile LAS unsigned* misc = (volatile LAS unsigned*)(F.lds + LDS_MISC);
    if (F.tid < 64) misc[F.tid] = 0u;
    __syncthreads();
    unsigned* ctl = (unsigned*)(a_in.ws + WS_CTL);
    XcdBarrier bar = xcd_barrier_post(ctl + (size_t)li * XCD_BAR_WORDS, misc);
#ifndef PHASE_SET
#define PHASE_SET 0xFFFF
#endif
#define HAS(k) ((PHASE_SET >> (k)) & 1)
#ifndef REPEAT_PHASE
#define REPEAT_PHASE -1
#endif
#define REP(k) for (int _r = 0; _r < ((REPEAT_PHASE == (k)) ? 2 : 1); ++_r)
#define IN(k) (ph_lo <= (k) && (k) < ph_hi)
#define SEAM(k) do { if (IN(k) && IN((k) + 1)) xcd_barrier(bar); } while (0)
#define FRESH() do { int _l = __builtin_amdgcn_mbcnt_hi(~0u, __builtin_amdgcn_mbcnt_lo(~0u, 0u)); asm volatile("" : "+v"(_l)); int _w = wave_s; asm volatile("" : "+s"(_w)); F.lane = _l; F.wave = _w; F.tid = _w * 64 + _l; F.gw = F.bid * NWAVES + F.wave; { KArgsP _k = (KArgsP)__builtin_amdgcn_kernarg_segment_ptr(); asm volatile("" : "+s"(_k)); ap = _k; } } while (0)
    if (HAS(12) && IN(0)) { FRESH(); const Args a = load_args(ap); REP(12) { p_prologue(F, a); } SEAM(0); }
#define PHASE_ENTER() FRESH(); const Args a = load_args(ap); unsigned char* ws = a.ws; bf16_t* cols = (bf16_t*)(ws + WS_COLS); (void)cols
#define UNIT_FRAME(Fu) Frame Fu = F; { int _l = F.lane; asm volatile("" : "+v"(_l)); Fu.lane = _l; Fu.tid = F.wave * 64 + _l; }
    for (int L = 0; L < DEPTH; ++L) {
        const int pb = 1 + PH_PER_LAYER * L;
        if (HAS(0) && IN(pb + 0)) { PHASE_ENTER(); const float* xin = L == 0 ? a.x : (const float*)(ws + WS_X);
            p_rmsnorm<false>(F, xin, a.norm_w + L * D, ws + WS_H); SEAM(pb + 0); }
        if (HAS(1) && IN(pb + 1)) { PHASE_ENTER();
            pg8::Gemm g{(const bf16_t*)(ws + WS_H), (const bf16_t*)(ws + WS_WIN) + (size_t)L * NP * D, D, D, D};
            pg8::OrderMN S; S.init(T, NP, F.G, F.bid); pg8::EpiCols E{cols, NP};
            pg8::gemm_phase<pg8::EpiCols, pg8::OrderMN, false, true, true>(F.lds, g, S, E, F.tid);
            SEAM(pb + 1); }
        if (HAS(2) && IN(pb + 2)) { PHASE_ENTER();
            unsigned* cnt = (unsigned*)(ws + WS_CTL) + WQ_WORD0 + 8192 + 64 * L;
            for (;;) { const int u = wq_pull(cnt, misc + 16, F.tid); if (u >= 128 + 512 + 256) break;
                UNIT_FRAME(Fu);
                if (u < 128) { pg8::Gemm g{cols, (const bf16_t*)(ws + WS_W1T) + (size_t)L * 2 * 256 * 4096, 16 * NP, 4096, 512};
                    pg8::OrderCmp S; S.init(1 << 20, u); pg8::EpiPart E{(float*)(ws + WS_CPART)};
                    __syncthreads();
                    pg8::gemm_phase<pg8::EpiPart, pg8::OrderCmp, true, false, true>(Fu.lds, g, S, E, Fu.tid); }
                else if (u < 640) { const int v = u - 128; gla_g1_unit(Fu, a, L, v >> 2, v & 3); }
                else transpose_unit(Fu, a, u - 640); }
            SEAM(pb + 2); }
        if (HAS(3) && IN(pb + 3)) { PHASE_ENTER(); for (int u = F.bid; u < 256; u += F.G) mlp2_unit(F, a, L, u >> 5, u & 31); SEAM(pb + 3); }
        if (HAS(4) && IN(pb + 4)) { PHASE_ENTER();
            REP(4) { unsigned* cnt = (unsigned*)(ws + WS_CTL) + WQ_WORD0 + 64 * (2 * L + 16 * _r);
            for (;;) { const int u = wq_pull(cnt, misc + 16, F.tid); if (u >= 512 + 512) break;
                UNIT_FRAME(Fu);
                if (u < 512) ca_chunk(Fu, a, 127 - (u >> 2), u & 3);
                else { const int v = u - 512; fa_chunk<1>(Fu, a, 127 - (v >> 2), v & 3); } } }
            SEAM(pb + 4); }
        if (HAS(5) && IN(pb + 5)) { PHASE_ENTER();
            REP(5) { unsigned* cnt = (unsigned*)(ws + WS_CTL) + WQ_WORD0 + 64 * (2 * L + 1 + 16 * _r);
            unsigned* grp = (unsigned*)(ws + WS_CTL) + WQ_WORD0 + 4096 + 64 * (8 * L + 32 * _r);
            unsigned* claimed = (unsigned*)(ws + WS_CTL) + WQ_WORD0 + 32768 + 64 * (L + 4 * _r);
            { const unsigned x = xb_xcc_id() & 7u;
              __syncthreads();
              if (F.tid == 0) { unsigned r = __hip_atomic_fetch_add(grp + 64 * x, 1u, __ATOMIC_RELAXED, __HIP_MEMORY_SCOPE_AGENT); unsigned got = 0xffffffffu;
                  if (r < 8u && __hip_atomic_exchange(claimed + 8 * x + r, 1u, __ATOMIC_RELAXED, __HIP_MEMORY_SCOPE_AGENT) == 0u) got = 8u * x + r;
                  misc[16] = got; }
              __syncthreads();
              const unsigned su = misc[16];
              if (su != 0xffffffffu) { UNIT_FRAME(Fu); gla_scan_unit(Fu, a, (int)(su >> 4), (int)(su & 7u), (int)((su >> 3) & 1u)); } }
            for (;;) { const int u = wq_pull(cnt, misc + 16, F.tid); if (u >= 64) break;
                UNIT_FRAME(Fu);
                __syncthreads(); if (F.tid == 0) misc[17] = __hip_atomic_exchange(claimed + u, 1u, __ATOMIC_RELAXED, __HIP_MEMORY_SCOPE_AGENT); __syncthreads();
                if (misc[17] == 0u) gla_scan_unit(Fu, a, u >> 4, u & 7, (u >> 3) & 1); }
            { const int g0 = (int)(xb_xcc_id() & 3u);
              for (int gi = 0; gi < 4; ++gi) { const int gq = (g0 + gi) & 3; unsigned* qcnt = (unsigned*)(ws + WS_CTL) + WQ_WORD0 + 12288 + 64 * (4 * L + gq + 32 * _r);
                  for (;;) { const int u = wq_pull(qcnt, misc + 16, F.tid); if (u >= 128) break;
                      UNIT_FRAME(Fu);
                      fa_chunk<0>(Fu, a, 127 - u, gq); } } } }
            SEAM(pb + 5); }
        if (HAS(6) && IN(pb + 6)) { PHASE_ENTER(); p_combine(F, a, L); SEAM(pb + 6); }
        if (HAS(7) && IN(pb + 7)) { PHASE_ENTER();
            pg8::Gemm g{(const bf16_t*)(ws + WS_A1), (const bf16_t*)(ws + WS_WPA) + (size_t)L * D * D, D, D, D};
            pg8::OrderAB S; S.mn.init(T, D, F.G, F.bid); S.A2 = (const bf16_t*)(ws + WS_A2); S.B2 = (const bf16_t*)(ws + WS_WPB) + (size_t)L * D * D;
            pg8::EpiGateAB E{(bf16_t*)(ws + WS_Y), (bf16_t*)(ws + WS_TMP), cols + C_GA, cols + C_GB};
            pg8::gemm_phase<pg8::EpiGateAB, pg8::OrderAB, false, true, true>(F.lds, g, S, E, F.tid);
            SEAM(pb + 7); }
        if (HAS(8) && IN(pb + 8)) { PHASE_ENTER(); }
        if (HAS(9) && IN(pb + 9)) { PHASE_ENTER(); const float* xin = L == 0 ? a.x : (const float*)(ws + WS_X);
            pg8::Gemm g{(const bf16_t*)(ws + WS_Y), (const bf16_t*)(ws + WS_WOUT) + (size_t)L * D * D, D, D, D};
            pg8::OrderMN S; S.init(T, D, F.G, F.bid); pg8::EpiResid E{xin, (float*)(ws + WS_X)};
            pg8::gemm_phase<pg8::EpiResid, pg8::OrderMN, false, false, true>(F.lds, g, S, E, F.tid);
            SEAM(pb + 9); }
    }
    if (HAS(13) && IN(N_PHASES - 1)) { FRESH(); const Args a = load_args(ap); p_rmsnorm<true>(F, (const float*)(a.ws + WS_X), a.final_w, a.out); }
#undef IN
#undef SEAM
}

extern "C" void kernel_launch(void* const* d_in, const int* in_sizes, int n_in, void* d_out, int out_size, void* d_ws, size_t ws_size, hipStream_t stream) {
    static int grid = 0;
    if (grid == 0) {
        if (n_in != 15 || ws_size < WS_END) { fprintf(stderr, "kernel_launch: unexpected inputs (n_in %d, ws %zu, need %zu)\n", n_in, ws_size, (size_t)WS_END); grid = -1; return; }
        int dev = 0, cus = 0;
        if (hipGetDevice(&dev) != hipSuccess || hipDeviceGetAttribute(&cus, hipDeviceAttributeMultiprocessorCount, dev) != hipSuccess) { grid = -1; return; }
        if (hipFuncSetAttribute((const void*)mk_fwd, hipFuncAttributeMaxDynamicSharedMemorySize, LDS_BYTES) != hipSuccess) { fprintf(stderr, "kernel_launch: hipFuncSetAttribute failed\n"); grid = -1; return; }
        int per_cu = 0;
        if (hipOccupancyMaxActiveBlocksPerMultiprocessor(&per_cu, (const void*)mk_fwd, NTHR, LDS_BYTES) != hipSuccess || per_cu < 1) fprintf(stderr, "kernel_launch: occupancy query reports %d\n", per_cu);
        (void)hipGetLastError();
        grid = cus;
    }
    if (grid < 0) return;
    (void)hipMemsetAsync((char*)d_ws + WS_CTL, 0, CTL_BYTES, stream);
    Args a{};
    a.x = (const float*)d_in[0]; a.norm_w = (const float*)d_in[1]; a.w_in = (const float*)d_in[2]; a.cmp_pe = (const float*)d_in[3]; a.cmp_w1 = (const float*)d_in[4];
    a.cmp_b1 = (const float*)d_in[5]; a.cmp_w2 = (const float*)d_in[6]; a.cmp_b2 = (const float*)d_in[7]; a.alpha_w = (const float*)d_in[8]; a.alpha_b = (const float*)d_in[9];
    a.gla_norm_w = (const float*)d_in[10]; a.p_a = (const float*)d_in[11]; a.p_b = (const float*)d_in[12]; a.w_out = (const float*)d_in[13]; a.final_w = (const float*)d_in[14];
    a.out = (float*)d_out; a.ws = (unsigned char*)d_ws;
#if MK_PER_PHASE
    for (int k = 0; k < N_PHASES; ++k) { a.ph_lo = k; a.ph_hi = k + 1; hipLaunchKernelGGL(mk_fwd, dim3(grid), dim3(NTHR), LDS_BYTES, stream, a, k); }
#else
    a.ph_lo = 0; a.ph_hi = N_PHASES; hipLaunchKernelGGL(mk_fwd, dim3(grid), dim3(NTHR), LDS_BYTES, stream, a, 0);
#endif
}
```

```cpp
#include <hip/hip_runtime.h>
#include <cstdio>
#include <cstdint>

#ifndef MK_PER_PHASE
#define MK_PER_PHASE 0
#endif

#define LAS __attribute__((address_space(3)))
#define GAS __attribute__((address_space(1)))
typedef unsigned short bf16_t;
typedef short bf16x8 __attribute__((ext_vector_type(8)));
typedef short s16x4 __attribute__((ext_vector_type(4)));
typedef float f32x4 __attribute__((ext_vector_type(4)));
typedef float f32x2 __attribute__((ext_vector_type(2)));
typedef unsigned u32x4 __attribute__((ext_vector_type(4)));
typedef unsigned u32x2 __attribute__((ext_vector_type(2)));
#define DI __device__ __forceinline__
#define MFMA16(a, b, c) __builtin_amdgcn_mfma_f32_16x16x32_bf16((a), (b), (c), 0, 0, 0)

constexpr int T = 8192, D = 2048, DEPTH = 4, NIN = 17472, NP = 17664;
constexpr int NCH = 128;
constexpr int C_QA = 0, C_KCMP = 2048, C_VCMP = 2560, C_KSEL = 3072, C_VSEL = 3584, C_KWIN = 4096, C_VWIN = 4608, C_ZA = 5120,
              C_QB = 7168, C_KB = 8192, C_VB = 9216, C_ZB = 11264, C_GA = 13312, C_GB = 15360, C_GBR = 17408, C_ALR = 17456;
constexpr float NORM_EPS = 1e-6f;
constexpr float ATT_C = 0.08838834764831845f * 1.4426950408889634f;

DI int map_col(int n) {
    if (n < 5120) return n;
    if (n < 5168) return C_GBR + (n - 5120);
    if (n < 11312) return n - 48;
    if (n < 11328) return C_ALR + (n - 11312);
    return n - 64;
}

constexpr size_t MiB = 1u << 20;
constexpr size_t al(size_t x) { return (x + MiB - 1) / MiB * MiB; }
constexpr size_t WS_CTL = 0, CTL_BYTES = MiB;
constexpr size_t WS_WIN = WS_CTL + CTL_BYTES;
constexpr size_t WS_WPA = WS_WIN + al((size_t)DEPTH * NP * D * 2);
constexpr size_t WS_WPB = WS_WPA + al((size_t)DEPTH * D * D * 2);
constexpr size_t WS_WOUT = WS_WPB + al((size_t)DEPTH * D * D * 2);
constexpr size_t WS_W1T = WS_WOUT + al((size_t)DEPTH * D * D * 2);
constexpr size_t WS_W2T = WS_W1T + al((size_t)DEPTH * 2 * 256 * 4096 * 2);
constexpr size_t WS_B1P = WS_W2T + al((size_t)DEPTH * 2 * 128 * 256 * 2);
constexpr size_t WS_X = WS_B1P + MiB;
constexpr size_t WS_H = WS_X + al((size_t)T * D * 4);
constexpr size_t WS_COLS = WS_H + al((size_t)T * D * 2);
constexpr size_t WS_CPART = WS_COLS + al((size_t)(T + 64) * NP * 2);
constexpr size_t WS_KC = WS_CPART + al((size_t)8 * 8 * 512 * 256 * 4);
constexpr size_t WS_VCT = WS_KC + MiB;
constexpr size_t WS_SELM = WS_VCT + MiB;
constexpr size_t WS_OCMP = WS_SELM + MiB;
constexpr size_t WS_OSEL = WS_OCMP + al((size_t)T * D * 2);
constexpr size_t WS_OWIN = WS_OSEL + al((size_t)T * D * 2);
constexpr size_t WS_VSELT = WS_OWIN + al((size_t)T * D * 2);
constexpr size_t WS_VWINT = WS_VSELT + al((size_t)4 * 128 * 128 * 64 * 2);
constexpr size_t WS_QDEC = WS_VWINT + al((size_t)4 * 128 * 128 * 64 * 2);
constexpr size_t WS_KST = WS_QDEC + al((size_t)T * 1024 * 2);
constexpr size_t WS_VT = WS_KST + al((size_t)T * 1024 * 2);
constexpr size_t WS_ATT = WS_VT + al((size_t)T * 2048 * 2);
constexpr size_t WS_DEC = WS_ATT + al((size_t)128 * 4 * 64 * 64 * 2);
constexpr size_t WS_OPART = WS_DEC + MiB;
constexpr size_t WS_A1 = WS_OPART + al((size_t)2 * T * 2048 * 4);
constexpr size_t WS_A2 = WS_A1 + al((size_t)T * D * 2);
constexpr size_t WS_TMP = WS_A2 + al((size_t)T * D * 2);
constexpr size_t WS_Y = WS_TMP + al((size_t)T * D * 4);
constexpr size_t WS_END = WS_Y + al((size_t)T * D * 2);

constexpr int LDS_MAIN = 131072;
constexpr int LDS_BYTES = 147456;
constexpr int LDS_MISC = LDS_BYTES - 256;
constexpr int NWAVES = 8, NTHR = 512;

DI float bf2f(unsigned short b) { return __uint_as_float(((unsigned)b) << 16); }
DI unsigned f2bf(float f) { unsigned u = __float_as_uint(f); return (u + 0x7fffu + ((u >> 16) & 1u)) >> 16; }
DI unsigned pk2_sw(float lo, float hi) { return f2bf(lo) | (f2bf(hi) << 16); }
typedef __bf16 bf16x2_t __attribute__((ext_vector_type(2)));
DI unsigned cvt_pk_bf16(float lo, float hi) { const f32x2 v = {lo, hi}; const bf16x2_t b = __builtin_convertvector(v, bf16x2_t); return __builtin_bit_cast(unsigned, b); }
DI unsigned pk2(float lo, float hi) { return cvt_pk_bf16(lo, hi); }
DI float lo_bf(unsigned w) { return __uint_as_float(w << 16); }
DI float hi_bf(unsigned w) { return __uint_as_float(w & 0xffff0000u); }
DI float sigmoidf_(float x) { return 1.f / (1.f + __expf(-x)); }
DI float siluf_(float x) { return x / (1.f + __expf(-x)); }
DI float shx(float v, int off, int lane) { return __int_as_float(__builtin_amdgcn_ds_bpermute((lane ^ off) << 2, __float_as_int(v))); }
DI int shxi(int v, int off, int lane) { return __builtin_amdgcn_ds_bpermute((lane ^ off) << 2, v); }
DI float wave_sum(float v, int lane) {
#pragma unroll
    for (int o = 1; o < 64; o <<= 1) v += shx(v, o, lane);
    return v;
}
#define LDS_WAIT() asm volatile("s_waitcnt lgkmcnt(0)" ::: "memory")
#define VM_WAIT() asm volatile("s_waitcnt vmcnt(0)" ::: "memory")

namespace pg8 {
constexpr int BM = 256, BK = 64, HALF = 128, HTB = HALF * BK * 2, STAGE_BYTES = 8 * HTB, NXCD = 8, WGM = 8;
__host__ __device__ __forceinline__ int lds_byte(int r, int c) { const int st = (r >> 4) * 2 + (c >> 5), rr = r & 15, cc = c & 31, ob = rr * 64 + cc * 2; return st * 1024 + (ob ^ (((ob >> 9) & 1) << 5)); }
__host__ __device__ __forceinline__ void stage_rc(int b, int& R, int& C) { const int st = b / 1024, sb = b % 1024, swz = sb ^ (((sb >> 9) & 1) << 5); R = (st >> 1) * 16 + swz / 64; C = (st & 1) * 32 + (swz % 64) / 2; }
__host__ __device__ __forceinline__ int perm32(int rho) { const int n = rho >> 4, i = rho & 15; return 8 * (i >> 2) + 4 * n + (i & 3); }

struct Unit { int pm, pn, pk, pz; };
struct Gemm { const bf16_t* A; const bf16_t* Bt; int lda, ldb, K; };

struct OrderMN {
    static constexpr bool SIGNAL = false;
    int nM, nN, nwg, G, c, rep;
    DI void init(int M, int N, int G_, int c_, int rep_ = 1) { nM = M / BM; nN = N / BM; nwg = nM * nN; G = G_; c = c_; rep = rep_; }
    DI bool next(int i, Unit& u) const {
        long L = (long)i * G + c; if (L >= (long)nwg * rep) return false;
        if (L >= nwg) L -= nwg;
        int wgid = (int)L; { const int q = nwg / NXCD, r = nwg % NXCD, xcd = wgid % NXCD, off = wgid / NXCD; wgid = (xcd < r ? xcd * (q + 1) : r * (q + 1) + (xcd - r) * q) + off; }
        const int nig = WGM * nN, gid = wgid / nig, fm = gid * WGM, gsz = (nM - fm) < WGM ? (nM - fm) : WGM;
        u.pm = fm + ((wgid % nig) % gsz); u.pn = (wgid % nig) / gsz; u.pk = 0; u.pz = 0; return true;
    }
    DI const char* a_ptr(const Gemm& g, const Unit& u) const { return (const char*)g.A + (size_t)u.pm * BM * g.lda * 2; }
    DI const char* b_ptr(const Gemm& g, const Unit& u) const { return (const char*)g.Bt + (size_t)u.pn * BM * g.ldb * 2; }
};
DI int in_col_tile(int p, int& early) {
    int i;
    if (p < 13) { early = 1; i = p; } else if (p < 35) { early = 0; i = p - 13; } else if (p < 47) { early = 1; i = p - 22; } else { early = 0; i = p - 25; }
    if (early) return i < 4 ? 8 + i : i < 6 ? 10 + i : i < 8 ? 12 + i : i < 24 ? 20 + i : 68;
    return i < 8 ? i : i < 10 ? 4 + i : i < 12 ? 6 + i : i < 20 ? 8 + i : 24 + i;
}
constexpr unsigned IN_EARLY_TILES = 25 * (T / 256);
struct OrderIn {
    static constexpr bool SIGNAL = true;
    OrderMN mn; unsigned* sig;
    DI bool next(int i, Unit& u) const { if (!mn.next(i, u)) return false; int e; u.pn = in_col_tile(u.pn, e); u.pz = e; return true; }
    DI const char* a_ptr(const Gemm& g, const Unit& u) const { return mn.a_ptr(g, u); }
    DI const char* b_ptr(const Gemm& g, const Unit& u) const { return mn.b_ptr(g, u); }
};
struct OrderCmp {
    static constexpr bool SIGNAL = false;
    int G, c;
    DI void init(int G_, int c_) { G = G_; c = c_; }
    DI bool next(int i, Unit& u) const { const int L = i * G + c; if (L >= 128) return false; u.pk = L & 7; u.pm = (L >> 3) & 1; u.pz = L >> 4; u.pn = 0; return true; }
    DI const char* a_ptr(const Gemm& g, const Unit& u) const { const int kv = u.pz >> 2, gg = u.pz & 3;
        return (const char*)g.A + ((size_t)(u.pm * BM * 16 + u.pk * 4) * NP + (kv ? C_VCMP : C_KCMP) + gg * 128) * 2; }
    DI const char* b_ptr(const Gemm& g, const Unit& u) const { const int kv = u.pz >> 2; return (const char*)g.Bt + ((size_t)kv * 256 * 4096 + u.pk * 512) * 2; }
};

template <class Epi, class Sched, bool IM2COL = false, bool ALIGN_EPI = false, bool SP2 = false>
DI void gemm_phase(LAS unsigned char* lds, const Gemm g, const Sched& S, const Epi& E, const int tid) {
    const int wid = __builtin_amdgcn_readfirstlane(tid >> 6), lane = tid & 63, wr = wid >> 2, wc = wid & 3, fr = lane & 15, fq = lane >> 4;
    const int nt = g.K / BK;
    unsigned voffA[2], voffB[2];
#pragma unroll
    for (int i = 0; i < 2; ++i) { int R, C; stage_rc(tid * 16 + i * 8192, R, C); const int Rb = Epi::PERM ? ((R & ~31) + perm32(R & 31)) : R;
        voffA[i] = (unsigned)(R * g.lda + C) * 2u; voffB[i] = (unsigned)(Rb * g.ldb + C) * 2u; }
    const size_t hstepA = (size_t)HALF * g.lda * 2, hstepB = (size_t)HALF * g.ldb * 2;
    const unsigned ldsw = (unsigned)wid * 1024u;
    const int aoff = lds_byte(wr * 64 + fr, fq * 8), boff = lds_byte(wc * 32 + fr, fq * 8);
#define PG8_KA(kt) (IM2COL ? ((size_t)((kt) >> 1) * (NP * 2) + (size_t)((kt) & 1) * 128) : (size_t)(kt) * 128)
#define PG8_KB(kt) ((size_t)(kt) * 128)
#define PG8_SA(b, h) (((b) * 2 + (h)) * HTB)
#define PG8_SB(b, h) ((4 + (b) * 2 + (h)) * HTB)
#define PG8_STAGE(bufoff, gbase, voff) do { _Pragma("unroll") for (int _i = 0; _i < 2; ++_i) \
        __builtin_amdgcn_global_load_lds((const unsigned*)((const char*)(gbase) + (voff)[_i]), (LAS unsigned*)(lds + (bufoff) + ldsw + _i * 8192), 16, 0, 0); } while (0)
#define PG8_LDA(dst, b, h) do { _Pragma("unroll") for (int m = 0; m < 4; ++m) _Pragma("unroll") for (int k = 0; k < 2; ++k) dst[m][k] = *(const LAS bf16x8*)(lds + PG8_SA(b, h) + aoff + m * 2048 + k * 1024); } while (0)
#define PG8_LDB(dst, b, h) do { _Pragma("unroll") for (int n = 0; n < 2; ++n) _Pragma("unroll") for (int k = 0; k < 2; ++k) dst[n][k] = *(const LAS bf16x8*)(lds + PG8_SB(b, h) + boff + n * 2048 + k * 1024); } while (0)
#define PG8_MMA(ai, bj, At, Bt) do { __builtin_amdgcn_s_setprio(1); _Pragma("unroll") for (int m = 0; m < 4; ++m) _Pragma("unroll") for (int n = 0; n < 2; ++n) _Pragma("unroll") for (int k = 0; k < 2; ++k) \
        acc[ai][bj][m][n] = __builtin_amdgcn_mfma_f32_16x16x32_bf16(Bt[n][k], At[m][k], acc[ai][bj][m][n], 0, 0, 0); __builtin_amdgcn_s_setprio(0); } while (0)
#define PG8_WAIT_V(n) asm volatile("s_waitcnt vmcnt(" #n ")" ::: "memory")
#define PG8_WAIT_L(n) asm volatile("s_waitcnt lgkmcnt(" #n ")" ::: "memory")
#define PG8_BAR __builtin_amdgcn_s_barrier()
#define PG8_SCHED __builtin_amdgcn_sched_barrier(0)
    Unit cur, nxt; int ui = 0; int nsig = 0; (void)nsig;
    if (!S.next(0, cur)) return;
    f32x4 acc[2][2][4][2];
#pragma unroll
    for (int a = 0; a < 2; ++a)
#pragma unroll
        for (int b = 0; b < 2; ++b)
#pragma unroll
            for (int m = 0; m < 4; ++m)
#pragma unroll
                for (int n = 0; n < 2; ++n) acc[a][b][m][n] = (f32x4){0.f, 0.f, 0.f, 0.f};
    bf16x8 At[4][2], B0[2][2], B1[2][2];
    const char* cA = S.a_ptr(g, cur); const char* cB = S.b_ptr(g, cur);
    if constexpr (SP2) {
        PG8_STAGE(PG8_SB(0, 0), cB, voffB); PG8_STAGE(PG8_SB(0, 1), cB + hstepB, voffB); PG8_STAGE(PG8_SA(0, 0), cA, voffA); PG8_STAGE(PG8_SA(0, 1), cA + hstepA, voffA);
        if (wr == 1) PG8_BAR;
        PG8_WAIT_V(2); PG8_BAR;
        PG8_STAGE(PG8_SB(1, 0), cB + PG8_KB(1), voffB); PG8_STAGE(PG8_SA(1, 0), cA + PG8_KA(1), voffA); PG8_STAGE(PG8_SB(1, 1), cB + hstepB + PG8_KB(1), voffB);
        PG8_WAIT_V(6); PG8_BAR;
    } else {
    PG8_STAGE(PG8_SB(0, 0), cB, voffB); PG8_STAGE(PG8_SA(0, 0), cA, voffA); PG8_STAGE(PG8_SB(0, 1), cB + hstepB, voffB); PG8_STAGE(PG8_SA(0, 1), cA + hstepA, voffA);
    if (wr == 1) PG8_BAR;
    PG8_WAIT_V(4); PG8_BAR;
    PG8_STAGE(PG8_SB(1, 0), cB + PG8_KB(1), voffB); PG8_STAGE(PG8_SA(1, 0), cA + PG8_KA(1), voffA); PG8_STAGE(PG8_SB(1, 1), cB + hstepB + PG8_KB(1), voffB);
    PG8_WAIT_V(6); PG8_BAR;
    }
    for (;;) {
        const bool has_next = S.next(ui + 1, nxt);
        const char* nA = has_next ? S.a_ptr(g, nxt) : cA; const char* nB = has_next ? S.b_ptr(g, nxt) : cB;
        for (int t = 0; t < nt; t += 2) {
            const bool last = (t == nt - 2);
            const char* a1 = cA + PG8_KA(t + 1);
            const char* a2 = last ? nA : cA + PG8_KA(t + 2); const char* b2 = last ? nB : cB + PG8_KB(t + 2);
            const char* a3 = last ? nA + PG8_KA(1) : cA + PG8_KA(t + 3); const char* b3 = b2 + 128;
            if constexpr (SP2) {
            PG8_LDB(B0, 0, 0); PG8_LDB(B1, 0, 1); PG8_SCHED; PG8_LDA(At, 0, 0); PG8_STAGE(PG8_SA(1, 1), a1 + hstepA, voffA);
            PG8_WAIT_V(8); PG8_WAIT_L(0); PG8_BAR; PG8_MMA(0, 0, At, B0); PG8_MMA(0, 1, At, B1); PG8_BAR; PG8_SCHED;
            PG8_LDA(At, 0, 1); PG8_STAGE(PG8_SB(0, 0), b2, voffB); PG8_STAGE(PG8_SB(0, 1), b2 + hstepB, voffB); PG8_STAGE(PG8_SA(0, 0), a2, voffA);
            PG8_WAIT_V(8); PG8_WAIT_L(0); PG8_BAR; PG8_MMA(1, 0, At, B0); PG8_MMA(1, 1, At, B1); PG8_BAR; PG8_SCHED;
            PG8_LDB(B0, 1, 0); PG8_LDB(B1, 1, 1); PG8_SCHED; PG8_LDA(At, 1, 0); PG8_STAGE(PG8_SA(0, 1), a2 + hstepA, voffA);
            PG8_WAIT_V(8); PG8_WAIT_L(0); PG8_BAR; PG8_MMA(0, 0, At, B0); PG8_MMA(0, 1, At, B1); PG8_BAR; PG8_SCHED;
            PG8_LDA(At, 1, 1); PG8_STAGE(PG8_SB(1, 0), b3, voffB); PG8_STAGE(PG8_SB(1, 1), b3 + hstepB, voffB); PG8_STAGE(PG8_SA(1, 0), a3, voffA);
            PG8_WAIT_V(8); PG8_WAIT_L(0); PG8_BAR; PG8_MMA(1, 0, At, B0); PG8_MMA(1, 1, At, B1); PG8_BAR; PG8_SCHED;
            } else {
            PG8_LDB(B0, 0, 0); PG8_SCHED; PG8_LDA(At, 0, 0); PG8_STAGE(PG8_SA(1, 1), a1 + hstepA, voffA);
            PG8_WAIT_L(8); PG8_BAR; PG8_WAIT_L(0); PG8_MMA(0, 0, At, B0); PG8_BAR; PG8_SCHED;
            PG8_LDB(B1, 0, 1); PG8_STAGE(PG8_SB(0, 0), b2, voffB);
            PG8_BAR; PG8_WAIT_L(0); PG8_MMA(0, 1, At, B1); PG8_BAR;
            PG8_LDA(At, 0, 1); PG8_STAGE(PG8_SA(0, 0), a2, voffA);
            PG8_BAR; PG8_WAIT_L(0); PG8_MMA(1, 0, At, B0); PG8_BAR; PG8_SCHED;
            PG8_STAGE(PG8_SB(0, 1), b2 + hstepB, voffB);
            PG8_WAIT_V(6); PG8_BAR; PG8_MMA(1, 1, At, B1); PG8_BAR;
            PG8_LDB(B0, 1, 0); PG8_SCHED; PG8_LDA(At, 1, 0); PG8_STAGE(PG8_SA(0, 1), a2 + hstepA, voffA);
            PG8_WAIT_L(8); PG8_BAR; PG8_WAIT_L(0); PG8_MMA(0, 0, At, B0); PG8_BAR; PG8_SCHED;
            PG8_LDB(B1, 1, 1); PG8_STAGE(PG8_SB(1, 0), b3, voffB);
            PG8_BAR; PG8_WAIT_L(0); PG8_MMA(0, 1, At, B1); PG8_BAR;
            PG8_LDA(At, 1, 1); PG8_STAGE(PG8_SA(1, 0), a3, voffA);
            PG8_BAR; PG8_WAIT_L(0); PG8_MMA(1, 0, At, B0); PG8_BAR; PG8_SCHED;
            PG8_STAGE(PG8_SB(1, 1), b3 + hstepB, voffB);
            PG8_WAIT_V(6); PG8_BAR; PG8_MMA(1, 1, At, B1); PG8_BAR;
            }
        }
        if constexpr (ALIGN_EPI) { if (wr == 0) PG8_BAR; }
        E(acc, cur, wr, wc, fr, fq);
        if constexpr (Sched::SIGNAL) {
            nsig += cur.pz;
            if (cur.pz && !(has_next && nxt.pz)) { PG8_WAIT_V(0); PG8_BAR;
                if (tid == 0) { __builtin_amdgcn_fence(__ATOMIC_RELEASE, "agent"); PG8_WAIT_V(0); (void)__hip_atomic_fetch_add(S.sig, (unsigned)nsig, __ATOMIC_RELAXED, __HIP_MEMORY_SCOPE_AGENT); }
                nsig = 0; } }
        if (!has_next) break;
#pragma unroll
        for (int a = 0; a < 2; ++a)
#pragma unroll
            for (int b = 0; b < 2; ++b)
#pragma unroll
                for (int m = 0; m < 4; ++m)
#pragma unroll
                    for (int n = 0; n < 2; ++n) acc[a][b][m][n] = (f32x4){0.f, 0.f, 0.f, 0.f};
        cur = nxt; cA = nA; cB = nB; ++ui;
        if constexpr (ALIGN_EPI) { if (wr == 1) PG8_BAR; }
    }
    PG8_WAIT_V(0);
    if constexpr (!ALIGN_EPI) { if (wr == 0) PG8_BAR; }
    PG8_BAR;
#undef PG8_KA
#undef PG8_KB
#undef PG8_SA
#undef PG8_SB
#undef PG8_STAGE
#undef PG8_LDA
#undef PG8_LDB
#undef PG8_MMA
#undef PG8_WAIT_V
#undef PG8_WAIT_L
#undef PG8_BAR
#undef PG8_SCHED
}

struct EpiCols {
    static constexpr bool PERM = true;
    bf16_t* O; int ldc;
    DI void operator()(const f32x4 (&acc)[2][2][4][2], const Unit& u, int wr, int wc, int fr, int fq) const {
        const int row0 = u.pm * BM + wr * 64 + fr, col0 = u.pn * BM + wc * 32 + 8 * fq;
#pragma unroll
        for (int ai = 0; ai < 2; ++ai)
#pragma unroll
            for (int m = 0; m < 4; ++m) { bf16_t* rowp = O + (size_t)(row0 + ai * HALF + m * 16) * ldc + col0;
#pragma unroll
                for (int bj = 0; bj < 2; ++bj) { const f32x4 v0 = acc[ai][bj][m][0], v1 = acc[ai][bj][m][1];
                    u32x4 w; w.x = cvt_pk_bf16(v0[0], v0[1]); w.y = cvt_pk_bf16(v0[2], v0[3]); w.z = cvt_pk_bf16(v1[0], v1[1]); w.w = cvt_pk_bf16(v1[2], v1[3]);
                    *(u32x4*)(rowp + bj * HALF) = w; } }
    }
};
struct EpiPart {
    static constexpr bool PERM = false;
    float* P;
    DI void operator()(const f32x4 (&acc)[2][2][4][2], const Unit& u, int wr, int wc, int fr, int fq) const {
        float* base = P + ((size_t)(u.pk * 8 + u.pz) * 512 + u.pm * BM) * 256;
        const int row0 = wr * 64 + fr, col0 = wc * 32 + 4 * fq;
#pragma unroll
        for (int ai = 0; ai < 2; ++ai)
#pragma unroll
            for (int m = 0; m < 4; ++m) { float* rowp = base + (size_t)(row0 + ai * HALF + m * 16) * 256 + col0;
#pragma unroll
                for (int bj = 0; bj < 2; ++bj)
#pragma unroll
                    for (int n = 0; n < 2; ++n) *(f32x4*)(rowp + bj * HALF + n * 16) = acc[ai][bj][m][n]; }
    }
};
struct EpiGateTmp {
    static constexpr bool PERM = true;
    float* O; const bf16_t* gate;
    DI void operator()(const f32x4 (&acc)[2][2][4][2], const Unit& u, int wr, int wc, int fr, int fq) const {
        const int row0 = u.pm * BM + wr * 64 + fr, col0 = u.pn * BM + wc * 32 + 8 * fq;
#pragma unroll
        for (int ai = 0; ai < 2; ++ai)
#pragma unroll
            for (int m = 0; m < 4; ++m) { const int row = row0 + ai * HALF + m * 16;
#pragma unroll
                for (int bj = 0; bj < 2; ++bj) { const u32x4 gw = *(const u32x4*)(gate + (size_t)row * NP + col0 + bj * HALF);
                    const f32x4 v0 = acc[ai][bj][m][0], v1 = acc[ai][bj][m][1]; f32x4 o0, o1;
                    o0[0] = v0[0] * sigmoidf_(lo_bf(gw.x)); o0[1] = v0[1] * sigmoidf_(hi_bf(gw.x)); o0[2] = v0[2] * sigmoidf_(lo_bf(gw.y)); o0[3] = v0[3] * sigmoidf_(hi_bf(gw.y));
                    o1[0] = v1[0] * sigmoidf_(lo_bf(gw.z)); o1[1] = v1[1] * sigmoidf_(hi_bf(gw.z)); o1[2] = v1[2] * sigmoidf_(lo_bf(gw.w)); o1[3] = v1[3] * sigmoidf_(hi_bf(gw.w));
                    float* op = O + (size_t)row * D + col0 + bj * HALF; *(f32x4*)op = o0; *(f32x4*)(op + 4) = o1; }
                asm volatile("" ::: "memory"); }
    }
};
struct EpiGateAdd {
    static constexpr bool PERM = true;
    bf16_t* Y; const float* tmp; const bf16_t* gate;
    DI void operator()(const f32x4 (&acc)[2][2][4][2], const Unit& u, int wr, int wc, int fr, int fq) const {
        const int row0 = u.pm * BM + wr * 64 + fr, col0 = u.pn * BM + wc * 32 + 8 * fq;
#pragma unroll
        for (int ai = 0; ai < 2; ++ai)
#pragma unroll
            for (int m = 0; m < 4; ++m) { const int row = row0 + ai * HALF + m * 16;
#pragma unroll
                for (int bj = 0; bj < 2; ++bj) { const u32x4 gw = *(const u32x4*)(gate + (size_t)row * NP + col0 + bj * HALF);
                    const float* tp = tmp + (size_t)row * D + col0 + bj * HALF; const f32x4 t0 = *(const f32x4*)tp, t1 = *(const f32x4*)(tp + 4);
                    const f32x4 v0 = acc[ai][bj][m][0], v1 = acc[ai][bj][m][1]; f32x4 o0, o1;
                    o0[0] = t0[0] + v0[0] * sigmoidf_(lo_bf(gw.x)); o0[1] = t0[1] + v0[1] * sigmoidf_(hi_bf(gw.x)); o0[2] = t0[2] + v0[2] * sigmoidf_(lo_bf(gw.y)); o0[3] = t0[3] + v0[3] * sigmoidf_(hi_bf(gw.y));
                    o1[0] = t1[0] + v1[0] * sigmoidf_(lo_bf(gw.z)); o1[1] = t1[1] + v1[1] * sigmoidf_(hi_bf(gw.z)); o1[2] = t1[2] + v1[2] * sigmoidf_(lo_bf(gw.w)); o1[3] = t1[3] + v1[3] * sigmoidf_(hi_bf(gw.w));
                    u32x4 w; w.x = cvt_pk_bf16(o0[0], o0[1]); w.y = cvt_pk_bf16(o0[2], o0[3]); w.z = cvt_pk_bf16(o1[0], o1[1]); w.w = cvt_pk_bf16(o1[2], o1[3]);
                    *(u32x4*)(Y + (size_t)row * D + col0 + bj * HALF) = w; }
                asm volatile("" ::: "memory"); }
    }
};
struct EpiResid {
    static constexpr bool PERM = true;
    const float* xi; float* xo;
    DI void operator()(const f32x4 (&acc)[2][2][4][2], const Unit& u, int wr, int wc, int fr, int fq) const {
        const int row0 = u.pm * BM + wr * 64 + fr, col0 = u.pn * BM + wc * 32 + 8 * fq;
#pragma unroll
        for (int ai = 0; ai < 2; ++ai) { f32x4 t[4][2][2];
#pragma unroll
            for (int m = 0; m < 4; ++m) { const size_t off = (size_t)(row0 + ai * HALF + m * 16) * D + col0;
#pragma unroll
                for (int bj = 0; bj < 2; ++bj) { t[m][bj][0] = *(const f32x4*)(xi + off + bj * HALF); t[m][bj][1] = *(const f32x4*)(xi + off + bj * HALF + 4); } }
#pragma unroll
            for (int m = 0; m < 4; ++m) { const size_t off = (size_t)(row0 + ai * HALF + m * 16) * D + col0;
#pragma unroll
                for (int bj = 0; bj < 2; ++bj) { *(f32x4*)(xo + off + bj * HALF) = t[m][bj][0] + acc[ai][bj][m][0]; *(f32x4*)(xo + off + bj * HALF + 4) = t[m][bj][1] + acc[ai][bj][m][1]; } }
            asm volatile("" ::: "memory"); }
    }
};
struct OrderAB {
    static constexpr bool SIGNAL = false;
    OrderMN mn; const bf16_t* A2; const bf16_t* B2;
    DI bool next(int i, Unit& u) const { if (!mn.next(i >> 1, u)) return false; u.pz = i & 1; return true; }
    DI const char* a_ptr(const Gemm& g, const Unit& u) const { return (const char*)(u.pz ? A2 : g.A) + (size_t)u.pm * BM * g.lda * 2; }
    DI const char* b_ptr(const Gemm& g, const Unit& u) const { return (const char*)(u.pz ? B2 : g.Bt) + (size_t)u.pn * BM * g.ldb * 2; }
};
struct EpiGateAB {
    static constexpr bool PERM = true;
    bf16_t* Y; bf16_t* tmp; const bf16_t* gate_a; const bf16_t* gate_b;
    DI void operator()(const f32x4 (&acc)[2][2][4][2], const Unit& u, int wr, int wc, int fr, int fq) const {
        const int row0 = u.pm * BM + wr * 64 + fr, col0 = u.pn * BM + wc * 32 + 8 * fq;
        const bf16_t* gate = u.pz ? gate_b : gate_a; bf16_t* dst = u.pz ? Y : tmp;
#pragma unroll
        for (int ai = 0; ai < 2; ++ai) { u32x4 gw[4][2], tw[4][2];
#pragma unroll
            for (int m = 0; m < 4; ++m) { const int row = row0 + ai * HALF + m * 16;
#pragma unroll
                for (int bj = 0; bj < 2; ++bj) { gw[m][bj] = *(const u32x4*)(gate + (size_t)row * NP + col0 + bj * HALF);
                    tw[m][bj] = (u32x4){0u, 0u, 0u, 0u}; if (u.pz) tw[m][bj] = *(const u32x4*)(tmp + (size_t)row * D + col0 + bj * HALF); } }
#pragma unroll
            for (int m = 0; m < 4; ++m) { const int row = row0 + ai * HALF + m * 16;
#pragma unroll
                for (int bj = 0; bj < 2; ++bj) { const u32x4 g_ = gw[m][bj], t_ = tw[m][bj];
                    const f32x4 v0 = acc[ai][bj][m][0], v1 = acc[ai][bj][m][1]; f32x4 o0, o1;
                    o0[0] = lo_bf(t_.x) + v0[0] * sigmoidf_(lo_bf(g_.x)); o0[1] = hi_bf(t_.x) + v0[1] * sigmoidf_(hi_bf(g_.x)); o0[2] = lo_bf(t_.y) + v0[2] * sigmoidf_(lo_bf(g_.y)); o0[3] = hi_bf(t_.y) + v0[3] * sigmoidf_(hi_bf(g_.y));
                    o1[0] = lo_bf(t_.z) + v1[0] * sigmoidf_(lo_bf(g_.z)); o1[1] = hi_bf(t_.z) + v1[1] * sigmoidf_(hi_bf(g_.z)); o1[2] = lo_bf(t_.w) + v1[2] * sigmoidf_(lo_bf(g_.w)); o1[3] = hi_bf(t_.w) + v1[3] * sigmoidf_(hi_bf(g_.w));
                    u32x4 w; w.x = cvt_pk_bf16(o0[0], o0[1]); w.y = cvt_pk_bf16(o0[2], o0[3]); w.z = cvt_pk_bf16(o1[0], o1[1]); w.w = cvt_pk_bf16(o1[2], o1[3]);
                    *(u32x4*)(dst + (size_t)row * D + col0 + bj * HALF) = w; } }
            asm volatile("" ::: "memory"); }
    }
};
}

#define XB_TMO      128
#define XB_XCNT(j)  (256  + 64 * (j))
#define XB_XSUB(j)  (1280 + 64 * (j))
#define XB_XGEN(j)  (2304 + 64 * (j))
#define XB_TOP      3328
#define XB_TOPGEN   3392
#define XCD_BAR_WORDS 3456
#define XB_SPIN_CAP (1u << 18)
__device__ __forceinline__ unsigned xb_ld(unsigned* p)              { return __hip_atomic_load(p, __ATOMIC_RELAXED, __HIP_MEMORY_SCOPE_AGENT); }
__device__ __forceinline__ unsigned xb_add(unsigned* p, unsigned v) { return __hip_atomic_fetch_add(p, v, __ATOMIC_RELAXED, __HIP_MEMORY_SCOPE_AGENT); }
__device__ __forceinline__ unsigned xb_xcc_id() { return (unsigned)__builtin_amdgcn_s_getreg((3 << 11) | 20) & 0xFu; }
#define XB_SPIN(cond, bar) do { unsigned _sp = 0; while (cond) { __builtin_amdgcn_s_sleep(1); \
    if ((++_sp & 255u) == 0u) { if (xb_ld(&(bar)[XB_TMO])) break; if (_sp > XB_SPIN_CAP) { atomicAdd(&(bar)[XB_TMO], 1u); break; } } } } while (0)
struct XcdBarrier { unsigned* bar; unsigned x; volatile LAS unsigned* st; };
__device__ __forceinline__ XcdBarrier xcd_barrier_post(unsigned* bar, volatile LAS unsigned* st) {
    XcdBarrier b; b.bar = bar; b.x = xb_xcc_id(); b.st = st;
    if (threadIdx.x == 0) (void)xb_add(&bar[XB_XCNT(b.x)], 1u);
    return b;
}
__device__ __forceinline__ void xcd_barrier_complete(unsigned* bar, unsigned x, unsigned& nloc, unsigned& nx) {
    const unsigned G = gridDim.x * gridDim.y * gridDim.z;
    unsigned sum, cnt, mine, sp = 0u;
    for (;;) {
        sum = 0u; cnt = 0u; mine = 0u;
#pragma unroll
        for (unsigned j = 0; j < 16; ++j) { const unsigned c = xb_ld(&bar[XB_XCNT(j)]); sum += c; cnt += (c > 0u) ? 1u : 0u; mine = (j == x) ? c : mine; }
        if (sum == G) break;
        __builtin_amdgcn_s_sleep(1);
        if ((++sp & 255u) == 0u) { if (xb_ld(&bar[XB_TMO])) break; if (sp > XB_SPIN_CAP) { atomicAdd(&bar[XB_TMO], 1u); break; } }
    }
    nloc = mine > 0u ? mine : 1u; nx = cnt > 0u ? cnt : 1u;
}
__device__ __forceinline__ void xcd_barrier(const XcdBarrier& b) {
    asm volatile("s_waitcnt vmcnt(0)" ::: "memory");
    __syncthreads();
    if (threadIdx.x == 0) {
        unsigned* bar = b.bar;
        __builtin_amdgcn_s_waitcnt(0);
        unsigned nloc = b.st[0], nx = b.st[1];
        if (nloc == 0u) { xcd_barrier_complete(bar, b.x, nloc, nx); b.st[0] = nloc; b.st[1] = nx; }
        const unsigned old = xb_add(&bar[XB_XSUB(b.x)], 1u);
        const unsigned gen = old / nloc;
        if (old + 1u == (gen + 1u) * nloc) {
            __builtin_amdgcn_fence(__ATOMIC_RELEASE, "agent");
            asm volatile("s_waitcnt vmcnt(0)" ::: "memory");
            const unsigned og = xb_add(&bar[XB_TOP], 1u);
            const unsigned tg = og / nx;
            if (og + 1u == (tg + 1u) * nx) xb_add(&bar[XB_TOPGEN], 1u);
            else XB_SPIN(xb_ld(&bar[XB_TOPGEN]) == tg, bar);
            __builtin_amdgcn_fence(__ATOMIC_ACQUIRE, "agent");
            xb_add(&bar[XB_XGEN(b.x)], 1u);
            asm volatile("s_waitcnt vmcnt(0)" ::: "memory");
        } else {
            XB_SPIN(xb_ld(&bar[XB_XGEN(b.x)]) == gen, bar);
            __builtin_amdgcn_fence(__ATOMIC_ACQUIRE, "agent");
            asm volatile("s_waitcnt vmcnt(0)" ::: "memory");
        }
    }
    __syncthreads();
}

struct Args {
    const float *x, *norm_w, *w_in, *cmp_pe, *cmp_w1, *cmp_b1, *cmp_w2, *cmp_b2, *alpha_w, *alpha_b, *gla_norm_w, *p_a, *p_b, *w_out, *final_w;
    float* out; unsigned char* ws; int ph_lo, ph_hi;
};
typedef const __attribute__((address_space(4))) Args* KArgsP;
DI Args load_args(KArgsP p) { Args a; a.x = p->x; a.norm_w = p->norm_w; a.w_in = p->w_in; a.cmp_pe = p->cmp_pe; a.cmp_w1 = p->cmp_w1; a.cmp_b1 = p->cmp_b1; a.cmp_w2 = p->cmp_w2; a.cmp_b2 = p->cmp_b2;
    a.alpha_w = p->alpha_w; a.alpha_b = p->alpha_b; a.gla_norm_w = p->gla_norm_w; a.p_a = p->p_a; a.p_b = p->p_b; a.w_out = p->w_out; a.final_w = p->final_w; a.out = p->out; a.ws = p->ws; a.ph_lo = 0; a.ph_hi = 0; return a; }
struct Frame {
    LAS unsigned char* lds; int tid, lane, wave, G, bid, gw, NGW;
};

struct CvItem { const float* W; bf16_t* WT; int K, N, item; bool map; };
DI void cv_load(f32x4 (&v)[16], const CvItem& c, int lane) {
    const int nblk = c.N / 64, kb = c.item / nblk, nb = c.item % nblk, k0 = 64 * kb, n0 = 64 * nb;
#pragma unroll
    for (int i = 0; i < 16; ++i) v[i] = *(const f32x4*)(c.W + (size_t)(k0 + 4 * i + (lane >> 4)) * c.N + n0 + 4 * (lane & 15));
}
DI void cv_store(const f32x4 (&v)[16], const CvItem& c, LAS float* scr, int lane) {
    const int nblk = c.N / 64, kb = c.item / nblk, nb = c.item % nblk, k0 = 64 * kb, n0 = 64 * nb;
#pragma unroll
    for (int i = 0; i < 16; ++i) { LAS float* d = scr + (4 * i + (lane >> 4)) * 65 + 4 * (lane & 15); d[0] = v[i].x; d[1] = v[i].y; d[2] = v[i].z; d[3] = v[i].w; }
    LDS_WAIT(); asm volatile("" ::: "memory");
    const int ch = lane & 7;
#pragma unroll
    for (int j = 0; j < 8; ++j) { const int n = (lane >> 3) + 8 * j; const LAS float* s = scr + (8 * ch) * 65 + n;
        u32x4 o; o.x = pk2(s[0 * 65], s[1 * 65]); o.y = pk2(s[2 * 65], s[3 * 65]); o.z = pk2(s[4 * 65], s[5 * 65]); o.w = pk2(s[6 * 65], s[7 * 65]);
        const int drow = c.map ? map_col(n0 + n) : (n0 + n);
        *(u32x4*)(c.WT + (size_t)drow * c.K + k0 + 8 * ch) = o; }
    LDS_WAIT(); asm volatile("" ::: "memory");
}
constexpr int CV_IN = (D / 64) * (NIN / 64), CV_SQ = (D / 64) * (D / 64), CV_W1 = (4096 / 64) * (256 / 64), CV_W2 = (256 / 64) * (128 / 64);
constexpr int CV_PER_L = CV_IN + 3 * CV_SQ + 2 * CV_W1 + 2 * CV_W2;
DI CvItem cv_item(const Args& a, int it) {
    unsigned char* ws = a.ws; const int l = it / CV_PER_L; int r = it % CV_PER_L; CvItem c;
    if (r < CV_IN) { c.W = a.w_in + (size_t)l * D * NIN; c.WT = (bf16_t*)(ws + WS_WIN) + (size_t)l * NP * D; c.K = D; c.N = NIN; c.item = r; c.map = true; return c; } r -= CV_IN;
    c.map = false;
    if (r < CV_SQ) { c.W = a.p_a + (size_t)l * D * D; c.WT = (bf16_t*)(ws + WS_WPA) + (size_t)l * D * D; c.K = D; c.N = D; c.item = r; return c; } r -= CV_SQ;
    if (r < CV_SQ) { c.W = a.p_b + (size_t)l * D * D; c.WT = (bf16_t*)(ws + WS_WPB) + (size_t)l * D * D; c.K = D; c.N = D; c.item = r; return c; } r -= CV_SQ;
    if (r < CV_SQ) { c.W = a.w_out + (size_t)l * D * D; c.WT = (bf16_t*)(ws + WS_WOUT) + (size_t)l * D * D; c.K = D; c.N = D; c.item = r; return c; } r -= CV_SQ;
    if (r < 2 * CV_W1) { const int kv = r / CV_W1; c.W = a.cmp_w1 + (size_t)(l * 2 + kv) * 4096 * 256; c.WT = (bf16_t*)(ws + WS_W1T) + (size_t)(l * 2 + kv) * 256 * 4096; c.K = 4096; c.N = 256; c.item = r % CV_W1; return c; } r -= 2 * CV_W1;
    { const int kv = r / CV_W2; c.W = a.cmp_w2 + (size_t)(l * 2 + kv) * 256 * 128; c.WT = (bf16_t*)(ws + WS_W2T) + (size_t)(l * 2 + kv) * 128 * 256; c.K = 256; c.N = 128; c.item = r % CV_W2; }
    return c;
}
DI void p_prologue(const Frame& F, const Args& a) {
    LAS float* scr = (LAS float*)(F.lds + F.wave * 16640);
    unsigned char* ws = a.ws;
    constexpr int TOT = DEPTH * CV_PER_L;
    f32x4 va[16], vb[16];
    int it = F.gw;
    if (it < TOT) { CvItem ca = cv_item(a, it); cv_load(va, ca, F.lane);
        for (;;) {
            const int itb = it + F.NGW; CvItem cb; const bool hb = itb < TOT; if (hb) { cb = cv_item(a, itb); cv_load(vb, cb, F.lane); }
            cv_store(va, ca, scr, F.lane);
            if (!hb) break;
            const int itc = itb + F.NGW; const bool hc = itc < TOT; if (hc) { ca = cv_item(a, itc); cv_load(va, ca, F.lane); }
            cv_store(vb, cb, scr, F.lane);
            if (!hc) break;
            it = itc;
        } }
    __syncthreads();
    LAS float* red = (LAS float*)F.lds;
    for (int job = F.bid; job < DEPTH * 2; job += F.G) {
        const float* w1 = a.cmp_w1 + (size_t)job * 4096 * 256; const float* pe = a.cmp_pe + (size_t)job * 4096;
        f32x4 s = {0.f, 0.f, 0.f, 0.f};
        for (int k = F.wave * 512; k < F.wave * 512 + 512; ++k) { const f32x4 w = *(const f32x4*)(w1 + (size_t)k * 256 + 4 * F.lane); s += w * pe[k]; }
        *(LAS f32x4*)(red + F.wave * 256 + 4 * F.lane) = s;
        __syncthreads();
        if (F.tid < 256) { float t = a.cmp_b1[job * 256 + F.tid];
#pragma unroll
            for (int w = 0; w < 8; ++w) t += red[w * 256 + F.tid];
            ((float*)(ws + WS_B1P))[job * 256 + F.tid] = t; }
        __syncthreads();
    }
}

template <bool OUT_F32>
DI void p_rmsnorm(const Frame& F, const float* x, const float* w, void* out) {
    f32x4 wv[8];
#pragma unroll
    for (int j = 0; j < 8; ++j) wv[j] = *(const f32x4*)(w + 4 * F.lane + 256 * j);
    for (int row = F.gw; row < T; row += F.NGW) {
        const float* xr = x + (size_t)row * D + 4 * F.lane;
        f32x4 v[8]; float s = 0.f;
#pragma unroll
        for (int j = 0; j < 8; ++j) { v[j] = *(const f32x4*)(xr + 256 * j); s += (v[j].x * v[j].x + v[j].y * v[j].y) + (v[j].z * v[j].z + v[j].w * v[j].w); }
        const float rs = rsqrtf(wave_sum(s, F.lane) * (1.f / D) + NORM_EPS);
        if (OUT_F32) { float* o = (float*)out + (size_t)row * D + 4 * F.lane;
#pragma unroll
            for (int j = 0; j < 8; ++j) *(f32x4*)(o + 256 * j) = v[j] * rs * wv[j];
        } else { bf16_t* o = (bf16_t*)out + (size_t)row * D + 4 * F.lane;
#pragma unroll
            for (int j = 0; j < 8; ++j) { const f32x4 y = v[j] * rs * wv[j]; u32x2 p; p.x = pk2(y.x, y.y); p.y = pk2(y.z, y.w); *(u32x2*)(o + 256 * j) = p; } }
    }
}

constexpr int KTILE = 16384, VTILE = 16384, ABUF = KTILE + VTILE;
DI void glds16(const void* gsrc, LAS unsigned char* dst) { unsigned keep; const unsigned lds_dst = (unsigned)(uintptr_t)dst;
    asm volatile("s_mov_b32 %0, m0\n\ts_mov_b32 m0, %2\n\ts_nop 0\n\tglobal_load_lds_dwordx4 %1, off\n\ts_mov_b32 m0, %0" : "=&s"(keep) : "v"(gsrc), "s"(lds_dst) : "memory"); }
DI void dma_k(LAS unsigned char* kb, const bf16_t* kbase, size_t kpitch, int w, int lane) {
#pragma unroll
    for (int i = 0; i < 2; ++i) { const int b = w + 8 * i, row = 4 * b + (lane >> 4), c = (lane & 15) ^ (row & 15);
        glds16(kbase + (size_t)row * kpitch + c * 8, kb + b * 1024); }
}
DI void dma_v(LAS unsigned char* vb, const bf16_t* vbase, size_t vpitch, int w, int lane) {
#pragma unroll
    for (int i = 0; i < 2; ++i) { const int b = w + 8 * i, row = 8 * b + (lane >> 3), c = (lane & 7) ^ ((row >> 1) & 7);
        glds16(vbase + (size_t)row * vpitch + c * 8, vb + b * 1024); }
}
#define VMCNT(n) asm volatile("s_waitcnt vmcnt(" #n ")" ::: "memory")
#define RAW_BARRIER() do { asm volatile("" ::: "memory"); __builtin_amdgcn_s_barrier(); asm volatile("" ::: "memory"); } while (0)

template <bool PERMK>
DI void transpose64x64(const bf16_t* src, size_t pitch, bf16_t* dst, LAS unsigned char* scr, int lane) {
    u32x4 v[8];
#pragma unroll
    for (int i = 0; i < 8; ++i) { const int id = i * 64 + lane, row = id >> 3, ch = id & 7; v[i] = *(const u32x4*)(src + (size_t)row * pitch + ch * 8); }
#pragma unroll
    for (int i = 0; i < 8; ++i) { const int id = i * 64 + lane, row = id >> 3, ch = id & 7;
        const int pos = PERMK ? ((row & 32) | (((row >> 2) & 3) << 3) | (((row >> 4) & 1) << 2) | (row & 3)) : row;
        LAS unsigned char* d = scr + (8 * ch) * 136 + pos * 2;
        *(LAS unsigned short*)(d + 0 * 136) = (unsigned short)(v[i].x & 0xffffu); *(LAS unsigned short*)(d + 1 * 136) = (unsigned short)(v[i].x >> 16);
        *(LAS unsigned short*)(d + 2 * 136) = (unsigned short)(v[i].y & 0xffffu); *(LAS unsigned short*)(d + 3 * 136) = (unsigned short)(v[i].y >> 16);
        *(LAS unsigned short*)(d + 4 * 136) = (unsigned short)(v[i].z & 0xffffu); *(LAS unsigned short*)(d + 5 * 136) = (unsigned short)(v[i].z >> 16);
        *(LAS unsigned short*)(d + 6 * 136) = (unsigned short)(v[i].w & 0xffffu); *(LAS unsigned short*)(d + 7 * 136) = (unsigned short)(v[i].w >> 16); }
    LDS_WAIT(); asm volatile("" ::: "memory");
#pragma unroll
    for (int i = 0; i < 8; ++i) { const int id = i * 64 + lane, col = id >> 3, tg = id & 7;
        const u32x2 lo = *(const LAS u32x2*)(scr + col * 136 + tg * 16), hi = *(const LAS u32x2*)(scr + col * 136 + tg * 16 + 8);
        u32x4 o; o.x = lo.x; o.y = lo.y; o.z = hi.x; o.w = hi.y;
        *(u32x4*)(dst + (size_t)col * 64 + 8 * tg) = o; }
    LDS_WAIT(); asm volatile("" ::: "memory");
}

DI void gla_g1_unit(const Frame& F, const Args& a, int layer, int n, int h) {
    const bf16_t* cols = (const bf16_t*)(a.ws + WS_COLS);
    LAS float* alr = (LAS float*)(F.lds); LAS float* part = (LAS float*)(F.lds + 4096);
    LAS unsigned char* QR = F.lds + 8192; LAS unsigned char* KR = F.lds + 8192 + 32768;
    __syncthreads();
#pragma unroll
    for (int hf = 0; hf < 2; ++hf) { dma_k(QR + hf * 16384, cols + (size_t)(64 * n) * NP + C_QB + h * 256 + hf * 128, NP, F.wave, F.lane);
        dma_k(KR + hf * 16384, cols + (size_t)(64 * n) * NP + C_KB + h * 256 + hf * 128, NP, F.wave, F.lane); }
    if (F.tid < 256) { const int t = F.tid >> 2, k4 = (F.tid & 3) * 4; const u32x2 w = *(const u32x2*)(cols + (size_t)(64 * n + t) * NP + C_ALR + k4);
        alr[t * 16 + k4 + 0] = lo_bf(w.x); alr[t * 16 + k4 + 1] = hi_bf(w.x); alr[t * 16 + k4 + 2] = lo_bf(w.y); alr[t * 16 + k4 + 3] = hi_bf(w.y); }
    __syncthreads();
    const int d = F.tid & 255, half = F.tid >> 8, col = h * 256 + d;
    float w[16];
#pragma unroll
    for (int k = 0; k < 16; ++k) w[k] = a.alpha_w[(size_t)(layer * 16 + k) * 1024 + col];
    const float b = a.alpha_b[layer * 1024 + col];
    float cum[32]; float run = 0.f;
#pragma unroll
    for (int i = 0; i < 32; ++i) { const int t = half * 32 + i; float ga = b;
#pragma unroll
        for (int k4 = 0; k4 < 4; ++k4) { const f32x4 av = *(const LAS f32x4*)(alr + t * 16 + 4 * k4); ga += av.x * w[4 * k4] + av.y * w[4 * k4 + 1] + av.z * w[4 * k4 + 2] + av.w * w[4 * k4 + 3]; }
        const float ls = fminf(ga, 0.f) - __logf(1.f + __expf(-fabsf(ga)));
        run += ls * 0.0625f; cum[i] = run; }
    part[half * 256 + d] = run;
    VMCNT(0);
    __syncthreads();
    const float p0 = part[d], last = p0 + part[256 + d], elast = __expf(last);
    if (half) {
#pragma unroll
        for (int i = 0; i < 32; ++i) cum[i] += p0; }
    bf16_t* kst = (bf16_t*)(a.ws + WS_KST);
    const int eoff = (d >> 7) * 16384 + (d & 7) * 2, ech = (d & 127) >> 3;
    unsigned ksw[16];
#pragma unroll
    for (int i = 0; i < 32; ++i) { const int t = half * 32 + i; const int off = eoff + t * 256 + ((ech ^ (t & 15)) << 4);
        const float qv = bf2f(*(const LAS unsigned short*)(QR + off)), kv = bf2f(*(const LAS unsigned short*)(KR + off));
        const float ec = __expf(cum[i]), kin = kv * __expf(-cum[i]);
        const unsigned qb = f2bf(qv * 0.0625f * ec), kib = f2bf(kin), ksb = f2bf(kin * elast);
        *(LAS unsigned short*)(QR + off) = (unsigned short)qb; *(LAS unsigned short*)(KR + off) = (unsigned short)kib;
        if (i & 1) ksw[i >> 1] |= ksb << 16; else ksw[i >> 1] = ksb; }
    { bf16_t* kp = kst + ((size_t)((n * 4 + h) * 256 + d)) * 64 + half * 32;
#pragma unroll
        for (int j = 0; j < 4; ++j) { u32x4 o; o.x = ksw[4 * j]; o.y = ksw[4 * j + 1]; o.z = ksw[4 * j + 2]; o.w = ksw[4 * j + 3]; *(u32x4*)(kp + 8 * j) = o; } }
    if (half == 0) ((float*)(a.ws + WS_DEC))[(n * 4 + h) * 256 + d] = elast;
    __syncthreads();
    { bf16_t* qdec = (bf16_t*)(a.ws + WS_QDEC);
#pragma unroll
        for (int i = 0; i < 4; ++i) { const int id = F.tid + 512 * i, t = id >> 5, c32 = id & 31, hf = c32 >> 4, c = c32 & 15;
            *(u32x4*)(qdec + (size_t)(64 * n + t) * 1024 + h * 256 + c32 * 8) = *(const LAS u32x4*)(QR + hf * 16384 + t * 256 + ((c ^ (t & 15)) << 4)); } }
    bf16_t* att = (bf16_t*)(a.ws + WS_ATT) + (size_t)(n * 4 + h) * 4096;
    const int fr = F.lane & 15, fq = F.lane >> 4, ms = F.wave >> 1;
#pragma unroll
    for (int z = 0; z < 2; ++z) { const int nt = 2 * (F.wave & 1) + z; f32x4 acc = {0.f, 0.f, 0.f, 0.f};
#pragma unroll
        for (int ks = 0; ks < 8; ++ks) { const int fo = (ks >> 2) * 16384 + (((4 * (ks & 3) + fq) ^ fr) << 4);
            const bf16x8 A = *(const LAS bf16x8*)(KR + fo + (16 * ms + fr) * 256);
            const bf16x8 B = *(const LAS bf16x8*)(QR + fo + (16 * nt + fr) * 256); acc = MFMA16(A, B, acc); }
        const int t = 16 * nt + fr, s0 = 16 * ms + 4 * fq;
        u32x2 o; o.x = pk2(s0 + 0 <= t ? acc[0] : 0.f, s0 + 1 <= t ? acc[1] : 0.f); o.y = pk2(s0 + 2 <= t ? acc[2] : 0.f, s0 + 3 <= t ? acc[3] : 0.f);
        *(u32x2*)(att + t * 64 + s0) = o; }
}

DI void transpose_unit(const Frame& F, const Args& a, int tu) {
    __syncthreads();
    const bf16_t* cols = (const bf16_t*)(a.ws + WS_COLS);
    LAS unsigned char* scr = F.lds + F.wave * 9216;
#pragma unroll 1
    for (int rep = 0; rep < 3; ++rep) { const int it = (tu * 3 + rep) * 8 + F.wave;
    if (it < 4096) { const int n = it >> 5, cg = it & 31;
        transpose64x64<false>(cols + (size_t)(64 * n) * NP + C_VB + 64 * cg, NP, (bf16_t*)(a.ws + WS_VT) + ((size_t)n * 2048 + 64 * cg) * 64, scr, F.lane); }
    else { const int r = (it - 4096) & 1023, win = (it - 4096) >> 10, j = r >> 3, g = (r >> 1) & 3, hf = r & 1;
        transpose64x64<true>(cols + (size_t)(64 * j) * NP + (win ? C_VWIN : C_VSEL) + 128 * g + 64 * hf, NP,
                             (bf16_t*)(a.ws + (win ? WS_VWINT : WS_VSELT)) + ((size_t)(g * 128 + j) * 128 + 64 * hf) * 64, scr, F.lane); } }
}

DI float gelu_tanh(float x) { const float u = 0.7978845608028654f * (x + 0.044715f * x * x * x); const float t = __expf(2.f * u); return 0.5f * x * (2.f - 2.f / (t + 1.f)); }
DI void mlp2_unit(const Frame& F, const Args& a, int layer, int pz, int rt) {
    const float* cpart = (const float*)(a.ws + WS_CPART);
    LAS unsigned char* hid = F.lds;
    const int kv = pz >> 2, g = pz & 3;
    __syncthreads();
    { const int r = F.tid >> 5, c0 = (F.tid & 31) * 8; f32x4 s0, s1;
        const float* bp = (const float*)(a.ws + WS_B1P) + (layer * 2 + kv) * 256 + c0;
        s0 = *(const f32x4*)bp; s1 = *(const f32x4*)(bp + 4);
#pragma unroll
        for (int pk = 0; pk < 8; ++pk) { const float* p = cpart + ((size_t)(pk * 8 + pz) * 512 + rt * 16 + r) * 256 + c0; s0 += *(const f32x4*)p; s1 += *(const f32x4*)(p + 4); }
        u32x4 o; o.x = pk2(gelu_tanh(s0.x), gelu_tanh(s0.y)); o.y = pk2(gelu_tanh(s0.z), gelu_tanh(s0.w)); o.z = pk2(gelu_tanh(s1.x), gelu_tanh(s1.y)); o.w = pk2(gelu_tanh(s1.z), gelu_tanh(s1.w));
        *(LAS u32x4*)(hid + r * 528 + c0 * 2) = o; }
    __syncthreads();
    const bf16_t* w2t = (const bf16_t*)(a.ws + WS_W2T) + (size_t)(layer * 2 + kv) * 128 * 256;
    const int fr = F.lane & 15, fq = F.lane >> 4, dt = F.wave;
    const float* b2 = a.cmp_b2 + (layer * 2 + kv) * 128;
    f32x4 acc = {0.f, 0.f, 0.f, 0.f};
#pragma unroll
    for (int ks = 0; ks < 8; ++ks) { const bf16x8 wf = *(const bf16x8*)(w2t + (16 * dt + fr) * 256 + 32 * ks + 8 * fq);
        const bf16x8 hf = *(const LAS bf16x8*)(hid + fr * 528 + (32 * ks + 8 * fq) * 2);
        acc = kv ? MFMA16(hf, wf, acc) : MFMA16(wf, hf, acc); }
    if (!kv) { const int n = 16 * rt + fr, dim = 16 * dt + 4 * fq; const f32x4 bb = *(const f32x4*)(b2 + dim); u32x2 o;
        if (n == 511) { o.x = 0u; o.y = 0u; } else { o.x = pk2(acc[0] + bb.x, acc[1] + bb.y); o.y = pk2(acc[2] + bb.z, acc[3] + bb.w); }
        *(u32x2*)((bf16_t*)(a.ws + WS_KC) + ((size_t)g * 512 + n) * 128 + dim) = o; }
    else { const int n0 = 16 * rt + 4 * fq, dim = 16 * dt + fr; const float bb = b2[dim]; u32x2 o;
        o.x = pk2(acc[0] + bb, acc[1] + bb); o.y = pk2(acc[2] + bb, (n0 + 3 == 511) ? 0.f : acc[3] + bb);
        const int pos = 64 * (rt >> 2) + 32 * ((rt & 3) >> 1) + 8 * fq + 4 * (rt & 1);
        *(u32x2*)((bf16_t*)(a.ws + WS_VCT) + ((size_t)g * 128 + dim) * 512 + pos) = o; }
}

template <int ACT>
DI void qk_tile(f32x4 (&s)[4][2], const LAS unsigned char* kb, const bf16x8 (&qf)[2][4], int fr, int fq) {
    const LAS unsigned char* kr = kb + fr * 256; const int x0 = (fq ^ fr) << 4, x1 = ((4 + fq) ^ fr) << 4, x2 = ((8 + fq) ^ fr) << 4, x3 = ((12 + fq) ^ fr) << 4;
    const f32x4 zero = {0.f, 0.f, 0.f, 0.f};
#pragma unroll
    for (int kt = 0; kt < 4; ++kt) { const LAS unsigned char* kn = kr + kt * 4096; bf16x8 kf[4];
        kf[0] = *(const LAS bf16x8*)(kn + x0); kf[1] = *(const LAS bf16x8*)(kn + x1); kf[2] = *(const LAS bf16x8*)(kn + x2); kf[3] = *(const LAS bf16x8*)(kn + x3);
        if (ACT & 1) { s[kt][0] = MFMA16(kf[0], qf[0][0], zero); } if (ACT & 2) { s[kt][1] = MFMA16(kf[0], qf[1][0], zero); }
#pragma unroll
        for (int ks = 1; ks < 4; ++ks) { if (ACT & 1) s[kt][0] = MFMA16(kf[ks], qf[0][ks], s[kt][0]); if (ACT & 2) s[kt][1] = MFMA16(kf[ks], qf[1][ks], s[kt][1]); }
    }
}
template <int ACT, bool WITH_L = true>
DI void pv_tile(f32x4 (&O)[8][2], f32x4 (&L)[2], const LAS unsigned char* vb, const bf16x8 (&pf)[2][2], int fr, int fq) {
    const LAS unsigned char* vr = vb + fr * 128; const int x = (fr >> 1) & 7, y0 = (fq ^ x) << 4, y1 = ((4 + fq) ^ x) << 4;
    const bf16x8 ones = {0x3f80, 0x3f80, 0x3f80, 0x3f80, 0x3f80, 0x3f80, 0x3f80, 0x3f80};
    if (WITH_L && (ACT & 1)) { L[0] = MFMA16(ones, pf[0][0], L[0]); L[0] = MFMA16(ones, pf[1][0], L[0]); }
    if (WITH_L && (ACT & 2)) { L[1] = MFMA16(ones, pf[0][1], L[1]); L[1] = MFMA16(ones, pf[1][1], L[1]); }
#pragma unroll
    for (int dt = 0; dt < 8; ++dt) {
        const bf16x8 v0 = *(const LAS bf16x8*)(vr + dt * 2048 + y0), v1 = *(const LAS bf16x8*)(vr + dt * 2048 + y1);
        if (ACT & 1) O[dt][0] = MFMA16(v0, pf[0][0], O[dt][0]); if (ACT & 2) O[dt][1] = MFMA16(v0, pf[0][1], O[dt][1]);
        if (ACT & 1) O[dt][0] = MFMA16(v1, pf[1][0], O[dt][0]); if (ACT & 2) O[dt][1] = MFMA16(v1, pf[1][1], O[dt][1]);
    }
}
DI float max3f(float a, float b, float c) { return fmaxf(fmaxf(a, b), c); }
DI bf16x8 pack_p(const f32x4& a, const f32x4& b) { u32x4 w; w.x = cvt_pk_bf16(a[0], a[1]); w.y = cvt_pk_bf16(a[2], a[3]); w.z = cvt_pk_bf16(b[0], b[1]); w.w = cvt_pk_bf16(b[2], b[3]); return __builtin_bit_cast(bf16x8, w); }
DI float quad_max(float v, int lane) {
    auto r = __builtin_amdgcn_permlane16_swap(__float_as_uint(v), __float_as_uint(v), false, false); v = fmaxf(__uint_as_float(r[0]), __uint_as_float(r[1]));
    r = __builtin_amdgcn_permlane32_swap(__float_as_uint(v), __float_as_uint(v), false, false); return fmaxf(__uint_as_float(r[0]), __uint_as_float(r[1])); }
DI float quad_sum(float v, int lane) {
    auto r = __builtin_amdgcn_permlane16_swap(__float_as_uint(v), __float_as_uint(v), false, false); v = __uint_as_float(r[0]) + __uint_as_float(r[1]);
    r = __builtin_amdgcn_permlane32_swap(__float_as_uint(v), __float_as_uint(v), false, false); return __uint_as_float(r[0]) + __uint_as_float(r[1]); }
constexpr float NEG_INF = -__builtin_inff();

template <int MODE, int ACT>
DI void fa_tile(f32x4 (&O)[8][2], f32x4 (&L)[2], float (&m)[2], const bf16x8 (&qf)[2][4], const LAS unsigned char* kb, const LAS unsigned char* vb,
                const bool (&bit)[2], const int (&tokl)[2], bool diag, bool left, int fr, int fq, int lane) {
    f32x4 s[4][2];
    qk_tile<ACT>(s, kb, qf, fr, fq);
    bf16x8 pf[2][2];
#pragma unroll
    for (int ct = 0; ct < 2; ++ct) {
        if (!((ACT >> ct) & 1)) continue;
        if (diag || left) {
            const int thr_hi = diag ? tokl[ct] : 63, thr_lo = left ? tokl[ct] : -1;
            int kq = 4 * fq; asm volatile("" : "+v"(kq));
#pragma unroll
            for (int kt = 0; kt < 4; ++kt)
#pragma unroll
                for (int r = 0; r < 4; ++r) { const int kl = 16 * kt + kq + r;
                    s[kt][ct][r] = (kl <= thr_hi && kl > thr_lo) ? s[kt][ct][r] : NEG_INF; } }
        float mx = max3f(s[0][ct][0], s[0][ct][1], s[0][ct][2]);
        mx = max3f(mx, s[0][ct][3], s[1][ct][0]); mx = max3f(mx, s[1][ct][1], s[1][ct][2]); mx = max3f(mx, s[1][ct][3], s[2][ct][0]); mx = max3f(mx, s[2][ct][1], s[2][ct][2]);
        mx = max3f(mx, s[2][ct][3], s[3][ct][0]); mx = max3f(mx, s[3][ct][1], s[3][ct][2]); mx = fmaxf(mx, s[3][ct][3]);
        mx = quad_max(mx, lane);
        if (MODE == 0 && !bit[ct]) mx = NEG_INF;
        if (__ballot((mx - m[ct]) * ATT_C > 8.f) != 0ull) {
            const float mn = fmaxf(m[ct], mx), alpha = __builtin_amdgcn_exp2f((m[ct] - mn) * ATT_C); m[ct] = mn; L[ct] *= alpha;
#pragma unroll
            for (int dt = 0; dt < 8; ++dt) O[dt][ct] *= alpha; }
        const float mc = (MODE == 0 && !bit[ct]) ? __builtin_inff() : m[ct] * ATT_C;
#pragma unroll
        for (int kt = 0; kt < 4; ++kt)
#pragma unroll
            for (int r = 0; r < 4; ++r) s[kt][ct][r] = __builtin_amdgcn_exp2f(s[kt][ct][r] * ATT_C - mc);
        pf[0][ct] = pack_p(s[0][ct], s[1][ct]); pf[1][ct] = pack_p(s[2][ct], s[3][ct]);
    }
    pv_tile<ACT>(O, L, vb, pf, fr, fq);
}

template <int MODE>
DI bool fa_rowmax(float (&m)[2], float (&mc)[2], float (&alpha)[2], f32x4 (&s)[4][2], const bool (&bit)[2], const int (&tokl)[2], bool diag, bool left, int fq, int lane) {
    bool need = false;
#pragma unroll
    for (int ct = 0; ct < 2; ++ct) {
        if (diag || left) {
            const int thr_hi = diag ? tokl[ct] : 63, thr_lo = left ? tokl[ct] : -1;
            int kq = 4 * fq; asm volatile("" : "+v"(kq));
#pragma unroll
            for (int kt = 0; kt < 4; ++kt)
#pragma unroll
                for (int r = 0; r < 4; ++r) { const int kl = 16 * kt + kq + r; s[kt][ct][r] = (kl <= thr_hi && kl > thr_lo) ? s[kt][ct][r] : NEG_INF; } }
        float mx = max3f(s[0][ct][0], s[0][ct][1], s[0][ct][2]);
        mx = max3f(mx, s[0][ct][3], s[1][ct][0]); mx = max3f(mx, s[1][ct][1], s[1][ct][2]); mx = max3f(mx, s[1][ct][3], s[2][ct][0]); mx = max3f(mx, s[2][ct][1], s[2][ct][2]);
        mx = max3f(mx, s[2][ct][3], s[3][ct][0]); mx = max3f(mx, s[3][ct][1], s[3][ct][2]); mx = fmaxf(mx, s[3][ct][3]);
        mx = quad_max(mx, lane);
        if (MODE == 0 && !bit[ct]) mx = NEG_INF;
        alpha[ct] = 1.f;
        if (__ballot((mx - m[ct]) * ATT_C > 8.f) != 0ull) { const float mn = fmaxf(m[ct], mx); alpha[ct] = __builtin_amdgcn_exp2f((m[ct] - mn) * ATT_C); m[ct] = mn; need = true; }
        mc[ct] = (MODE == 0 && !bit[ct]) ? __builtin_inff() : m[ct] * ATT_C;
    }
    return need;
}
template <bool HAS_PREV>
DI void fa_exp_pv(f32x4 (&s)[4][2], const float (&mc)[2], bf16x8 (&pfc)[2][2], f32x4 (&O)[8][2], f32x4 (&L)[2], const bf16x8 (&pfp)[2][2], const LAS unsigned char* vbp, int fr, int fq) {
#define FA_EXP1(e) do { if ((e) < 32) { const int _ct = (e) >> 4, _kt = ((e) >> 2) & 3, _r = (e) & 3; s[_kt][_ct][_r] = __builtin_amdgcn_exp2f(s[_kt][_ct][_r] * ATT_C - mc[_ct]); } \
        if ((e) == 8) pfc[0][0] = pack_p(s[0][0], s[1][0]); if ((e) == 16) pfc[1][0] = pack_p(s[2][0], s[3][0]); \
        if ((e) == 24) pfc[0][1] = pack_p(s[0][1], s[1][1]); if ((e) == 32) pfc[1][1] = pack_p(s[2][1], s[3][1]); } while (0)
    if (!HAS_PREV) {
#pragma unroll
        for (int e = 0; e <= 32; ++e) FA_EXP1(e);
    } else {
        const LAS unsigned char* vr = vbp + fr * 128; const int x = (fr >> 1) & 7, y0 = (fq ^ x) << 4, y1 = ((4 + fq) ^ x) << 4;
        const bf16x8 ones = {0x3f80, 0x3f80, 0x3f80, 0x3f80, 0x3f80, 0x3f80, 0x3f80, 0x3f80};
        bf16x8 vf[2][2];
        vf[0][0] = *(const LAS bf16x8*)(vr + y0); vf[0][1] = *(const LAS bf16x8*)(vr + y1);
#define FA_SLOT(mfma_stmt, e) do { mfma_stmt; FA_EXP1(e); __builtin_amdgcn_sched_barrier(0); } while (0)
        FA_SLOT(L[0] = MFMA16(ones, pfp[0][0], L[0]), 0); FA_SLOT(L[1] = MFMA16(ones, pfp[0][1], L[1]), 1);
        FA_SLOT(L[0] = MFMA16(ones, pfp[1][0], L[0]), 2); FA_SLOT(L[1] = MFMA16(ones, pfp[1][1], L[1]), 3);
#pragma unroll
        for (int dt = 0; dt < 8; ++dt) { const int cb = dt & 1, nb = cb ^ 1;
            if (dt < 7) { vf[nb][0] = *(const LAS bf16x8*)(vr + (dt + 1) * 2048 + y0); vf[nb][1] = *(const LAS bf16x8*)(vr + (dt + 1) * 2048 + y1); }
            FA_SLOT(O[dt][0] = MFMA16(vf[cb][0], pfp[0][0], O[dt][0]), 4 + 4 * dt); FA_SLOT(O[dt][1] = MFMA16(vf[cb][0], pfp[0][1], O[dt][1]), 5 + 4 * dt);
            FA_SLOT(O[dt][0] = MFMA16(vf[cb][1], pfp[1][0], O[dt][0]), 6 + 4 * dt); FA_SLOT(O[dt][1] = MFMA16(vf[cb][1], pfp[1][1], O[dt][1]), 7 + 4 * dt); }
#undef FA_SLOT
    }
#undef FA_EXP1
}

template <int MODE  >
DI void fa_chunk(const Frame& F, const Args& a, int c, int g) {
    const bf16_t* cols = (const bf16_t*)(a.ws + WS_COLS);
    const int fr = F.lane & 15, fq = F.lane >> 4, w = F.wave, tid = F.tid;
    LAS unsigned char* lds = F.lds;
    LAS int* list = (LAS int*)(lds + 4 * ABUF); LAS unsigned* maskw = (LAS unsigned*)(lds + 4 * ABUF + 1024);
    const bf16_t* kcol = cols + (MODE ? C_KWIN : C_KSEL) + 128 * g;
    const bf16_t* vT = (const bf16_t*)(a.ws + (MODE ? WS_VWINT : WS_VSELT)) + (size_t)g * 128 * 8192;
    __syncthreads();
    int ntile, j0 = 0;
    if (MODE == 0) {
        const unsigned* selm = (const unsigned*)(a.ws + WS_SELM);
        if (tid < 256) maskw[tid] = selm[((size_t)(64 * c + (tid >> 2)) * 4 + g) * 4 + (tid & 3)];
        __syncthreads();
        if (w == 0) { int base = 0;
#pragma unroll
            for (int hf = 0; hf < 2; ++hf) { const int j = hf * 64 + F.lane; unsigned orv = 0u;
                for (int tk = 0; tk < 64; ++tk) orv |= maskw[tk * 4 + (j >> 5)];
                const bool act = ((orv >> (j & 31)) & 1u) && (j <= c); const unsigned long long bl = __ballot(act);
                if (act) list[base + __popcll(bl & ((1ull << F.lane) - 1ull))] = j; base += __popcll(bl); }
            if (F.lane == 0) list[129] = base; }
        __syncthreads();
        ntile = list[129];
    } else { j0 = c > 8 ? c - 8 : 0; ntile = c - j0 + 1; }
    int tokl[2]; tokl[0] = 8 * w + (fr >> 2); tokl[1] = tokl[0] + 4;
    const int head = 4 * g + (fr & 3);
    bf16x8 qf[2][4];
#pragma unroll
    for (int ct = 0; ct < 2; ++ct)
#pragma unroll
        for (int ks = 0; ks < 4; ++ks) qf[ct][ks] = *(const bf16x8*)(cols + (size_t)(64 * c + tokl[ct]) * NP + C_QA + head * 128 + 32 * ks + 8 * fq);
    f32x4 O[8][2], L[2]; float m[2] = {-1e30f, -1e30f};
    L[0] = (f32x4){0.f, 0.f, 0.f, 0.f}; L[1] = L[0];
#pragma unroll
    for (int dt = 0; dt < 8; ++dt) { O[dt][0] = (f32x4){0.f, 0.f, 0.f, 0.f}; O[dt][1] = (f32x4){0.f, 0.f, 0.f, 0.f}; }
#define FA_TILE(t) (MODE ? j0 + (t) : list[(t)])
#define FA_ISSUE(t) do { const int _j = FA_TILE(t); LAS unsigned char* _b = lds + ((t) & 3) * ABUF; \
        dma_k(_b, kcol + (size_t)(64 * _j) * NP, NP, w, F.lane); dma_v(_b + KTILE, vT + (size_t)_j * 8192, 64, w, F.lane); } while (0)
    FA_ISSUE(0); if (ntile > 1) FA_ISSUE(1);
    f32x4 s[4][2]; bf16x8 pfp[2][2], pfc[2][2]; float mc[2], alpha[2]; bool bit[2] = {true, true};
    for (int t = 0; t < ntile; ++t) {
        if (t + 1 < ntile) VMCNT(4); else VMCNT(0);
        RAW_BARRIER();
        if (t + 2 < ntile) FA_ISSUE(t + 2);
        const int j = FA_TILE(t);
        qk_tile<3>(s, lds + (t & 3) * ABUF, qf, fr, fq);
        if (MODE == 0) {
#pragma unroll
            for (int ct = 0; ct < 2; ++ct) bit[ct] = (maskw[tokl[ct] * 4 + (j >> 5)] >> (j & 31)) & 1u; }
        const bool need = fa_rowmax<MODE>(m, mc, alpha, s, bit, tokl, j == c, (MODE == 1) && (j == c - 8), fq, F.lane);
        __builtin_amdgcn_sched_barrier(0);
        if (t > 0) fa_exp_pv<true>(s, mc, pfc, O, L, pfp, lds + ((t - 1) & 3) * ABUF + KTILE, fr, fq); else fa_exp_pv<false>(s, mc, pfc, O, L, pfp, lds, fr, fq);
        __builtin_amdgcn_sched_barrier(0);
        if (need) {
#pragma unroll
            for (int ct = 0; ct < 2; ++ct) { L[ct] *= alpha[ct];
#pragma unroll
                for (int dt = 0; dt < 8; ++dt) O[dt][ct] *= alpha[ct]; } }
#pragma unroll
        for (int ct = 0; ct < 2; ++ct) { pfp[0][ct] = pfc[0][ct]; pfp[1][ct] = pfc[1][ct]; }
    }
    pv_tile<3>(O, L, lds + ((ntile - 1) & 3) * ABUF + KTILE, pfp, fr, fq);
#undef FA_ISSUE
#undef FA_TILE
    bf16_t* out = (bf16_t*)(a.ws + (MODE ? WS_OWIN : WS_OSEL));
#pragma unroll
    for (int ct = 0; ct < 2; ++ct) { const float inv = 1.f / L[ct][0]; bf16_t* op = out + (size_t)(64 * c + tokl[ct]) * D + head * 128 + 4 * fq;
#pragma unroll
        for (int dt = 0; dt < 8; ++dt) { u32x2 o; o.x = pk2(O[dt][ct][0] * inv, O[dt][ct][1] * inv); o.y = pk2(O[dt][ct][2] * inv, O[dt][ct][3] * inv); *(u32x2*)(op + 16 * dt) = o; } }
}

DI void ca_chunk(const Frame& F, const Args& a, int c, int g) {
    const bf16_t* cols = (const bf16_t*)(a.ws + WS_COLS);
    const int fr = F.lane & 15, fq = F.lane >> 4, w = F.wave, tid = F.tid;
    LAS unsigned char* lds = F.lds;
    LAS float* pslc = (LAS float*)(lds + 2 * ABUF); LAS float* p3 = (LAS float*)(lds + 2 * ABUF + 32768);
    const bf16_t* kc = (const bf16_t*)(a.ws + WS_KC) + (size_t)g * 512 * 128;
    const bf16_t* vct = (const bf16_t*)(a.ws + WS_VCT) + (size_t)g * 128 * 512;
    const int ntile = ((4 * c + 2) >> 6) + 1;
    int tokl[2]; tokl[0] = 8 * w + (fr >> 2); tokl[1] = tokl[0] + 4;
    const int head = 4 * g + (fr & 3);
    int nlim[2];
#pragma unroll
    for (int ct = 0; ct < 2; ++ct) { const int t = 64 * c + tokl[ct]; nlim[ct] = t >= 31 ? ((t - 31) >> 4) : -1; }
    bf16x8 qf[2][4];
#pragma unroll
    for (int ct = 0; ct < 2; ++ct)
#pragma unroll
        for (int ks = 0; ks < 4; ++ks) qf[ct][ks] = *(const bf16x8*)(cols + (size_t)(64 * c + tokl[ct]) * NP + C_QA + head * 128 + 32 * ks + 8 * fq);
    float m[2] = {-1e30f, -1e30f}, l[2] = {0.f, 0.f};
    __syncthreads();
    dma_k(lds, kc, 128, w, F.lane);
    for (int jt = 0; jt < ntile; ++jt) {
        VMCNT(0); RAW_BARRIER();
        if (jt + 1 < ntile) dma_k(lds + ((jt + 1) & 1) * ABUF, kc + (size_t)(64 * (jt + 1)) * 128, 128, w, F.lane);
        const LAS unsigned char* kb = lds + (jt & 1) * ABUF;
        f32x4 s[4][2];
        qk_tile<3>(s, kb, qf, fr, fq);
        const bool edge = jt >= ntile - 2;
        int kq = 4 * fq; asm volatile("" : "+v"(kq));
#pragma unroll
        for (int ct = 0; ct < 2; ++ct) {
            float mx = NEG_INF;
#pragma unroll
            for (int kt = 0; kt < 4; ++kt)
#pragma unroll
                for (int r = 0; r < 4; ++r) { float v = s[kt][ct][r]; if (edge) { const int n = 64 * jt + 16 * kt + kq + r; v = (n <= nlim[ct]) ? v : NEG_INF; s[kt][ct][r] = v; } mx = fmaxf(mx, v); }
            mx = quad_max(mx, F.lane);
            if (__ballot((mx - m[ct]) * ATT_C > 8.f) != 0ull) { const float mn = fmaxf(m[ct], mx); l[ct] *= __builtin_amdgcn_exp2f((m[ct] - mn) * ATT_C); m[ct] = mn; }
            const float mc = m[ct] * ATT_C;
            float rs = 0.f;
#pragma unroll
            for (int kt = 0; kt < 4; ++kt)
#pragma unroll
                for (int r = 0; r < 4; ++r) rs += __builtin_amdgcn_exp2f(s[kt][ct][r] * ATT_C - mc);
            l[ct] += quad_sum(rs, F.lane);
        }
    }
    f32x4 O[8][2];
#pragma unroll
    for (int dt = 0; dt < 8; ++dt) { O[dt][0] = (f32x4){0.f, 0.f, 0.f, 0.f}; O[dt][1] = (f32x4){0.f, 0.f, 0.f, 0.f}; }
    float mc[2], inv[2];
#pragma unroll
    for (int ct = 0; ct < 2; ++ct) { mc[ct] = m[ct] * ATT_C; inv[ct] = l[ct] > 0.f ? 1.f / l[ct] : 0.f; }
    RAW_BARRIER();
    dma_k(lds, kc, 128, w, F.lane); dma_v(lds + KTILE, vct, 512, w, F.lane);
    for (int jt = 0; jt < ntile; ++jt) {
        VMCNT(0); RAW_BARRIER();
        if (jt + 1 < ntile) { LAS unsigned char* nb = lds + ((jt + 1) & 1) * ABUF; dma_k(nb, kc + (size_t)(64 * (jt + 1)) * 128, 128, w, F.lane); dma_v(nb + KTILE, vct + 64 * (jt + 1), 512, w, F.lane); }
        const LAS unsigned char* kb = lds + (jt & 1) * ABUF;
        f32x4 s[4][2];
        qk_tile<3>(s, kb, qf, fr, fq);
        const bool edge = jt >= ntile - 2;
        int kq = 4 * fq; asm volatile("" : "+v"(kq));
        bf16x8 pf[2][2];
#pragma unroll
        for (int ct = 0; ct < 2; ++ct) {
#pragma unroll
            for (int kt = 0; kt < 4; ++kt) {
#pragma unroll
                for (int r = 0; r < 4; ++r) { float p = __builtin_amdgcn_exp2f(s[kt][ct][r] * ATT_C - mc[ct]) * inv[ct];
                    if (edge) { const int n = 64 * jt + 16 * kt + kq + r; p = (n <= nlim[ct]) ? p : 0.f; }
                    s[kt][ct][r] = p; }
                float h3 = s[kt][ct][3], hs = (s[kt][ct][0] + s[kt][ct][1]) + (s[kt][ct][2] + h3);
                hs += shx(hs, 1, F.lane); hs += shx(hs, 2, F.lane); h3 += shx(h3, 1, F.lane); h3 += shx(h3, 2, F.lane);
                if ((fr & 3) == 0) { const int jj = 16 * jt + 4 * kt + fq; pslc[tokl[ct] * 128 + jj] = hs; p3[tokl[ct] * 128 + jj] = h3; }
            }
            pf[0][ct] = pack_p(s[0][ct], s[1][ct]); pf[1][ct] = pack_p(s[2][ct], s[3][ct]);
        }
        { f32x4 Ldummy[2]; pv_tile<3, false>(O, Ldummy, kb + KTILE, pf, fr, fq); }
    }
    bf16_t* out = (bf16_t*)(a.ws + WS_OCMP);
#pragma unroll
    for (int ct = 0; ct < 2; ++ct) { bf16_t* op = out + (size_t)(64 * c + tokl[ct]) * D + head * 128 + 4 * fq;
#pragma unroll
        for (int dt = 0; dt < 8; ++dt) { u32x2 o; o.x = pk2(O[dt][ct][0], O[dt][ct][1]); o.y = pk2(O[dt][ct][2], O[dt][ct][3]); *(u32x2*)(op + 16 * dt) = o; } }
    LDS_WAIT(); asm volatile("" ::: "memory");
    unsigned* selm = (unsigned*)(a.ws + WS_SELM);
    {
        int li = F.lane & 15, tq = F.lane >> 4; asm volatile("" : "+v"(li), "+v"(tq));
        unsigned mw[2][4];
        if (c <= 15) {
            const unsigned all = (c == 31) ? 0xffffffffu : ((2u << c) - 1u);
#pragma unroll
            for (int b = 0; b < 2; ++b) { mw[b][0] = all; mw[b][1] = 0u; mw[b][2] = 0u; mw[b][3] = 0u; }
        } else {
            unsigned long long key[2][8];
#pragma unroll
            for (int b = 0; b < 2; ++b) { const int tok = 8 * w + 4 * b + tq;
#pragma unroll
                for (int e = 0; e < 8; ++e) { const int jj = li + 16 * e; const bool ok = (jj >= 1) && (jj <= c - 2);
                    const float sc = ok ? pslc[tok * 128 + jj] + p3[tok * 128 + jj - 1] : 0.f;
                    key[b][e] = ok ? (((unsigned long long)__float_as_uint(sc) << 32) | (unsigned)(127 - jj)) : 0ull; }
#pragma unroll
                for (int q = 0; q < 4; ++q) mw[b][q] = 0u;
                { const int f0 = 0, f1 = c - 1, f2 = c;
#pragma unroll
                  for (int q = 0; q < 4; ++q) mw[b][q] |= ((f0 >> 5) == q ? 1u << (f0 & 31) : 0u) | ((f1 >> 5) == q ? 1u << (f1 & 31) : 0u) | ((f2 >> 5) == q ? 1u << (f2 & 31) : 0u); } }
#define ROR64(v, n) ((((unsigned long long)(unsigned)__builtin_amdgcn_update_dpp(0, (int)(unsigned)((v) >> 32), 0x120 + (n), 0xf, 0xf, false)) << 32) | (unsigned)__builtin_amdgcn_update_dpp(0, (int)(unsigned)(v), 0x120 + (n), 0xf, 0xf, false))
#pragma unroll 1
            for (int round = 0; round < 13; ++round) {
#pragma unroll
                for (int b = 0; b < 2; ++b) {
                    unsigned long long best = key[b][0];
#pragma unroll
                    for (int e = 1; e < 8; ++e) best = key[b][e] > best ? key[b][e] : best;
                    { unsigned long long o; o = ROR64(best, 1); best = o > best ? o : best; o = ROR64(best, 2); best = o > best ? o : best;
                      o = ROR64(best, 4); best = o > best ? o : best; o = ROR64(best, 8); best = o > best ? o : best; }
                    if (best != 0ull) { const int jb = 127 - (int)(unsigned)best;
#pragma unroll
                        for (int q = 0; q < 4; ++q) mw[b][q] |= ((jb >> 5) == q) ? (1u << (jb & 31)) : 0u;
#pragma unroll
                        for (int e = 0; e < 8; ++e) key[b][e] = (key[b][e] == best) ? 0ull : key[b][e]; }
                }
            }
#undef ROR64
        }
        if (li == 0) {
#pragma unroll
            for (int b = 0; b < 2; ++b) { const int tok = 8 * w + 4 * b + tq; u32x4 o; o.x = mw[b][0]; o.y = mw[b][1]; o.z = mw[b][2]; o.w = mw[b][3];
                *(u32x4*)(selm + ((size_t)(64 * c + tok) * 4 + g) * 4) = o; } }
    }
}

struct ScanRegs { bf16x8 ks[2]; bf16x8 at; f32x4 dc; };
DI void dma_v8(LAS unsigned char* vb, const bf16_t* vbase, int w, int lane) {
    const int row = 8 * w + (lane >> 3), c = (lane & 7) ^ ((row >> 1) & 7);
    glds16(vbase + (size_t)row * 64 + c * 8, vb + w * 1024);
}
constexpr int SC_SROW = 272, SC_SBUF = 64 * SC_SROW, SC_Q = 0, SC_V = 4 * 16384, SC_S = SC_V + 4 * 8192;
static_assert(SC_S + 2 * SC_SBUF <= LDS_MISC, "scan LDS map");
DI void scan_issue(ScanRegs& r, LAS unsigned char* lds, const Args& a, int n, int h, int sl, int kh, int w, int lane, int fr, int fq) {
    const bf16_t* qdec = (const bf16_t*)(a.ws + WS_QDEC); const bf16_t* kst = (const bf16_t*)(a.ws + WS_KST);
    const bf16_t* vt = (const bf16_t*)(a.ws + WS_VT); const bf16_t* att = (const bf16_t*)(a.ws + WS_ATT); const float* dec = (const float*)(a.ws + WS_DEC);
    dma_k(lds + SC_Q + (n & 3) * 16384, qdec + (size_t)(64 * n) * 1024 + h * 256 + kh * 128, 1024, w, lane);
    dma_v8(lds + SC_V + (n & 3) * 8192, vt + ((size_t)n * 2048 + h * 512 + 64 * sl) * 64, w, lane);
    { const bf16_t* kp = kst + ((size_t)(n * 4 + h) * 256 + kh * 128 + 16 * w + fr) * 64 + 8 * fq;
      asm volatile("global_load_dwordx4 %0, %1, off" : "=v"(r.ks[0]) : "v"(kp) : "memory");
      asm volatile("global_load_dwordx4 %0, %1, off offset:64" : "=v"(r.ks[1]) : "v"(kp) : "memory"); }
    { const bf16_t* ap_ = att + ((size_t)(n * 4 + h) * 64 + 16 * (w & 3) + fr) * 64 + 32 * kh + 8 * fq; asm volatile("global_load_dwordx4 %0, %1, off" : "=v"(r.at) : "v"(ap_) : "memory"); }
    { const float* dp = dec + (n * 4 + h) * 256 + kh * 128 + 16 * w + 4 * fq; asm volatile("global_load_dwordx4 %0, %1, off" : "=v"(r.dc) : "v"(dp) : "memory"); }
}
DI void scan_step(const ScanRegs& cur, f32x4 (&S)[4], LAS unsigned char* lds, bf16_t* opart, int n, int h, int sl, int kh, int w, int fr, int fq) {
    const LAS unsigned char* sc = lds + SC_S + (n & 1) * SC_SBUF; const LAS unsigned char* qb = lds + SC_Q + (n & 3) * 16384; const LAS unsigned char* vb = lds + SC_V + (n & 3) * 8192;
    const int tt = w & 3, vt0 = 2 * (w >> 2), xv = (fr >> 1) & 7;
    const LAS unsigned char* vr = vb + fr * 128; const int y0 = (fq ^ xv) << 4, y1 = ((4 + fq) ^ xv) << 4;
    bf16x8 qf[4], sf[2][4];
#pragma unroll
    for (int ks = 0; ks < 4; ++ks) qf[ks] = *(const LAS bf16x8*)(qb + (16 * tt + fr) * 256 + (((4 * ks + fq) ^ fr) << 4));
#pragma unroll
    for (int z = 0; z < 2; ++z)
#pragma unroll
        for (int ks = 0; ks < 4; ++ks) sf[z][ks] = *(const LAS bf16x8*)(sc + (16 * (vt0 + z) + fr) * SC_SROW + (32 * ks + 8 * fq) * 2);
    LDS_WAIT(); __builtin_amdgcn_sched_barrier(0);
    f32x4 acc[2];
#pragma unroll
    for (int z = 0; z < 2; ++z) { acc[z] = (f32x4){0.f, 0.f, 0.f, 0.f};
#pragma unroll
        for (int ks = 0; ks < 4; ++ks) acc[z] = MFMA16(sf[z][ks], qf[ks], acc[z]); }
    bf16x8 vf[4][2];
#pragma unroll
    for (int vt = 0; vt < 4; ++vt) { vf[vt][0] = *(const LAS bf16x8*)(vr + vt * 2048 + y0); vf[vt][1] = *(const LAS bf16x8*)(vr + vt * 2048 + y1); }
    LDS_WAIT(); __builtin_amdgcn_sched_barrier(0);
    { const bf16x8 va0 = vt0 ? (kh ? vf[2][1] : vf[2][0]) : (kh ? vf[0][1] : vf[0][0]), va1 = vt0 ? (kh ? vf[3][1] : vf[3][0]) : (kh ? vf[1][1] : vf[1][0]);
      acc[0] = MFMA16(va0, cur.at, acc[0]); acc[1] = MFMA16(va1, cur.at, acc[1]); }
    LAS unsigned char* sn = lds + SC_S + ((n + 1) & 1) * SC_SBUF;
#pragma unroll
    for (int vt = 0; vt < 4; ++vt) { S[vt] = S[vt] * cur.dc; S[vt] = MFMA16(cur.ks[0], vf[vt][0], S[vt]); S[vt] = MFMA16(cur.ks[1], vf[vt][1], S[vt]); }
#pragma unroll
    for (int z = 0; z < 2; ++z) { u32x2 o; o.x = pk2(acc[z][0], acc[z][1]); o.y = pk2(acc[z][2], acc[z][3]);
        *(u32x2*)(opart + (size_t)(64 * n + 16 * tt + fr) * 2048 + h * 512 + 64 * sl + 16 * (vt0 + z) + 4 * fq) = o; }
#pragma unroll
    for (int vt = 0; vt < 4; ++vt) { u32x2 o; o.x = pk2(S[vt][0], S[vt][1]); o.y = pk2(S[vt][2], S[vt][3]); *(LAS u32x2*)(sn + (16 * vt + fr) * SC_SROW + (16 * w + 4 * fq) * 2) = o; }
}
DI void gla_scan_unit(const Frame& F, const Args& a, int h, int sl, int kh) {
    LAS unsigned char* lds = F.lds;
    const int fr = F.lane & 15, fq = F.lane >> 4, w = F.wave;
    bf16_t* opart = (bf16_t*)(a.ws + WS_OPART) + (size_t)kh * T * 2048;
    __syncthreads();
    for (int i = F.tid; i < SC_SBUF / 4; i += NTHR) ((LAS unsigned*)(lds + SC_S))[i] = 0u;
    f32x4 S[4];
#pragma unroll
    for (int vt = 0; vt < 4; ++vt) S[vt] = (f32x4){0.f, 0.f, 0.f, 0.f};
    ScanRegs r0, r1, r2, r3;
    scan_issue(r0, lds, a, 0, h, sl, kh, w, F.lane, fr, fq); scan_issue(r1, lds, a, 1, h, sl, kh, w, F.lane, fr, fq); scan_issue(r2, lds, a, 2, h, sl, kh, w, F.lane, fr, fq);
#define SC_STEP(rn, rc, n) do { if ((n) < 3) asm volatile("s_waitcnt vmcnt(14)" ::: "memory"); else asm volatile("s_waitcnt vmcnt(20)" ::: "memory"); LDS_WAIT(); RAW_BARRIER(); \
        scan_issue(rn, lds, a, ((n) + 3 < NCH) ? (n) + 3 : NCH - 1, h, sl, kh, w, F.lane, fr, fq); scan_step(rc, S, lds, opart, (n), h, sl, kh, w, fr, fq); } while (0)
    for (int n = 0; n < NCH; n += 4) { SC_STEP(r3, r0, n); SC_STEP(r0, r1, n + 1); SC_STEP(r1, r2, n + 2); SC_STEP(r2, r3, n + 3); }
#undef SC_STEP
    VM_WAIT();
}

DI void unpack8(const u32x4& w, float (&f)[8]) { f[0] = lo_bf(w.x); f[1] = hi_bf(w.x); f[2] = lo_bf(w.y); f[3] = hi_bf(w.y); f[4] = lo_bf(w.z); f[5] = hi_bf(w.z); f[6] = lo_bf(w.w); f[7] = hi_bf(w.w); }
DI void p_combine(const Frame& F, const Args& a, int layer) {
    const bf16_t* cols = (const bf16_t*)(a.ws + WS_COLS);
    const bf16_t* ocmp = (const bf16_t*)(a.ws + WS_OCMP); const bf16_t* osel = (const bf16_t*)(a.ws + WS_OSEL); const bf16_t* owin = (const bf16_t*)(a.ws + WS_OWIN);
    const bf16_t* op0 = (const bf16_t*)(a.ws + WS_OPART); const bf16_t* op1 = op0 + (size_t)T * 2048;
    bf16_t* A1 = (bf16_t*)(a.ws + WS_A1); bf16_t* A2 = (bf16_t*)(a.ws + WS_A2);
    const int c8 = 8 * F.lane;
    f32x4 nw[2]; nw[0] = *(const f32x4*)(a.gla_norm_w + layer * 512 + c8); nw[1] = *(const f32x4*)(a.gla_norm_w + layer * 512 + c8 + 4);
    for (int row = F.gw; row < T; row += F.NGW) {
        const bf16_t* cr = cols + (size_t)row * NP; const size_t ro = (size_t)row * D;
#pragma unroll
        for (int j = 0; j < 4; ++j) { const int c0 = 512 * j + c8, head = 4 * j + (F.lane >> 4);
            const float g0 = sigmoidf_(bf2f(cr[C_GBR + head * 3 + 0])), g1 = sigmoidf_(bf2f(cr[C_GBR + head * 3 + 1])), g2 = sigmoidf_(bf2f(cr[C_GBR + head * 3 + 2]));
            float oc[8], os[8], ow[8], za[8], p0[8], p1[8], zb[8];
            unpack8(*(const u32x4*)(ocmp + ro + c0), oc); unpack8(*(const u32x4*)(osel + ro + c0), os); unpack8(*(const u32x4*)(owin + ro + c0), ow); unpack8(*(const u32x4*)(cr + C_ZA + c0), za);
            unpack8(*(const u32x4*)(op0 + ro + c0), p0); unpack8(*(const u32x4*)(op1 + ro + c0), p1); unpack8(*(const u32x4*)(cr + C_ZB + c0), zb);
            float r[8], o[8], ss = 0.f;
#pragma unroll
            for (int e = 0; e < 8; ++e) { r[e] = (g0 * oc[e] + g1 * os[e] + g2 * ow[e]) * siluf_(za[e]); o[e] = p0[e] + p1[e]; ss += o[e] * o[e]; }
            { u32x4 q; q.x = pk2(r[0], r[1]); q.y = pk2(r[2], r[3]); q.z = pk2(r[4], r[5]); q.w = pk2(r[6], r[7]); *(u32x4*)(A1 + ro + c0) = q; }
            const float rs = rsqrtf(wave_sum(ss, F.lane) * (1.f / 512.f) + NORM_EPS);
            float y[8];
#pragma unroll
            for (int e = 0; e < 8; ++e) y[e] = o[e] * rs * nw[e >> 2][e & 3] * siluf_(zb[e]);
            { u32x4 q; q.x = pk2(y[0], y[1]); q.y = pk2(y[2], y[3]); q.z = pk2(y[4], y[5]); q.w = pk2(y[6], y[7]); *(u32x4*)(A2 + ro + c0) = q; } }
    }
}

constexpr int PH_PER_LAYER = 10, N_PHASES = 2 + DEPTH * PH_PER_LAYER;
constexpr int WQ_WORD0 = 16384;
DI int wq_pull(unsigned* cnt, volatile LAS unsigned* slot, int tid) {
    __syncthreads();
    if (tid == 0) *slot = __hip_atomic_fetch_add(cnt, 1u, __ATOMIC_RELAXED, __HIP_MEMORY_SCOPE_AGENT);
    __syncthreads();
    return (int)*slot;
}
__global__ void __launch_bounds__(NTHR, 2) mk_fwd(Args a_in, int li) {
    KArgsP ap = (KArgsP)__builtin_amdgcn_kernarg_segment_ptr();
    const int ph_lo = a_in.ph_lo, ph_hi = a_in.ph_hi;
    extern __shared__ __attribute__((aligned(16))) unsigned char lds_raw[];
    Frame F;
    F.lds = (LAS unsigned char*)lds_raw;
    F.tid = threadIdx.x; F.lane = F.tid & 63; F.wave = __builtin_amdgcn_readfirstlane(F.tid >> 6);
    const int wave_s = F.wave;
    F.G = gridDim.x; F.bid = blockIdx.x; F.gw = F.bid * NWAVES + F.wave; F.NGW = F.G * NWAVES;
    volatile LAS unsigned* misc = (volatile LAS unsigned*)(F.lds + LDS_MISC);
    if (F.tid < 64) misc[F.tid] = 0u;
    __syncthreads();
    unsigned* ctl = (unsigned*)(a_in.ws + WS_CTL);
    XcdBarrier bar = xcd_barrier_post(ctl + (size_t)li * XCD_BAR_WORDS, misc);
#ifndef PHASE_SET
#define PHASE_SET 0xFFFF
#endif
#define HAS(k) ((PHASE_SET >> (k)) & 1)
#ifndef REPEAT_PHASE
#define REPEAT_PHASE -1
#endif
#define REP(k) for (int _r = 0; _r < ((REPEAT_PHASE == (k)) ? 2 : 1); ++_r)
#define IN(k) (ph_lo <= (k) && (k) < ph_hi)
#define SEAM(k) do { if (IN(k) && IN((k) + 1)) xcd_barrier(bar); } while (0)
#define FRESH() do { int _l = __builtin_amdgcn_mbcnt_hi(~0u, __builtin_amdgcn_mbcnt_lo(~0u, 0u)); asm volatile("" : "+v"(_l)); int _w = wave_s; asm volatile("" : "+s"(_w)); F.lane = _l; F.wave = _w; F.tid = _w * 64 + _l; F.gw = F.bid * NWAVES + F.wave; { KArgsP _k = (KArgsP)__builtin_amdgcn_kernarg_segment_ptr(); asm volatile("" : "+s"(_k)); ap = _k; } } while (0)
    if (HAS(12) && IN(0)) { FRESH(); const Args a = load_args(ap); REP(12) { p_prologue(F, a); } SEAM(0); }
#define PHASE_ENTER() FRESH(); const Args a = load_args(ap); unsigned char* ws = a.ws; bf16_t* cols = (bf16_t*)(ws + WS_COLS); (void)cols
#define UNIT_FRAME(Fu) Frame Fu = F; { int _l = F.lane; asm volatile("" : "+v"(_l)); Fu.lane = _l; Fu.tid = F.wave * 64 + _l; }
    for (int L = 0; L < DEPTH; ++L) {
        const int pb = 1 + PH_PER_LAYER * L;
        if (HAS(0) && IN(pb + 0)) { PHASE_ENTER(); const float* xin = L == 0 ? a.x : (const float*)(ws + WS_X);
            p_rmsnorm<false>(F, xin, a.norm_w + L * D, ws + WS_H); SEAM(pb + 0); }
        if (HAS(1) && IN(pb + 1)) { PHASE_ENTER();
            pg8::Gemm g{(const bf16_t*)(ws + WS_H), (const bf16_t*)(ws + WS_WIN) + (size_t)L * NP * D, D, D, D};
            pg8::OrderIn S; S.mn.init(T, NP, F.G, F.bid); S.sig = (unsigned*)(ws + WS_CTL) + WQ_WORD0 + 40960 + 64 * L; pg8::EpiCols E{cols, NP};
            pg8::gemm_phase<pg8::EpiCols, pg8::OrderIn, false, true, true>(F.lds, g, S, E, F.tid); }
        if (HAS(2) && IN(pb + 2)) { PHASE_ENTER();
            unsigned* cnt = (unsigned*)(ws + WS_CTL) + WQ_WORD0 + 8192 + 64 * L;
            { unsigned* sig = (unsigned*)(ws + WS_CTL) + WQ_WORD0 + 40960 + 64 * L;
              if (F.tid == 0) { XB_SPIN(xb_ld(sig) < pg8::IN_EARLY_TILES, bar.bar); __builtin_amdgcn_fence(__ATOMIC_ACQUIRE, "agent"); asm volatile("s_waitcnt vmcnt(0)" ::: "memory"); }
              __syncthreads(); }
            for (;;) { const int u = wq_pull(cnt, misc + 16, F.tid); if (u >= 128 + 512 + 256) break;
                UNIT_FRAME(Fu);
                if (u < 128) { pg8::Gemm g{cols, (const bf16_t*)(ws + WS_W1T) + (size_t)L * 2 * 256 * 4096, 16 * NP, 4096, 512};
                    pg8::OrderCmp S; S.init(1 << 20, u); pg8::EpiPart E{(float*)(ws + WS_CPART)};
                    __syncthreads();
                    pg8::gemm_phase<pg8::EpiPart, pg8::OrderCmp, true, false, true>(Fu.lds, g, S, E, Fu.tid); }
                else if (u < 640) { const int v = u - 128; gla_g1_unit(Fu, a, L, v >> 2, v & 3); }
                else transpose_unit(Fu, a, u - 640); }
            SEAM(pb + 2); }
        if (HAS(3) && IN(pb + 3)) { PHASE_ENTER(); for (int u = F.bid; u < 256; u += F.G) mlp2_unit(F, a, L, u >> 5, u & 31); SEAM(pb + 3); }
        if (HAS(4) && IN(pb + 4)) { PHASE_ENTER();
            REP(4) { unsigned* cnt = (unsigned*)(ws + WS_CTL) + WQ_WORD0 + 64 * (2 * L + 16 * _r);
            for (;;) { const int u = wq_pull(cnt, misc + 16, F.tid); if (u >= 512 + 512) break;
                UNIT_FRAME(Fu);
                if (u < 512) ca_chunk(Fu, a, 127 - (u >> 2), u & 3);
                else { const int v = u - 512; fa_chunk<1>(Fu, a, 127 - (v >> 2), v & 3); } } }
            SEAM(pb + 4); }
        if (HAS(5) && IN(pb + 5)) { PHASE_ENTER();
            REP(5) { unsigned* cnt = (unsigned*)(ws + WS_CTL) + WQ_WORD0 + 64 * (2 * L + 1 + 16 * _r);
            unsigned* grp = (unsigned*)(ws + WS_CTL) + WQ_WORD0 + 4096 + 64 * (8 * L + 32 * _r);
            unsigned* claimed = (unsigned*)(ws + WS_CTL) + WQ_WORD0 + 32768 + 64 * (L + 4 * _r);
            { const unsigned x = xb_xcc_id() & 7u;
              __syncthreads();
              if (F.tid == 0) { unsigned r = __hip_atomic_fetch_add(grp + 64 * x, 1u, __ATOMIC_RELAXED, __HIP_MEMORY_SCOPE_AGENT); unsigned got = 0xffffffffu;
                  if (r < 8u && __hip_atomic_exchange(claimed + 8 * x + r, 1u, __ATOMIC_RELAXED, __HIP_MEMORY_SCOPE_AGENT) == 0u) got = 8u * x + r;
                  misc[16] = got; }
              __syncthreads();
              const unsigned su = misc[16];
              if (su != 0xffffffffu) { UNIT_FRAME(Fu); gla_scan_unit(Fu, a, (int)(su >> 4), (int)(su & 7u), (int)((su >> 3) & 1u)); } }
            for (;;) { const int u = wq_pull(cnt, misc + 16, F.tid); if (u >= 64) break;
                UNIT_FRAME(Fu);
                __syncthreads(); if (F.tid == 0) misc[17] = __hip_atomic_exchange(claimed + u, 1u, __ATOMIC_RELAXED, __HIP_MEMORY_SCOPE_AGENT); __syncthreads();
                if (misc[17] == 0u) gla_scan_unit(Fu, a, u >> 4, u & 7, (u >> 3) & 1); }
            { const int g0 = (int)(xb_xcc_id() & 3u);
              for (int gi = 0; gi < 4; ++gi) { const int gq = (g0 + gi) & 3; unsigned* qcnt = (unsigned*)(ws + WS_CTL) + WQ_WORD0 + 12288 + 64 * (4 * L + gq + 32 * _r);
                  for (;;) { const int u = wq_pull(qcnt, misc + 16, F.tid); if (u >= 128) break;
                      UNIT_FRAME(Fu);
                      fa_chunk<0>(Fu, a, 127 - u, gq); } } } }
            SEAM(pb + 5); }
        if (HAS(6) && IN(pb + 6)) { PHASE_ENTER(); p_combine(F, a, L); SEAM(pb + 6); }
        if (HAS(7) && IN(pb + 7)) { PHASE_ENTER();
            pg8::Gemm g{(const bf16_t*)(ws + WS_A1), (const bf16_t*)(ws + WS_WPA) + (size_t)L * D * D, D, D, D};
            pg8::OrderAB S; S.mn.init(T, D, F.G, F.bid); S.A2 = (const bf16_t*)(ws + WS_A2); S.B2 = (const bf16_t*)(ws + WS_WPB) + (size_t)L * D * D;
            pg8::EpiGateAB E{(bf16_t*)(ws + WS_Y), (bf16_t*)(ws + WS_TMP), cols + C_GA, cols + C_GB};
            pg8::gemm_phase<pg8::EpiGateAB, pg8::OrderAB, false, true, true>(F.lds, g, S, E, F.tid);
            SEAM(pb + 7); }
        if (HAS(8) && IN(pb + 8)) { PHASE_ENTER(); }
        if (HAS(9) && IN(pb + 9)) { PHASE_ENTER(); const float* xin = L == 0 ? a.x : (const float*)(ws + WS_X);
            pg8::Gemm g{(const bf16_t*)(ws + WS_Y), (const bf16_t*)(ws + WS_WOUT) + (size_t)L * D * D, D, D, D};
            pg8::OrderMN S; S.init(T, D, F.G, F.bid); pg8::EpiResid E{xin, (float*)(ws + WS_X)};
            pg8::gemm_phase<pg8::EpiResid, pg8::OrderMN, false, false, true>(F.lds, g, S, E, F.tid);
            SEAM(pb + 9); }
    }
    if (HAS(13) && IN(N_PHASES - 1)) { FRESH(); const Args a = load_args(ap); p_rmsnorm<true>(F, (const float*)(a.ws + WS_X), a.final_w, a.out); }
#undef IN
#undef SEAM
}

extern "C" void kernel_launch(void* const* d_in, const int* in_sizes, int n_in, void* d_out, int out_size, void* d_ws, size_t ws_size, hipStream_t stream) {
    static int grid = 0;
    if (grid == 0) {
        if (n_in != 15 || ws_size < WS_END) { fprintf(stderr, "kernel_launch: unexpected inputs (n_in %d, ws %zu, need %zu)\n", n_in, ws_size, (size_t)WS_END); grid = -1; return; }
        int dev = 0, cus = 0;
        if (hipGetDevice(&dev) != hipSuccess || hipDeviceGetAttribute(&cus, hipDeviceAttributeMultiprocessorCount, dev) != hipSuccess) { grid = -1; return; }
        if (hipFuncSetAttribute((const void*)mk_fwd, hipFuncAttributeMaxDynamicSharedMemorySize, LDS_BYTES) != hipSuccess) { fprintf(stderr, "kernel_launch: hipFuncSetAttribute failed\n"); grid = -1; return; }
        int per_cu = 0;
        if (hipOccupancyMaxActiveBlocksPerMultiprocessor(&per_cu, (const void*)mk_fwd, NTHR, LDS_BYTES) != hipSuccess || per_cu < 1) fprintf(stderr, "kernel_launch: occupancy query reports %d\n", per_cu);
        (void)hipGetLastError();
        grid = cus;
    }
    if (grid < 0) return;
    (void)hipMemsetAsync((char*)d_ws + WS_CTL, 0, CTL_BYTES, stream);
    Args a{};
    a.x = (const float*)d_in[0]; a.norm_w = (const float*)d_in[1]; a.w_in = (const float*)d_in[2]; a.cmp_pe = (const float*)d_in[3]; a.cmp_w1 = (const float*)d_in[4];
    a.cmp_b1 = (const float*)d_in[5]; a.cmp_w2 = (const float*)d_in[6]; a.cmp_b2 = (const float*)d_in[7]; a.alpha_w = (const float*)d_in[8]; a.alpha_b = (const float*)d_in[9];
    a.gla_norm_w = (const float*)d_in[10]; a.p_a = (const float*)d_in[11]; a.p_b = (const float*)d_in[12]; a.w_out = (const float*)d_in[13]; a.final_w = (const float*)d_in[14];
    a.out = (float*)d_out; a.ws = (unsigned char*)d_ws;
#if MK_PER_PHASE
    for (int k = 0; k < N_PHASES; ++k) { a.ph_lo = k; a.ph_hi = k + 1; hipLaunchKernelGGL(mk_fwd, dim3(grid), dim3(NTHR), LDS_BYTES, stream, a, k); }
#else
    a.ph_lo = 0; a.ph_hi = N_PHASES; hipLaunchKernelGGL(mk_fwd, dim3(grid), dim3(NTHR), LDS_BYTES, stream, a, 0);
#endif
}
```

```cpp
#include <hip/hip_runtime.h>
#include <cstdio>
#include <cstdint>

#ifndef MK_PER_PHASE
#define MK_PER_PHASE 0
#endif

#define LAS __attribute__((address_space(3)))
#define GAS __attribute__((address_space(1)))
typedef unsigned short bf16_t;
typedef short bf16x8 __attribute__((ext_vector_type(8)));
typedef short s16x4 __attribute__((ext_vector_type(4)));
typedef float f32x4 __attribute__((ext_vector_type(4)));
typedef float f32x2 __attribute__((ext_vector_type(2)));
typedef unsigned u32x4 __attribute__((ext_vector_type(4)));
typedef unsigned u32x2 __attribute__((ext_vector_type(2)));
#define DI __device__ __forceinline__
#define MFMA16(a, b, c) __builtin_amdgcn_mfma_f32_16x16x32_bf16((a), (b), (c), 0, 0, 0)

constexpr int T = 8192, D = 2048, DEPTH = 4, NIN = 17472, NP = 17664;
constexpr int NCH = 128;
constexpr int C_QA = 0, C_KCMP = 2048, C_VCMP = 2560, C_KSEL = 3072, C_VSEL = 3584, C_KWIN = 4096, C_VWIN = 4608, C_ZA = 5120,
              C_QB = 7168, C_KB = 8192, C_VB = 9216, C_ZB = 11264, C_GA = 13312, C_GB = 15360, C_GBR = 17408, C_ALR = 17456;
constexpr float NORM_EPS = 1e-6f;
constexpr float ATT_C = 0.08838834764831845f * 1.4426950408889634f;

DI int map_col(int n) {
    if (n < 5120) return n;
    if (n < 5168) return C_GBR + (n - 5120);
    if (n < 11312) return n - 48;
    if (n < 11328) return C_ALR + (n - 11312);
    return n - 64;
}

constexpr size_t MiB = 1u << 20;
constexpr size_t al(size_t x) { return (x + MiB - 1) / MiB * MiB; }
constexpr size_t WS_CTL = 0, CTL_BYTES = MiB;
constexpr size_t WS_WIN = WS_CTL + CTL_BYTES;
constexpr size_t WS_WPA = WS_WIN + al((size_t)DEPTH * NP * D * 2);
constexpr size_t WS_WPB = WS_WPA + al((size_t)DEPTH * D * D * 2);
constexpr size_t WS_WOUT = WS_WPB + al((size_t)DEPTH * D * D * 2);
constexpr size_t WS_W1T = WS_WOUT + al((size_t)DEPTH * D * D * 2);
constexpr size_t WS_W2T = WS_W1T + al((size_t)DEPTH * 2 * 256 * 4096 * 2);
constexpr size_t WS_B1P = WS_W2T + al((size_t)DEPTH * 2 * 128 * 256 * 2);
constexpr size_t WS_X = WS_B1P + MiB;
constexpr size_t WS_H = WS_X + al((size_t)T * D * 4);
constexpr size_t WS_COLS = WS_H + al((size_t)T * D * 2);
constexpr size_t WS_CPART = WS_COLS + al((size_t)(T + 64) * NP * 2);
constexpr size_t WS_KC = WS_CPART + al((size_t)8 * 8 * 512 * 256 * 4);
constexpr size_t WS_VCT = WS_KC + MiB;
constexpr size_t WS_SELM = WS_VCT + MiB;
constexpr size_t WS_OCMP = WS_SELM + MiB;
constexpr size_t WS_OSEL = WS_OCMP + al((size_t)T * D * 2);
constexpr size_t WS_OWIN = WS_OSEL + al((size_t)T * D * 2);
constexpr size_t WS_VSELT = WS_OWIN + al((size_t)T * D * 2);
constexpr size_t WS_VWINT = WS_VSELT + al((size_t)4 * 128 * 128 * 64 * 2);
constexpr size_t WS_QDEC = WS_VWINT + al((size_t)4 * 128 * 128 * 64 * 2);
constexpr size_t WS_KST = WS_QDEC + al((size_t)T * 1024 * 2);
constexpr size_t WS_VT = WS_KST + al((size_t)T * 1024 * 2);
constexpr size_t WS_ATT = WS_VT + al((size_t)T * 2048 * 2);
constexpr size_t WS_DEC = WS_ATT + al((size_t)128 * 4 * 64 * 64 * 2);
constexpr size_t WS_OPART = WS_DEC + MiB;
constexpr size_t WS_A1 = WS_OPART + al((size_t)2 * T * 2048 * 4);
constexpr size_t WS_A2 = WS_A1 + al((size_t)T * D * 2);
constexpr size_t WS_TMP = WS_A2 + al((size_t)T * D * 2);
constexpr size_t WS_Y = WS_TMP + al((size_t)T * D * 4);
constexpr size_t WS_END = WS_Y + al((size_t)T * D * 2);

constexpr int LDS_MAIN = 131072;
constexpr int LDS_BYTES = 147456;
constexpr int LDS_MISC = LDS_BYTES - 256;
constexpr int NWAVES = 8, NTHR = 512;

DI float bf2f(unsigned short b) { return __uint_as_float(((unsigned)b) << 16); }
DI unsigned f2bf(float f) { unsigned u = __float_as_uint(f); return (u + 0x7fffu + ((u >> 16) & 1u)) >> 16; }
DI unsigned pk2_sw(float lo, float hi) { return f2bf(lo) | (f2bf(hi) << 16); }
typedef __bf16 bf16x2_t __attribute__((ext_vector_type(2)));
DI unsigned cvt_pk_bf16(float lo, float hi) { const f32x2 v = {lo, hi}; const bf16x2_t b = __builtin_convertvector(v, bf16x2_t); return __builtin_bit_cast(unsigned, b); }
DI unsigned pk2(float lo, float hi) { return cvt_pk_bf16(lo, hi); }
DI float lo_bf(unsigned w) { return __uint_as_float(w << 16); }
DI float hi_bf(unsigned w) { return __uint_as_float(w & 0xffff0000u); }
DI void unpack8(const u32x4& w, float (&f)[8]) { f[0] = lo_bf(w.x); f[1] = hi_bf(w.x); f[2] = lo_bf(w.y); f[3] = hi_bf(w.y); f[4] = lo_bf(w.z); f[5] = hi_bf(w.z); f[6] = lo_bf(w.w); f[7] = hi_bf(w.w); }
typedef _Float16 f16x2_t __attribute__((ext_vector_type(2)));
DI unsigned pk2h(float lo, float hi) { const f32x2 v = {lo, hi}; const f16x2_t h = __builtin_convertvector(v, f16x2_t); return __builtin_bit_cast(unsigned, h); }
DI float lo_h(unsigned w) { const f16x2_t h = __builtin_bit_cast(f16x2_t, w); return (float)h[0]; }
DI float hi_h(unsigned w) { const f16x2_t h = __builtin_bit_cast(f16x2_t, w); return (float)h[1]; }
DI void unpack8h(const u32x4& w, float (&f)[8]) { f[0] = lo_h(w.x); f[1] = hi_h(w.x); f[2] = lo_h(w.y); f[3] = hi_h(w.y); f[4] = lo_h(w.z); f[5] = hi_h(w.z); f[6] = lo_h(w.w); f[7] = hi_h(w.w); }
DI float sigmoidf_(float x) { return 1.f / (1.f + __expf(-x)); }
DI float siluf_(float x) { return x / (1.f + __expf(-x)); }
DI float shx(float v, int off, int lane) { return __int_as_float(__builtin_amdgcn_ds_bpermute((lane ^ off) << 2, __float_as_int(v))); }
DI int shxi(int v, int off, int lane) { return __builtin_amdgcn_ds_bpermute((lane ^ off) << 2, v); }
DI float wave_sum(float v, int lane) {
#pragma unroll
    for (int o = 1; o < 64; o <<= 1) v += shx(v, o, lane);
    return v;
}
#define LDS_WAIT() asm volatile("s_waitcnt lgkmcnt(0)" ::: "memory")
#define VM_WAIT() asm volatile("s_waitcnt vmcnt(0)" ::: "memory")

namespace pg8 {
constexpr int BM = 256, BK = 64, HALF = 128, HTB = HALF * BK * 2, STAGE_BYTES = 8 * HTB, NXCD = 8, WGM = 8;
__host__ __device__ __forceinline__ int lds_byte(int r, int c) { const int st = (r >> 4) * 2 + (c >> 5), rr = r & 15, cc = c & 31, ob = rr * 64 + cc * 2; return st * 1024 + (ob ^ (((ob >> 9) & 1) << 5)); }
__host__ __device__ __forceinline__ void stage_rc(int b, int& R, int& C) { const int st = b / 1024, sb = b % 1024, swz = sb ^ (((sb >> 9) & 1) << 5); R = (st >> 1) * 16 + swz / 64; C = (st & 1) * 32 + (swz % 64) / 2; }
__host__ __device__ __forceinline__ int perm32(int rho) { const int n = rho >> 4, i = rho & 15; return 8 * (i >> 2) + 4 * n + (i & 3); }

struct Unit { int pm, pn, pk, pz; };
struct Gemm { const bf16_t* A; const bf16_t* Bt; int lda, ldb, K; };

struct OrderMN {
    static constexpr bool SIGNAL = false;
    int nM, nN, nwg, G, c, rep;
    DI void init(int M, int N, int G_, int c_, int rep_ = 1) { nM = M / BM; nN = N / BM; nwg = nM * nN; G = G_; c = c_; rep = rep_; }
    DI bool next(int i, Unit& u) const {
        long L = (long)i * G + c; if (L >= (long)nwg * rep) return false;
        if (L >= nwg) L -= nwg;
        int wgid = (int)L; { const int q = nwg / NXCD, r = nwg % NXCD, xcd = wgid % NXCD, off = wgid / NXCD; wgid = (xcd < r ? xcd * (q + 1) : r * (q + 1) + (xcd - r) * q) + off; }
        const int nig = WGM * nN, gid = wgid / nig, fm = gid * WGM, gsz = (nM - fm) < WGM ? (nM - fm) : WGM;
        u.pm = fm + ((wgid % nig) % gsz); u.pn = (wgid % nig) / gsz; u.pk = 0; u.pz = 0; return true;
    }
    DI const char* a_ptr(const Gemm& g, const Unit& u) const { return (const char*)g.A + (size_t)u.pm * BM * g.lda * 2; }
    DI const char* b_ptr(const Gemm& g, const Unit& u) const { return (const char*)g.Bt + (size_t)u.pn * BM * g.ldb * 2; }
};
DI int in_col_tile(int p, int& early) {
    int i;
    if (p < 13) { early = 1; i = p; } else if (p < 35) { early = 0; i = p - 13; } else if (p < 47) { early = 1; i = p - 22; } else { early = 0; i = p - 25; }
    if (early) return i < 4 ? 8 + i : i < 6 ? 10 + i : i < 8 ? 12 + i : i < 24 ? 20 + i : 68;
    return i < 8 ? i : i < 10 ? 4 + i : i < 12 ? 6 + i : i < 20 ? 8 + i : 24 + i;
}
constexpr unsigned IN_EARLY_TILES = 25 * (T / 256);
struct OrderIn {
    static constexpr bool SIGNAL = true;
    OrderMN mn; unsigned* sig;
    DI bool next(int i, Unit& u) const { if (!mn.next(i, u)) return false; int e; u.pn = in_col_tile(u.pn, e); u.pz = e; return true; }
    DI const char* a_ptr(const Gemm& g, const Unit& u) const { return mn.a_ptr(g, u); }
    DI const char* b_ptr(const Gemm& g, const Unit& u) const { return mn.b_ptr(g, u); }
};
struct OrderCmp {
    static constexpr bool SIGNAL = false;
    int G, c;
    DI void init(int G_, int c_) { G = G_; c = c_; }
    DI bool next(int i, Unit& u) const { const int L = i * G + c; if (L >= 128) return false; u.pk = L & 7; u.pm = (L >> 3) & 1; u.pz = L >> 4; u.pn = 0; return true; }
    DI const char* a_ptr(const Gemm& g, const Unit& u) const { const int kv = u.pz >> 2, gg = u.pz & 3;
        return (const char*)g.A + ((size_t)(u.pm * BM * 16 + u.pk * 4) * NP + (kv ? C_VCMP : C_KCMP) + gg * 128) * 2; }
    DI const char* b_ptr(const Gemm& g, const Unit& u) const { const int kv = u.pz >> 2; return (const char*)g.Bt + ((size_t)kv * 256 * 4096 + u.pk * 512) * 2; }
};

template <class Epi, class Sched, bool IM2COL = false, bool ALIGN_EPI = false, bool SP2 = false>
DI void gemm_phase(LAS unsigned char* lds, const Gemm g, const Sched& S, const Epi& E, const int tid) {
    const int wid = __builtin_amdgcn_readfirstlane(tid >> 6), lane = tid & 63, wr = wid >> 2, wc = wid & 3, fr = lane & 15, fq = lane >> 4;
    const int nt = g.K / BK;
    unsigned voffA[2], voffB[2];
#pragma unroll
    for (int i = 0; i < 2; ++i) { int R, C; stage_rc(tid * 16 + i * 8192, R, C); const int Rb = Epi::PERM ? ((R & ~31) + perm32(R & 31)) : R;
        voffA[i] = (unsigned)(R * g.lda + C) * 2u; voffB[i] = (unsigned)(Rb * g.ldb + C) * 2u; }
    const size_t hstepA = (size_t)HALF * g.lda * 2, hstepB = (size_t)HALF * g.ldb * 2;
    const unsigned ldsw = (unsigned)wid * 1024u;
    const int aoff = lds_byte(wr * 64 + fr, fq * 8), boff = lds_byte(wc * 32 + fr, fq * 8);
#define PG8_KA(kt) (IM2COL ? ((size_t)((kt) >> 1) * (NP * 2) + (size_t)((kt) & 1) * 128) : (size_t)(kt) * 128)
#define PG8_KB(kt) ((size_t)(kt) * 128)
#define PG8_SA(b, h) (((b) * 2 + (h)) * HTB)
#define PG8_SB(b, h) ((4 + (b) * 2 + (h)) * HTB)
#define PG8_STAGE(bufoff, gbase, voff) do { _Pragma("unroll") for (int _i = 0; _i < 2; ++_i) \
        __builtin_amdgcn_global_load_lds((const unsigned*)((const char*)(gbase) + (voff)[_i]), (LAS unsigned*)(lds + (bufoff) + ldsw + _i * 8192), 16, 0, 0); } while (0)
#define PG8_LDA(dst, b, h) do { _Pragma("unroll") for (int m = 0; m < 4; ++m) _Pragma("unroll") for (int k = 0; k < 2; ++k) dst[m][k] = *(const LAS bf16x8*)(lds + PG8_SA(b, h) + aoff + m * 2048 + k * 1024); } while (0)
#define PG8_LDB(dst, b, h) do { _Pragma("unroll") for (int n = 0; n < 2; ++n) _Pragma("unroll") for (int k = 0; k < 2; ++k) dst[n][k] = *(const LAS bf16x8*)(lds + PG8_SB(b, h) + boff + n * 2048 + k * 1024); } while (0)
#define PG8_MMA(ai, bj, At, Bt) do { __builtin_amdgcn_s_setprio(1); _Pragma("unroll") for (int m = 0; m < 4; ++m) _Pragma("unroll") for (int n = 0; n < 2; ++n) _Pragma("unroll") for (int k = 0; k < 2; ++k) \
        acc[ai][bj][m][n] = __builtin_amdgcn_mfma_f32_16x16x32_bf16(Bt[n][k], At[m][k], acc[ai][bj][m][n], 0, 0, 0); __builtin_amdgcn_s_setprio(0); } while (0)
#define PG8_WAIT_V(n) asm volatile("s_waitcnt vmcnt(" #n ")" ::: "memory")
#define PG8_WAIT_L(n) asm volatile("s_waitcnt lgkmcnt(" #n ")" ::: "memory")
#define PG8_BAR __builtin_amdgcn_s_barrier()
#define PG8_SCHED __builtin_amdgcn_sched_barrier(0)
    Unit cur, nxt; int ui = 0; int nsig = 0; (void)nsig;
    if (!S.next(0, cur)) return;
    f32x4 acc[2][2][4][2];
#pragma unroll
    for (int a = 0; a < 2; ++a)
#pragma unroll
        for (int b = 0; b < 2; ++b)
#pragma unroll
            for (int m = 0; m < 4; ++m)
#pragma unroll
                for (int n = 0; n < 2; ++n) acc[a][b][m][n] = (f32x4){0.f, 0.f, 0.f, 0.f};
    bf16x8 At[4][2], B0[2][2], B1[2][2];
    const char* cA = S.a_ptr(g, cur); const char* cB = S.b_ptr(g, cur);
    if constexpr (SP2) {
        PG8_STAGE(PG8_SB(0, 0), cB, voffB); PG8_STAGE(PG8_SB(0, 1), cB + hstepB, voffB); PG8_STAGE(PG8_SA(0, 0), cA, voffA); PG8_STAGE(PG8_SA(0, 1), cA + hstepA, voffA);
        if (wr == 1) PG8_BAR;
        PG8_WAIT_V(2); PG8_BAR;
        PG8_STAGE(PG8_SB(1, 0), cB + PG8_KB(1), voffB); PG8_STAGE(PG8_SA(1, 0), cA + PG8_KA(1), voffA); PG8_STAGE(PG8_SB(1, 1), cB + hstepB + PG8_KB(1), voffB);
        PG8_WAIT_V(6); PG8_BAR;
    } else {
    PG8_STAGE(PG8_SB(0, 0), cB, voffB); PG8_STAGE(PG8_SA(0, 0), cA, voffA); PG8_STAGE(PG8_SB(0, 1), cB + hstepB, voffB); PG8_STAGE(PG8_SA(0, 1), cA + hstepA, voffA);
    if (wr == 1) PG8_BAR;
    PG8_WAIT_V(4); PG8_BAR;
    PG8_STAGE(PG8_SB(1, 0), cB + PG8_KB(1), voffB); PG8_STAGE(PG8_SA(1, 0), cA + PG8_KA(1), voffA); PG8_STAGE(PG8_SB(1, 1), cB + hstepB + PG8_KB(1), voffB);
    PG8_WAIT_V(6); PG8_BAR;
    }
    for (;;) {
        const bool has_next = S.next(ui + 1, nxt);
        const char* nA = has_next ? S.a_ptr(g, nxt) : cA; const char* nB = has_next ? S.b_ptr(g, nxt) : cB;
        for (int t = 0; t < nt; t += 2) {
            const bool last = (t == nt - 2);
            const char* a1 = cA + PG8_KA(t + 1);
            const char* a2 = last ? nA : cA + PG8_KA(t + 2); const char* b2 = last ? nB : cB + PG8_KB(t + 2);
            const char* a3 = last ? nA + PG8_KA(1) : cA + PG8_KA(t + 3); const char* b3 = b2 + 128;
            if constexpr (SP2) {
            PG8_LDB(B0, 0, 0); PG8_LDB(B1, 0, 1); PG8_SCHED; PG8_LDA(At, 0, 0); PG8_STAGE(PG8_SA(1, 1), a1 + hstepA, voffA);
            PG8_WAIT_V(8); PG8_WAIT_L(0); PG8_BAR; PG8_MMA(0, 0, At, B0); PG8_MMA(0, 1, At, B1); PG8_BAR; PG8_SCHED;
            PG8_LDA(At, 0, 1); PG8_STAGE(PG8_SB(0, 0), b2, voffB); PG8_STAGE(PG8_SB(0, 1), b2 + hstepB, voffB); PG8_STAGE(PG8_SA(0, 0), a2, voffA);
            PG8_WAIT_V(8); PG8_WAIT_L(0); PG8_BAR; PG8_MMA(1, 0, At, B0); PG8_MMA(1, 1, At, B1); PG8_BAR; PG8_SCHED;
            PG8_LDB(B0, 1, 0); PG8_LDB(B1, 1, 1); PG8_SCHED; PG8_LDA(At, 1, 0); PG8_STAGE(PG8_SA(0, 1), a2 + hstepA, voffA);
            PG8_WAIT_V(8); PG8_WAIT_L(0); PG8_BAR; PG8_MMA(0, 0, At, B0); PG8_MMA(0, 1, At, B1); PG8_BAR; PG8_SCHED;
            PG8_LDA(At, 1, 1); PG8_STAGE(PG8_SB(1, 0), b3, voffB); PG8_STAGE(PG8_SB(1, 1), b3 + hstepB, voffB); PG8_STAGE(PG8_SA(1, 0), a3, voffA);
            PG8_WAIT_V(8); PG8_WAIT_L(0); PG8_BAR; PG8_MMA(1, 0, At, B0); PG8_MMA(1, 1, At, B1); PG8_BAR; PG8_SCHED;
            } else {
            PG8_LDB(B0, 0, 0); PG8_SCHED; PG8_LDA(At, 0, 0); PG8_STAGE(PG8_SA(1, 1), a1 + hstepA, voffA);
            PG8_WAIT_L(8); PG8_BAR; PG8_WAIT_L(0); PG8_MMA(0, 0, At, B0); PG8_BAR; PG8_SCHED;
            PG8_LDB(B1, 0, 1); PG8_STAGE(PG8_SB(0, 0), b2, voffB);
            PG8_BAR; PG8_WAIT_L(0); PG8_MMA(0, 1, At, B1); PG8_BAR;
            PG8_LDA(At, 0, 1); PG8_STAGE(PG8_SA(0, 0), a2, voffA);
            PG8_BAR; PG8_WAIT_L(0); PG8_MMA(1, 0, At, B0); PG8_BAR; PG8_SCHED;
            PG8_STAGE(PG8_SB(0, 1), b2 + hstepB, voffB);
            PG8_WAIT_V(6); PG8_BAR; PG8_MMA(1, 1, At, B1); PG8_BAR;
            PG8_LDB(B0, 1, 0); PG8_SCHED; PG8_LDA(At, 1, 0); PG8_STAGE(PG8_SA(0, 1), a2 + hstepA, voffA);
            PG8_WAIT_L(8); PG8_BAR; PG8_WAIT_L(0); PG8_MMA(0, 0, At, B0); PG8_BAR; PG8_SCHED;
            PG8_LDB(B1, 1, 1); PG8_STAGE(PG8_SB(1, 0), b3, voffB);
            PG8_BAR; PG8_WAIT_L(0); PG8_MMA(0, 1, At, B1); PG8_BAR;
            PG8_LDA(At, 1, 1); PG8_STAGE(PG8_SA(1, 0), a3, voffA);
            PG8_BAR; PG8_WAIT_L(0); PG8_MMA(1, 0, At, B0); PG8_BAR; PG8_SCHED;
            PG8_STAGE(PG8_SB(1, 1), b3 + hstepB, voffB);
            PG8_WAIT_V(6); PG8_BAR; PG8_MMA(1, 1, At, B1); PG8_BAR;
            }
        }
        if constexpr (ALIGN_EPI) { if (wr == 0) PG8_BAR; }
        E(acc, cur, wr, wc, fr, fq);
        if constexpr (Sched::SIGNAL) {
            nsig += cur.pz;
            if (cur.pz && !(has_next && nxt.pz)) { PG8_WAIT_V(0); PG8_BAR;
                if (tid == 0) { __builtin_amdgcn_fence(__ATOMIC_RELEASE, "agent"); PG8_WAIT_V(0); (void)__hip_atomic_fetch_add(S.sig, (unsigned)nsig, __ATOMIC_RELAXED, __HIP_MEMORY_SCOPE_AGENT); }
                nsig = 0; } }
        if (!has_next) break;
#pragma unroll
        for (int a = 0; a < 2; ++a)
#pragma unroll
            for (int b = 0; b < 2; ++b)
#pragma unroll
                for (int m = 0; m < 4; ++m)
#pragma unroll
                    for (int n = 0; n < 2; ++n) acc[a][b][m][n] = (f32x4){0.f, 0.f, 0.f, 0.f};
        cur = nxt; cA = nA; cB = nB; ++ui;
        if constexpr (ALIGN_EPI) { if (wr == 1) PG8_BAR; }
    }
    PG8_WAIT_V(0);
    if constexpr (!ALIGN_EPI) { if (wr == 0) PG8_BAR; }
    PG8_BAR;
#undef PG8_KA
#undef PG8_KB
#undef PG8_SA
#undef PG8_SB
#undef PG8_STAGE
#undef PG8_LDA
#undef PG8_LDB
#undef PG8_MMA
#undef PG8_WAIT_V
#undef PG8_WAIT_L
#undef PG8_BAR
#undef PG8_SCHED
}

struct EpiCols {
    static constexpr bool PERM = true;
    bf16_t* O; int ldc;
    DI void operator()(const f32x4 (&acc)[2][2][4][2], const Unit& u, int wr, int wc, int fr, int fq) const {
        const int row0 = u.pm * BM + wr * 64 + fr, col0 = u.pn * BM + wc * 32 + 8 * fq;
#pragma unroll
        for (int ai = 0; ai < 2; ++ai)
#pragma unroll
            for (int m = 0; m < 4; ++m) { bf16_t* rowp = O + (size_t)(row0 + ai * HALF + m * 16) * ldc + col0;
#pragma unroll
                for (int bj = 0; bj < 2; ++bj) { const f32x4 v0 = acc[ai][bj][m][0], v1 = acc[ai][bj][m][1];
                    u32x4 w; w.x = cvt_pk_bf16(v0[0], v0[1]); w.y = cvt_pk_bf16(v0[2], v0[3]); w.z = cvt_pk_bf16(v1[0], v1[1]); w.w = cvt_pk_bf16(v1[2], v1[3]);
                    *(u32x4*)(rowp + bj * HALF) = w; } }
    }
};
struct EpiPart {
    static constexpr bool PERM = false;
    float* P;
    DI void operator()(const f32x4 (&acc)[2][2][4][2], const Unit& u, int wr, int wc, int fr, int fq) const {
        float* base = P + ((size_t)(u.pk * 8 + u.pz) * 512 + u.pm * BM) * 256;
        const int row0 = wr * 64 + fr, col0 = wc * 32 + 4 * fq;
#pragma unroll
        for (int ai = 0; ai < 2; ++ai)
#pragma unroll
            for (int m = 0; m < 4; ++m) { float* rowp = base + (size_t)(row0 + ai * HALF + m * 16) * 256 + col0;
#pragma unroll
                for (int bj = 0; bj < 2; ++bj)
#pragma unroll
                    for (int n = 0; n < 2; ++n) *(f32x4*)(rowp + bj * HALF + n * 16) = acc[ai][bj][m][n]; }
    }
};
struct EpiGateTmp {
    static constexpr bool PERM = true;
    float* O; const bf16_t* gate;
    DI void operator()(const f32x4 (&acc)[2][2][4][2], const Unit& u, int wr, int wc, int fr, int fq) const {
        const int row0 = u.pm * BM + wr * 64 + fr, col0 = u.pn * BM + wc * 32 + 8 * fq;
#pragma unroll
        for (int ai = 0; ai < 2; ++ai)
#pragma unroll
            for (int m = 0; m < 4; ++m) { const int row = row0 + ai * HALF + m * 16;
#pragma unroll
                for (int bj = 0; bj < 2; ++bj) { const u32x4 gw = *(const u32x4*)(gate + (size_t)row * NP + col0 + bj * HALF);
                    const f32x4 v0 = acc[ai][bj][m][0], v1 = acc[ai][bj][m][1]; f32x4 o0, o1;
                    o0[0] = v0[0] * sigmoidf_(lo_bf(gw.x)); o0[1] = v0[1] * sigmoidf_(hi_bf(gw.x)); o0[2] = v0[2] * sigmoidf_(lo_bf(gw.y)); o0[3] = v0[3] * sigmoidf_(hi_bf(gw.y));
                    o1[0] = v1[0] * sigmoidf_(lo_bf(gw.z)); o1[1] = v1[1] * sigmoidf_(hi_bf(gw.z)); o1[2] = v1[2] * sigmoidf_(lo_bf(gw.w)); o1[3] = v1[3] * sigmoidf_(hi_bf(gw.w));
                    float* op = O + (size_t)row * D + col0 + bj * HALF; *(f32x4*)op = o0; *(f32x4*)(op + 4) = o1; }
                asm volatile("" ::: "memory"); }
    }
};
struct EpiGateAdd {
    static constexpr bool PERM = true;
    bf16_t* Y; const float* tmp; const bf16_t* gate;
    DI void operator()(const f32x4 (&acc)[2][2][4][2], const Unit& u, int wr, int wc, int fr, int fq) const {
        const int row0 = u.pm * BM + wr * 64 + fr, col0 = u.pn * BM + wc * 32 + 8 * fq;
#pragma unroll
        for (int ai = 0; ai < 2; ++ai)
#pragma unroll
            for (int m = 0; m < 4; ++m) { const int row = row0 + ai * HALF + m * 16;
#pragma unroll
                for (int bj = 0; bj < 2; ++bj) { const u32x4 gw = *(const u32x4*)(gate + (size_t)row * NP + col0 + bj * HALF);
                    const float* tp = tmp + (size_t)row * D + col0 + bj * HALF; const f32x4 t0 = *(const f32x4*)tp, t1 = *(const f32x4*)(tp + 4);
                    const f32x4 v0 = acc[ai][bj][m][0], v1 = acc[ai][bj][m][1]; f32x4 o0, o1;
                    o0[0] = t0[0] + v0[0] * sigmoidf_(lo_bf(gw.x)); o0[1] = t0[1] + v0[1] * sigmoidf_(hi_bf(gw.x)); o0[2] = t0[2] + v0[2] * sigmoidf_(lo_bf(gw.y)); o0[3] = t0[3] + v0[3] * sigmoidf_(hi_bf(gw.y));
                    o1[0] = t1[0] + v1[0] * sigmoidf_(lo_bf(gw.z)); o1[1] = t1[1] + v1[1] * sigmoidf_(hi_bf(gw.z)); o1[2] = t1[2] + v1[2] * sigmoidf_(lo_bf(gw.w)); o1[3] = t1[3] + v1[3] * sigmoidf_(hi_bf(gw.w));
                    u32x4 w; w.x = cvt_pk_bf16(o0[0], o0[1]); w.y = cvt_pk_bf16(o0[2], o0[3]); w.z = cvt_pk_bf16(o1[0], o1[1]); w.w = cvt_pk_bf16(o1[2], o1[3]);
                    *(u32x4*)(Y + (size_t)row * D + col0 + bj * HALF) = w; }
                asm volatile("" ::: "memory"); }
    }
};
struct EpiResid {
    static constexpr bool PERM = true;
    const float* xf; const bf16_t* xb; bf16_t* xo;
    DI void operator()(const f32x4 (&acc)[2][2][4][2], const Unit& u, int wr, int wc, int fr, int fq) const {
        const int row0 = u.pm * BM + wr * 64 + fr, col0 = u.pn * BM + wc * 32 + 8 * fq;
#pragma unroll
        for (int ai = 0; ai < 2; ++ai) {
            if (xf) { f32x4 t[4][2][2];
#pragma unroll
                for (int m = 0; m < 4; ++m) { const size_t off = (size_t)(row0 + ai * HALF + m * 16) * D + col0;
#pragma unroll
                    for (int bj = 0; bj < 2; ++bj) { t[m][bj][0] = *(const f32x4*)(xf + off + bj * HALF); t[m][bj][1] = *(const f32x4*)(xf + off + bj * HALF + 4); } }
#pragma unroll
                for (int m = 0; m < 4; ++m) { const size_t off = (size_t)(row0 + ai * HALF + m * 16) * D + col0;
#pragma unroll
                    for (int bj = 0; bj < 2; ++bj) { const f32x4 o0 = t[m][bj][0] + acc[ai][bj][m][0], o1 = t[m][bj][1] + acc[ai][bj][m][1];
                        u32x4 w; w.x = pk2h(o0[0], o0[1]); w.y = pk2h(o0[2], o0[3]); w.z = pk2h(o1[0], o1[1]); w.w = pk2h(o1[2], o1[3]);
                        *(u32x4*)(xo + off + bj * HALF) = w; } }
            } else { u32x4 t[4][2];
#pragma unroll
                for (int m = 0; m < 4; ++m) { const size_t off = (size_t)(row0 + ai * HALF + m * 16) * D + col0;
#pragma unroll
                    for (int bj = 0; bj < 2; ++bj) t[m][bj] = *(const u32x4*)(xb + off + bj * HALF); }
#pragma unroll
                for (int m = 0; m < 4; ++m) { const size_t off = (size_t)(row0 + ai * HALF + m * 16) * D + col0;
#pragma unroll
                    for (int bj = 0; bj < 2; ++bj) { const u32x4 x_ = t[m][bj]; const f32x4 v0 = acc[ai][bj][m][0], v1 = acc[ai][bj][m][1];
                        u32x4 w; w.x = pk2h(lo_h(x_.x) + v0[0], hi_h(x_.x) + v0[1]); w.y = pk2h(lo_h(x_.y) + v0[2], hi_h(x_.y) + v0[3]);
                        w.z = pk2h(lo_h(x_.z) + v1[0], hi_h(x_.z) + v1[1]); w.w = pk2h(lo_h(x_.w) + v1[2], hi_h(x_.w) + v1[3]);
                        *(u32x4*)(xo + off + bj * HALF) = w; } } }
            asm volatile("" ::: "memory"); }
    }
};
struct OrderAB {
    static constexpr bool SIGNAL = false;
    OrderMN mn; const bf16_t* A2; const bf16_t* B2;
    DI bool next(int i, Unit& u) const { if (!mn.next(i >> 1, u)) return false; u.pz = i & 1; return true; }
    DI const char* a_ptr(const Gemm& g, const Unit& u) const { return (const char*)(u.pz ? A2 : g.A) + (size_t)u.pm * BM * g.lda * 2; }
    DI const char* b_ptr(const Gemm& g, const Unit& u) const { return (const char*)(u.pz ? B2 : g.Bt) + (size_t)u.pn * BM * g.ldb * 2; }
};
struct EpiGateAB {
    static constexpr bool PERM = true;
    bf16_t* Y; bf16_t* tmp; const bf16_t* gate_a; const bf16_t* gate_b;
    DI void operator()(const f32x4 (&acc)[2][2][4][2], const Unit& u, int wr, int wc, int fr, int fq) const {
        const int row0 = u.pm * BM + wr * 64 + fr, col0 = u.pn * BM + wc * 32 + 8 * fq;
        const bf16_t* gate = u.pz ? gate_b : gate_a; bf16_t* dst = u.pz ? Y : tmp;
#pragma unroll
        for (int ai = 0; ai < 2; ++ai) { u32x4 gw[4][2], tw[4][2];
#pragma unroll
            for (int m = 0; m < 4; ++m) { const int row = row0 + ai * HALF + m * 16;
#pragma unroll
                for (int bj = 0; bj < 2; ++bj) { gw[m][bj] = *(const u32x4*)(gate + (size_t)row * NP + col0 + bj * HALF);
                    tw[m][bj] = (u32x4){0u, 0u, 0u, 0u}; if (u.pz) tw[m][bj] = *(const u32x4*)(tmp + (size_t)row * D + col0 + bj * HALF); } }
#pragma unroll
            for (int m = 0; m < 4; ++m) { const int row = row0 + ai * HALF + m * 16;
#pragma unroll
                for (int bj = 0; bj < 2; ++bj) { const u32x4 g_ = gw[m][bj], t_ = tw[m][bj];
                    const f32x4 v0 = acc[ai][bj][m][0], v1 = acc[ai][bj][m][1]; f32x4 o0, o1;
                    o0[0] = lo_bf(t_.x) + v0[0] * sigmoidf_(lo_bf(g_.x)); o0[1] = hi_bf(t_.x) + v0[1] * sigmoidf_(hi_bf(g_.x)); o0[2] = lo_bf(t_.y) + v0[2] * sigmoidf_(lo_bf(g_.y)); o0[3] = hi_bf(t_.y) + v0[3] * sigmoidf_(hi_bf(g_.y));
                    o1[0] = lo_bf(t_.z) + v1[0] * sigmoidf_(lo_bf(g_.z)); o1[1] = hi_bf(t_.z) + v1[1] * sigmoidf_(hi_bf(g_.z)); o1[2] = lo_bf(t_.w) + v1[2] * sigmoidf_(lo_bf(g_.w)); o1[3] = hi_bf(t_.w) + v1[3] * sigmoidf_(hi_bf(g_.w));
                    u32x4 w; w.x = cvt_pk_bf16(o0[0], o0[1]); w.y = cvt_pk_bf16(o0[2], o0[3]); w.z = cvt_pk_bf16(o1[0], o1[1]); w.w = cvt_pk_bf16(o1[2], o1[3]);
                    *(u32x4*)(dst + (size_t)row * D + col0 + bj * HALF) = w; } }
            asm volatile("" ::: "memory"); }
    }
};
}

#define XB_TMO      128
#define XB_XCNT(j)  (256  + 64 * (j))
#define XB_XSUB(j)  (1280 + 64 * (j))
#define XB_XGEN(j)  (2304 + 64 * (j))
#define XB_TOP      3328
#define XB_TOPGEN   3392
#define XCD_BAR_WORDS 3456
#define XB_SPIN_CAP (1u << 18)
__device__ __forceinline__ unsigned xb_ld(unsigned* p)              { return __hip_atomic_load(p, __ATOMIC_RELAXED, __HIP_MEMORY_SCOPE_AGENT); }
__device__ __forceinline__ unsigned xb_add(unsigned* p, unsigned v) { return __hip_atomic_fetch_add(p, v, __ATOMIC_RELAXED, __HIP_MEMORY_SCOPE_AGENT); }
__device__ __forceinline__ unsigned xb_xcc_id() { return (unsigned)__builtin_amdgcn_s_getreg((3 << 11) | 20) & 0xFu; }
#define XB_SPIN(cond, bar) do { unsigned _sp = 0; while (cond) { __builtin_amdgcn_s_sleep(1); \
    if ((++_sp & 255u) == 0u) { if (xb_ld(&(bar)[XB_TMO])) break; if (_sp > XB_SPIN_CAP) { atomicAdd(&(bar)[XB_TMO], 1u); break; } } } } while (0)
struct XcdBarrier { unsigned* bar; unsigned x; volatile LAS unsigned* st; };
__device__ __forceinline__ XcdBarrier xcd_barrier_post(unsigned* bar, volatile LAS unsigned* st) {
    XcdBarrier b; b.bar = bar; b.x = xb_xcc_id(); b.st = st;
    if (threadIdx.x == 0) (void)xb_add(&bar[XB_XCNT(b.x)], 1u);
    return b;
}
__device__ __forceinline__ void xcd_barrier_complete(unsigned* bar, unsigned x, unsigned& nloc, unsigned& nx) {
    const unsigned G = gridDim.x * gridDim.y * gridDim.z;
    unsigned sum, cnt, mine, sp = 0u;
    for (;;) {
        sum = 0u; cnt = 0u; mine = 0u;
#pragma unroll
        for (unsigned j = 0; j < 16; ++j) { const unsigned c = xb_ld(&bar[XB_XCNT(j)]); sum += c; cnt += (c > 0u) ? 1u : 0u; mine = (j == x) ? c : mine; }
        if (sum == G) break;
        __builtin_amdgcn_s_sleep(1);
        if ((++sp & 255u) == 0u) { if (xb_ld(&bar[XB_TMO])) break; if (sp > XB_SPIN_CAP) { atomicAdd(&bar[XB_TMO], 1u); break; } }
    }
    nloc = mine > 0u ? mine : 1u; nx = cnt > 0u ? cnt : 1u;
}
__device__ __forceinline__ void xcd_barrier(const XcdBarrier& b) {
    asm volatile("s_waitcnt vmcnt(0)" ::: "memory");
    __syncthreads();
    if (threadIdx.x == 0) {
        unsigned* bar = b.bar;
        __builtin_amdgcn_s_waitcnt(0);
        unsigned nloc = b.st[0], nx = b.st[1];
        if (nloc == 0u) { xcd_barrier_complete(bar, b.x, nloc, nx); b.st[0] = nloc; b.st[1] = nx; }
        const unsigned old = xb_add(&bar[XB_XSUB(b.x)], 1u);
        const unsigned gen = old / nloc;
        if (old + 1u == (gen + 1u) * nloc) {
            __builtin_amdgcn_fence(__ATOMIC_RELEASE, "agent");
            asm volatile("s_waitcnt vmcnt(0)" ::: "memory");
            const unsigned og = xb_add(&bar[XB_TOP], 1u);
            const unsigned tg = og / nx;
            if (og + 1u == (tg + 1u) * nx) xb_add(&bar[XB_TOPGEN], 1u);
            else XB_SPIN(xb_ld(&bar[XB_TOPGEN]) == tg, bar);
            __builtin_amdgcn_fence(__ATOMIC_ACQUIRE, "agent");
            xb_add(&bar[XB_XGEN(b.x)], 1u);
            asm volatile("s_waitcnt vmcnt(0)" ::: "memory");
        } else {
            XB_SPIN(xb_ld(&bar[XB_XGEN(b.x)]) == gen, bar);
            __builtin_amdgcn_fence(__ATOMIC_ACQUIRE, "agent");
            asm volatile("s_waitcnt vmcnt(0)" ::: "memory");
        }
    }
    __syncthreads();
}

struct Args {
    const float *x, *norm_w, *w_in, *cmp_pe, *cmp_w1, *cmp_b1, *cmp_w2, *cmp_b2, *alpha_w, *alpha_b, *gla_norm_w, *p_a, *p_b, *w_out, *final_w;
    float* out; unsigned char* ws; int ph_lo, ph_hi;
};
typedef const __attribute__((address_space(4))) Args* KArgsP;
DI Args load_args(KArgsP p) { Args a; a.x = p->x; a.norm_w = p->norm_w; a.w_in = p->w_in; a.cmp_pe = p->cmp_pe; a.cmp_w1 = p->cmp_w1; a.cmp_b1 = p->cmp_b1; a.cmp_w2 = p->cmp_w2; a.cmp_b2 = p->cmp_b2;
    a.alpha_w = p->alpha_w; a.alpha_b = p->alpha_b; a.gla_norm_w = p->gla_norm_w; a.p_a = p->p_a; a.p_b = p->p_b; a.w_out = p->w_out; a.final_w = p->final_w; a.out = p->out; a.ws = p->ws; a.ph_lo = 0; a.ph_hi = 0; return a; }
struct Frame {
    LAS unsigned char* lds; int tid, lane, wave, G, bid, gw, NGW;
};

struct CvItem { const float* W; bf16_t* WT; int K, N, item; bool map; };
DI void cv_load(f32x4 (&v)[16], const CvItem& c, int lane) {
    const int nblk = c.N / 64, kb = c.item / nblk, nb = c.item % nblk, k0 = 64 * kb, n0 = 64 * nb;
#pragma unroll
    for (int i = 0; i < 16; ++i) v[i] = *(const f32x4*)(c.W + (size_t)(k0 + 4 * i + (lane >> 4)) * c.N + n0 + 4 * (lane & 15));
}
DI void cv_store(const f32x4 (&v)[16], const CvItem& c, LAS float* scr, int lane) {
    const int nblk = c.N / 64, kb = c.item / nblk, nb = c.item % nblk, k0 = 64 * kb, n0 = 64 * nb;
#pragma unroll
    for (int i = 0; i < 16; ++i) { LAS float* d = scr + (4 * i + (lane >> 4)) * 65 + 4 * (lane & 15); d[0] = v[i].x; d[1] = v[i].y; d[2] = v[i].z; d[3] = v[i].w; }
    LDS_WAIT(); asm volatile("" ::: "memory");
    const int ch = lane & 7;
#pragma unroll
    for (int j = 0; j < 8; ++j) { const int n = (lane >> 3) + 8 * j; const LAS float* s = scr + (8 * ch) * 65 + n;
        u32x4 o; o.x = pk2(s[0 * 65], s[1 * 65]); o.y = pk2(s[2 * 65], s[3 * 65]); o.z = pk2(s[4 * 65], s[5 * 65]); o.w = pk2(s[6 * 65], s[7 * 65]);
        const int drow = c.map ? map_col(n0 + n) : (n0 + n);
        *(u32x4*)(c.WT + (size_t)drow * c.K + k0 + 8 * ch) = o; }
    LDS_WAIT(); asm volatile("" ::: "memory");
}
constexpr int CV_IN = (D / 64) * (NIN / 64), CV_SQ = (D / 64) * (D / 64), CV_W1 = (4096 / 64) * (256 / 64), CV_W2 = (256 / 64) * (128 / 64);
constexpr int CV_PER_L = CV_IN + 3 * CV_SQ + 2 * CV_W1 + 2 * CV_W2;
DI CvItem cv_item(const Args& a, int it) {
    unsigned char* ws = a.ws; const int l = it / CV_PER_L; int r = it % CV_PER_L; CvItem c;
    if (r < CV_IN) { c.W = a.w_in + (size_t)l * D * NIN; c.WT = (bf16_t*)(ws + WS_WIN) + (size_t)l * NP * D; c.K = D; c.N = NIN; c.item = r; c.map = true; return c; } r -= CV_IN;
    c.map = false;
    if (r < CV_SQ) { c.W = a.p_a + (size_t)l * D * D; c.WT = (bf16_t*)(ws + WS_WPA) + (size_t)l * D * D; c.K = D; c.N = D; c.item = r; return c; } r -= CV_SQ;
    if (r < CV_SQ) { c.W = a.p_b + (size_t)l * D * D; c.WT = (bf16_t*)(ws + WS_WPB) + (size_t)l * D * D; c.K = D; c.N = D; c.item = r; return c; } r -= CV_SQ;
    if (r < CV_SQ) { c.W = a.w_out + (size_t)l * D * D; c.WT = (bf16_t*)(ws + WS_WOUT) + (size_t)l * D * D; c.K = D; c.N = D; c.item = r; return c; } r -= CV_SQ;
    if (r < 2 * CV_W1) { const int kv = r / CV_W1; c.W = a.cmp_w1 + (size_t)(l * 2 + kv) * 4096 * 256; c.WT = (bf16_t*)(ws + WS_W1T) + (size_t)(l * 2 + kv) * 256 * 4096; c.K = 4096; c.N = 256; c.item = r % CV_W1; return c; } r -= 2 * CV_W1;
    { const int kv = r / CV_W2; c.W = a.cmp_w2 + (size_t)(l * 2 + kv) * 256 * 128; c.WT = (bf16_t*)(ws + WS_W2T) + (size_t)(l * 2 + kv) * 128 * 256; c.K = 256; c.N = 128; c.item = r % CV_W2; }
    return c;
}
DI void p_prologue(const Frame& F, const Args& a) {
    LAS float* scr = (LAS float*)(F.lds + F.wave * 16640);
    unsigned char* ws = a.ws;
    constexpr int TOT = DEPTH * CV_PER_L;
    f32x4 va[16], vb[16];
    int it = F.gw;
    if (it < TOT) { CvItem ca = cv_item(a, it); cv_load(va, ca, F.lane);
        for (;;) {
            const int itb = it + F.NGW; CvItem cb; const bool hb = itb < TOT; if (hb) { cb = cv_item(a, itb); cv_load(vb, cb, F.lane); }
            cv_store(va, ca, scr, F.lane);
            if (!hb) break;
            const int itc = itb + F.NGW; const bool hc = itc < TOT; if (hc) { ca = cv_item(a, itc); cv_load(va, ca, F.lane); }
            cv_store(vb, cb, scr, F.lane);
            if (!hc) break;
            it = itc;
        } }
    __syncthreads();
    LAS float* red = (LAS float*)F.lds;
    for (int job = F.bid; job < DEPTH * 2; job += F.G) {
        const float* w1 = a.cmp_w1 + (size_t)job * 4096 * 256; const float* pe = a.cmp_pe + (size_t)job * 4096;
        f32x4 s = {0.f, 0.f, 0.f, 0.f};
        for (int k = F.wave * 512; k < F.wave * 512 + 512; ++k) { const f32x4 w = *(const f32x4*)(w1 + (size_t)k * 256 + 4 * F.lane); s += w * pe[k]; }
        *(LAS f32x4*)(red + F.wave * 256 + 4 * F.lane) = s;
        __syncthreads();
        if (F.tid < 256) { float t = a.cmp_b1[job * 256 + F.tid];
#pragma unroll
            for (int w = 0; w < 8; ++w) t += red[w * 256 + F.tid];
            ((float*)(ws + WS_B1P))[job * 256 + F.tid] = t; }
        __syncthreads();
    }
}

template <bool OUT_F32, bool IN_BF16>
DI void p_rmsnorm(const Frame& F, const void* xin, const float* w, void* out) {
    f32x4 wv[4][2];
#pragma unroll
    for (int j = 0; j < 4; ++j) { wv[j][0] = *(const f32x4*)(w + 512 * j + 8 * F.lane); wv[j][1] = *(const f32x4*)(w + 512 * j + 8 * F.lane + 4); }
    for (int row = F.gw; row < T; row += F.NGW) {
        float v[4][8]; float s = 0.f;
        if (IN_BF16) { const bf16_t* xr = (const bf16_t*)xin + (size_t)row * D + 8 * F.lane; u32x4 q[4];
#pragma unroll
            for (int j = 0; j < 4; ++j) q[j] = *(const u32x4*)(xr + 512 * j);
#pragma unroll
            for (int j = 0; j < 4; ++j) unpack8h(q[j], v[j]);
        } else { const float* xr = (const float*)xin + (size_t)row * D + 8 * F.lane; f32x4 q[4][2];
#pragma unroll
            for (int j = 0; j < 4; ++j) { q[j][0] = *(const f32x4*)(xr + 512 * j); q[j][1] = *(const f32x4*)(xr + 512 * j + 4); }
#pragma unroll
            for (int j = 0; j < 4; ++j)
#pragma unroll
                for (int e = 0; e < 8; ++e) v[j][e] = q[j][e >> 2][e & 3]; }
#pragma unroll
        for (int j = 0; j < 4; ++j) s += ((v[j][0] * v[j][0] + v[j][1] * v[j][1]) + (v[j][2] * v[j][2] + v[j][3] * v[j][3])) + ((v[j][4] * v[j][4] + v[j][5] * v[j][5]) + (v[j][6] * v[j][6] + v[j][7] * v[j][7]));
        const float rs = rsqrtf(wave_sum(s, F.lane) * (1.f / D) + NORM_EPS);
        if (OUT_F32) { float* o = (float*)out + (size_t)row * D + 8 * F.lane;
#pragma unroll
            for (int j = 0; j < 4; ++j) { f32x4 y0, y1;
#pragma unroll
                for (int e = 0; e < 4; ++e) { y0[e] = v[j][e] * rs * wv[j][0][e]; y1[e] = v[j][4 + e] * rs * wv[j][1][e]; }
                *(f32x4*)(o + 512 * j) = y0; *(f32x4*)(o + 512 * j + 4) = y1; }
        } else { bf16_t* o = (bf16_t*)out + (size_t)row * D + 8 * F.lane;
#pragma unroll
            for (int j = 0; j < 4; ++j) { float y[8];
#pragma unroll
                for (int e = 0; e < 8; ++e) y[e] = v[j][e] * rs * wv[j][e >> 2][e & 3];
                u32x4 p; p.x = pk2(y[0], y[1]); p.y = pk2(y[2], y[3]); p.z = pk2(y[4], y[5]); p.w = pk2(y[6], y[7]); *(u32x4*)(o + 512 * j) = p; } }
    }
}

constexpr int KTILE = 16384, VTILE = 16384, ABUF = KTILE + VTILE;
DI void glds16(const void* gsrc, LAS unsigned char* dst) { unsigned keep; const unsigned lds_dst = (unsigned)(uintptr_t)dst;
    asm volatile("s_mov_b32 %0, m0\n\ts_mov_b32 m0, %2\n\ts_nop 0\n\tglobal_load_lds_dwordx4 %1, off\n\ts_mov_b32 m0, %0" : "=&s"(keep) : "v"(gsrc), "s"(lds_dst) : "memory"); }
DI void dma_k(LAS unsigned char* kb, const bf16_t* kbase, size_t kpitch, int w, int lane) {
#pragma unroll
    for (int i = 0; i < 2; ++i) { const int b = w + 8 * i, row = 4 * b + (lane >> 4), c = (lane & 15) ^ (row & 15);
        glds16(kbase + (size_t)row * kpitch + c * 8, kb + b * 1024); }
}
DI void dma_v(LAS unsigned char* vb, const bf16_t* vbase, size_t vpitch, int w, int lane) {
#pragma unroll
    for (int i = 0; i < 2; ++i) { const int b = w + 8 * i, row = 8 * b + (lane >> 3), c = (lane & 7) ^ ((row >> 1) & 7);
        glds16(vbase + (size_t)row * vpitch + c * 8, vb + b * 1024); }
}
#define VMCNT(n) asm volatile("s_waitcnt vmcnt(" #n ")" ::: "memory")
#define RAW_BARRIER() do { asm volatile("" ::: "memory"); __builtin_amdgcn_s_barrier(); asm volatile("" ::: "memory"); } while (0)

template <bool PERMK>
DI void transpose64x64(const bf16_t* src, size_t pitch, bf16_t* dst, LAS unsigned char* scr, int lane) {
    u32x4 v[8];
#pragma unroll
    for (int i = 0; i < 8; ++i) { const int id = i * 64 + lane, row = id >> 3, ch = id & 7; v[i] = *(const u32x4*)(src + (size_t)row * pitch + ch * 8); }
#pragma unroll
    for (int i = 0; i < 8; ++i) { const int id = i * 64 + lane, row = id >> 3, ch = id & 7;
        const int pos = PERMK ? ((row & 32) | (((row >> 2) & 3) << 3) | (((row >> 4) & 1) << 2) | (row & 3)) : row;
        LAS unsigned char* d = scr + (8 * ch) * 136 + pos * 2;
        *(LAS unsigned short*)(d + 0 * 136) = (unsigned short)(v[i].x & 0xffffu); *(LAS unsigned short*)(d + 1 * 136) = (unsigned short)(v[i].x >> 16);
        *(LAS unsigned short*)(d + 2 * 136) = (unsigned short)(v[i].y & 0xffffu); *(LAS unsigned short*)(d + 3 * 136) = (unsigned short)(v[i].y >> 16);
        *(LAS unsigned short*)(d + 4 * 136) = (unsigned short)(v[i].z & 0xffffu); *(LAS unsigned short*)(d + 5 * 136) = (unsigned short)(v[i].z >> 16);
        *(LAS unsigned short*)(d + 6 * 136) = (unsigned short)(v[i].w & 0xffffu); *(LAS unsigned short*)(d + 7 * 136) = (unsigned short)(v[i].w >> 16); }
    LDS_WAIT(); asm volatile("" ::: "memory");
#pragma unroll
    for (int i = 0; i < 8; ++i) { const int id = i * 64 + lane, col = id >> 3, tg = id & 7;
        const u32x2 lo = *(const LAS u32x2*)(scr + col * 136 + tg * 16), hi = *(const LAS u32x2*)(scr + col * 136 + tg * 16 + 8);
        u32x4 o; o.x = lo.x; o.y = lo.y; o.z = hi.x; o.w = hi.y;
        *(u32x4*)(dst + (size_t)col * 64 + 8 * tg) = o; }
    LDS_WAIT(); asm volatile("" ::: "memory");
}

DI void gla_g1_unit(const Frame& F, const Args& a, int layer, int n, int h) {
    const bf16_t* cols = (const bf16_t*)(a.ws + WS_COLS);
    LAS float* alr = (LAS float*)(F.lds); LAS float* part = (LAS float*)(F.lds + 4096);
    LAS unsigned char* QR = F.lds + 8192; LAS unsigned char* KR = F.lds + 8192 + 32768;
    __syncthreads();
#pragma unroll
    for (int hf = 0; hf < 2; ++hf) { dma_k(QR + hf * 16384, cols + (size_t)(64 * n) * NP + C_QB + h * 256 + hf * 128, NP, F.wave, F.lane);
        dma_k(KR + hf * 16384, cols + (size_t)(64 * n) * NP + C_KB + h * 256 + hf * 128, NP, F.wave, F.lane); }
    if (F.tid < 256) { const int t = F.tid >> 2, k4 = (F.tid & 3) * 4; const u32x2 w = *(const u32x2*)(cols + (size_t)(64 * n + t) * NP + C_ALR + k4);
        alr[t * 16 + k4 + 0] = lo_bf(w.x); alr[t * 16 + k4 + 1] = hi_bf(w.x); alr[t * 16 + k4 + 2] = lo_bf(w.y); alr[t * 16 + k4 + 3] = hi_bf(w.y); }
    __syncthreads();
    const int d = F.tid & 255, half = F.tid >> 8, col = h * 256 + d;
    float w[16];
#pragma unroll
    for (int k = 0; k < 16; ++k) w[k] = a.alpha_w[(size_t)(layer * 16 + k) * 1024 + col];
    const float b = a.alpha_b[layer * 1024 + col];
    float cum[32]; float run = 0.f;
#pragma unroll
    for (int i = 0; i < 32; ++i) { const int t = half * 32 + i; float ga = b;
#pragma unroll
        for (int k4 = 0; k4 < 4; ++k4) { const f32x4 av = *(const LAS f32x4*)(alr + t * 16 + 4 * k4); ga += av.x * w[4 * k4] + av.y * w[4 * k4 + 1] + av.z * w[4 * k4 + 2] + av.w * w[4 * k4 + 3]; }
        const float ls = fminf(ga, 0.f) - __logf(1.f + __expf(-fabsf(ga)));
        run += ls * 0.0625f; cum[i] = run; }
    part[half * 256 + d] = run;
    VMCNT(0);
    __syncthreads();
    const float p0 = part[d], last = p0 + part[256 + d], elast = __expf(last);
    if (half) {
#pragma unroll
        for (int i = 0; i < 32; ++i) cum[i] += p0; }
    bf16_t* kst = (bf16_t*)(a.ws + WS_KST);
    const int eoff = (d >> 7) * 16384 + (d & 7) * 2, ech = (d & 127) >> 3;
    unsigned ksw[16];
#pragma unroll
    for (int i = 0; i < 32; ++i) { const int t = half * 32 + i; const int off = eoff + t * 256 + ((ech ^ (t & 15)) << 4);
        const float qv = bf2f(*(const LAS unsigned short*)(QR + off)), kv = bf2f(*(const LAS unsigned short*)(KR + off));
        const float ec = __expf(cum[i]), kin = kv * __expf(-cum[i]);
        const unsigned qb = f2bf(qv * 0.0625f * ec), kib = f2bf(kin), ksb = f2bf(kin * elast);
        *(LAS unsigned short*)(QR + off) = (unsigned short)qb; *(LAS unsigned short*)(KR + off) = (unsigned short)kib;
        if (i & 1) ksw[i >> 1] |= ksb << 16; else ksw[i >> 1] = ksb; }
    { bf16_t* kp = kst + ((size_t)((n * 4 + h) * 256 + d)) * 64 + half * 32;
#pragma unroll
        for (int j = 0; j < 4; ++j) { u32x4 o; o.x = ksw[4 * j]; o.y = ksw[4 * j + 1]; o.z = ksw[4 * j + 2]; o.w = ksw[4 * j + 3]; *(u32x4*)(kp + 8 * j) = o; } }
    if (half == 0) ((float*)(a.ws + WS_DEC))[(n * 4 + h) * 256 + d] = elast;
    __syncthreads();
    { bf16_t* qdec = (bf16_t*)(a.ws + WS_QDEC);
#pragma unroll
        for (int i = 0; i < 4; ++i) { const int id = F.tid + 512 * i, t = id >> 5, c32 = id & 31, hf = c32 >> 4, c = c32 & 15;
            *(u32x4*)(qdec + (size_t)(64 * n + t) * 1024 + h * 256 + c32 * 8) = *(const LAS u32x4*)(QR + hf * 16384 + t * 256 + ((c ^ (t & 15)) << 4)); } }
    bf16_t* att = (bf16_t*)(a.ws + WS_ATT) + (size_t)(n * 4 + h) * 4096;
    const int fr = F.lane & 15, fq = F.lane >> 4, ms = F.wave >> 1;
#pragma unroll
    for (int z = 0; z < 2; ++z) { const int nt = 2 * (F.wave & 1) + z; f32x4 acc = {0.f, 0.f, 0.f, 0.f};
#pragma unroll
        for (int ks = 0; ks < 8; ++ks) { const int fo = (ks >> 2) * 16384 + (((4 * (ks & 3) + fq) ^ fr) << 4);
            const bf16x8 A = *(const LAS bf16x8*)(KR + fo + (16 * ms + fr) * 256);
            const bf16x8 B = *(const LAS bf16x8*)(QR + fo + (16 * nt + fr) * 256); acc = MFMA16(A, B, acc); }
        const int t = 16 * nt + fr, s0 = 16 * ms + 4 * fq;
        u32x2 o; o.x = pk2(s0 + 0 <= t ? acc[0] : 0.f, s0 + 1 <= t ? acc[1] : 0.f); o.y = pk2(s0 + 2 <= t ? acc[2] : 0.f, s0 + 3 <= t ? acc[3] : 0.f);
        *(u32x2*)(att + t * 64 + s0) = o; }
}

DI void transpose_unit(const Frame& F, const Args& a, int tu) {
    __syncthreads();
    const bf16_t* cols = (const bf16_t*)(a.ws + WS_COLS);
    LAS unsigned char* scr = F.lds + F.wave * 9216;
#pragma unroll 1
    for (int rep = 0; rep < 3; ++rep) { const int it = (tu * 3 + rep) * 8 + F.wave;
    if (it < 4096) { const int n = it >> 5, cg = it & 31;
        transpose64x64<false>(cols + (size_t)(64 * n) * NP + C_VB + 64 * cg, NP, (bf16_t*)(a.ws + WS_VT) + ((size_t)n * 2048 + 64 * cg) * 64, scr, F.lane); }
    else { const int r = (it - 4096) & 1023, win = (it - 4096) >> 10, j = r >> 3, g = (r >> 1) & 3, hf = r & 1;
        transpose64x64<true>(cols + (size_t)(64 * j) * NP + (win ? C_VWIN : C_VSEL) + 128 * g + 64 * hf, NP,
                             (bf16_t*)(a.ws + (win ? WS_VWINT : WS_VSELT)) + ((size_t)(g * 128 + j) * 128 + 64 * hf) * 64, scr, F.lane); } }
}

DI float gelu_tanh(float x) { const float u = 0.7978845608028654f * (x + 0.044715f * x * x * x); const float t = __expf(2.f * u); return 0.5f * x * (2.f - 2.f / (t + 1.f)); }
DI void mlp2_unit(const Frame& F, const Args& a, int layer, int pz, int rt) {
    const float* cpart = (const float*)(a.ws + WS_CPART);
    LAS unsigned char* hid = F.lds;
    const int kv = pz >> 2, g = pz & 3;
    __syncthreads();
    { const int r = F.tid >> 5, c0 = (F.tid & 31) * 8; f32x4 s0, s1;
        const float* bp = (const float*)(a.ws + WS_B1P) + (layer * 2 + kv) * 256 + c0;
        s0 = *(const f32x4*)bp; s1 = *(const f32x4*)(bp + 4);
#pragma unroll
        for (int pk = 0; pk < 8; ++pk) { const float* p = cpart + ((size_t)(pk * 8 + pz) * 512 + rt * 16 + r) * 256 + c0; s0 += *(const f32x4*)p; s1 += *(const f32x4*)(p + 4); }
        u32x4 o; o.x = pk2(gelu_tanh(s0.x), gelu_tanh(s0.y)); o.y = pk2(gelu_tanh(s0.z), gelu_tanh(s0.w)); o.z = pk2(gelu_tanh(s1.x), gelu_tanh(s1.y)); o.w = pk2(gelu_tanh(s1.z), gelu_tanh(s1.w));
        *(LAS u32x4*)(hid + r * 528 + c0 * 2) = o; }
    __syncthreads();
    const bf16_t* w2t = (const bf16_t*)(a.ws + WS_W2T) + (size_t)(layer * 2 + kv) * 128 * 256;
    const int fr = F.lane & 15, fq = F.lane >> 4, dt = F.wave;
    const float* b2 = a.cmp_b2 + (layer * 2 + kv) * 128;
    f32x4 acc = {0.f, 0.f, 0.f, 0.f};
#pragma unroll
    for (int ks = 0; ks < 8; ++ks) { const bf16x8 wf = *(const bf16x8*)(w2t + (16 * dt + fr) * 256 + 32 * ks + 8 * fq);
        const bf16x8 hf = *(const LAS bf16x8*)(hid + fr * 528 + (32 * ks + 8 * fq) * 2);
        acc = kv ? MFMA16(hf, wf, acc) : MFMA16(wf, hf, acc); }
    if (!kv) { const int n = 16 * rt + fr, dim = 16 * dt + 4 * fq; const f32x4 bb = *(const f32x4*)(b2 + dim); u32x2 o;
        if (n == 511) { o.x = 0u; o.y = 0u; } else { o.x = pk2(acc[0] + bb.x, acc[1] + bb.y); o.y = pk2(acc[2] + bb.z, acc[3] + bb.w); }
        *(u32x2*)((bf16_t*)(a.ws + WS_KC) + ((size_t)g * 512 + n) * 128 + dim) = o; }
    else { const int n0 = 16 * rt + 4 * fq, dim = 16 * dt + fr; const float bb = b2[dim]; u32x2 o;
        o.x = pk2(acc[0] + bb, acc[1] + bb); o.y = pk2(acc[2] + bb, (n0 + 3 == 511) ? 0.f : acc[3] + bb);
        const int pos = 64 * (rt >> 2) + 32 * ((rt & 3) >> 1) + 8 * fq + 4 * (rt & 1);
        *(u32x2*)((bf16_t*)(a.ws + WS_VCT) + ((size_t)g * 128 + dim) * 512 + pos) = o; }
}

template <int ACT>
DI void qk_tile(f32x4 (&s)[4][2], const LAS unsigned char* kb, const bf16x8 (&qf)[2][4], int fr, int fq) {
    const LAS unsigned char* kr = kb + fr * 256; const int x0 = (fq ^ fr) << 4, x1 = ((4 + fq) ^ fr) << 4, x2 = ((8 + fq) ^ fr) << 4, x3 = ((12 + fq) ^ fr) << 4;
    const f32x4 zero = {0.f, 0.f, 0.f, 0.f};
#pragma unroll
    for (int kt = 0; kt < 4; ++kt) { const LAS unsigned char* kn = kr + kt * 4096; bf16x8 kf[4];
        kf[0] = *(const LAS bf16x8*)(kn + x0); kf[1] = *(const LAS bf16x8*)(kn + x1); kf[2] = *(const LAS bf16x8*)(kn + x2); kf[3] = *(const LAS bf16x8*)(kn + x3);
        if (ACT & 1) { s[kt][0] = MFMA16(kf[0], qf[0][0], zero); } if (ACT & 2) { s[kt][1] = MFMA16(kf[0], qf[1][0], zero); }
#pragma unroll
        for (int ks = 1; ks < 4; ++ks) { if (ACT & 1) s[kt][0] = MFMA16(kf[ks], qf[0][ks], s[kt][0]); if (ACT & 2) s[kt][1] = MFMA16(kf[ks], qf[1][ks], s[kt][1]); }
    }
}
template <int ACT, bool WITH_L = true>
DI void pv_tile(f32x4 (&O)[8][2], f32x4 (&L)[2], const LAS unsigned char* vb, const bf16x8 (&pf)[2][2], int fr, int fq) {
    const LAS unsigned char* vr = vb + fr * 128; const int x = (fr >> 1) & 7, y0 = (fq ^ x) << 4, y1 = ((4 + fq) ^ x) << 4;
    const bf16x8 ones = {0x3f80, 0x3f80, 0x3f80, 0x3f80, 0x3f80, 0x3f80, 0x3f80, 0x3f80};
    if (WITH_L && (ACT & 1)) { L[0] = MFMA16(ones, pf[0][0], L[0]); L[0] = MFMA16(ones, pf[1][0], L[0]); }
    if (WITH_L && (ACT & 2)) { L[1] = MFMA16(ones, pf[0][1], L[1]); L[1] = MFMA16(ones, pf[1][1], L[1]); }
#pragma unroll
    for (int dt = 0; dt < 8; ++dt) {
        const bf16x8 v0 = *(const LAS bf16x8*)(vr + dt * 2048 + y0), v1 = *(const LAS bf16x8*)(vr + dt * 2048 + y1);
        if (ACT & 1) O[dt][0] = MFMA16(v0, pf[0][0], O[dt][0]); if (ACT & 2) O[dt][1] = MFMA16(v0, pf[0][1], O[dt][1]);
        if (ACT & 1) O[dt][0] = MFMA16(v1, pf[1][0], O[dt][0]); if (ACT & 2) O[dt][1] = MFMA16(v1, pf[1][1], O[dt][1]);
    }
}
DI float max3f(float a, float b, float c) { return fmaxf(fmaxf(a, b), c); }
DI bf16x8 pack_p(const f32x4& a, const f32x4& b) { u32x4 w; w.x = cvt_pk_bf16(a[0], a[1]); w.y = cvt_pk_bf16(a[2], a[3]); w.z = cvt_pk_bf16(b[0], b[1]); w.w = cvt_pk_bf16(b[2], b[3]); return __builtin_bit_cast(bf16x8, w); }
DI float quad_max(float v, int lane) {
    auto r = __builtin_amdgcn_permlane16_swap(__float_as_uint(v), __float_as_uint(v), false, false); v = fmaxf(__uint_as_float(r[0]), __uint_as_float(r[1]));
    r = __builtin_amdgcn_permlane32_swap(__float_as_uint(v), __float_as_uint(v), false, false); return fmaxf(__uint_as_float(r[0]), __uint_as_float(r[1])); }
DI float quad_sum(float v, int lane) {
    auto r = __builtin_amdgcn_permlane16_swap(__float_as_uint(v), __float_as_uint(v), false, false); v = __uint_as_float(r[0]) + __uint_as_float(r[1]);
    r = __builtin_amdgcn_permlane32_swap(__float_as_uint(v), __float_as_uint(v), false, false); return __uint_as_float(r[0]) + __uint_as_float(r[1]); }
constexpr float NEG_INF = -__builtin_inff();

template <int MODE, int ACT>
DI void fa_tile(f32x4 (&O)[8][2], f32x4 (&L)[2], float (&m)[2], const bf16x8 (&qf)[2][4], const LAS unsigned char* kb, const LAS unsigned char* vb,
                const bool (&bit)[2], const int (&tokl)[2], bool diag, bool left, int fr, int fq, int lane) {
    f32x4 s[4][2];
    qk_tile<ACT>(s, kb, qf, fr, fq);
    bf16x8 pf[2][2];
#pragma unroll
    for (int ct = 0; ct < 2; ++ct) {
        if (!((ACT >> ct) & 1)) continue;
        if (diag || left) {
            const int thr_hi = diag ? tokl[ct] : 63, thr_lo = left ? tokl[ct] : -1;
            int kq = 4 * fq; asm volatile("" : "+v"(kq));
#pragma unroll
            for (int kt = 0; kt < 4; ++kt)
#pragma unroll
                for (int r = 0; r < 4; ++r) { const int kl = 16 * kt + kq + r;
                    s[kt][ct][r] = (kl <= thr_hi && kl > thr_lo) ? s[kt][ct][r] : NEG_INF; } }
        float mx = max3f(s[0][ct][0], s[0][ct][1], s[0][ct][2]);
        mx = max3f(mx, s[0][ct][3], s[1][ct][0]); mx = max3f(mx, s[1][ct][1], s[1][ct][2]); mx = max3f(mx, s[1][ct][3], s[2][ct][0]); mx = max3f(mx, s[2][ct][1], s[2][ct][2]);
        mx = max3f(mx, s[2][ct][3], s[3][ct][0]); mx = max3f(mx, s[3][ct][1], s[3][ct][2]); mx = fmaxf(mx, s[3][ct][3]);
        mx = quad_max(mx, lane);
        if (MODE == 0 && !bit[ct]) mx = NEG_INF;
        if (__ballot((mx - m[ct]) * ATT_C > 8.f) != 0ull) {
            const float mn = fmaxf(m[ct], mx), alpha = __builtin_amdgcn_exp2f((m[ct] - mn) * ATT_C); m[ct] = mn; L[ct] *= alpha;
#pragma unroll
            for (int dt = 0; dt < 8; ++dt) O[dt][ct] *= alpha; }
        const float mc = (MODE == 0 && !bit[ct]) ? __builtin_inff() : m[ct] * ATT_C;
#pragma unroll
        for (int kt = 0; kt < 4; ++kt)
#pragma unroll
            for (int r = 0; r < 4; ++r) s[kt][ct][r] = __builtin_amdgcn_exp2f(s[kt][ct][r] * ATT_C - mc);
        pf[0][ct] = pack_p(s[0][ct], s[1][ct]); pf[1][ct] = pack_p(s[2][ct], s[3][ct]);
    }
    pv_tile<ACT>(O, L, vb, pf, fr, fq);
}

template <int MODE>
DI bool fa_rowmax(float (&m)[2], float (&mc)[2], float (&alpha)[2], f32x4 (&s)[4][2], const bool (&bit)[2], const int (&tokl)[2], bool diag, bool left, int fq, int lane) {
    bool need = false;
#pragma unroll
    for (int ct = 0; ct < 2; ++ct) {
        if (diag || left) {
            const int thr_hi = diag ? tokl[ct] : 63, thr_lo = left ? tokl[ct] : -1;
            int kq = 4 * fq; asm volatile("" : "+v"(kq));
#pragma unroll
            for (int kt = 0; kt < 4; ++kt)
#pragma unroll
                for (int r = 0; r < 4; ++r) { const int kl = 16 * kt + kq + r; s[kt][ct][r] = (kl <= thr_hi && kl > thr_lo) ? s[kt][ct][r] : NEG_INF; } }
        float mx = max3f(s[0][ct][0], s[0][ct][1], s[0][ct][2]);
        mx = max3f(mx, s[0][ct][3], s[1][ct][0]); mx = max3f(mx, s[1][ct][1], s[1][ct][2]); mx = max3f(mx, s[1][ct][3], s[2][ct][0]); mx = max3f(mx, s[2][ct][1], s[2][ct][2]);
        mx = max3f(mx, s[2][ct][3], s[3][ct][0]); mx = max3f(mx, s[3][ct][1], s[3][ct][2]); mx = fmaxf(mx, s[3][ct][3]);
        mx = quad_max(mx, lane);
        if (MODE == 0 && !bit[ct]) mx = NEG_INF;
        alpha[ct] = 1.f;
        if (__ballot((mx - m[ct]) * ATT_C > 8.f) != 0ull) { const float mn = fmaxf(m[ct], mx); alpha[ct] = __builtin_amdgcn_exp2f((m[ct] - mn) * ATT_C); m[ct] = mn; need = true; }
        mc[ct] = (MODE == 0 && !bit[ct]) ? __builtin_inff() : m[ct] * ATT_C;
    }
    return need;
}
template <bool HAS_PREV>
DI void fa_exp_pv(f32x4 (&s)[4][2], const float (&mc)[2], bf16x8 (&pfc)[2][2], f32x4 (&O)[8][2], f32x4 (&L)[2], const bf16x8 (&pfp)[2][2], const LAS unsigned char* vbp, int fr, int fq) {
#define FA_EXP1(e) do { if ((e) < 32) { const int _ct = (e) >> 4, _kt = ((e) >> 2) & 3, _r = (e) & 3; s[_kt][_ct][_r] = __builtin_amdgcn_exp2f(s[_kt][_ct][_r] * ATT_C - mc[_ct]); } \
        if ((e) == 8) pfc[0][0] = pack_p(s[0][0], s[1][0]); if ((e) == 16) pfc[1][0] = pack_p(s[2][0], s[3][0]); \
        if ((e) == 24) pfc[0][1] = pack_p(s[0][1], s[1][1]); if ((e) == 32) pfc[1][1] = pack_p(s[2][1], s[3][1]); } while (0)
    if (!HAS_PREV) {
#pragma unroll
        for (int e = 0; e <= 32; ++e) FA_EXP1(e);
    } else {
        const LAS unsigned char* vr = vbp + fr * 128; const int x = (fr >> 1) & 7, y0 = (fq ^ x) << 4, y1 = ((4 + fq) ^ x) << 4;
        const bf16x8 ones = {0x3f80, 0x3f80, 0x3f80, 0x3f80, 0x3f80, 0x3f80, 0x3f80, 0x3f80};
        bf16x8 vf[2][2];
        vf[0][0] = *(const LAS bf16x8*)(vr + y0); vf[0][1] = *(const LAS bf16x8*)(vr + y1);
#define FA_SLOT(mfma_stmt, e) do { mfma_stmt; FA_EXP1(e); __builtin_amdgcn_sched_barrier(0); } while (0)
        FA_SLOT(L[0] = MFMA16(ones, pfp[0][0], L[0]), 0); FA_SLOT(L[1] = MFMA16(ones, pfp[0][1], L[1]), 1);
        FA_SLOT(L[0] = MFMA16(ones, pfp[1][0], L[0]), 2); FA_SLOT(L[1] = MFMA16(ones, pfp[1][1], L[1]), 3);
#pragma unroll
        for (int dt = 0; dt < 8; ++dt) { const int cb = dt & 1, nb = cb ^ 1;
            if (dt < 7) { vf[nb][0] = *(const LAS bf16x8*)(vr + (dt + 1) * 2048 + y0); vf[nb][1] = *(const LAS bf16x8*)(vr + (dt + 1) * 2048 + y1); }
            FA_SLOT(O[dt][0] = MFMA16(vf[cb][0], pfp[0][0], O[dt][0]), 4 + 4 * dt); FA_SLOT(O[dt][1] = MFMA16(vf[cb][0], pfp[0][1], O[dt][1]), 5 + 4 * dt);
            FA_SLOT(O[dt][0] = MFMA16(vf[cb][1], pfp[1][0], O[dt][0]), 6 + 4 * dt); FA_SLOT(O[dt][1] = MFMA16(vf[cb][1], pfp[1][1], O[dt][1]), 7 + 4 * dt); }
#undef FA_SLOT
    }
#undef FA_EXP1
}

template <int MODE  >
DI void fa_chunk(const Frame& F, const Args& a, int c, int g) {
    const bf16_t* cols = (const bf16_t*)(a.ws + WS_COLS);
    const int fr = F.lane & 15, fq = F.lane >> 4, w = F.wave, tid = F.tid;
    LAS unsigned char* lds = F.lds;
    LAS int* list = (LAS int*)(lds + 4 * ABUF); LAS unsigned* maskw = (LAS unsigned*)(lds + 4 * ABUF + 1024);
    const bf16_t* kcol = cols + (MODE ? C_KWIN : C_KSEL) + 128 * g;
    const bf16_t* vT = (const bf16_t*)(a.ws + (MODE ? WS_VWINT : WS_VSELT)) + (size_t)g * 128 * 8192;
    __syncthreads();
    int ntile, j0 = 0;
    if (MODE == 0) {
        const unsigned* selm = (const unsigned*)(a.ws + WS_SELM);
        if (tid < 256) maskw[tid] = selm[((size_t)(64 * c + (tid >> 2)) * 4 + g) * 4 + (tid & 3)];
        __syncthreads();
        if (w == 0) { int base = 0;
#pragma unroll
            for (int hf = 0; hf < 2; ++hf) { const int j = hf * 64 + F.lane; unsigned orv = 0u;
                for (int tk = 0; tk < 64; ++tk) orv |= maskw[tk * 4 + (j >> 5)];
                const bool act = ((orv >> (j & 31)) & 1u) && (j <= c); const unsigned long long bl = __ballot(act);
                if (act) list[base + __popcll(bl & ((1ull << F.lane) - 1ull))] = j; base += __popcll(bl); }
            if (F.lane == 0) list[129] = base; }
        __syncthreads();
        ntile = list[129];
    } else { j0 = c > 8 ? c - 8 : 0; ntile = c - j0 + 1; }
    int tokl[2]; tokl[0] = 8 * w + (fr >> 2); tokl[1] = tokl[0] + 4;
    const int head = 4 * g + (fr & 3);
    bf16x8 qf[2][4];
#pragma unroll
    for (int ct = 0; ct < 2; ++ct)
#pragma unroll
        for (int ks = 0; ks < 4; ++ks) qf[ct][ks] = *(const bf16x8*)(cols + (size_t)(64 * c + tokl[ct]) * NP + C_QA + head * 128 + 32 * ks + 8 * fq);
    f32x4 O[8][2], L[2]; float m[2] = {-1e30f, -1e30f};
    L[0] = (f32x4){0.f, 0.f, 0.f, 0.f}; L[1] = L[0];
#pragma unroll
    for (int dt = 0; dt < 8; ++dt) { O[dt][0] = (f32x4){0.f, 0.f, 0.f, 0.f}; O[dt][1] = (f32x4){0.f, 0.f, 0.f, 0.f}; }
#define FA_TILE(t) (MODE ? j0 + (t) : list[(t)])
#define FA_ISSUE(t) do { const int _j = FA_TILE(t); LAS unsigned char* _b = lds + ((t) & 3) * ABUF; \
        dma_k(_b, kcol + (size_t)(64 * _j) * NP, NP, w, F.lane); dma_v(_b + KTILE, vT + (size_t)_j * 8192, 64, w, F.lane); } while (0)
    FA_ISSUE(0); if (ntile > 1) FA_ISSUE(1);
    f32x4 s[4][2]; bf16x8 pfp[2][2], pfc[2][2]; float mc[2], alpha[2]; bool bit[2] = {true, true};
    for (int t = 0; t < ntile; ++t) {
        if (t + 1 < ntile) VMCNT(4); else VMCNT(0);
        RAW_BARRIER();
        if (t + 2 < ntile) FA_ISSUE(t + 2);
        const int j = FA_TILE(t);
        qk_tile<3>(s, lds + (t & 3) * ABUF, qf, fr, fq);
        if (MODE == 0) {
#pragma unroll
            for (int ct = 0; ct < 2; ++ct) bit[ct] = (maskw[tokl[ct] * 4 + (j >> 5)] >> (j & 31)) & 1u; }
        const bool need = fa_rowmax<MODE>(m, mc, alpha, s, bit, tokl, j == c, (MODE == 1) && (j == c - 8), fq, F.lane);
        __builtin_amdgcn_sched_barrier(0);
        if (t > 0) fa_exp_pv<true>(s, mc, pfc, O, L, pfp, lds + ((t - 1) & 3) * ABUF + KTILE, fr, fq); else fa_exp_pv<false>(s, mc, pfc, O, L, pfp, lds, fr, fq);
        __builtin_amdgcn_sched_barrier(0);
        if (need) {
#pragma unroll
            for (int ct = 0; ct < 2; ++ct) { L[ct] *= alpha[ct];
#pragma unroll
                for (int dt = 0; dt < 8; ++dt) O[dt][ct] *= alpha[ct]; } }
#pragma unroll
        for (int ct = 0; ct < 2; ++ct) { pfp[0][ct] = pfc[0][ct]; pfp[1][ct] = pfc[1][ct]; }
    }
    pv_tile<3>(O, L, lds + ((ntile - 1) & 3) * ABUF + KTILE, pfp, fr, fq);
#undef FA_ISSUE
#undef FA_TILE
    bf16_t* out = (bf16_t*)(a.ws + (MODE ? WS_OWIN : WS_OSEL));
#pragma unroll
    for (int ct = 0; ct < 2; ++ct) { const float inv = 1.f / L[ct][0]; bf16_t* op = out + (size_t)(64 * c + tokl[ct]) * D + head * 128 + 4 * fq;
#pragma unroll
        for (int dt = 0; dt < 8; ++dt) { u32x2 o; o.x = pk2(O[dt][ct][0] * inv, O[dt][ct][1] * inv); o.y = pk2(O[dt][ct][2] * inv, O[dt][ct][3] * inv); *(u32x2*)(op + 16 * dt) = o; } }
}

DI void ca_chunk(const Frame& F, const Args& a, int c, int g) {
    const bf16_t* cols = (const bf16_t*)(a.ws + WS_COLS);
    const int fr = F.lane & 15, fq = F.lane >> 4, w = F.wave, tid = F.tid;
    LAS unsigned char* lds = F.lds;
    LAS float* pslc = (LAS float*)(lds + 2 * ABUF); LAS float* p3 = (LAS float*)(lds + 2 * ABUF + 32768);
    const bf16_t* kc = (const bf16_t*)(a.ws + WS_KC) + (size_t)g * 512 * 128;
    const bf16_t* vct = (const bf16_t*)(a.ws + WS_VCT) + (size_t)g * 128 * 512;
    const int ntile = ((4 * c + 2) >> 6) + 1;
    int tokl[2]; tokl[0] = 8 * w + (fr >> 2); tokl[1] = tokl[0] + 4;
    const int head = 4 * g + (fr & 3);
    int nlim[2];
#pragma unroll
    for (int ct = 0; ct < 2; ++ct) { const int t = 64 * c + tokl[ct]; nlim[ct] = t >= 31 ? ((t - 31) >> 4) : -1; }
    bf16x8 qf[2][4];
#pragma unroll
    for (int ct = 0; ct < 2; ++ct)
#pragma unroll
        for (int ks = 0; ks < 4; ++ks) qf[ct][ks] = *(const bf16x8*)(cols + (size_t)(64 * c + tokl[ct]) * NP + C_QA + head * 128 + 32 * ks + 8 * fq);
    float m[2] = {-1e30f, -1e30f}, l[2] = {0.f, 0.f};
    __syncthreads();
    dma_k(lds, kc, 128, w, F.lane);
    for (int jt = 0; jt < ntile; ++jt) {
        VMCNT(0); RAW_BARRIER();
        if (jt + 1 < ntile) dma_k(lds + ((jt + 1) & 1) * ABUF, kc + (size_t)(64 * (jt + 1)) * 128, 128, w, F.lane);
        const LAS unsigned char* kb = lds + (jt & 1) * ABUF;
        f32x4 s[4][2];
        qk_tile<3>(s, kb, qf, fr, fq);
        const bool edge = jt >= ntile - 2;
        int kq = 4 * fq; asm volatile("" : "+v"(kq));
#pragma unroll
        for (int ct = 0; ct < 2; ++ct) {
            float mx = NEG_INF;
#pragma unroll
            for (int kt = 0; kt < 4; ++kt)
#pragma unroll
                for (int r = 0; r < 4; ++r) { float v = s[kt][ct][r]; if (edge) { const int n = 64 * jt + 16 * kt + kq + r; v = (n <= nlim[ct]) ? v : NEG_INF; s[kt][ct][r] = v; } mx = fmaxf(mx, v); }
            mx = quad_max(mx, F.lane);
            if (__ballot((mx - m[ct]) * ATT_C > 8.f) != 0ull) { const float mn = fmaxf(m[ct], mx); l[ct] *= __builtin_amdgcn_exp2f((m[ct] - mn) * ATT_C); m[ct] = mn; }
            const float mc = m[ct] * ATT_C;
            float rs = 0.f;
#pragma unroll
            for (int kt = 0; kt < 4; ++kt)
#pragma unroll
                for (int r = 0; r < 4; ++r) rs += __builtin_amdgcn_exp2f(s[kt][ct][r] * ATT_C - mc);
            l[ct] += quad_sum(rs, F.lane);
        }
    }
    f32x4 O[8][2];
#pragma unroll
    for (int dt = 0; dt < 8; ++dt) { O[dt][0] = (f32x4){0.f, 0.f, 0.f, 0.f}; O[dt][1] = (f32x4){0.f, 0.f, 0.f, 0.f}; }
    float mc[2], inv[2];
#pragma unroll
    for (int ct = 0; ct < 2; ++ct) { mc[ct] = m[ct] * ATT_C; inv[ct] = l[ct] > 0.f ? 1.f / l[ct] : 0.f; }
    RAW_BARRIER();
    dma_k(lds, kc, 128, w, F.lane); dma_v(lds + KTILE, vct, 512, w, F.lane);
    for (int jt = 0; jt < ntile; ++jt) {
        VMCNT(0); RAW_BARRIER();
        if (jt + 1 < ntile) { LAS unsigned char* nb = lds + ((jt + 1) & 1) * ABUF; dma_k(nb, kc + (size_t)(64 * (jt + 1)) * 128, 128, w, F.lane); dma_v(nb + KTILE, vct + 64 * (jt + 1), 512, w, F.lane); }
        const LAS unsigned char* kb = lds + (jt & 1) * ABUF;
        f32x4 s[4][2];
        qk_tile<3>(s, kb, qf, fr, fq);
        const bool edge = jt >= ntile - 2;
        int kq = 4 * fq; asm volatile("" : "+v"(kq));
        bf16x8 pf[2][2];
#pragma unroll
        for (int ct = 0; ct < 2; ++ct) {
#pragma unroll
            for (int kt = 0; kt < 4; ++kt) {
#pragma unroll
                for (int r = 0; r < 4; ++r) { float p = __builtin_amdgcn_exp2f(s[kt][ct][r] * ATT_C - mc[ct]) * inv[ct];
                    if (edge) { const int n = 64 * jt + 16 * kt + kq + r; p = (n <= nlim[ct]) ? p : 0.f; }
                    s[kt][ct][r] = p; }
                float h3 = s[kt][ct][3], hs = (s[kt][ct][0] + s[kt][ct][1]) + (s[kt][ct][2] + h3);
                hs += shx(hs, 1, F.lane); hs += shx(hs, 2, F.lane); h3 += shx(h3, 1, F.lane); h3 += shx(h3, 2, F.lane);
                if ((fr & 3) == 0) { const int jj = 16 * jt + 4 * kt + fq; pslc[tokl[ct] * 128 + jj] = hs; p3[tokl[ct] * 128 + jj] = h3; }
            }
            pf[0][ct] = pack_p(s[0][ct], s[1][ct]); pf[1][ct] = pack_p(s[2][ct], s[3][ct]);
        }
        { f32x4 Ldummy[2]; pv_tile<3, false>(O, Ldummy, kb + KTILE, pf, fr, fq); }
    }
    bf16_t* out = (bf16_t*)(a.ws + WS_OCMP);
#pragma unroll
    for (int ct = 0; ct < 2; ++ct) { bf16_t* op = out + (size_t)(64 * c + tokl[ct]) * D + head * 128 + 4 * fq;
#pragma unroll
        for (int dt = 0; dt < 8; ++dt) { u32x2 o; o.x = pk2(O[dt][ct][0], O[dt][ct][1]); o.y = pk2(O[dt][ct][2], O[dt][ct][3]); *(u32x2*)(op + 16 * dt) = o; } }
    LDS_WAIT(); asm volatile("" ::: "memory");
    unsigned* selm = (unsigned*)(a.ws + WS_SELM);
    {
        int li = F.lane & 15, tq = F.lane >> 4; asm volatile("" : "+v"(li), "+v"(tq));
        unsigned mw[2][4];
        if (c <= 15) {
            const unsigned all = (c == 31) ? 0xffffffffu : ((2u << c) - 1u);
#pragma unroll
            for (int b = 0; b < 2; ++b) { mw[b][0] = all; mw[b][1] = 0u; mw[b][2] = 0u; mw[b][3] = 0u; }
        } else {
            unsigned long long key[2][8];
#pragma unroll
            for (int b = 0; b < 2; ++b) { const int tok = 8 * w + 4 * b + tq;
#pragma unroll
                for (int e = 0; e < 8; ++e) { const int jj = li + 16 * e; const bool ok = (jj >= 1) && (jj <= c - 2);
                    const float sc = ok ? pslc[tok * 128 + jj] + p3[tok * 128 + jj - 1] : 0.f;
                    key[b][e] = ok ? (((unsigned long long)__float_as_uint(sc) << 32) | (unsigned)(127 - jj)) : 0ull; }
#pragma unroll
                for (int q = 0; q < 4; ++q) mw[b][q] = 0u;
                { const int f0 = 0, f1 = c - 1, f2 = c;
#pragma unroll
                  for (int q = 0; q < 4; ++q) mw[b][q] |= ((f0 >> 5) == q ? 1u << (f0 & 31) : 0u) | ((f1 >> 5) == q ? 1u << (f1 & 31) : 0u) | ((f2 >> 5) == q ? 1u << (f2 & 31) : 0u); } }
#define ROR64(v, n) ((((unsigned long long)(unsigned)__builtin_amdgcn_update_dpp(0, (int)(unsigned)((v) >> 32), 0x120 + (n), 0xf, 0xf, false)) << 32) | (unsigned)__builtin_amdgcn_update_dpp(0, (int)(unsigned)(v), 0x120 + (n), 0xf, 0xf, false))
#pragma unroll 1
            for (int round = 0; round < 13; ++round) {
#pragma unroll
                for (int b = 0; b < 2; ++b) {
                    unsigned long long best = key[b][0];
#pragma unroll
                    for (int e = 1; e < 8; ++e) best = key[b][e] > best ? key[b][e] : best;
                    { unsigned long long o; o = ROR64(best, 1); best = o > best ? o : best; o = ROR64(best, 2); best = o > best ? o : best;
                      o = ROR64(best, 4); best = o > best ? o : best; o = ROR64(best, 8); best = o > best ? o : best; }
                    if (best != 0ull) { const int jb = 127 - (int)(unsigned)best;
#pragma unroll
                        for (int q = 0; q < 4; ++q) mw[b][q] |= ((jb >> 5) == q) ? (1u << (jb & 31)) : 0u;
#pragma unroll
                        for (int e = 0; e < 8; ++e) key[b][e] = (key[b][e] == best) ? 0ull : key[b][e]; }
                }
            }
#undef ROR64
        }
        if (li == 0) {
#pragma unroll
            for (int b = 0; b < 2; ++b) { const int tok = 8 * w + 4 * b + tq; u32x4 o; o.x = mw[b][0]; o.y = mw[b][1]; o.z = mw[b][2]; o.w = mw[b][3];
                *(u32x4*)(selm + ((size_t)(64 * c + tok) * 4 + g) * 4) = o; } }
    }
}

struct ScanRegs { bf16x8 ks[2]; bf16x8 at; f32x4 dc; };
DI void dma_v8(LAS unsigned char* vb, const bf16_t* vbase, int w, int lane) {
    const int row = 8 * w + (lane >> 3), c = (lane & 7) ^ ((row >> 1) & 7);
    glds16(vbase + (size_t)row * 64 + c * 8, vb + w * 1024);
}
constexpr int SC_SROW = 272, SC_SBUF = 64 * SC_SROW, SC_Q = 0, SC_V = 4 * 16384, SC_S = SC_V + 4 * 8192;
static_assert(SC_S + 2 * SC_SBUF <= LDS_MISC, "scan LDS map");
DI void scan_issue(ScanRegs& r, LAS unsigned char* lds, const Args& a, int n, int h, int sl, int kh, int w, int lane, int fr, int fq) {
    const bf16_t* qdec = (const bf16_t*)(a.ws + WS_QDEC); const bf16_t* kst = (const bf16_t*)(a.ws + WS_KST);
    const bf16_t* vt = (const bf16_t*)(a.ws + WS_VT); const bf16_t* att = (const bf16_t*)(a.ws + WS_ATT); const float* dec = (const float*)(a.ws + WS_DEC);
    dma_k(lds + SC_Q + (n & 3) * 16384, qdec + (size_t)(64 * n) * 1024 + h * 256 + kh * 128, 1024, w, lane);
    dma_v8(lds + SC_V + (n & 3) * 8192, vt + ((size_t)n * 2048 + h * 512 + 64 * sl) * 64, w, lane);
    { const bf16_t* kp = kst + ((size_t)(n * 4 + h) * 256 + kh * 128 + 16 * w + fr) * 64 + 8 * fq;
      asm volatile("global_load_dwordx4 %0, %1, off" : "=v"(r.ks[0]) : "v"(kp) : "memory");
      asm volatile("global_load_dwordx4 %0, %1, off offset:64" : "=v"(r.ks[1]) : "v"(kp) : "memory"); }
    { const bf16_t* ap_ = att + ((size_t)(n * 4 + h) * 64 + 16 * (w & 3) + fr) * 64 + 32 * kh + 8 * fq; asm volatile("global_load_dwordx4 %0, %1, off" : "=v"(r.at) : "v"(ap_) : "memory"); }
    { const float* dp = dec + (n * 4 + h) * 256 + kh * 128 + 16 * w + 4 * fq; asm volatile("global_load_dwordx4 %0, %1, off" : "=v"(r.dc) : "v"(dp) : "memory"); }
}
DI void scan_step(const ScanRegs& cur, f32x4 (&S)[4], LAS unsigned char* lds, bf16_t* opart, int n, int h, int sl, int kh, int w, int fr, int fq) {
    const LAS unsigned char* sc = lds + SC_S + (n & 1) * SC_SBUF; const LAS unsigned char* qb = lds + SC_Q + (n & 3) * 16384; const LAS unsigned char* vb = lds + SC_V + (n & 3) * 8192;
    const int tt = w & 3, vt0 = 2 * (w >> 2), xv = (fr >> 1) & 7;
    const LAS unsigned char* vr = vb + fr * 128; const int y0 = (fq ^ xv) << 4, y1 = ((4 + fq) ^ xv) << 4;
    bf16x8 qf[4], sf[2][4];
#pragma unroll
    for (int ks = 0; ks < 4; ++ks) qf[ks] = *(const LAS bf16x8*)(qb + (16 * tt + fr) * 256 + (((4 * ks + fq) ^ fr) << 4));
#pragma unroll
    for (int z = 0; z < 2; ++z)
#pragma unroll
        for (int ks = 0; ks < 4; ++ks) sf[z][ks] = *(const LAS bf16x8*)(sc + (16 * (vt0 + z) + fr) * SC_SROW + (32 * ks + 8 * fq) * 2);
    LDS_WAIT(); __builtin_amdgcn_sched_barrier(0);
    f32x4 acc[2];
#pragma unroll
    for (int z = 0; z < 2; ++z) { acc[z] = (f32x4){0.f, 0.f, 0.f, 0.f};
#pragma unroll
        for (int ks = 0; ks < 4; ++ks) acc[z] = MFMA16(sf[z][ks], qf[ks], acc[z]); }
    bf16x8 vf[4][2];
#pragma unroll
    for (int vt = 0; vt < 4; ++vt) { vf[vt][0] = *(const LAS bf16x8*)(vr + vt * 2048 + y0); vf[vt][1] = *(const LAS bf16x8*)(vr + vt * 2048 + y1); }
    LDS_WAIT(); __builtin_amdgcn_sched_barrier(0);
    { const bf16x8 va0 = vt0 ? (kh ? vf[2][1] : vf[2][0]) : (kh ? vf[0][1] : vf[0][0]), va1 = vt0 ? (kh ? vf[3][1] : vf[3][0]) : (kh ? vf[1][1] : vf[1][0]);
      acc[0] = MFMA16(va0, cur.at, acc[0]); acc[1] = MFMA16(va1, cur.at, acc[1]); }
    LAS unsigned char* sn = lds + SC_S + ((n + 1) & 1) * SC_SBUF;
#pragma unroll
    for (int vt = 0; vt < 4; ++vt) { S[vt] = S[vt] * cur.dc; S[vt] = MFMA16(cur.ks[0], vf[vt][0], S[vt]); S[vt] = MFMA16(cur.ks[1], vf[vt][1], S[vt]); }
#pragma unroll
    for (int z = 0; z < 2; ++z) { u32x2 o; o.x = pk2(acc[z][0], acc[z][1]); o.y = pk2(acc[z][2], acc[z][3]);
        *(u32x2*)(opart + (size_t)(64 * n + 16 * tt + fr) * 2048 + h * 512 + 64 * sl + 16 * (vt0 + z) + 4 * fq) = o; }
#pragma unroll
    for (int vt = 0; vt < 4; ++vt) { u32x2 o; o.x = pk2(S[vt][0], S[vt][1]); o.y = pk2(S[vt][2], S[vt][3]); *(LAS u32x2*)(sn + (16 * vt + fr) * SC_SROW + (16 * w + 4 * fq) * 2) = o; }
}
DI void gla_scan_unit(const Frame& F, const Args& a, int h, int sl, int kh) {
    LAS unsigned char* lds = F.lds;
    const int fr = F.lane & 15, fq = F.lane >> 4, w = F.wave;
    bf16_t* opart = (bf16_t*)(a.ws + WS_OPART) + (size_t)kh * T * 2048;
    __syncthreads();
    for (int i = F.tid; i < SC_SBUF / 4; i += NTHR) ((LAS unsigned*)(lds + SC_S))[i] = 0u;
    f32x4 S[4];
#pragma unroll
    for (int vt = 0; vt < 4; ++vt) S[vt] = (f32x4){0.f, 0.f, 0.f, 0.f};
    ScanRegs r0, r1, r2, r3;
    scan_issue(r0, lds, a, 0, h, sl, kh, w, F.lane, fr, fq); scan_issue(r1, lds, a, 1, h, sl, kh, w, F.lane, fr, fq); scan_issue(r2, lds, a, 2, h, sl, kh, w, F.lane, fr, fq);
#define SC_STEP(rn, rc, n) do { if ((n) < 3) asm volatile("s_waitcnt vmcnt(14)" ::: "memory"); else asm volatile("s_waitcnt vmcnt(20)" ::: "memory"); LDS_WAIT(); RAW_BARRIER(); \
        scan_issue(rn, lds, a, ((n) + 3 < NCH) ? (n) + 3 : NCH - 1, h, sl, kh, w, F.lane, fr, fq); scan_step(rc, S, lds, opart, (n), h, sl, kh, w, fr, fq); } while (0)
    for (int n = 0; n < NCH; n += 4) { SC_STEP(r3, r0, n); SC_STEP(r0, r1, n + 1); SC_STEP(r1, r2, n + 2); SC_STEP(r2, r3, n + 3); }
#undef SC_STEP
    VM_WAIT();
}

DI void p_combine(const Frame& F, const Args& a, int layer) {
    const bf16_t* cols = (const bf16_t*)(a.ws + WS_COLS);
    const bf16_t* ocmp = (const bf16_t*)(a.ws + WS_OCMP); const bf16_t* osel = (const bf16_t*)(a.ws + WS_OSEL); const bf16_t* owin = (const bf16_t*)(a.ws + WS_OWIN);
    const bf16_t* op0 = (const bf16_t*)(a.ws + WS_OPART); const bf16_t* op1 = op0 + (size_t)T * 2048;
    bf16_t* A1 = (bf16_t*)(a.ws + WS_A1); bf16_t* A2 = (bf16_t*)(a.ws + WS_A2);
    const int c8 = 8 * F.lane;
    f32x4 nw[2]; nw[0] = *(const f32x4*)(a.gla_norm_w + layer * 512 + c8); nw[1] = *(const f32x4*)(a.gla_norm_w + layer * 512 + c8 + 4);
    for (int row = F.gw; row < T; row += F.NGW) {
        const bf16_t* cr = cols + (size_t)row * NP; const size_t ro = (size_t)row * D;
#pragma unroll
        for (int j = 0; j < 4; ++j) { const int c0 = 512 * j + c8, head = 4 * j + (F.lane >> 4);
            const float g0 = sigmoidf_(bf2f(cr[C_GBR + head * 3 + 0])), g1 = sigmoidf_(bf2f(cr[C_GBR + head * 3 + 1])), g2 = sigmoidf_(bf2f(cr[C_GBR + head * 3 + 2]));
            float oc[8], os[8], ow[8], za[8], p0[8], p1[8], zb[8];
            unpack8(*(const u32x4*)(ocmp + ro + c0), oc); unpack8(*(const u32x4*)(osel + ro + c0), os); unpack8(*(const u32x4*)(owin + ro + c0), ow); unpack8(*(const u32x4*)(cr + C_ZA + c0), za);
            unpack8(*(const u32x4*)(op0 + ro + c0), p0); unpack8(*(const u32x4*)(op1 + ro + c0), p1); unpack8(*(const u32x4*)(cr + C_ZB + c0), zb);
            float r[8], o[8], ss = 0.f;
#pragma unroll
            for (int e = 0; e < 8; ++e) { r[e] = (g0 * oc[e] + g1 * os[e] + g2 * ow[e]) * siluf_(za[e]); o[e] = p0[e] + p1[e]; ss += o[e] * o[e]; }
            { u32x4 q; q.x = pk2(r[0], r[1]); q.y = pk2(r[2], r[3]); q.z = pk2(r[4], r[5]); q.w = pk2(r[6], r[7]); *(u32x4*)(A1 + ro + c0) = q; }
            const float rs = rsqrtf(wave_sum(ss, F.lane) * (1.f / 512.f) + NORM_EPS);
            float y[8];
#pragma unroll
            for (int e = 0; e < 8; ++e) y[e] = o[e] * rs * nw[e >> 2][e & 3] * siluf_(zb[e]);
            { u32x4 q; q.x = pk2(y[0], y[1]); q.y = pk2(y[2], y[3]); q.z = pk2(y[4], y[5]); q.w = pk2(y[6], y[7]); *(u32x4*)(A2 + ro + c0) = q; } }
    }
}

constexpr int PH_PER_LAYER = 10, N_PHASES = 2 + DEPTH * PH_PER_LAYER;
constexpr int WQ_WORD0 = 16384;
DI int wq_pull(unsigned* cnt, volatile LAS unsigned* slot, int tid) {
    __syncthreads();
    if (tid == 0) *slot = __hip_atomic_fetch_add(cnt, 1u, __ATOMIC_RELAXED, __HIP_MEMORY_SCOPE_AGENT);
    __syncthreads();
    return (int)*slot;
}
__global__ void __launch_bounds__(NTHR, 2) mk_fwd(Args a_in, int li) {
    KArgsP ap = (KArgsP)__builtin_amdgcn_kernarg_segment_ptr();
    const int ph_lo = a_in.ph_lo, ph_hi = a_in.ph_hi;
    extern __shared__ __attribute__((aligned(16))) unsigned char lds_raw[];
    Frame F;
    F.lds = (LAS unsigned char*)lds_raw;
    F.tid = threadIdx.x; F.lane = F.tid & 63; F.wave = __builtin_amdgcn_readfirstlane(F.tid >> 6);
    const int wave_s = F.wave;
    F.G = gridDim.x; F.bid = blockIdx.x; F.gw = F.bid * NWAVES + F.wave; F.NGW = F.G * NWAVES;
    volatile LAS unsigned* misc = (volatile LAS unsigned*)(F.lds + LDS_MISC);
    if (F.tid < 64) misc[F.tid] = 0u;
    __syncthreads();
    unsigned* ctl = (unsigned*)(a_in.ws + WS_CTL);
    XcdBarrier bar = xcd_barrier_post(ctl + (size_t)li * XCD_BAR_WORDS, misc);
#ifndef PHASE_SET
#define PHASE_SET 0xFFFF
#endif
#define HAS(k) ((PHASE_SET >> (k)) & 1)
#ifndef REPEAT_PHASE
#define REPEAT_PHASE -1
#endif
#define REP(k) for (int _r = 0; _r < ((REPEAT_PHASE == (k)) ? 2 : 1); ++_r)
#define IN(k) (ph_lo <= (k) && (k) < ph_hi)
#define SEAM(k) do { if (IN(k) && IN((k) + 1)) xcd_barrier(bar); } while (0)
#define FRESH() do { int _l = __builtin_amdgcn_mbcnt_hi(~0u, __builtin_amdgcn_mbcnt_lo(~0u, 0u)); asm volatile("" : "+v"(_l)); int _w = wave_s; asm volatile("" : "+s"(_w)); F.lane = _l; F.wave = _w; F.tid = _w * 64 + _l; F.gw = F.bid * NWAVES + F.wave; { KArgsP _k = (KArgsP)__builtin_amdgcn_kernarg_segment_ptr(); asm volatile("" : "+s"(_k)); ap = _k; } } while (0)
    if (HAS(12) && IN(0)) { FRESH(); const Args a = load_args(ap); REP(12) { p_prologue(F, a); } SEAM(0); }
#define PHASE_ENTER() FRESH(); const Args a = load_args(ap); unsigned char* ws = a.ws; bf16_t* cols = (bf16_t*)(ws + WS_COLS); (void)cols
#define UNIT_FRAME(Fu) Frame Fu = F; { int _l = F.lane; asm volatile("" : "+v"(_l)); Fu.lane = _l; Fu.tid = F.wave * 64 + _l; }
    for (int L = 0; L < DEPTH; ++L) {
        const int pb = 1 + PH_PER_LAYER * L;
        if (HAS(0) && IN(pb + 0)) { PHASE_ENTER();
            if (L == 0) p_rmsnorm<false, false>(F, a.x, a.norm_w, ws + WS_H); else p_rmsnorm<false, true>(F, ws + WS_X, a.norm_w + L * D, ws + WS_H);
            SEAM(pb + 0); }
        if (HAS(1) && IN(pb + 1)) { PHASE_ENTER();
            pg8::Gemm g{(const bf16_t*)(ws + WS_H), (const bf16_t*)(ws + WS_WIN) + (size_t)L * NP * D, D, D, D};
            pg8::OrderIn S; S.mn.init(T, NP, F.G, F.bid); S.sig = (unsigned*)(ws + WS_CTL) + WQ_WORD0 + 40960 + 64 * L; pg8::EpiCols E{cols, NP};
            pg8::gemm_phase<pg8::EpiCols, pg8::OrderIn, false, true, true>(F.lds, g, S, E, F.tid); }
        if (HAS(2) && IN(pb + 2)) { PHASE_ENTER();
            unsigned* cnt = (unsigned*)(ws + WS_CTL) + WQ_WORD0 + 8192 + 64 * L;
            { unsigned* sig = (unsigned*)(ws + WS_CTL) + WQ_WORD0 + 40960 + 64 * L;
              if (F.tid == 0) { XB_SPIN(xb_ld(sig) < pg8::IN_EARLY_TILES, bar.bar); __builtin_amdgcn_fence(__ATOMIC_ACQUIRE, "agent"); asm volatile("s_waitcnt vmcnt(0)" ::: "memory"); }
              __syncthreads(); }
            for (;;) { const int u = wq_pull(cnt, misc + 16, F.tid); if (u >= 128 + 512 + 256) break;
                UNIT_FRAME(Fu);
                if (u < 128) { pg8::Gemm g{cols, (const bf16_t*)(ws + WS_W1T) + (size_t)L * 2 * 256 * 4096, 16 * NP, 4096, 512};
                    pg8::OrderCmp S; S.init(1 << 20, u); pg8::EpiPart E{(float*)(ws + WS_CPART)};
                    __syncthreads();
                    pg8::gemm_phase<pg8::EpiPart, pg8::OrderCmp, true, false, true>(Fu.lds, g, S, E, Fu.tid); }
                else if (u < 640) { const int v = u - 128; gla_g1_unit(Fu, a, L, v >> 2, v & 3); }
                else transpose_unit(Fu, a, u - 640); }
            SEAM(pb + 2); }
        if (HAS(3) && IN(pb + 3)) { PHASE_ENTER(); for (int u = F.bid; u < 256; u += F.G) mlp2_unit(F, a, L, u >> 5, u & 31); SEAM(pb + 3); }
        if (HAS(4) && IN(pb + 4)) { PHASE_ENTER();
            REP(4) { unsigned* cnt = (unsigned*)(ws + WS_CTL) + WQ_WORD0 + 64 * (2 * L + 16 * _r);
            for (;;) { const int u = wq_pull(cnt, misc + 16, F.tid); if (u >= 512 + 512) break;
                UNIT_FRAME(Fu);
                if (u < 512) ca_chunk(Fu, a, 127 - (u >> 2), u & 3);
                else { const int v = u - 512; fa_chunk<1>(Fu, a, 127 - (v >> 2), v & 3); } } }
            SEAM(pb + 4); }
        if (HAS(5) && IN(pb + 5)) { PHASE_ENTER();
            REP(5) { unsigned* cnt = (unsigned*)(ws + WS_CTL) + WQ_WORD0 + 64 * (2 * L + 1 + 16 * _r);
            unsigned* grp = (unsigned*)(ws + WS_CTL) + WQ_WORD0 + 4096 + 64 * (8 * L + 32 * _r);
            unsigned* claimed = (unsigned*)(ws + WS_CTL) + WQ_WORD0 + 32768 + 64 * (L + 4 * _r);
            { const unsigned x = xb_xcc_id() & 7u;
              __syncthreads();
              if (F.tid == 0) { unsigned r = __hip_atomic_fetch_add(grp + 64 * x, 1u, __ATOMIC_RELAXED, __HIP_MEMORY_SCOPE_AGENT); unsigned got = 0xffffffffu;
                  if (r < 8u && __hip_atomic_exchange(claimed + 8 * x + r, 1u, __ATOMIC_RELAXED, __HIP_MEMORY_SCOPE_AGENT) == 0u) got = 8u * x + r;
                  misc[16] = got; }
              __syncthreads();
              const unsigned su = misc[16];
              if (su != 0xffffffffu) { UNIT_FRAME(Fu); gla_scan_unit(Fu, a, (int)(su >> 4), (int)(su & 7u), (int)((su >> 3) & 1u)); } }
            for (;;) { const int u = wq_pull(cnt, misc + 16, F.tid); if (u >= 64) break;
                UNIT_FRAME(Fu);
                __syncthreads(); if (F.tid == 0) misc[17] = __hip_atomic_exchange(claimed + u, 1u, __ATOMIC_RELAXED, __HIP_MEMORY_SCOPE_AGENT); __syncthreads();
                if (misc[17] == 0u) gla_scan_unit(Fu, a, u >> 4, u & 7, (u >> 3) & 1); }
            { const int g0 = (int)(xb_xcc_id() & 3u);
              for (int gi = 0; gi < 4; ++gi) { const int gq = (g0 + gi) & 3; unsigned* qcnt = (unsigned*)(ws + WS_CTL) + WQ_WORD0 + 12288 + 64 * (4 * L + gq + 32 * _r);
                  for (;;) { const int u = wq_pull(qcnt, misc + 16, F.tid); if (u >= 128) break;
                      UNIT_FRAME(Fu);
                      fa_chunk<0>(Fu, a, 127 - u, gq); } } } }
            SEAM(pb + 5); }
        if (HAS(6) && IN(pb + 6)) { PHASE_ENTER(); p_combine(F, a, L); SEAM(pb + 6); }
        if (HAS(7) && IN(pb + 7)) { PHASE_ENTER();
            pg8::Gemm g{(const bf16_t*)(ws + WS_A1), (const bf16_t*)(ws + WS_WPA) + (size_t)L * D * D, D, D, D};
            pg8::OrderAB S; S.mn.init(T, D, F.G, F.bid); S.A2 = (const bf16_t*)(ws + WS_A2); S.B2 = (const bf16_t*)(ws + WS_WPB) + (size_t)L * D * D;
            pg8::EpiGateAB E{(bf16_t*)(ws + WS_Y), (bf16_t*)(ws + WS_TMP), cols + C_GA, cols + C_GB};
            pg8::gemm_phase<pg8::EpiGateAB, pg8::OrderAB, false, true, true>(F.lds, g, S, E, F.tid);
            SEAM(pb + 7); }
        if (HAS(8) && IN(pb + 8)) { PHASE_ENTER(); }
        if (HAS(9) && IN(pb + 9)) { PHASE_ENTER();
            pg8::Gemm g{(const bf16_t*)(ws + WS_Y), (const bf16_t*)(ws + WS_WOUT) + (size_t)L * D * D, D, D, D};
            pg8::OrderMN S; S.init(T, D, F.G, F.bid); pg8::EpiResid E{L == 0 ? a.x : (const float*)nullptr, (const bf16_t*)(ws + WS_X), (bf16_t*)(ws + WS_X)};
            pg8::gemm_phase<pg8::EpiResid, pg8::OrderMN, false, false, true>(F.lds, g, S, E, F.tid);
            SEAM(pb + 9); }
    }
    if (HAS(13) && IN(N_PHASES - 1)) { FRESH(); const Args a = load_args(ap); p_rmsnorm<true, true>(F, a.ws + WS_X, a.final_w, a.out); }
#undef IN
#undef SEAM
}

extern "C" void kernel_launch(void* const* d_in, const int* in_sizes, int n_in, void* d_out, int out_size, void* d_ws, size_t ws_size, hipStream_t stream) {
    static int grid = 0;
    if (grid == 0) {
        if (n_in != 15 || ws_size < WS_END) { fprintf(stderr, "kernel_launch: unexpected inputs (n_in %d, ws %zu, need %zu)\n", n_in, ws_size, (size_t)WS_END); grid = -1; return; }
        int dev = 0, cus = 0;
        if (hipGetDevice(&dev) != hipSuccess || hipDeviceGetAttribute(&cus, hipDeviceAttributeMultiprocessorCount, dev) != hipSuccess) { grid = -1; return; }
        if (hipFuncSetAttribute((const void*)mk_fwd, hipFuncAttributeMaxDynamicSharedMemorySize, LDS_BYTES) != hipSuccess) { fprintf(stderr, "kernel_launch: hipFuncSetAttribute failed\n"); grid = -1; return; }
        int per_cu = 0;
        if (hipOccupancyMaxActiveBlocksPerMultiprocessor(&per_cu, (const void*)mk_fwd, NTHR, LDS_BYTES) != hipSuccess || per_cu < 1) fprintf(stderr, "kernel_launch: occupancy query reports %d\n", per_cu);
        (void)hipGetLastError();
        grid = cus;
    }
    if (grid < 0) return;
    (void)hipMemsetAsync((char*)d_ws + WS_CTL, 0, CTL_BYTES, stream);
    Args a{};
    a.x = (const float*)d_in[0]; a.norm_w = (const float*)d_in[1]; a.w_in = (const float*)d_in[2]; a.cmp_pe = (const float*)d_in[3]; a.cmp_w1 = (const float*)d_in[4];
    a.cmp_b1 = (const float*)d_in[5]; a.cmp_w2 = (const float*)d_in[6]; a.cmp_b2 = (const float*)d_in[7]; a.alpha_w = (const float*)d_in[8]; a.alpha_b = (const float*)d_in[9];
    a.gla_norm_w = (const float*)d_in[10]; a.p_a = (const float*)d_in[11]; a.p_b = (const float*)d_in[12]; a.w_out = (const float*)d_in[13]; a.final_w = (const float*)d_in[14];
    a.out = (float*)d_out; a.ws = (unsigned char*)d_ws;
#if MK_PER_PHASE
    for (int k = 0; k < N_PHASES; ++k) { a.ph_lo = k; a.ph_hi = k + 1; hipLaunchKernelGGL(mk_fwd, dim3(grid), dim3(NTHR), LDS_BYTES, stream, a, k); }
#else
    a.ph_lo = 0; a.ph_hi = N_PHASES; hipLaunchKernelGGL(mk_fwd, dim3(grid), dim3(NTHR), LDS_BYTES, stream, a, 0);
#endif
}
```

```cpp
#include <hip/hip_runtime.h>
#include <cstdio>
#include <cstdint>

#ifndef MK_PER_PHASE
#define MK_PER_PHASE 0
#endif

#define LAS __attribute__((address_space(3)))
#define GAS __attribute__((address_space(1)))
typedef unsigned short bf16_t;
typedef short bf16x8 __attribute__((ext_vector_type(8)));
typedef short s16x4 __attribute__((ext_vector_type(4)));
typedef float f32x4 __attribute__((ext_vector_type(4)));
typedef float f32x2 __attribute__((ext_vector_type(2)));
typedef unsigned u32x4 __attribute__((ext_vector_type(4)));
typedef unsigned u32x2 __attribute__((ext_vector_type(2)));
#define DI __device__ __forceinline__
#define MFMA16(a, b, c) __builtin_amdgcn_mfma_f32_16x16x32_bf16((a), (b), (c), 0, 0, 0)

constexpr int T = 8192, D = 2048, DEPTH = 4, NIN = 17472, NP = 17664;
constexpr int NCH = 128;
constexpr int C_QA = 0, C_KCMP = 2048, C_VCMP = 2560, C_KSEL = 3072, C_VSEL = 3584, C_KWIN = 4096, C_VWIN = 4608, C_ZA = 5120,
              C_QB = 7168, C_KB = 8192, C_VB = 9216, C_ZB = 11264, C_GA = 13312, C_GB = 15360, C_GBR = 17408, C_ALR = 17456;
constexpr float NORM_EPS = 1e-6f;
constexpr float ATT_C = 0.08838834764831845f * 1.4426950408889634f;

DI int map_col(int n) {
    if (n < 5120) return n;
    if (n < 5168) return C_GBR + (n - 5120);
    if (n < 11312) return n - 48;
    if (n < 11328) return C_ALR + (n - 11312);
    return n - 64;
}

constexpr size_t MiB = 1u << 20;
constexpr size_t al(size_t x) { return (x + MiB - 1) / MiB * MiB; }
constexpr size_t WS_CTL = 0, CTL_BYTES = MiB;
constexpr size_t WS_WIN = WS_CTL + CTL_BYTES;
constexpr size_t WS_WPA = WS_WIN + al((size_t)DEPTH * NP * D * 2);
constexpr size_t WS_WPB = WS_WPA + al((size_t)DEPTH * D * D * 2);
constexpr size_t WS_WOUT = WS_WPB + al((size_t)DEPTH * D * D * 2);
constexpr size_t WS_W1T = WS_WOUT + al((size_t)DEPTH * D * D * 2);
constexpr size_t WS_W2T = WS_W1T + al((size_t)DEPTH * 2 * 256 * 4096 * 2);
constexpr size_t WS_B1P = WS_W2T + al((size_t)DEPTH * 2 * 128 * 256 * 2);
constexpr size_t WS_X = WS_B1P + MiB;
constexpr size_t WS_H = WS_X + al((size_t)T * D * 4);
constexpr size_t WS_COLS = WS_H + al((size_t)T * D * 2);
constexpr size_t WS_CPART = WS_COLS + al((size_t)(T + 64) * NP * 2);
constexpr size_t WS_KC = WS_CPART + al((size_t)8 * 8 * 512 * 256 * 4);
constexpr size_t WS_VCT = WS_KC + MiB;
constexpr size_t WS_SELM = WS_VCT + MiB;
constexpr size_t WS_OCMP = WS_SELM + MiB;
constexpr size_t WS_OSEL = WS_OCMP + al((size_t)T * D * 2);
constexpr size_t WS_OWIN = WS_OSEL + al((size_t)T * D * 2);
constexpr size_t WS_VSELT = WS_OWIN + al((size_t)T * D * 2);
constexpr size_t WS_VWINT = WS_VSELT + al((size_t)4 * 128 * 128 * 64 * 2);
constexpr size_t WS_QDEC = WS_VWINT + al((size_t)4 * 128 * 128 * 64 * 2);
constexpr size_t WS_KST = WS_QDEC + al((size_t)T * 1024 * 2);
constexpr size_t WS_VT = WS_KST + al((size_t)T * 1024 * 2);
constexpr size_t WS_ATT = WS_VT + al((size_t)T * 2048 * 2);
constexpr size_t WS_DEC = WS_ATT + al((size_t)128 * 4 * 64 * 64 * 2);
constexpr size_t WS_OPART = WS_DEC + MiB;
constexpr size_t WS_A1 = WS_OPART + al((size_t)2 * T * 2048 * 4);
constexpr size_t WS_A2 = WS_A1 + al((size_t)T * D * 2);
constexpr size_t WS_TMP = WS_A2 + al((size_t)T * D * 2);
constexpr size_t WS_Y = WS_TMP + al((size_t)T * D * 4);
constexpr size_t WS_END = WS_Y + al((size_t)T * D * 2);

constexpr int LDS_MAIN = 131072;
constexpr int LDS_BYTES = 147456;
constexpr int LDS_MISC = LDS_BYTES - 256;
constexpr int NWAVES = 8, NTHR = 512;

DI float bf2f(unsigned short b) { return __uint_as_float(((unsigned)b) << 16); }
DI unsigned f2bf(float f) { unsigned u = __float_as_uint(f); return (u + 0x7fffu + ((u >> 16) & 1u)) >> 16; }
DI unsigned pk2_sw(float lo, float hi) { return f2bf(lo) | (f2bf(hi) << 16); }
typedef __bf16 bf16x2_t __attribute__((ext_vector_type(2)));
DI unsigned cvt_pk_bf16(float lo, float hi) { const f32x2 v = {lo, hi}; const bf16x2_t b = __builtin_convertvector(v, bf16x2_t); return __builtin_bit_cast(unsigned, b); }
DI unsigned pk2(float lo, float hi) { return cvt_pk_bf16(lo, hi); }
DI float lo_bf(unsigned w) { return __uint_as_float(w << 16); }
DI float hi_bf(unsigned w) { return __uint_as_float(w & 0xffff0000u); }
DI void unpack8(const u32x4& w, float (&f)[8]) { f[0] = lo_bf(w.x); f[1] = hi_bf(w.x); f[2] = lo_bf(w.y); f[3] = hi_bf(w.y); f[4] = lo_bf(w.z); f[5] = hi_bf(w.z); f[6] = lo_bf(w.w); f[7] = hi_bf(w.w); }
typedef _Float16 f16x2_t __attribute__((ext_vector_type(2)));
DI unsigned pk2h(float lo, float hi) { const f32x2 v = {lo, hi}; const f16x2_t h = __builtin_convertvector(v, f16x2_t); return __builtin_bit_cast(unsigned, h); }
DI float lo_h(unsigned w) { const f16x2_t h = __builtin_bit_cast(f16x2_t, w); return (float)h[0]; }
DI float hi_h(unsigned w) { const f16x2_t h = __builtin_bit_cast(f16x2_t, w); return (float)h[1]; }
DI void unpack8h(const u32x4& w, float (&f)[8]) { f[0] = lo_h(w.x); f[1] = hi_h(w.x); f[2] = lo_h(w.y); f[3] = hi_h(w.y); f[4] = lo_h(w.z); f[5] = hi_h(w.z); f[6] = lo_h(w.w); f[7] = hi_h(w.w); }
DI float sigmoidf_(float x) { return 1.f / (1.f + __expf(-x)); }
DI float siluf_(float x) { return x / (1.f + __expf(-x)); }
DI float shx(float v, int off, int lane) { return __int_as_float(__builtin_amdgcn_ds_bpermute((lane ^ off) << 2, __float_as_int(v))); }
DI int shxi(int v, int off, int lane) { return __builtin_amdgcn_ds_bpermute((lane ^ off) << 2, v); }
DI float wave_sum(float v, int lane) {
#pragma unroll
    for (int o = 1; o < 64; o <<= 1) v += shx(v, o, lane);
    return v;
}
#define LDS_WAIT() asm volatile("s_waitcnt lgkmcnt(0)" ::: "memory")
#define VM_WAIT() asm volatile("s_waitcnt vmcnt(0)" ::: "memory")

namespace pg8 {
constexpr int BM = 256, BK = 64, HALF = 128, HTB = HALF * BK * 2, STAGE_BYTES = 8 * HTB, NXCD = 8, WGM = 8;
__host__ __device__ __forceinline__ int lds_byte(int r, int c) { const int st = (r >> 4) * 2 + (c >> 5), rr = r & 15, cc = c & 31, ob = rr * 64 + cc * 2; return st * 1024 + (ob ^ (((ob >> 9) & 1) << 5)); }
__host__ __device__ __forceinline__ void stage_rc(int b, int& R, int& C) { const int st = b / 1024, sb = b % 1024, swz = sb ^ (((sb >> 9) & 1) << 5); R = (st >> 1) * 16 + swz / 64; C = (st & 1) * 32 + (swz % 64) / 2; }
__host__ __device__ __forceinline__ int perm32(int rho) { const int n = rho >> 4, i = rho & 15; return 8 * (i >> 2) + 4 * n + (i & 3); }

struct Unit { int pm, pn, pk, pz; };
struct Gemm { const bf16_t* A; const bf16_t* Bt; int lda, ldb, K; };

struct OrderMN {
    static constexpr bool SIGNAL = false;
    int nM, nN, nwg, G, c, rep;
    DI void init(int M, int N, int G_, int c_, int rep_ = 1) { nM = M / BM; nN = N / BM; nwg = nM * nN; G = G_; c = c_; rep = rep_; }
    DI bool next(int i, Unit& u) const {
        long L = (long)i * G + c; if (L >= (long)nwg * rep) return false;
        if (L >= nwg) L -= nwg;
        int wgid = (int)L; { const int q = nwg / NXCD, r = nwg % NXCD, xcd = wgid % NXCD, off = wgid / NXCD; wgid = (xcd < r ? xcd * (q + 1) : r * (q + 1) + (xcd - r) * q) + off; }
        const int nig = WGM * nN, gid = wgid / nig, fm = gid * WGM, gsz = (nM - fm) < WGM ? (nM - fm) : WGM;
        u.pm = fm + ((wgid % nig) % gsz); u.pn = (wgid % nig) / gsz; u.pk = 0; u.pz = 0; return true;
    }
    DI const char* a_ptr(const Gemm& g, const Unit& u) const { return (const char*)g.A + (size_t)u.pm * BM * g.lda * 2; }
    DI const char* b_ptr(const Gemm& g, const Unit& u) const { return (const char*)g.Bt + (size_t)u.pn * BM * g.ldb * 2; }
};
DI int in_col_tile(int p, int& early) {
    int i;
    if (p < 13) { early = 1; i = p; } else if (p < 35) { early = 0; i = p - 13; } else if (p < 47) { early = 1; i = p - 22; } else { early = 0; i = p - 25; }
    if (early) return i < 4 ? 8 + i : i < 6 ? 10 + i : i < 8 ? 12 + i : i < 24 ? 20 + i : 68;
    return i < 8 ? i : i < 10 ? 4 + i : i < 12 ? 6 + i : i < 20 ? 8 + i : 24 + i;
}
constexpr unsigned IN_EARLY_TILES = 25 * (T / 256);
struct OrderIn {
    static constexpr bool SIGNAL = true;
    OrderMN mn; unsigned* sig;
    DI bool next(int i, Unit& u) const { if (!mn.next(i, u)) return false; int e; u.pn = in_col_tile(u.pn, e); u.pz = e; return true; }
    DI const char* a_ptr(const Gemm& g, const Unit& u) const { return mn.a_ptr(g, u); }
    DI const char* b_ptr(const Gemm& g, const Unit& u) const { return mn.b_ptr(g, u); }
};
struct OrderCmp {
    static constexpr bool SIGNAL = false;
    int G, c;
    DI void init(int G_, int c_) { G = G_; c = c_; }
    DI bool next(int i, Unit& u) const { const int L = i * G + c; if (L >= 128) return false; u.pk = L & 7; u.pm = (L >> 3) & 1; u.pz = L >> 4; u.pn = 0; return true; }
    DI const char* a_ptr(const Gemm& g, const Unit& u) const { const int kv = u.pz >> 2, gg = u.pz & 3;
        return (const char*)g.A + ((size_t)(u.pm * BM * 16 + u.pk * 4) * NP + (kv ? C_VCMP : C_KCMP) + gg * 128) * 2; }
    DI const char* b_ptr(const Gemm& g, const Unit& u) const { const int kv = u.pz >> 2; return (const char*)g.Bt + ((size_t)kv * 256 * 4096 + u.pk * 512) * 2; }
};

template <class Epi, class Sched, bool IM2COL = false, bool ALIGN_EPI = false, bool SP2 = false>
DI void gemm_phase(LAS unsigned char* lds, const Gemm g, const Sched& S, const Epi& E, const int tid) {
    const int wid = __builtin_amdgcn_readfirstlane(tid >> 6), lane = tid & 63, wr = wid >> 2, wc = wid & 3, fr = lane & 15, fq = lane >> 4;
    const int nt = g.K / BK;
    unsigned voffA[2], voffB[2];
#pragma unroll
    for (int i = 0; i < 2; ++i) { int R, C; stage_rc(tid * 16 + i * 8192, R, C); const int Rb = Epi::PERM ? ((R >> 5) * 64 + perm32(R & 31)) : R;
        voffA[i] = (unsigned)(R * g.lda + C) * 2u; voffB[i] = (unsigned)(Rb * g.ldb + C) * 2u; }
    const size_t hstepA = (size_t)HALF * g.lda * 2, hstepB = (size_t)(Epi::PERM ? 32 : HALF) * g.ldb * 2;
    const unsigned ldsw = (unsigned)wid * 1024u;
    const int aoff = lds_byte(wr * 64 + fr, fq * 8), boff = lds_byte(wc * 32 + fr, fq * 8);
#define PG8_KA(kt) (IM2COL ? ((size_t)((kt) >> 1) * (NP * 2) + (size_t)((kt) & 1) * 128) : (size_t)(kt) * 128)
#define PG8_KB(kt) ((size_t)(kt) * 128)
#define PG8_SA(b, h) (((b) * 2 + (h)) * HTB)
#define PG8_SB(b, h) ((4 + (b) * 2 + (h)) * HTB)
#define PG8_STAGE(bufoff, gbase, voff) do { _Pragma("unroll") for (int _i = 0; _i < 2; ++_i) \
        __builtin_amdgcn_global_load_lds((const unsigned*)((const char*)(gbase) + (voff)[_i]), (LAS unsigned*)(lds + (bufoff) + ldsw + _i * 8192), 16, 0, 0); } while (0)
#define PG8_LDA(dst, b, h) do { _Pragma("unroll") for (int m = 0; m < 4; ++m) _Pragma("unroll") for (int k = 0; k < 2; ++k) dst[m][k] = *(const LAS bf16x8*)(lds + PG8_SA(b, h) + aoff + m * 2048 + k * 1024); } while (0)
#define PG8_LDB(dst, b, h) do { _Pragma("unroll") for (int n = 0; n < 2; ++n) _Pragma("unroll") for (int k = 0; k < 2; ++k) dst[n][k] = *(const LAS bf16x8*)(lds + PG8_SB(b, h) + boff + n * 2048 + k * 1024); } while (0)
#define PG8_MMA(ai, bj, At, Bt) do { __builtin_amdgcn_s_setprio(1); _Pragma("unroll") for (int m = 0; m < 4; ++m) _Pragma("unroll") for (int n = 0; n < 2; ++n) _Pragma("unroll") for (int k = 0; k < 2; ++k) \
        acc[ai][bj][m][n] = __builtin_amdgcn_mfma_f32_16x16x32_bf16(Bt[n][k], At[m][k], acc[ai][bj][m][n], 0, 0, 0); __builtin_amdgcn_s_setprio(0); } while (0)
#define PG8_WAIT_V(n) asm volatile("s_waitcnt vmcnt(" #n ")" ::: "memory")
#define PG8_WAIT_L(n) asm volatile("s_waitcnt lgkmcnt(" #n ")" ::: "memory")
#define PG8_BAR __builtin_amdgcn_s_barrier()
#define PG8_SCHED __builtin_amdgcn_sched_barrier(0)
    Unit cur, nxt; int ui = 0; int nsig = 0; (void)nsig;
    if (!S.next(0, cur)) return;
    f32x4 acc[2][2][4][2];
#pragma unroll
    for (int a = 0; a < 2; ++a)
#pragma unroll
        for (int b = 0; b < 2; ++b)
#pragma unroll
            for (int m = 0; m < 4; ++m)
#pragma unroll
                for (int n = 0; n < 2; ++n) acc[a][b][m][n] = (f32x4){0.f, 0.f, 0.f, 0.f};
    bf16x8 At[4][2], B0[2][2], B1[2][2];
    const char* cA = S.a_ptr(g, cur); const char* cB = S.b_ptr(g, cur);
    if constexpr (SP2) {
        PG8_STAGE(PG8_SB(0, 0), cB, voffB); PG8_STAGE(PG8_SB(0, 1), cB + hstepB, voffB); PG8_STAGE(PG8_SA(0, 0), cA, voffA); PG8_STAGE(PG8_SA(0, 1), cA + hstepA, voffA);
        if (wr == 1) PG8_BAR;
        PG8_WAIT_V(2); PG8_BAR;
        PG8_STAGE(PG8_SB(1, 0), cB + PG8_KB(1), voffB); PG8_STAGE(PG8_SA(1, 0), cA + PG8_KA(1), voffA); PG8_STAGE(PG8_SB(1, 1), cB + hstepB + PG8_KB(1), voffB);
        PG8_WAIT_V(6); PG8_BAR;
    } else {
    PG8_STAGE(PG8_SB(0, 0), cB, voffB); PG8_STAGE(PG8_SA(0, 0), cA, voffA); PG8_STAGE(PG8_SB(0, 1), cB + hstepB, voffB); PG8_STAGE(PG8_SA(0, 1), cA + hstepA, voffA);
    if (wr == 1) PG8_BAR;
    PG8_WAIT_V(4); PG8_BAR;
    PG8_STAGE(PG8_SB(1, 0), cB + PG8_KB(1), voffB); PG8_STAGE(PG8_SA(1, 0), cA + PG8_KA(1), voffA); PG8_STAGE(PG8_SB(1, 1), cB + hstepB + PG8_KB(1), voffB);
    PG8_WAIT_V(6); PG8_BAR;
    }
    for (;;) {
        const bool has_next = S.next(ui + 1, nxt);
        const char* nA = has_next ? S.a_ptr(g, nxt) : cA; const char* nB = has_next ? S.b_ptr(g, nxt) : cB;
        for (int t = 0; t < nt; t += 2) {
            const bool last = (t == nt - 2);
            const char* a1 = cA + PG8_KA(t + 1);
            const char* a2 = last ? nA : cA + PG8_KA(t + 2); const char* b2 = last ? nB : cB + PG8_KB(t + 2);
            const char* a3 = last ? nA + PG8_KA(1) : cA + PG8_KA(t + 3); const char* b3 = b2 + 128;
            if constexpr (SP2) {
            PG8_LDB(B0, 0, 0); PG8_LDB(B1, 0, 1); PG8_SCHED; PG8_LDA(At, 0, 0); PG8_STAGE(PG8_SA(1, 1), a1 + hstepA, voffA);
            PG8_WAIT_V(8); PG8_WAIT_L(0); PG8_BAR; PG8_MMA(0, 0, At, B0); PG8_MMA(0, 1, At, B1); PG8_BAR; PG8_SCHED;
            PG8_LDA(At, 0, 1); PG8_STAGE(PG8_SB(0, 0), b2, voffB); PG8_STAGE(PG8_SB(0, 1), b2 + hstepB, voffB); PG8_STAGE(PG8_SA(0, 0), a2, voffA);
            PG8_WAIT_V(8); PG8_WAIT_L(0); PG8_BAR; PG8_MMA(1, 0, At, B0); PG8_MMA(1, 1, At, B1); PG8_BAR; PG8_SCHED;
            PG8_LDB(B0, 1, 0); PG8_LDB(B1, 1, 1); PG8_SCHED; PG8_LDA(At, 1, 0); PG8_STAGE(PG8_SA(0, 1), a2 + hstepA, voffA);
            PG8_WAIT_V(8); PG8_WAIT_L(0); PG8_BAR; PG8_MMA(0, 0, At, B0); PG8_MMA(0, 1, At, B1); PG8_BAR; PG8_SCHED;
            PG8_LDA(At, 1, 1); PG8_STAGE(PG8_SB(1, 0), b3, voffB); PG8_STAGE(PG8_SB(1, 1), b3 + hstepB, voffB); PG8_STAGE(PG8_SA(1, 0), a3, voffA);
            PG8_WAIT_V(8); PG8_WAIT_L(0); PG8_BAR; PG8_MMA(1, 0, At, B0); PG8_MMA(1, 1, At, B1); PG8_BAR; PG8_SCHED;
            } else {
            PG8_LDB(B0, 0, 0); PG8_SCHED; PG8_LDA(At, 0, 0); PG8_STAGE(PG8_SA(1, 1), a1 + hstepA, voffA);
            PG8_WAIT_L(8); PG8_BAR; PG8_WAIT_L(0); PG8_MMA(0, 0, At, B0); PG8_BAR; PG8_SCHED;
            PG8_LDB(B1, 0, 1); PG8_STAGE(PG8_SB(0, 0), b2, voffB);
            PG8_BAR; PG8_WAIT_L(0); PG8_MMA(0, 1, At, B1); PG8_BAR;
            PG8_LDA(At, 0, 1); PG8_STAGE(PG8_SA(0, 0), a2, voffA);
            PG8_BAR; PG8_WAIT_L(0); PG8_MMA(1, 0, At, B0); PG8_BAR; PG8_SCHED;
            PG8_STAGE(PG8_SB(0, 1), b2 + hstepB, voffB);
            PG8_WAIT_V(6); PG8_BAR; PG8_MMA(1, 1, At, B1); PG8_BAR;
            PG8_LDB(B0, 1, 0); PG8_SCHED; PG8_LDA(At, 1, 0); PG8_STAGE(PG8_SA(0, 1), a2 + hstepA, voffA);
            PG8_WAIT_L(8); PG8_BAR; PG8_WAIT_L(0); PG8_MMA(0, 0, At, B0); PG8_BAR; PG8_SCHED;
            PG8_LDB(B1, 1, 1); PG8_STAGE(PG8_SB(1, 0), b3, voffB);
            PG8_BAR; PG8_WAIT_L(0); PG8_MMA(0, 1, At, B1); PG8_BAR;
            PG8_LDA(At, 1, 1); PG8_STAGE(PG8_SA(1, 0), a3, voffA);
            PG8_BAR; PG8_WAIT_L(0); PG8_MMA(1, 0, At, B0); PG8_BAR; PG8_SCHED;
            PG8_STAGE(PG8_SB(1, 1), b3 + hstepB, voffB);
            PG8_WAIT_V(6); PG8_BAR; PG8_MMA(1, 1, At, B1); PG8_BAR;
            }
        }
        if constexpr (ALIGN_EPI) { if (wr == 0) PG8_BAR; }
        E(acc, cur, wr, wc, fr, fq);
        if constexpr (Sched::SIGNAL) {
            nsig += cur.pz;
            if (cur.pz && !(has_next && nxt.pz)) { PG8_WAIT_V(0); PG8_BAR;
                if (tid == 0) { __builtin_amdgcn_fence(__ATOMIC_RELEASE, "agent"); PG8_WAIT_V(0); (void)__hip_atomic_fetch_add(S.sig, (unsigned)nsig, __ATOMIC_RELAXED, __HIP_MEMORY_SCOPE_AGENT); }
                nsig = 0; } }
        if (!has_next) break;
#pragma unroll
        for (int a = 0; a < 2; ++a)
#pragma unroll
            for (int b = 0; b < 2; ++b)
#pragma unroll
                for (int m = 0; m < 4; ++m)
#pragma unroll
                    for (int n = 0; n < 2; ++n) acc[a][b][m][n] = (f32x4){0.f, 0.f, 0.f, 0.f};
        cur = nxt; cA = nA; cB = nB; ++ui;
        if constexpr (ALIGN_EPI) { if (wr == 1) PG8_BAR; }
    }
    PG8_WAIT_V(0);
    if constexpr (!ALIGN_EPI) { if (wr == 0) PG8_BAR; }
    PG8_BAR;
#undef PG8_KA
#undef PG8_KB
#undef PG8_SA
#undef PG8_SB
#undef PG8_STAGE
#undef PG8_LDA
#undef PG8_LDB
#undef PG8_MMA
#undef PG8_WAIT_V
#undef PG8_WAIT_L
#undef PG8_BAR
#undef PG8_SCHED
}

struct EpiCols {
    static constexpr bool PERM = true;
    bf16_t* O; int ldc;
    DI void operator()(const f32x4 (&acc)[2][2][4][2], const Unit& u, int wr, int wc, int fr, int fq) const {
        const bool lo = fr < 8;
        bf16_t* base = O + (size_t)(u.pm * BM + wr * 64 + (fr & 7)) * ldc + u.pn * BM + wc * 64 + 8 * fq + (lo ? 0 : 32);
#pragma unroll
        for (int ai = 0; ai < 2; ++ai)
#pragma unroll
            for (int m = 0; m < 4; ++m) { bf16_t* rowp = base + (size_t)(ai * HALF + m * 16) * ldc;
                u32x4 w[2];
#pragma unroll
                for (int bj = 0; bj < 2; ++bj) { const f32x4 v0 = acc[ai][bj][m][0], v1 = acc[ai][bj][m][1];
                    w[bj].x = cvt_pk_bf16(v0[0], v0[1]); w[bj].y = cvt_pk_bf16(v0[2], v0[3]); w[bj].z = cvt_pk_bf16(v1[0], v1[1]); w[bj].w = cvt_pk_bf16(v1[2], v1[3]); }
                u32x4 snd, rcv;
#pragma unroll
                for (int e = 0; e < 4; ++e) { snd[e] = lo ? w[1][e] : w[0][e]; rcv[e] = (unsigned)__builtin_amdgcn_update_dpp(0, (int)snd[e], 0x128, 0xf, 0xf, false); }
                u32x4 sa, sb;
#pragma unroll
                for (int e = 0; e < 4; ++e) { sa[e] = lo ? w[0][e] : rcv[e]; sb[e] = lo ? rcv[e] : w[1][e]; }
                *(u32x4*)rowp = sa; *(u32x4*)(rowp + (size_t)8 * ldc) = sb; }
    }
};
struct EpiPart {
    static constexpr bool PERM = false;
    float* P;
    DI void operator()(const f32x4 (&acc)[2][2][4][2], const Unit& u, int wr, int wc, int fr, int fq) const {
        float* base = P + ((size_t)(u.pk * 8 + u.pz) * 512 + u.pm * BM) * 256;
        const int row0 = wr * 64 + fr, col0 = wc * 32 + 4 * fq;
#pragma unroll
        for (int ai = 0; ai < 2; ++ai)
#pragma unroll
            for (int m = 0; m < 4; ++m) { float* rowp = base + (size_t)(row0 + ai * HALF + m * 16) * 256 + col0;
#pragma unroll
                for (int bj = 0; bj < 2; ++bj)
#pragma unroll
                    for (int n = 0; n < 2; ++n) *(f32x4*)(rowp + bj * HALF + n * 16) = acc[ai][bj][m][n]; }
    }
};
struct EpiGateTmp {
    static constexpr bool PERM = true;
    float* O; const bf16_t* gate;
    DI void operator()(const f32x4 (&acc)[2][2][4][2], const Unit& u, int wr, int wc, int fr, int fq) const {
        const int row0 = u.pm * BM + wr * 64 + fr, col0 = u.pn * BM + wc * 64 + 8 * fq;
#pragma unroll
        for (int ai = 0; ai < 2; ++ai)
#pragma unroll
            for (int m = 0; m < 4; ++m) { const int row = row0 + ai * HALF + m * 16;
#pragma unroll
                for (int bj = 0; bj < 2; ++bj) { const u32x4 gw = *(const u32x4*)(gate + (size_t)row * NP + col0 + bj * 32);
                    const f32x4 v0 = acc[ai][bj][m][0], v1 = acc[ai][bj][m][1]; f32x4 o0, o1;
                    o0[0] = v0[0] * sigmoidf_(lo_bf(gw.x)); o0[1] = v0[1] * sigmoidf_(hi_bf(gw.x)); o0[2] = v0[2] * sigmoidf_(lo_bf(gw.y)); o0[3] = v0[3] * sigmoidf_(hi_bf(gw.y));
                    o1[0] = v1[0] * sigmoidf_(lo_bf(gw.z)); o1[1] = v1[1] * sigmoidf_(hi_bf(gw.z)); o1[2] = v1[2] * sigmoidf_(lo_bf(gw.w)); o1[3] = v1[3] * sigmoidf_(hi_bf(gw.w));
                    float* op = O + (size_t)row * D + col0 + bj * 32; *(f32x4*)op = o0; *(f32x4*)(op + 4) = o1; }
                asm volatile("" ::: "memory"); }
    }
};
struct EpiGateAdd {
    static constexpr bool PERM = true;
    bf16_t* Y; const float* tmp; const bf16_t* gate;
    DI void operator()(const f32x4 (&acc)[2][2][4][2], const Unit& u, int wr, int wc, int fr, int fq) const {
        const int row0 = u.pm * BM + wr * 64 + fr, col0 = u.pn * BM + wc * 64 + 8 * fq;
#pragma unroll
        for (int ai = 0; ai < 2; ++ai)
#pragma unroll
            for (int m = 0; m < 4; ++m) { const int row = row0 + ai * HALF + m * 16;
#pragma unroll
                for (int bj = 0; bj < 2; ++bj) { const u32x4 gw = *(const u32x4*)(gate + (size_t)row * NP + col0 + bj * 32);
                    const float* tp = tmp + (size_t)row * D + col0 + bj * 32; const f32x4 t0 = *(const f32x4*)tp, t1 = *(const f32x4*)(tp + 4);
                    const f32x4 v0 = acc[ai][bj][m][0], v1 = acc[ai][bj][m][1]; f32x4 o0, o1;
                    o0[0] = t0[0] + v0[0] * sigmoidf_(lo_bf(gw.x)); o0[1] = t0[1] + v0[1] * sigmoidf_(hi_bf(gw.x)); o0[2] = t0[2] + v0[2] * sigmoidf_(lo_bf(gw.y)); o0[3] = t0[3] + v0[3] * sigmoidf_(hi_bf(gw.y));
                    o1[0] = t1[0] + v1[0] * sigmoidf_(lo_bf(gw.z)); o1[1] = t1[1] + v1[1] * sigmoidf_(hi_bf(gw.z)); o1[2] = t1[2] + v1[2] * sigmoidf_(lo_bf(gw.w)); o1[3] = t1[3] + v1[3] * sigmoidf_(hi_bf(gw.w));
                    u32x4 w; w.x = cvt_pk_bf16(o0[0], o0[1]); w.y = cvt_pk_bf16(o0[2], o0[3]); w.z = cvt_pk_bf16(o1[0], o1[1]); w.w = cvt_pk_bf16(o1[2], o1[3]);
                    *(u32x4*)(Y + (size_t)row * D + col0 + bj * 32) = w; }
                asm volatile("" ::: "memory"); }
    }
};
struct EpiResid {
    static constexpr bool PERM = true;
    const float* xf; const bf16_t* xb; bf16_t* xo;
    DI void operator()(const f32x4 (&acc)[2][2][4][2], const Unit& u, int wr, int wc, int fr, int fq) const {
        const int row0 = u.pm * BM + wr * 64 + fr, col0 = u.pn * BM + wc * 64 + 8 * fq;
#pragma unroll
        for (int ai = 0; ai < 2; ++ai) {
            if (xf) { f32x4 t[4][2][2];
#pragma unroll
                for (int m = 0; m < 4; ++m) { const size_t off = (size_t)(row0 + ai * HALF + m * 16) * D + col0;
#pragma unroll
                    for (int bj = 0; bj < 2; ++bj) { t[m][bj][0] = *(const f32x4*)(xf + off + bj * 32); t[m][bj][1] = *(const f32x4*)(xf + off + bj * 32 + 4); } }
#pragma unroll
                for (int m = 0; m < 4; ++m) { const size_t off = (size_t)(row0 + ai * HALF + m * 16) * D + col0;
#pragma unroll
                    for (int bj = 0; bj < 2; ++bj) { const f32x4 o0 = t[m][bj][0] + acc[ai][bj][m][0], o1 = t[m][bj][1] + acc[ai][bj][m][1];
                        u32x4 w; w.x = pk2h(o0[0], o0[1]); w.y = pk2h(o0[2], o0[3]); w.z = pk2h(o1[0], o1[1]); w.w = pk2h(o1[2], o1[3]);
                        *(u32x4*)(xo + off + bj * 32) = w; } }
            } else { u32x4 t[4][2];
#pragma unroll
                for (int m = 0; m < 4; ++m) { const size_t off = (size_t)(row0 + ai * HALF + m * 16) * D + col0;
#pragma unroll
                    for (int bj = 0; bj < 2; ++bj) t[m][bj] = *(const u32x4*)(xb + off + bj * 32); }
#pragma unroll
                for (int m = 0; m < 4; ++m) { const size_t off = (size_t)(row0 + ai * HALF + m * 16) * D + col0;
#pragma unroll
                    for (int bj = 0; bj < 2; ++bj) { const u32x4 x_ = t[m][bj]; const f32x4 v0 = acc[ai][bj][m][0], v1 = acc[ai][bj][m][1];
                        u32x4 w; w.x = pk2h(lo_h(x_.x) + v0[0], hi_h(x_.x) + v0[1]); w.y = pk2h(lo_h(x_.y) + v0[2], hi_h(x_.y) + v0[3]);
                        w.z = pk2h(lo_h(x_.z) + v1[0], hi_h(x_.z) + v1[1]); w.w = pk2h(lo_h(x_.w) + v1[2], hi_h(x_.w) + v1[3]);
                        *(u32x4*)(xo + off + bj * 32) = w; } } }
            asm volatile("" ::: "memory"); }
    }
};
struct OrderAB {
    static constexpr bool SIGNAL = false;
    OrderMN mn; const bf16_t* A2; const bf16_t* B2;
    DI bool next(int i, Unit& u) const { if (!mn.next(i >> 1, u)) return false; u.pz = i & 1; return true; }
    DI const char* a_ptr(const Gemm& g, const Unit& u) const { return (const char*)(u.pz ? A2 : g.A) + (size_t)u.pm * BM * g.lda * 2; }
    DI const char* b_ptr(const Gemm& g, const Unit& u) const { return (const char*)(u.pz ? B2 : g.Bt) + (size_t)u.pn * BM * g.ldb * 2; }
};
struct EpiGateAB {
    static constexpr bool PERM = true;
    bf16_t* Y; bf16_t* tmp; const bf16_t* gate_a; const bf16_t* gate_b;
    DI void operator()(const f32x4 (&acc)[2][2][4][2], const Unit& u, int wr, int wc, int fr, int fq) const {
        const int row0 = u.pm * BM + wr * 64 + fr, col0 = u.pn * BM + wc * 64 + 8 * fq;
        const bf16_t* gate = u.pz ? gate_b : gate_a; bf16_t* dst = u.pz ? Y : tmp;
#pragma unroll
        for (int ai = 0; ai < 2; ++ai) { u32x4 gw[4][2], tw[4][2];
#pragma unroll
            for (int m = 0; m < 4; ++m) { const int row = row0 + ai * HALF + m * 16;
#pragma unroll
                for (int bj = 0; bj < 2; ++bj) { gw[m][bj] = *(const u32x4*)(gate + (size_t)row * NP + col0 + bj * 32);
                    tw[m][bj] = (u32x4){0u, 0u, 0u, 0u}; if (u.pz) tw[m][bj] = *(const u32x4*)(tmp + (size_t)row * D + col0 + bj * 32); } }
#pragma unroll
            for (int m = 0; m < 4; ++m) { const int row = row0 + ai * HALF + m * 16;
#pragma unroll
                for (int bj = 0; bj < 2; ++bj) { const u32x4 g_ = gw[m][bj], t_ = tw[m][bj];
                    const f32x4 v0 = acc[ai][bj][m][0], v1 = acc[ai][bj][m][1]; f32x4 o0, o1;
                    o0[0] = lo_bf(t_.x) + v0[0] * sigmoidf_(lo_bf(g_.x)); o0[1] = hi_bf(t_.x) + v0[1] * sigmoidf_(hi_bf(g_.x)); o0[2] = lo_bf(t_.y) + v0[2] * sigmoidf_(lo_bf(g_.y)); o0[3] = hi_bf(t_.y) + v0[3] * sigmoidf_(hi_bf(g_.y));
                    o1[0] = lo_bf(t_.z) + v1[0] * sigmoidf_(lo_bf(g_.z)); o1[1] = hi_bf(t_.z) + v1[1] * sigmoidf_(hi_bf(g_.z)); o1[2] = lo_bf(t_.w) + v1[2] * sigmoidf_(lo_bf(g_.w)); o1[3] = hi_bf(t_.w) + v1[3] * sigmoidf_(hi_bf(g_.w));
                    u32x4 w; w.x = cvt_pk_bf16(o0[0], o0[1]); w.y = cvt_pk_bf16(o0[2], o0[3]); w.z = cvt_pk_bf16(o1[0], o1[1]); w.w = cvt_pk_bf16(o1[2], o1[3]);
                    *(u32x4*)(dst + (size_t)row * D + col0 + bj * 32) = w; } }
            asm volatile("" ::: "memory"); }
    }
};
}

#define XB_TMO      128
#define XB_XCNT(j)  (256  + 64 * (j))
#define XB_XSUB(j)  (1280 + 64 * (j))
#define XB_XGEN(j)  (2304 + 64 * (j))
#define XB_TOP      3328
#define XB_TOPGEN   3392
#define XCD_BAR_WORDS 3456
#define XB_SPIN_CAP (1u << 18)
__device__ __forceinline__ unsigned xb_ld(unsigned* p)              { return __hip_atomic_load(p, __ATOMIC_RELAXED, __HIP_MEMORY_SCOPE_AGENT); }
__device__ __forceinline__ unsigned xb_add(unsigned* p, unsigned v) { return __hip_atomic_fetch_add(p, v, __ATOMIC_RELAXED, __HIP_MEMORY_SCOPE_AGENT); }
__device__ __forceinline__ unsigned xb_xcc_id() { return (unsigned)__builtin_amdgcn_s_getreg((3 << 11) | 20) & 0xFu; }
#define XB_SPIN(cond, bar) do { unsigned _sp = 0; while (cond) { __builtin_amdgcn_s_sleep(1); \
    if ((++_sp & 255u) == 0u) { if (xb_ld(&(bar)[XB_TMO])) break; if (_sp > XB_SPIN_CAP) { atomicAdd(&(bar)[XB_TMO], 1u); break; } } } } while (0)
struct XcdBarrier { unsigned* bar; unsigned x; volatile LAS unsigned* st; };
__device__ __forceinline__ XcdBarrier xcd_barrier_post(unsigned* bar, volatile LAS unsigned* st) {
    XcdBarrier b; b.bar = bar; b.x = xb_xcc_id(); b.st = st;
    if (threadIdx.x == 0) (void)xb_add(&bar[XB_XCNT(b.x)], 1u);
    return b;
}
__device__ __forceinline__ void xcd_barrier_complete(unsigned* bar, unsigned x, unsigned& nloc, unsigned& nx) {
    const unsigned G = gridDim.x * gridDim.y * gridDim.z;
    unsigned sum, cnt, mine, sp = 0u;
    for (;;) {
        sum = 0u; cnt = 0u; mine = 0u;
#pragma unroll
        for (unsigned j = 0; j < 16; ++j) { const unsigned c = xb_ld(&bar[XB_XCNT(j)]); sum += c; cnt += (c > 0u) ? 1u : 0u; mine = (j == x) ? c : mine; }
        if (sum == G) break;
        __builtin_amdgcn_s_sleep(1);
        if ((++sp & 255u) == 0u) { if (xb_ld(&bar[XB_TMO])) break; if (sp > XB_SPIN_CAP) { atomicAdd(&bar[XB_TMO], 1u); break; } }
    }
    nloc = mine > 0u ? mine : 1u; nx = cnt > 0u ? cnt : 1u;
}
__device__ __forceinline__ void xcd_barrier(const XcdBarrier& b) {
    asm volatile("s_waitcnt vmcnt(0)" ::: "memory");
    __syncthreads();
    if (threadIdx.x == 0) {
        unsigned* bar = b.bar;
        __builtin_amdgcn_s_waitcnt(0);
        unsigned nloc = b.st[0], nx = b.st[1];
        if (nloc == 0u) { xcd_barrier_complete(bar, b.x, nloc, nx); b.st[0] = nloc; b.st[1] = nx; }
        const unsigned old = xb_add(&bar[XB_XSUB(b.x)], 1u);
        const unsigned gen = old / nloc;
        if (old + 1u == (gen + 1u) * nloc) {
            __builtin_amdgcn_fence(__ATOMIC_RELEASE, "agent");
            asm volatile("s_waitcnt vmcnt(0)" ::: "memory");
            const unsigned og = xb_add(&bar[XB_TOP], 1u);
            const unsigned tg = og / nx;
            if (og + 1u == (tg + 1u) * nx) xb_add(&bar[XB_TOPGEN], 1u);
            else XB_SPIN(xb_ld(&bar[XB_TOPGEN]) == tg, bar);
            __builtin_amdgcn_fence(__ATOMIC_ACQUIRE, "agent");
            xb_add(&bar[XB_XGEN(b.x)], 1u);
            asm volatile("s_waitcnt vmcnt(0)" ::: "memory");
        } else {
            XB_SPIN(xb_ld(&bar[XB_XGEN(b.x)]) == gen, bar);
            __builtin_amdgcn_fence(__ATOMIC_ACQUIRE, "agent");
            asm volatile("s_waitcnt vmcnt(0)" ::: "memory");
        }
    }
    __syncthreads();
}

struct Args {
    const float *x, *norm_w, *w_in, *cmp_pe, *cmp_w1, *cmp_b1, *cmp_w2, *cmp_b2, *alpha_w, *alpha_b, *gla_norm_w, *p_a, *p_b, *w_out, *final_w;
    float* out; unsigned char* ws; int ph_lo, ph_hi;
};
typedef const __attribute__((address_space(4))) Args* KArgsP;
DI Args load_args(KArgsP p) { Args a; a.x = p->x; a.norm_w = p->norm_w; a.w_in = p->w_in; a.cmp_pe = p->cmp_pe; a.cmp_w1 = p->cmp_w1; a.cmp_b1 = p->cmp_b1; a.cmp_w2 = p->cmp_w2; a.cmp_b2 = p->cmp_b2;
    a.alpha_w = p->alpha_w; a.alpha_b = p->alpha_b; a.gla_norm_w = p->gla_norm_w; a.p_a = p->p_a; a.p_b = p->p_b; a.w_out = p->w_out; a.final_w = p->final_w; a.out = p->out; a.ws = p->ws; a.ph_lo = 0; a.ph_hi = 0; return a; }
struct Frame {
    LAS unsigned char* lds; int tid, lane, wave, G, bid, gw, NGW;
};

struct CvItem { const float* W; bf16_t* WT; int K, N, item; bool map; };
DI void cv_load(f32x4 (&v)[16], const CvItem& c, int lane) {
    const int nblk = c.N / 64, kb = c.item / nblk, nb = c.item % nblk, k0 = 64 * kb, n0 = 64 * nb;
#pragma unroll
    for (int i = 0; i < 16; ++i) v[i] = *(const f32x4*)(c.W + (size_t)(k0 + 4 * i + (lane >> 4)) * c.N + n0 + 4 * (lane & 15));
}
DI void cv_store(const f32x4 (&v)[16], const CvItem& c, LAS float* scr, int lane) {
    const int nblk = c.N / 64, kb = c.item / nblk, nb = c.item % nblk, k0 = 64 * kb, n0 = 64 * nb;
#pragma unroll
    for (int i = 0; i < 16; ++i) { LAS float* d = scr + (4 * i + (lane >> 4)) * 65 + 4 * (lane & 15); d[0] = v[i].x; d[1] = v[i].y; d[2] = v[i].z; d[3] = v[i].w; }
    LDS_WAIT(); asm volatile("" ::: "memory");
    const int ch = lane & 7;
#pragma unroll
    for (int j = 0; j < 8; ++j) { const int n = (lane >> 3) + 8 * j; const LAS float* s = scr + (8 * ch) * 65 + n;
        u32x4 o; o.x = pk2(s[0 * 65], s[1 * 65]); o.y = pk2(s[2 * 65], s[3 * 65]); o.z = pk2(s[4 * 65], s[5 * 65]); o.w = pk2(s[6 * 65], s[7 * 65]);
        const int drow = c.map ? map_col(n0 + n) : (n0 + n);
        *(u32x4*)(c.WT + (size_t)drow * c.K + k0 + 8 * ch) = o; }
    LDS_WAIT(); asm volatile("" ::: "memory");
}
constexpr int CV_IN = (D / 64) * (NIN / 64), CV_SQ = (D / 64) * (D / 64), CV_W1 = (4096 / 64) * (256 / 64), CV_W2 = (256 / 64) * (128 / 64);
constexpr int CV_PER_L = CV_IN + 3 * CV_SQ + 2 * CV_W1 + 2 * CV_W2;
DI CvItem cv_item(const Args& a, int it) {
    unsigned char* ws = a.ws; const int l = it / CV_PER_L; int r = it % CV_PER_L; CvItem c;
    if (r < CV_IN) { c.W = a.w_in + (size_t)l * D * NIN; c.WT = (bf16_t*)(ws + WS_WIN) + (size_t)l * NP * D; c.K = D; c.N = NIN; c.item = r; c.map = true; return c; } r -= CV_IN;
    c.map = false;
    if (r < CV_SQ) { c.W = a.p_a + (size_t)l * D * D; c.WT = (bf16_t*)(ws + WS_WPA) + (size_t)l * D * D; c.K = D; c.N = D; c.item = r; return c; } r -= CV_SQ;
    if (r < CV_SQ) { c.W = a.p_b + (size_t)l * D * D; c.WT = (bf16_t*)(ws + WS_WPB) + (size_t)l * D * D; c.K = D; c.N = D; c.item = r; return c; } r -= CV_SQ;
    if (r < CV_SQ) { c.W = a.w_out + (size_t)l * D * D; c.WT = (bf16_t*)(ws + WS_WOUT) + (size_t)l * D * D; c.K = D; c.N = D; c.item = r; return c; } r -= CV_SQ;
    if (r < 2 * CV_W1) { const int kv = r / CV_W1; c.W = a.cmp_w1 + (size_t)(l * 2 + kv) * 4096 * 256; c.WT = (bf16_t*)(ws + WS_W1T) + (size_t)(l * 2 + kv) * 256 * 4096; c.K = 4096; c.N = 256; c.item = r % CV_W1; return c; } r -= 2 * CV_W1;
    { const int kv = r / CV_W2; c.W = a.cmp_w2 + (size_t)(l * 2 + kv) * 256 * 128; c.WT = (bf16_t*)(ws + WS_W2T) + (size_t)(l * 2 + kv) * 128 * 256; c.K = 256; c.N = 128; c.item = r % CV_W2; }
    return c;
}
DI void p_prologue(const Frame& F, const Args& a) {
    LAS float* scr = (LAS float*)(F.lds + F.wave * 16640);
    unsigned char* ws = a.ws;
    constexpr int TOT = DEPTH * CV_PER_L;
    f32x4 va[16], vb[16];
    int it = F.gw;
    if (it < TOT) { CvItem ca = cv_item(a, it); cv_load(va, ca, F.lane);
        for (;;) {
            const int itb = it + F.NGW; CvItem cb; const bool hb = itb < TOT; if (hb) { cb = cv_item(a, itb); cv_load(vb, cb, F.lane); }
            cv_store(va, ca, scr, F.lane);
            if (!hb) break;
            const int itc = itb + F.NGW; const bool hc = itc < TOT; if (hc) { ca = cv_item(a, itc); cv_load(va, ca, F.lane); }
            cv_store(vb, cb, scr, F.lane);
            if (!hc) break;
            it = itc;
        } }
    __syncthreads();
    LAS float* red = (LAS float*)F.lds;
    for (int job = F.bid; job < DEPTH * 2; job += F.G) {
        const float* w1 = a.cmp_w1 + (size_t)job * 4096 * 256; const float* pe = a.cmp_pe + (size_t)job * 4096;
        f32x4 s = {0.f, 0.f, 0.f, 0.f};
        for (int k = F.wave * 512; k < F.wave * 512 + 512; ++k) { const f32x4 w = *(const f32x4*)(w1 + (size_t)k * 256 + 4 * F.lane); s += w * pe[k]; }
        *(LAS f32x4*)(red + F.wave * 256 + 4 * F.lane) = s;
        __syncthreads();
        if (F.tid < 256) { float t = a.cmp_b1[job * 256 + F.tid];
#pragma unroll
            for (int w = 0; w < 8; ++w) t += red[w * 256 + F.tid];
            ((float*)(ws + WS_B1P))[job * 256 + F.tid] = t; }
        __syncthreads();
    }
}

template <bool OUT_F32, bool IN_BF16>
DI void p_rmsnorm(const Frame& F, const void* xin, const float* w, void* out) {
    f32x4 wv[4][2];
#pragma unroll
    for (int j = 0; j < 4; ++j) { wv[j][0] = *(const f32x4*)(w + 512 * j + 8 * F.lane); wv[j][1] = *(const f32x4*)(w + 512 * j + 8 * F.lane + 4); }
    for (int row = F.gw; row < T; row += F.NGW) {
        float v[4][8]; float s = 0.f;
        if (IN_BF16) { const bf16_t* xr = (const bf16_t*)xin + (size_t)row * D + 8 * F.lane; u32x4 q[4];
#pragma unroll
            for (int j = 0; j < 4; ++j) q[j] = *(const u32x4*)(xr + 512 * j);
#pragma unroll
            for (int j = 0; j < 4; ++j) unpack8h(q[j], v[j]);
        } else { const float* xr = (const float*)xin + (size_t)row * D + 8 * F.lane; f32x4 q[4][2];
#pragma unroll
            for (int j = 0; j < 4; ++j) { q[j][0] = *(const f32x4*)(xr + 512 * j); q[j][1] = *(const f32x4*)(xr + 512 * j + 4); }
#pragma unroll
            for (int j = 0; j < 4; ++j)
#pragma unroll
                for (int e = 0; e < 8; ++e) v[j][e] = q[j][e >> 2][e & 3]; }
#pragma unroll
        for (int j = 0; j < 4; ++j) s += ((v[j][0] * v[j][0] + v[j][1] * v[j][1]) + (v[j][2] * v[j][2] + v[j][3] * v[j][3])) + ((v[j][4] * v[j][4] + v[j][5] * v[j][5]) + (v[j][6] * v[j][6] + v[j][7] * v[j][7]));
        const float rs = rsqrtf(wave_sum(s, F.lane) * (1.f / D) + NORM_EPS);
        if (OUT_F32) { float* o = (float*)out + (size_t)row * D + 8 * F.lane;
#pragma unroll
            for (int j = 0; j < 4; ++j) { f32x4 y0, y1;
#pragma unroll
                for (int e = 0; e < 4; ++e) { y0[e] = v[j][e] * rs * wv[j][0][e]; y1[e] = v[j][4 + e] * rs * wv[j][1][e]; }
                *(f32x4*)(o + 512 * j) = y0; *(f32x4*)(o + 512 * j + 4) = y1; }
        } else { bf16_t* o = (bf16_t*)out + (size_t)row * D + 8 * F.lane;
#pragma unroll
            for (int j = 0; j < 4; ++j) { float y[8];
#pragma unroll
                for (int e = 0; e < 8; ++e) y[e] = v[j][e] * rs * wv[j][e >> 2][e & 3];
                u32x4 p; p.x = pk2(y[0], y[1]); p.y = pk2(y[2], y[3]); p.z = pk2(y[4], y[5]); p.w = pk2(y[6], y[7]); *(u32x4*)(o + 512 * j) = p; } }
    }
}

constexpr int KTILE = 16384, VTILE = 16384, ABUF = KTILE + VTILE;
DI void glds16(const void* gsrc, LAS unsigned char* dst) { unsigned keep; const unsigned lds_dst = (unsigned)(uintptr_t)dst;
    asm volatile("s_mov_b32 %0, m0\n\ts_mov_b32 m0, %2\n\ts_nop 0\n\tglobal_load_lds_dwordx4 %1, off\n\ts_mov_b32 m0, %0" : "=&s"(keep) : "v"(gsrc), "s"(lds_dst) : "memory"); }
DI void dma_k(LAS unsigned char* kb, const bf16_t* kbase, size_t kpitch, int w, int lane) {
#pragma unroll
    for (int i = 0; i < 2; ++i) { const int b = w + 8 * i, row = 4 * b + (lane >> 4), c = (lane & 15) ^ (row & 15);
        glds16(kbase + (size_t)row * kpitch + c * 8, kb + b * 1024); }
}
DI void dma_v(LAS unsigned char* vb, const bf16_t* vbase, size_t vpitch, int w, int lane) {
#pragma unroll
    for (int i = 0; i < 2; ++i) { const int b = w + 8 * i, row = 8 * b + (lane >> 3), c = (lane & 7) ^ ((row >> 1) & 7);
        glds16(vbase + (size_t)row * vpitch + c * 8, vb + b * 1024); }
}
#define VMCNT(n) asm volatile("s_waitcnt vmcnt(" #n ")" ::: "memory")
#define RAW_BARRIER() do { asm volatile("" ::: "memory"); __builtin_amdgcn_s_barrier(); asm volatile("" ::: "memory"); } while (0)

template <bool PERMK>
DI void transpose64x64(const bf16_t* src, size_t pitch, bf16_t* dst, LAS unsigned char* scr, int lane) {
    u32x4 v[8];
#pragma unroll
    for (int i = 0; i < 8; ++i) { const int id = i * 64 + lane, row = id >> 3, ch = id & 7; v[i] = *(const u32x4*)(src + (size_t)row * pitch + ch * 8); }
#pragma unroll
    for (int i = 0; i < 8; ++i) { const int id = i * 64 + lane, row = id >> 3, ch = id & 7;
        const int pos = PERMK ? ((row & 32) | (((row >> 2) & 3) << 3) | (((row >> 4) & 1) << 2) | (row & 3)) : row;
        LAS unsigned char* d = scr + (8 * ch) * 136 + pos * 2;
        *(LAS unsigned short*)(d + 0 * 136) = (unsigned short)(v[i].x & 0xffffu); *(LAS unsigned short*)(d + 1 * 136) = (unsigned short)(v[i].x >> 16);
        *(LAS unsigned short*)(d + 2 * 136) = (unsigned short)(v[i].y & 0xffffu); *(LAS unsigned short*)(d + 3 * 136) = (unsigned short)(v[i].y >> 16);
        *(LAS unsigned short*)(d + 4 * 136) = (unsigned short)(v[i].z & 0xffffu); *(LAS unsigned short*)(d + 5 * 136) = (unsigned short)(v[i].z >> 16);
        *(LAS unsigned short*)(d + 6 * 136) = (unsigned short)(v[i].w & 0xffffu); *(LAS unsigned short*)(d + 7 * 136) = (unsigned short)(v[i].w >> 16); }
    LDS_WAIT(); asm volatile("" ::: "memory");
#pragma unroll
    for (int i = 0; i < 8; ++i) { const int id = i * 64 + lane, col = id >> 3, tg = id & 7;
        const u32x2 lo = *(const LAS u32x2*)(scr + col * 136 + tg * 16), hi = *(const LAS u32x2*)(scr + col * 136 + tg * 16 + 8);
        u32x4 o; o.x = lo.x; o.y = lo.y; o.z = hi.x; o.w = hi.y;
        *(u32x4*)(dst + (size_t)col * 64 + 8 * tg) = o; }
    LDS_WAIT(); asm volatile("" ::: "memory");
}

DI void gla_g1_unit(const Frame& F, const Args& a, int layer, int n, int h) {
    const bf16_t* cols = (const bf16_t*)(a.ws + WS_COLS);
    LAS float* alr = (LAS float*)(F.lds); LAS float* part = (LAS float*)(F.lds + 4096);
    LAS unsigned char* QR = F.lds + 8192; LAS unsigned char* KR = F.lds + 8192 + 32768;
    __syncthreads();
#pragma unroll
    for (int hf = 0; hf < 2; ++hf) { dma_k(QR + hf * 16384, cols + (size_t)(64 * n) * NP + C_QB + h * 256 + hf * 128, NP, F.wave, F.lane);
        dma_k(KR + hf * 16384, cols + (size_t)(64 * n) * NP + C_KB + h * 256 + hf * 128, NP, F.wave, F.lane); }
    if (F.tid < 256) { const int t = F.tid >> 2, k4 = (F.tid & 3) * 4; const u32x2 w = *(const u32x2*)(cols + (size_t)(64 * n + t) * NP + C_ALR + k4);
        alr[t * 16 + k4 + 0] = lo_bf(w.x); alr[t * 16 + k4 + 1] = hi_bf(w.x); alr[t * 16 + k4 + 2] = lo_bf(w.y); alr[t * 16 + k4 + 3] = hi_bf(w.y); }
    __syncthreads();
    const int d = F.tid & 255, half = F.tid >> 8, col = h * 256 + d;
    float w[16];
#pragma unroll
    for (int k = 0; k < 16; ++k) w[k] = a.alpha_w[(size_t)(layer * 16 + k) * 1024 + col];
    const float b = a.alpha_b[layer * 1024 + col];
    float cum[32]; float run = 0.f;
#pragma unroll
    for (int i = 0; i < 32; ++i) { const int t = half * 32 + i; float ga = b;
#pragma unroll
        for (int k4 = 0; k4 < 4; ++k4) { const f32x4 av = *(const LAS f32x4*)(alr + t * 16 + 4 * k4); ga += av.x * w[4 * k4] + av.y * w[4 * k4 + 1] + av.z * w[4 * k4 + 2] + av.w * w[4 * k4 + 3]; }
        const float ls = fminf(ga, 0.f) - __logf(1.f + __expf(-fabsf(ga)));
        run += ls * 0.0625f; cum[i] = run; }
    part[half * 256 + d] = run;
    VMCNT(0);
    __syncthreads();
    const float p0 = part[d], last = p0 + part[256 + d], elast = __expf(last);
    if (half) {
#pragma unroll
        for (int i = 0; i < 32; ++i) cum[i] += p0; }
    bf16_t* kst = (bf16_t*)(a.ws + WS_KST);
    const int eoff = (d >> 7) * 16384 + (d & 7) * 2, ech = (d & 127) >> 3;
    unsigned ksw[16];
#pragma unroll
    for (int i = 0; i < 32; ++i) { const int t = half * 32 + i; const int off = eoff + t * 256 + ((ech ^ (t & 15)) << 4);
        const float qv = bf2f(*(const LAS unsigned short*)(QR + off)), kv = bf2f(*(const LAS unsigned short*)(KR + off));
        const float ec = __expf(cum[i]), kin = kv * __expf(-cum[i]);
        const unsigned qb = f2bf(qv * 0.0625f * ec), kib = f2bf(kin), ksb = f2bf(kin * elast);
        *(LAS unsigned short*)(QR + off) = (unsigned short)qb; *(LAS unsigned short*)(KR + off) = (unsigned short)kib;
        if (i & 1) ksw[i >> 1] |= ksb << 16; else ksw[i >> 1] = ksb; }
    { bf16_t* kp = kst + ((size_t)((n * 4 + h) * 256 + d)) * 64 + half * 32;
#pragma unroll
        for (int j = 0; j < 4; ++j) { u32x4 o; o.x = ksw[4 * j]; o.y = ksw[4 * j + 1]; o.z = ksw[4 * j + 2]; o.w = ksw[4 * j + 3]; *(u32x4*)(kp + 8 * j) = o; } }
    if (half == 0) ((float*)(a.ws + WS_DEC))[(n * 4 + h) * 256 + d] = elast;
    __syncthreads();
    { bf16_t* qdec = (bf16_t*)(a.ws + WS_QDEC);
#pragma unroll
        for (int i = 0; i < 4; ++i) { const int id = F.tid + 512 * i, t = id >> 5, c32 = id & 31, hf = c32 >> 4, c = c32 & 15;
            *(u32x4*)(qdec + (size_t)(64 * n + t) * 1024 + h * 256 + c32 * 8) = *(const LAS u32x4*)(QR + hf * 16384 + t * 256 + ((c ^ (t & 15)) << 4)); } }
    bf16_t* att = (bf16_t*)(a.ws + WS_ATT) + (size_t)(n * 4 + h) * 4096;
    const int fr = F.lane & 15, fq = F.lane >> 4, ms = F.wave >> 1;
#pragma unroll
    for (int z = 0; z < 2; ++z) { const int nt = 2 * (F.wave & 1) + z; f32x4 acc = {0.f, 0.f, 0.f, 0.f};
#pragma unroll
        for (int ks = 0; ks < 8; ++ks) { const int fo = (ks >> 2) * 16384 + (((4 * (ks & 3) + fq) ^ fr) << 4);
            const bf16x8 A = *(const LAS bf16x8*)(KR + fo + (16 * ms + fr) * 256);
            const bf16x8 B = *(const LAS bf16x8*)(QR + fo + (16 * nt + fr) * 256); acc = MFMA16(A, B, acc); }
        const int t = 16 * nt + fr, s0 = 16 * ms + 4 * fq;
        u32x2 o; o.x = pk2(s0 + 0 <= t ? acc[0] : 0.f, s0 + 1 <= t ? acc[1] : 0.f); o.y = pk2(s0 + 2 <= t ? acc[2] : 0.f, s0 + 3 <= t ? acc[3] : 0.f);
        *(u32x2*)(att + t * 64 + s0) = o; }
}

DI void transpose_unit(const Frame& F, const Args& a, int tu) {
    __syncthreads();
    const bf16_t* cols = (const bf16_t*)(a.ws + WS_COLS);
    LAS unsigned char* scr = F.lds + F.wave * 9216;
#pragma unroll 1
    for (int rep = 0; rep < 3; ++rep) { const int it = (tu * 3 + rep) * 8 + F.wave;
    if (it < 4096) { const int n = it >> 5, cg = it & 31;
        transpose64x64<false>(cols + (size_t)(64 * n) * NP + C_VB + 64 * cg, NP, (bf16_t*)(a.ws + WS_VT) + ((size_t)n * 2048 + 64 * cg) * 64, scr, F.lane); }
    else { const int r = (it - 4096) & 1023, win = (it - 4096) >> 10, j = r >> 3, g = (r >> 1) & 3, hf = r & 1;
        transpose64x64<true>(cols + (size_t)(64 * j) * NP + (win ? C_VWIN : C_VSEL) + 128 * g + 64 * hf, NP,
                             (bf16_t*)(a.ws + (win ? WS_VWINT : WS_VSELT)) + ((size_t)(g * 128 + j) * 128 + 64 * hf) * 64, scr, F.lane); } }
}

DI float gelu_tanh(float x) { const float u = 0.7978845608028654f * (x + 0.044715f * x * x * x); const float t = __expf(2.f * u); return 0.5f * x * (2.f - 2.f / (t + 1.f)); }
DI void mlp2_unit(const Frame& F, const Args& a, int layer, int pz, int rt) {
    const float* cpart = (const float*)(a.ws + WS_CPART);
    LAS unsigned char* hid = F.lds;
    const int kv = pz >> 2, g = pz & 3;
    __syncthreads();
    { const int r = F.tid >> 5, c0 = (F.tid & 31) * 8; f32x4 s0, s1;
        const float* bp = (const float*)(a.ws + WS_B1P) + (layer * 2 + kv) * 256 + c0;
        s0 = *(const f32x4*)bp; s1 = *(const f32x4*)(bp + 4);
#pragma unroll
        for (int pk = 0; pk < 8; ++pk) { const float* p = cpart + ((size_t)(pk * 8 + pz) * 512 + rt * 16 + r) * 256 + c0; s0 += *(const f32x4*)p; s1 += *(const f32x4*)(p + 4); }
        u32x4 o; o.x = pk2(gelu_tanh(s0.x), gelu_tanh(s0.y)); o.y = pk2(gelu_tanh(s0.z), gelu_tanh(s0.w)); o.z = pk2(gelu_tanh(s1.x), gelu_tanh(s1.y)); o.w = pk2(gelu_tanh(s1.z), gelu_tanh(s1.w));
        *(LAS u32x4*)(hid + r * 528 + c0 * 2) = o; }
    __syncthreads();
    const bf16_t* w2t = (const bf16_t*)(a.ws + WS_W2T) + (size_t)(layer * 2 + kv) * 128 * 256;
    const int fr = F.lane & 15, fq = F.lane >> 4, dt = F.wave;
    const float* b2 = a.cmp_b2 + (layer * 2 + kv) * 128;
    f32x4 acc = {0.f, 0.f, 0.f, 0.f};
#pragma unroll
    for (int ks = 0; ks < 8; ++ks) { const bf16x8 wf = *(const bf16x8*)(w2t + (16 * dt + fr) * 256 + 32 * ks + 8 * fq);
        const bf16x8 hf = *(const LAS bf16x8*)(hid + fr * 528 + (32 * ks + 8 * fq) * 2);
        acc = kv ? MFMA16(hf, wf, acc) : MFMA16(wf, hf, acc); }
    if (!kv) { const int n = 16 * rt + fr, dim = 16 * dt + 4 * fq; const f32x4 bb = *(const f32x4*)(b2 + dim); u32x2 o;
        if (n == 511) { o.x = 0u; o.y = 0u; } else { o.x = pk2(acc[0] + bb.x, acc[1] + bb.y); o.y = pk2(acc[2] + bb.z, acc[3] + bb.w); }
        *(u32x2*)((bf16_t*)(a.ws + WS_KC) + ((size_t)g * 512 + n) * 128 + dim) = o; }
    else { const int n0 = 16 * rt + 4 * fq, dim = 16 * dt + fr; const float bb = b2[dim]; u32x2 o;
        o.x = pk2(acc[0] + bb, acc[1] + bb); o.y = pk2(acc[2] + bb, (n0 + 3 == 511) ? 0.f : acc[3] + bb);
        const int pos = 64 * (rt >> 2) + 32 * ((rt & 3) >> 1) + 8 * fq + 4 * (rt & 1);
        *(u32x2*)((bf16_t*)(a.ws + WS_VCT) + ((size_t)g * 128 + dim) * 512 + pos) = o; }
}

template <int ACT>
DI void qk_tile(f32x4 (&s)[4][2], const LAS unsigned char* kb, const bf16x8 (&qf)[2][4], int fr, int fq) {
    const LAS unsigned char* kr = kb + fr * 256; const int x0 = (fq ^ fr) << 4, x1 = ((4 + fq) ^ fr) << 4, x2 = ((8 + fq) ^ fr) << 4, x3 = ((12 + fq) ^ fr) << 4;
    const f32x4 zero = {0.f, 0.f, 0.f, 0.f};
#pragma unroll
    for (int kt = 0; kt < 4; ++kt) { const LAS unsigned char* kn = kr + kt * 4096; bf16x8 kf[4];
        kf[0] = *(const LAS bf16x8*)(kn + x0); kf[1] = *(const LAS bf16x8*)(kn + x1); kf[2] = *(const LAS bf16x8*)(kn + x2); kf[3] = *(const LAS bf16x8*)(kn + x3);
        if (ACT & 1) { s[kt][0] = MFMA16(kf[0], qf[0][0], zero); } if (ACT & 2) { s[kt][1] = MFMA16(kf[0], qf[1][0], zero); }
#pragma unroll
        for (int ks = 1; ks < 4; ++ks) { if (ACT & 1) s[kt][0] = MFMA16(kf[ks], qf[0][ks], s[kt][0]); if (ACT & 2) s[kt][1] = MFMA16(kf[ks], qf[1][ks], s[kt][1]); }
    }
}
template <int ACT, bool WITH_L = true>
DI void pv_tile(f32x4 (&O)[8][2], f32x4 (&L)[2], const LAS unsigned char* vb, const bf16x8 (&pf)[2][2], int fr, int fq) {
    const LAS unsigned char* vr = vb + fr * 128; const int x = (fr >> 1) & 7, y0 = (fq ^ x) << 4, y1 = ((4 + fq) ^ x) << 4;
    const bf16x8 ones = {0x3f80, 0x3f80, 0x3f80, 0x3f80, 0x3f80, 0x3f80, 0x3f80, 0x3f80};
    if (WITH_L && (ACT & 1)) { L[0] = MFMA16(ones, pf[0][0], L[0]); L[0] = MFMA16(ones, pf[1][0], L[0]); }
    if (WITH_L && (ACT & 2)) { L[1] = MFMA16(ones, pf[0][1], L[1]); L[1] = MFMA16(ones, pf[1][1], L[1]); }
#pragma unroll
    for (int dt = 0; dt < 8; ++dt) {
        const bf16x8 v0 = *(const LAS bf16x8*)(vr + dt * 2048 + y0), v1 = *(const LAS bf16x8*)(vr + dt * 2048 + y1);
        if (ACT & 1) O[dt][0] = MFMA16(v0, pf[0][0], O[dt][0]); if (ACT & 2) O[dt][1] = MFMA16(v0, pf[0][1], O[dt][1]);
        if (ACT & 1) O[dt][0] = MFMA16(v1, pf[1][0], O[dt][0]); if (ACT & 2) O[dt][1] = MFMA16(v1, pf[1][1], O[dt][1]);
    }
}
DI float max3f(float a, float b, float c) { return fmaxf(fmaxf(a, b), c); }
DI bf16x8 pack_p(const f32x4& a, const f32x4& b) { u32x4 w; w.x = cvt_pk_bf16(a[0], a[1]); w.y = cvt_pk_bf16(a[2], a[3]); w.z = cvt_pk_bf16(b[0], b[1]); w.w = cvt_pk_bf16(b[2], b[3]); return __builtin_bit_cast(bf16x8, w); }
DI float quad_max(float v, int lane) {
    auto r = __builtin_amdgcn_permlane16_swap(__float_as_uint(v), __float_as_uint(v), false, false); v = fmaxf(__uint_as_float(r[0]), __uint_as_float(r[1]));
    r = __builtin_amdgcn_permlane32_swap(__float_as_uint(v), __float_as_uint(v), false, false); return fmaxf(__uint_as_float(r[0]), __uint_as_float(r[1])); }
DI float quad_sum(float v, int lane) {
    auto r = __builtin_amdgcn_permlane16_swap(__float_as_uint(v), __float_as_uint(v), false, false); v = __uint_as_float(r[0]) + __uint_as_float(r[1]);
    r = __builtin_amdgcn_permlane32_swap(__float_as_uint(v), __float_as_uint(v), false, false); return __uint_as_float(r[0]) + __uint_as_float(r[1]); }
constexpr float NEG_INF = -__builtin_inff();

template <int MODE, int ACT>
DI void fa_tile(f32x4 (&O)[8][2], f32x4 (&L)[2], float (&m)[2], const bf16x8 (&qf)[2][4], const LAS unsigned char* kb, const LAS unsigned char* vb,
                const bool (&bit)[2], const int (&tokl)[2], bool diag, bool left, int fr, int fq, int lane) {
    f32x4 s[4][2];
    qk_tile<ACT>(s, kb, qf, fr, fq);
    bf16x8 pf[2][2];
#pragma unroll
    for (int ct = 0; ct < 2; ++ct) {
        if (!((ACT >> ct) & 1)) continue;
        if (diag || left) {
            const int thr_hi = diag ? tokl[ct] : 63, thr_lo = left ? tokl[ct] : -1;
            int kq = 4 * fq; asm volatile("" : "+v"(kq));
#pragma unroll
            for (int kt = 0; kt < 4; ++kt)
#pragma unroll
                for (int r = 0; r < 4; ++r) { const int kl = 16 * kt + kq + r;
                    s[kt][ct][r] = (kl <= thr_hi && kl > thr_lo) ? s[kt][ct][r] : NEG_INF; } }
        float mx = max3f(s[0][ct][0], s[0][ct][1], s[0][ct][2]);
        mx = max3f(mx, s[0][ct][3], s[1][ct][0]); mx = max3f(mx, s[1][ct][1], s[1][ct][2]); mx = max3f(mx, s[1][ct][3], s[2][ct][0]); mx = max3f(mx, s[2][ct][1], s[2][ct][2]);
        mx = max3f(mx, s[2][ct][3], s[3][ct][0]); mx = max3f(mx, s[3][ct][1], s[3][ct][2]); mx = fmaxf(mx, s[3][ct][3]);
        mx = quad_max(mx, lane);
        if (MODE == 0 && !bit[ct]) mx = NEG_INF;
        if (__ballot((mx - m[ct]) * ATT_C > 8.f) != 0ull) {
            const float mn = fmaxf(m[ct], mx), alpha = __builtin_amdgcn_exp2f((m[ct] - mn) * ATT_C); m[ct] = mn; L[ct] *= alpha;
#pragma unroll
            for (int dt = 0; dt < 8; ++dt) O[dt][ct] *= alpha; }
        const float mc = (MODE == 0 && !bit[ct]) ? __builtin_inff() : m[ct] * ATT_C;
#pragma unroll
        for (int kt = 0; kt < 4; ++kt)
#pragma unroll
            for (int r = 0; r < 4; ++r) s[kt][ct][r] = __builtin_amdgcn_exp2f(s[kt][ct][r] * ATT_C - mc);
        pf[0][ct] = pack_p(s[0][ct], s[1][ct]); pf[1][ct] = pack_p(s[2][ct], s[3][ct]);
    }
    pv_tile<ACT>(O, L, vb, pf, fr, fq);
}

template <int MODE>
DI bool fa_rowmax(float (&m)[2], float (&mc)[2], float (&alpha)[2], f32x4 (&s)[4][2], const bool (&bit)[2], const int (&tokl)[2], bool diag, bool left, int fq, int lane) {
    bool need = false;
#pragma unroll
    for (int ct = 0; ct < 2; ++ct) {
        if (diag || left) {
            const int thr_hi = diag ? tokl[ct] : 63, thr_lo = left ? tokl[ct] : -1;
            int kq = 4 * fq; asm volatile("" : "+v"(kq));
#pragma unroll
            for (int kt = 0; kt < 4; ++kt)
#pragma unroll
                for (int r = 0; r < 4; ++r) { const int kl = 16 * kt + kq + r; s[kt][ct][r] = (kl <= thr_hi && kl > thr_lo) ? s[kt][ct][r] : NEG_INF; } }
        float mx = max3f(s[0][ct][0], s[0][ct][1], s[0][ct][2]);
        mx = max3f(mx, s[0][ct][3], s[1][ct][0]); mx = max3f(mx, s[1][ct][1], s[1][ct][2]); mx = max3f(mx, s[1][ct][3], s[2][ct][0]); mx = max3f(mx, s[2][ct][1], s[2][ct][2]);
        mx = max3f(mx, s[2][ct][3], s[3][ct][0]); mx = max3f(mx, s[3][ct][1], s[3][ct][2]); mx = fmaxf(mx, s[3][ct][3]);
        mx = quad_max(mx, lane);
        if (MODE == 0 && !bit[ct]) mx = NEG_INF;
        alpha[ct] = 1.f;
        if (__ballot((mx - m[ct]) * ATT_C > 8.f) != 0ull) { const float mn = fmaxf(m[ct], mx); alpha[ct] = __builtin_amdgcn_exp2f((m[ct] - mn) * ATT_C); m[ct] = mn; need = true; }
        mc[ct] = (MODE == 0 && !bit[ct]) ? __builtin_inff() : m[ct] * ATT_C;
    }
    return need;
}
template <bool HAS_PREV>
DI void fa_exp_pv(f32x4 (&s)[4][2], const float (&mc)[2], bf16x8 (&pfc)[2][2], f32x4 (&O)[8][2], f32x4 (&L)[2], const bf16x8 (&pfp)[2][2], const LAS unsigned char* vbp, int fr, int fq) {
#define FA_EXP1(e) do { if ((e) < 32) { const int _ct = (e) >> 4, _kt = ((e) >> 2) & 3, _r = (e) & 3; s[_kt][_ct][_r] = __builtin_amdgcn_exp2f(s[_kt][_ct][_r] * ATT_C - mc[_ct]); } \
        if ((e) == 8) pfc[0][0] = pack_p(s[0][0], s[1][0]); if ((e) == 16) pfc[1][0] = pack_p(s[2][0], s[3][0]); \
        if ((e) == 24) pfc[0][1] = pack_p(s[0][1], s[1][1]); if ((e) == 32) pfc[1][1] = pack_p(s[2][1], s[3][1]); } while (0)
    if (!HAS_PREV) {
#pragma unroll
        for (int e = 0; e <= 32; ++e) FA_EXP1(e);
    } else {
        const LAS unsigned char* vr = vbp + fr * 128; const int x = (fr >> 1) & 7, y0 = (fq ^ x) << 4, y1 = ((4 + fq) ^ x) << 4;
        const bf16x8 ones = {0x3f80, 0x3f80, 0x3f80, 0x3f80, 0x3f80, 0x3f80, 0x3f80, 0x3f80};
        bf16x8 vf[2][2];
        vf[0][0] = *(const LAS bf16x8*)(vr + y0); vf[0][1] = *(const LAS bf16x8*)(vr + y1);
#define FA_SLOT(mfma_stmt, e) do { mfma_stmt; FA_EXP1(e); __builtin_amdgcn_sched_barrier(0); } while (0)
        FA_SLOT(L[0] = MFMA16(ones, pfp[0][0], L[0]), 0); FA_SLOT(L[1] = MFMA16(ones, pfp[0][1], L[1]), 1);
        FA_SLOT(L[0] = MFMA16(ones, pfp[1][0], L[0]), 2); FA_SLOT(L[1] = MFMA16(ones, pfp[1][1], L[1]), 3);
#pragma unroll
        for (int dt = 0; dt < 8; ++dt) { const int cb = dt & 1, nb = cb ^ 1;
            if (dt < 7) { vf[nb][0] = *(const LAS bf16x8*)(vr + (dt + 1) * 2048 + y0); vf[nb][1] = *(const LAS bf16x8*)(vr + (dt + 1) * 2048 + y1); }
            FA_SLOT(O[dt][0] = MFMA16(vf[cb][0], pfp[0][0], O[dt][0]), 4 + 4 * dt); FA_SLOT(O[dt][1] = MFMA16(vf[cb][0], pfp[0][1], O[dt][1]), 5 + 4 * dt);
            FA_SLOT(O[dt][0] = MFMA16(vf[cb][1], pfp[1][0], O[dt][0]), 6 + 4 * dt); FA_SLOT(O[dt][1] = MFMA16(vf[cb][1], pfp[1][1], O[dt][1]), 7 + 4 * dt); }
#undef FA_SLOT
    }
#undef FA_EXP1
}

template <int MODE  >
DI void fa_chunk(const Frame& F, const Args& a, int c, int g) {
    const bf16_t* cols = (const bf16_t*)(a.ws + WS_COLS);
    const int fr = F.lane & 15, fq = F.lane >> 4, w = F.wave, tid = F.tid;
    LAS unsigned char* lds = F.lds;
    LAS int* list = (LAS int*)(lds + 4 * ABUF); LAS unsigned* maskw = (LAS unsigned*)(lds + 4 * ABUF + 1024);
    const bf16_t* kcol = cols + (MODE ? C_KWIN : C_KSEL) + 128 * g;
    const bf16_t* vT = (const bf16_t*)(a.ws + (MODE ? WS_VWINT : WS_VSELT)) + (size_t)g * 128 * 8192;
    __syncthreads();
    int ntile, j0 = 0;
    if (MODE == 0) {
        const unsigned* selm = (const unsigned*)(a.ws + WS_SELM);
        if (tid < 256) maskw[tid] = selm[((size_t)(64 * c + (tid >> 2)) * 4 + g) * 4 + (tid & 3)];
        __syncthreads();
        if (w == 0) { int base = 0;
#pragma unroll
            for (int hf = 0; hf < 2; ++hf) { const int j = hf * 64 + F.lane; unsigned orv = 0u;
                for (int tk = 0; tk < 64; ++tk) orv |= maskw[tk * 4 + (j >> 5)];
                const bool act = ((orv >> (j & 31)) & 1u) && (j <= c); const unsigned long long bl = __ballot(act);
                if (act) list[base + __popcll(bl & ((1ull << F.lane) - 1ull))] = j; base += __popcll(bl); }
            if (F.lane == 0) list[129] = base; }
        __syncthreads();
        ntile = list[129];
    } else { j0 = c > 8 ? c - 8 : 0; ntile = c - j0 + 1; }
    int tokl[2]; tokl[0] = 8 * w + (fr >> 2); tokl[1] = tokl[0] + 4;
    const int head = 4 * g + (fr & 3);
    bf16x8 qf[2][4];
#pragma unroll
    for (int ct = 0; ct < 2; ++ct)
#pragma unroll
        for (int ks = 0; ks < 4; ++ks) qf[ct][ks] = *(const bf16x8*)(cols + (size_t)(64 * c + tokl[ct]) * NP + C_QA + head * 128 + 32 * ks + 8 * fq);
    f32x4 O[8][2], L[2]; float m[2] = {-1e30f, -1e30f};
    L[0] = (f32x4){0.f, 0.f, 0.f, 0.f}; L[1] = L[0];
#pragma unroll
    for (int dt = 0; dt < 8; ++dt) { O[dt][0] = (f32x4){0.f, 0.f, 0.f, 0.f}; O[dt][1] = (f32x4){0.f, 0.f, 0.f, 0.f}; }
#define FA_TILE(t) (MODE ? j0 + (t) : list[(t)])
#define FA_ISSUE(t) do { const int _j = FA_TILE(t); LAS unsigned char* _b = lds + ((t) & 3) * ABUF; \
        dma_k(_b, kcol + (size_t)(64 * _j) * NP, NP, w, F.lane); dma_v(_b + KTILE, vT + (size_t)_j * 8192, 64, w, F.lane); } while (0)
    FA_ISSUE(0); if (ntile > 1) FA_ISSUE(1);
    f32x4 s[4][2]; bf16x8 pfp[2][2], pfc[2][2]; float mc[2], alpha[2]; bool bit[2] = {true, true};
    for (int t = 0; t < ntile; ++t) {
        if (t + 1 < ntile) VMCNT(4); else VMCNT(0);
        RAW_BARRIER();
        if (t + 2 < ntile) FA_ISSUE(t + 2);
        const int j = FA_TILE(t);
        qk_tile<3>(s, lds + (t & 3) * ABUF, qf, fr, fq);
        if (MODE == 0) {
#pragma unroll
            for (int ct = 0; ct < 2; ++ct) bit[ct] = (maskw[tokl[ct] * 4 + (j >> 5)] >> (j & 31)) & 1u; }
        const bool need = fa_rowmax<MODE>(m, mc, alpha, s, bit, tokl, j == c, (MODE == 1) && (j == c - 8), fq, F.lane);
        __builtin_amdgcn_sched_barrier(0);
        if (t > 0) fa_exp_pv<true>(s, mc, pfc, O, L, pfp, lds + ((t - 1) & 3) * ABUF + KTILE, fr, fq); else fa_exp_pv<false>(s, mc, pfc, O, L, pfp, lds, fr, fq);
        __builtin_amdgcn_sched_barrier(0);
        if (need) {
#pragma unroll
            for (int ct = 0; ct < 2; ++ct) { L[ct] *= alpha[ct];
#pragma unroll
                for (int dt = 0; dt < 8; ++dt) O[dt][ct] *= alpha[ct]; } }
#pragma unroll
        for (int ct = 0; ct < 2; ++ct) { pfp[0][ct] = pfc[0][ct]; pfp[1][ct] = pfc[1][ct]; }
    }
    pv_tile<3>(O, L, lds + ((ntile - 1) & 3) * ABUF + KTILE, pfp, fr, fq);
#undef FA_ISSUE
#undef FA_TILE
    bf16_t* out = (bf16_t*)(a.ws + (MODE ? WS_OWIN : WS_OSEL));
#pragma unroll
    for (int ct = 0; ct < 2; ++ct) { const float inv = 1.f / L[ct][0]; bf16_t* op = out + (size_t)(64 * c + tokl[ct]) * D + head * 128 + 4 * fq;
#pragma unroll
        for (int dt = 0; dt < 8; ++dt) { u32x2 o; o.x = pk2(O[dt][ct][0] * inv, O[dt][ct][1] * inv); o.y = pk2(O[dt][ct][2] * inv, O[dt][ct][3] * inv); *(u32x2*)(op + 16 * dt) = o; } }
}

DI void ca_chunk(const Frame& F, const Args& a, int c, int g) {
    const bf16_t* cols = (const bf16_t*)(a.ws + WS_COLS);
    const int fr = F.lane & 15, fq = F.lane >> 4, w = F.wave, tid = F.tid;
    LAS unsigned char* lds = F.lds;
    LAS float* pslc = (LAS float*)(lds + 2 * ABUF); LAS float* p3 = (LAS float*)(lds + 2 * ABUF + 32768);
    const bf16_t* kc = (const bf16_t*)(a.ws + WS_KC) + (size_t)g * 512 * 128;
    const bf16_t* vct = (const bf16_t*)(a.ws + WS_VCT) + (size_t)g * 128 * 512;
    const int ntile = ((4 * c + 2) >> 6) + 1;
    int tokl[2]; tokl[0] = 8 * w + (fr >> 2); tokl[1] = tokl[0] + 4;
    const int head = 4 * g + (fr & 3);
    int nlim[2];
#pragma unroll
    for (int ct = 0; ct < 2; ++ct) { const int t = 64 * c + tokl[ct]; nlim[ct] = t >= 31 ? ((t - 31) >> 4) : -1; }
    bf16x8 qf[2][4];
#pragma unroll
    for (int ct = 0; ct < 2; ++ct)
#pragma unroll
        for (int ks = 0; ks < 4; ++ks) qf[ct][ks] = *(const bf16x8*)(cols + (size_t)(64 * c + tokl[ct]) * NP + C_QA + head * 128 + 32 * ks + 8 * fq);
    float m[2] = {-1e30f, -1e30f}, l[2] = {0.f, 0.f};
    __syncthreads();
    dma_k(lds, kc, 128, w, F.lane);
    for (int jt = 0; jt < ntile; ++jt) {
        VMCNT(0); RAW_BARRIER();
        if (jt + 1 < ntile) dma_k(lds + ((jt + 1) & 1) * ABUF, kc + (size_t)(64 * (jt + 1)) * 128, 128, w, F.lane);
        const LAS unsigned char* kb = lds + (jt & 1) * ABUF;
        f32x4 s[4][2];
        qk_tile<3>(s, kb, qf, fr, fq);
        const bool edge = jt >= ntile - 2;
        int kq = 4 * fq; asm volatile("" : "+v"(kq));
#pragma unroll
        for (int ct = 0; ct < 2; ++ct) {
            float mx = NEG_INF;
#pragma unroll
            for (int kt = 0; kt < 4; ++kt)
#pragma unroll
                for (int r = 0; r < 4; ++r) { float v = s[kt][ct][r]; if (edge) { const int n = 64 * jt + 16 * kt + kq + r; v = (n <= nlim[ct]) ? v : NEG_INF; s[kt][ct][r] = v; } mx = fmaxf(mx, v); }
            mx = quad_max(mx, F.lane);
            if (__ballot((mx - m[ct]) * ATT_C > 8.f) != 0ull) { const float mn = fmaxf(m[ct], mx); l[ct] *= __builtin_amdgcn_exp2f((m[ct] - mn) * ATT_C); m[ct] = mn; }
            const float mc = m[ct] * ATT_C;
            float rs = 0.f;
#pragma unroll
            for (int kt = 0; kt < 4; ++kt)
#pragma unroll
                for (int r = 0; r < 4; ++r) rs += __builtin_amdgcn_exp2f(s[kt][ct][r] * ATT_C - mc);
            l[ct] += quad_sum(rs, F.lane);
        }
    }
    f32x4 O[8][2];
#pragma unroll
    for (int dt = 0; dt < 8; ++dt) { O[dt][0] = (f32x4){0.f, 0.f, 0.f, 0.f}; O[dt][1] = (f32x4){0.f, 0.f, 0.f, 0.f}; }
    float mc[2], inv[2];
#pragma unroll
    for (int ct = 0; ct < 2; ++ct) { mc[ct] = m[ct] * ATT_C; inv[ct] = l[ct] > 0.f ? 1.f / l[ct] : 0.f; }
    RAW_BARRIER();
    dma_k(lds, kc, 128, w, F.lane); dma_v(lds + KTILE, vct, 512, w, F.lane);
    for (int jt = 0; jt < ntile; ++jt) {
        VMCNT(0); RAW_BARRIER();
        if (jt + 1 < ntile) { LAS unsigned char* nb = lds + ((jt + 1) & 1) * ABUF; dma_k(nb, kc + (size_t)(64 * (jt + 1)) * 128, 128, w, F.lane); dma_v(nb + KTILE, vct + 64 * (jt + 1), 512, w, F.lane); }
        const LAS unsigned char* kb = lds + (jt & 1) * ABUF;
        f32x4 s[4][2];
        qk_tile<3>(s, kb, qf, fr, fq);
        const bool edge = jt >= ntile - 2;
        int kq = 4 * fq; asm volatile("" : "+v"(kq));
        bf16x8 pf[2][2];
#pragma unroll
        for (int ct = 0; ct < 2; ++ct) {
#pragma unroll
            for (int kt = 0; kt < 4; ++kt) {
#pragma unroll
                for (int r = 0; r < 4; ++r) { float p = __builtin_amdgcn_exp2f(s[kt][ct][r] * ATT_C - mc[ct]) * inv[ct];
                    if (edge) { const int n = 64 * jt + 16 * kt + kq + r; p = (n <= nlim[ct]) ? p : 0.f; }
                    s[kt][ct][r] = p; }
                float h3 = s[kt][ct][3], hs = (s[kt][ct][0] + s[kt][ct][1]) + (s[kt][ct][2] + h3);
                hs += shx(hs, 1, F.lane); hs += shx(hs, 2, F.lane); h3 += shx(h3, 1, F.lane); h3 += shx(h3, 2, F.lane);
                if ((fr & 3) == 0) { const int jj = 16 * jt + 4 * kt + fq; pslc[tokl[ct] * 128 + jj] = hs; p3[tokl[ct] * 128 + jj] = h3; }
            }
            pf[0][ct] = pack_p(s[0][ct], s[1][ct]); pf[1][ct] = pack_p(s[2][ct], s[3][ct]);
        }
        { f32x4 Ldummy[2]; pv_tile<3, false>(O, Ldummy, kb + KTILE, pf, fr, fq); }
    }
    bf16_t* out = (bf16_t*)(a.ws + WS_OCMP);
#pragma unroll
    for (int ct = 0; ct < 2; ++ct) { bf16_t* op = out + (size_t)(64 * c + tokl[ct]) * D + head * 128 + 4 * fq;
#pragma unroll
        for (int dt = 0; dt < 8; ++dt) { u32x2 o; o.x = pk2(O[dt][ct][0], O[dt][ct][1]); o.y = pk2(O[dt][ct][2], O[dt][ct][3]); *(u32x2*)(op + 16 * dt) = o; } }
    LDS_WAIT(); asm volatile("" ::: "memory");
    unsigned* selm = (unsigned*)(a.ws + WS_SELM);
    {
        int li = F.lane & 15, tq = F.lane >> 4; asm volatile("" : "+v"(li), "+v"(tq));
        unsigned mw[2][4];
        if (c <= 15) {
            const unsigned all = (c == 31) ? 0xffffffffu : ((2u << c) - 1u);
#pragma unroll
            for (int b = 0; b < 2; ++b) { mw[b][0] = all; mw[b][1] = 0u; mw[b][2] = 0u; mw[b][3] = 0u; }
        } else {
            unsigned long long key[2][8];
#pragma unroll
            for (int b = 0; b < 2; ++b) { const int tok = 8 * w + 4 * b + tq;
#pragma unroll
                for (int e = 0; e < 8; ++e) { const int jj = li + 16 * e; const bool ok = (jj >= 1) && (jj <= c - 2);
                    const float sc = ok ? pslc[tok * 128 + jj] + p3[tok * 128 + jj - 1] : 0.f;
                    key[b][e] = ok ? (((unsigned long long)__float_as_uint(sc) << 32) | (unsigned)(127 - jj)) : 0ull; }
#pragma unroll
                for (int q = 0; q < 4; ++q) mw[b][q] = 0u;
                { const int f0 = 0, f1 = c - 1, f2 = c;
#pragma unroll
                  for (int q = 0; q < 4; ++q) mw[b][q] |= ((f0 >> 5) == q ? 1u << (f0 & 31) : 0u) | ((f1 >> 5) == q ? 1u << (f1 & 31) : 0u) | ((f2 >> 5) == q ? 1u << (f2 & 31) : 0u); } }
#define ROR64(v, n) ((((unsigned long long)(unsigned)__builtin_amdgcn_update_dpp(0, (int)(unsigned)((v) >> 32), 0x120 + (n), 0xf, 0xf, false)) << 32) | (unsigned)__builtin_amdgcn_update_dpp(0, (int)(unsigned)(v), 0x120 + (n), 0xf, 0xf, false))
#pragma unroll 1
            for (int round = 0; round < 13; ++round) {
#pragma unroll
                for (int b = 0; b < 2; ++b) {
                    unsigned long long best = key[b][0];
#pragma unroll
                    for (int e = 1; e < 8; ++e) best = key[b][e] > best ? key[b][e] : best;
                    { unsigned long long o; o = ROR64(best, 1); best = o > best ? o : best; o = ROR64(best, 2); best = o > best ? o : best;
                      o = ROR64(best, 4); best = o > best ? o : best; o = ROR64(best, 8); best = o > best ? o : best; }
                    if (best != 0ull) { const int jb = 127 - (int)(unsigned)best;
#pragma unroll
                        for (int q = 0; q < 4; ++q) mw[b][q] |= ((jb >> 5) == q) ? (1u << (jb & 31)) : 0u;
#pragma unroll
                        for (int e = 0; e < 8; ++e) key[b][e] = (key[b][e] == best) ? 0ull : key[b][e]; }
                }
            }
#undef ROR64
        }
        if (li == 0) {
#pragma unroll
            for (int b = 0; b < 2; ++b) { const int tok = 8 * w + 4 * b + tq; u32x4 o; o.x = mw[b][0]; o.y = mw[b][1]; o.z = mw[b][2]; o.w = mw[b][3];
                *(u32x4*)(selm + ((size_t)(64 * c + tok) * 4 + g) * 4) = o; } }
    }
}

struct ScanRegs { bf16x8 ks[2]; bf16x8 at; f32x4 dc; };
DI void dma_v8(LAS unsigned char* vb, const bf16_t* vbase, int w, int lane) {
    const int row = 8 * w + (lane >> 3), c = (lane & 7) ^ ((row >> 1) & 7);
    glds16(vbase + (size_t)row * 64 + c * 8, vb + w * 1024);
}
constexpr int SC_SROW = 272, SC_SBUF = 64 * SC_SROW, SC_Q = 0, SC_V = 4 * 16384, SC_S = SC_V + 4 * 8192;
static_assert(SC_S + 2 * SC_SBUF <= LDS_MISC, "scan LDS map");
DI void scan_issue(ScanRegs& r, LAS unsigned char* lds, const Args& a, int n, int h, int sl, int kh, int w, int lane, int fr, int fq) {
    const bf16_t* qdec = (const bf16_t*)(a.ws + WS_QDEC); const bf16_t* kst = (const bf16_t*)(a.ws + WS_KST);
    const bf16_t* vt = (const bf16_t*)(a.ws + WS_VT); const bf16_t* att = (const bf16_t*)(a.ws + WS_ATT); const float* dec = (const float*)(a.ws + WS_DEC);
    dma_k(lds + SC_Q + (n & 3) * 16384, qdec + (size_t)(64 * n) * 1024 + h * 256 + kh * 128, 1024, w, lane);
    dma_v8(lds + SC_V + (n & 3) * 8192, vt + ((size_t)n * 2048 + h * 512 + 64 * sl) * 64, w, lane);
    { const bf16_t* kp = kst + ((size_t)(n * 4 + h) * 256 + kh * 128 + 16 * w + fr) * 64 + 8 * fq;
      asm volatile("global_load_dwordx4 %0, %1, off" : "=v"(r.ks[0]) : "v"(kp) : "memory");
      asm volatile("global_load_dwordx4 %0, %1, off offset:64" : "=v"(r.ks[1]) : "v"(kp) : "memory"); }
    { const bf16_t* ap_ = att + ((size_t)(n * 4 + h) * 64 + 16 * (w & 3) + fr) * 64 + 32 * kh + 8 * fq; asm volatile("global_load_dwordx4 %0, %1, off" : "=v"(r.at) : "v"(ap_) : "memory"); }
    { const float* dp = dec + (n * 4 + h) * 256 + kh * 128 + 16 * w + 4 * fq; asm volatile("global_load_dwordx4 %0, %1, off" : "=v"(r.dc) : "v"(dp) : "memory"); }
}
DI void scan_step(const ScanRegs& cur, f32x4 (&S)[4], LAS unsigned char* lds, bf16_t* opart, int n, int h, int sl, int kh, int w, int fr, int fq) {
    const LAS unsigned char* sc = lds + SC_S + (n & 1) * SC_SBUF; const LAS unsigned char* qb = lds + SC_Q + (n & 3) * 16384; const LAS unsigned char* vb = lds + SC_V + (n & 3) * 8192;
    const int tt = w & 3, vt0 = 2 * (w >> 2), xv = (fr >> 1) & 7;
    const LAS unsigned char* vr = vb + fr * 128; const int y0 = (fq ^ xv) << 4, y1 = ((4 + fq) ^ xv) << 4;
    bf16x8 qf[4], sf[2][4];
#pragma unroll
    for (int ks = 0; ks < 4; ++ks) qf[ks] = *(const LAS bf16x8*)(qb + (16 * tt + fr) * 256 + (((4 * ks + fq) ^ fr) << 4));
#pragma unroll
    for (int z = 0; z < 2; ++z)
#pragma unroll
        for (int ks = 0; ks < 4; ++ks) sf[z][ks] = *(const LAS bf16x8*)(sc + (16 * (vt0 + z) + fr) * SC_SROW + (32 * ks + 8 * fq) * 2);
    LDS_WAIT(); __builtin_amdgcn_sched_barrier(0);
    f32x4 acc[2];
#pragma unroll
    for (int z = 0; z < 2; ++z) { acc[z] = (f32x4){0.f, 0.f, 0.f, 0.f};
#pragma unroll
        for (int ks = 0; ks < 4; ++ks) acc[z] = MFMA16(sf[z][ks], qf[ks], acc[z]); }
    bf16x8 vf[4][2];
#pragma unroll
    for (int vt = 0; vt < 4; ++vt) { vf[vt][0] = *(const LAS bf16x8*)(vr + vt * 2048 + y0); vf[vt][1] = *(const LAS bf16x8*)(vr + vt * 2048 + y1); }
    LDS_WAIT(); __builtin_amdgcn_sched_barrier(0);
    { const bf16x8 va0 = vt0 ? (kh ? vf[2][1] : vf[2][0]) : (kh ? vf[0][1] : vf[0][0]), va1 = vt0 ? (kh ? vf[3][1] : vf[3][0]) : (kh ? vf[1][1] : vf[1][0]);
      acc[0] = MFMA16(va0, cur.at, acc[0]); acc[1] = MFMA16(va1, cur.at, acc[1]); }
    LAS unsigned char* sn = lds + SC_S + ((n + 1) & 1) * SC_SBUF;
#pragma unroll
    for (int vt = 0; vt < 4; ++vt) { S[vt] = S[vt] * cur.dc; S[vt] = MFMA16(cur.ks[0], vf[vt][0], S[vt]); S[vt] = MFMA16(cur.ks[1], vf[vt][1], S[vt]); }
#pragma unroll
    for (int z = 0; z < 2; ++z) { u32x2 o; o.x = pk2(acc[z][0], acc[z][1]); o.y = pk2(acc[z][2], acc[z][3]);
        *(u32x2*)(opart + (size_t)(64 * n + 16 * tt + fr) * 2048 + h * 512 + 64 * sl + 16 * (vt0 + z) + 4 * fq) = o; }
#pragma unroll
    for (int vt = 0; vt < 4; ++vt) { u32x2 o; o.x = pk2(S[vt][0], S[vt][1]); o.y = pk2(S[vt][2], S[vt][3]); *(LAS u32x2*)(sn + (16 * vt + fr) * SC_SROW + (16 * w + 4 * fq) * 2) = o; }
}
DI void gla_scan_unit(const Frame& F, const Args& a, int h, int sl, int kh) {
    LAS unsigned char* lds = F.lds;
    const int fr = F.lane & 15, fq = F.lane >> 4, w = F.wave;
    bf16_t* opart = (bf16_t*)(a.ws + WS_OPART) + (size_t)kh * T * 2048;
    __syncthreads();
    for (int i = F.tid; i < SC_SBUF / 4; i += NTHR) ((LAS unsigned*)(lds + SC_S))[i] = 0u;
    f32x4 S[4];
#pragma unroll
    for (int vt = 0; vt < 4; ++vt) S[vt] = (f32x4){0.f, 0.f, 0.f, 0.f};
    ScanRegs r0, r1, r2, r3;
    scan_issue(r0, lds, a, 0, h, sl, kh, w, F.lane, fr, fq); scan_issue(r1, lds, a, 1, h, sl, kh, w, F.lane, fr, fq); scan_issue(r2, lds, a, 2, h, sl, kh, w, F.lane, fr, fq);
#define SC_STEP(rn, rc, n) do { if ((n) < 3) asm volatile("s_waitcnt vmcnt(14)" ::: "memory"); else asm volatile("s_waitcnt vmcnt(20)" ::: "memory"); LDS_WAIT(); RAW_BARRIER(); \
        scan_issue(rn, lds, a, ((n) + 3 < NCH) ? (n) + 3 : NCH - 1, h, sl, kh, w, F.lane, fr, fq); scan_step(rc, S, lds, opart, (n), h, sl, kh, w, fr, fq); } while (0)
    for (int n = 0; n < NCH; n += 4) { SC_STEP(r3, r0, n); SC_STEP(r0, r1, n + 1); SC_STEP(r1, r2, n + 2); SC_STEP(r2, r3, n + 3); }
#undef SC_STEP
    VM_WAIT();
}

DI void p_combine(const Frame& F, const Args& a, int layer) {
    const bf16_t* cols = (const bf16_t*)(a.ws + WS_COLS);
    const bf16_t* ocmp = (const bf16_t*)(a.ws + WS_OCMP); const bf16_t* osel = (const bf16_t*)(a.ws + WS_OSEL); const bf16_t* owin = (const bf16_t*)(a.ws + WS_OWIN);
    const bf16_t* op0 = (const bf16_t*)(a.ws + WS_OPART); const bf16_t* op1 = op0 + (size_t)T * 2048;
    bf16_t* A1 = (bf16_t*)(a.ws + WS_A1); bf16_t* A2 = (bf16_t*)(a.ws + WS_A2);
    const int c8 = 8 * F.lane;
    f32x4 nw[2]; nw[0] = *(const f32x4*)(a.gla_norm_w + layer * 512 + c8); nw[1] = *(const f32x4*)(a.gla_norm_w + layer * 512 + c8 + 4);
    for (int row = F.gw; row < T; row += F.NGW) {
        const bf16_t* cr = cols + (size_t)row * NP; const size_t ro = (size_t)row * D;
#pragma unroll
        for (int j = 0; j < 4; ++j) { const int c0 = 512 * j + c8, head = 4 * j + (F.lane >> 4);
            const float g0 = sigmoidf_(bf2f(cr[C_GBR + head * 3 + 0])), g1 = sigmoidf_(bf2f(cr[C_GBR + head * 3 + 1])), g2 = sigmoidf_(bf2f(cr[C_GBR + head * 3 + 2]));
            float oc[8], os[8], ow[8], za[8], p0[8], p1[8], zb[8];
            unpack8(*(const u32x4*)(ocmp + ro + c0), oc); unpack8(*(const u32x4*)(osel + ro + c0), os); unpack8(*(const u32x4*)(owin + ro + c0), ow); unpack8(*(const u32x4*)(cr + C_ZA + c0), za);
            unpack8(*(const u32x4*)(op0 + ro + c0), p0); unpack8(*(const u32x4*)(op1 + ro + c0), p1); unpack8(*(const u32x4*)(cr + C_ZB + c0), zb);
            float r[8], o[8], ss = 0.f;
#pragma unroll
            for (int e = 0; e < 8; ++e) { r[e] = (g0 * oc[e] + g1 * os[e] + g2 * ow[e]) * siluf_(za[e]); o[e] = p0[e] + p1[e]; ss += o[e] * o[e]; }
            { u32x4 q; q.x = pk2(r[0], r[1]); q.y = pk2(r[2], r[3]); q.z = pk2(r[4], r[5]); q.w = pk2(r[6], r[7]); *(u32x4*)(A1 + ro + c0) = q; }
            const float rs = rsqrtf(wave_sum(ss, F.lane) * (1.f / 512.f) + NORM_EPS);
            float y[8];
#pragma unroll
            for (int e = 0; e < 8; ++e) y[e] = o[e] * rs * nw[e >> 2][e & 3] * siluf_(zb[e]);
            { u32x4 q; q.x = pk2(y[0], y[1]); q.y = pk2(y[2], y[3]); q.z = pk2(y[4], y[5]); q.w = pk2(y[6], y[7]); *(u32x4*)(A2 + ro + c0) = q; } }
    }
}

constexpr int PH_PER_LAYER = 10, N_PHASES = 2 + DEPTH * PH_PER_LAYER;
constexpr int WQ_WORD0 = 16384;
DI int wq_pull(unsigned* cnt, volatile LAS unsigned* slot, int tid) {
    __syncthreads();
    if (tid == 0) *slot = __hip_atomic_fetch_add(cnt, 1u, __ATOMIC_RELAXED, __HIP_MEMORY_SCOPE_AGENT);
    __syncthreads();
    return (int)*slot;
}
__global__ void __launch_bounds__(NTHR, 2) mk_fwd(Args a_in, int li) {
    KArgsP ap = (KArgsP)__builtin_amdgcn_kernarg_segment_ptr();
    const int ph_lo = a_in.ph_lo, ph_hi = a_in.ph_hi;
    extern __shared__ __attribute__((aligned(16))) unsigned char lds_raw[];
    Frame F;
    F.lds = (LAS unsigned char*)lds_raw;
    F.tid = threadIdx.x; F.lane = F.tid & 63; F.wave = __builtin_amdgcn_readfirstlane(F.tid >> 6);
    const int wave_s = F.wave;
    F.G = gridDim.x; F.bid = blockIdx.x; F.gw = F.bid * NWAVES + F.wave; F.NGW = F.G * NWAVES;
    volatile LAS unsigned* misc = (volatile LAS unsigned*)(F.lds + LDS_MISC);
    if (F.tid < 64) misc[F.tid] = 0u;
    __syncthreads();
    unsigned* ctl = (unsigned*)(a_in.ws + WS_CTL);
    XcdBarrier bar = xcd_barrier_post(ctl + (size_t)li * XCD_BAR_WORDS, misc);
#ifndef PHASE_SET
#define PHASE_SET 0xFFFF
#endif
#define HAS(k) ((PHASE_SET >> (k)) & 1)
#ifndef REPEAT_PHASE
#define REPEAT_PHASE -1
#endif
#define REP(k) for (int _r = 0; _r < ((REPEAT_PHASE == (k)) ? 2 : 1); ++_r)
#define IN(k) (ph_lo <= (k) && (k) < ph_hi)
#define SEAM(k) do { if (IN(k) && IN((k) + 1)) xcd_barrier(bar); } while (0)
#define FRESH() do { int _l = __builtin_amdgcn_mbcnt_hi(~0u, __builtin_amdgcn_mbcnt_lo(~0u, 0u)); asm volatile("" : "+v"(_l)); int _w = wave_s; asm volatile("" : "+s"(_w)); F.lane = _l; F.wave = _w; F.tid = _w * 64 + _l; F.gw = F.bid * NWAVES + F.wave; { KArgsP _k = (KArgsP)__builtin_amdgcn_kernarg_segment_ptr(); asm volatile("" : "+s"(_k)); ap = _k; } } while (0)
    if (HAS(12) && IN(0)) { FRESH(); const Args a = load_args(ap); REP(12) { p_prologue(F, a); } SEAM(0); }
#define PHASE_ENTER() FRESH(); const Args a = load_args(ap); unsigned char* ws = a.ws; bf16_t* cols = (bf16_t*)(ws + WS_COLS); (void)cols
#define UNIT_FRAME(Fu) Frame Fu = F; { int _l = F.lane; asm volatile("" : "+v"(_l)); Fu.lane = _l; Fu.tid = F.wave * 64 + _l; }
    for (int L = 0; L < DEPTH; ++L) {
        const int pb = 1 + PH_PER_LAYER * L;
        if (HAS(0) && IN(pb + 0)) { PHASE_ENTER();
            if (L == 0) p_rmsnorm<false, false>(F, a.x, a.norm_w, ws + WS_H); else p_rmsnorm<false, true>(F, ws + WS_X, a.norm_w + L * D, ws + WS_H);
            SEAM(pb + 0); }
        if (HAS(1) && IN(pb + 1)) { PHASE_ENTER();
            pg8::Gemm g{(const bf16_t*)(ws + WS_H), (const bf16_t*)(ws + WS_WIN) + (size_t)L * NP * D, D, D, D};
            pg8::OrderIn S; S.mn.init(T, NP, F.G, F.bid); S.sig = (unsigned*)(ws + WS_CTL) + WQ_WORD0 + 40960 + 64 * L; pg8::EpiCols E{cols, NP};
            pg8::gemm_phase<pg8::EpiCols, pg8::OrderIn, false, true, true>(F.lds, g, S, E, F.tid); }
        if (HAS(2) && IN(pb + 2)) { PHASE_ENTER();
            unsigned* cnt = (unsigned*)(ws + WS_CTL) + WQ_WORD0 + 8192 + 64 * L;
            { unsigned* sig = (unsigned*)(ws + WS_CTL) + WQ_WORD0 + 40960 + 64 * L;
              if (F.tid == 0) { XB_SPIN(xb_ld(sig) < pg8::IN_EARLY_TILES, bar.bar); __builtin_amdgcn_fence(__ATOMIC_ACQUIRE, "agent"); asm volatile("s_waitcnt vmcnt(0)" ::: "memory"); }
              __syncthreads(); }
            for (;;) { const int u = wq_pull(cnt, misc + 16, F.tid); if (u >= 128 + 512 + 256) break;
                UNIT_FRAME(Fu);
                if (u < 128) { pg8::Gemm g{cols, (const bf16_t*)(ws + WS_W1T) + (size_t)L * 2 * 256 * 4096, 16 * NP, 4096, 512};
                    pg8::OrderCmp S; S.init(1 << 20, u); pg8::EpiPart E{(float*)(ws + WS_CPART)};
                    __syncthreads();
                    pg8::gemm_phase<pg8::EpiPart, pg8::OrderCmp, true, false, true>(Fu.lds, g, S, E, Fu.tid); }
                else if (u < 640) { const int v = u - 128; gla_g1_unit(Fu, a, L, v >> 2, v & 3); }
                else transpose_unit(Fu, a, u - 640); }
            SEAM(pb + 2); }
        if (HAS(3) && IN(pb + 3)) { PHASE_ENTER(); for (int u = F.bid; u < 256; u += F.G) mlp2_unit(F, a, L, u >> 5, u & 31); SEAM(pb + 3); }
        if (HAS(4) && IN(pb + 4)) { PHASE_ENTER();
            REP(4) { unsigned* cnt = (unsigned*)(ws + WS_CTL) + WQ_WORD0 + 64 * (2 * L + 16 * _r);
            for (;;) { const int u = wq_pull(cnt, misc + 16, F.tid); if (u >= 512 + 512) break;
                UNIT_FRAME(Fu);
                if (u < 512) ca_chunk(Fu, a, 127 - (u >> 2), u & 3);
                else { const int v = u - 512; fa_chunk<1>(Fu, a, 127 - (v >> 2), v & 3); } } }
            SEAM(pb + 4); }
        if (HAS(5) && IN(pb + 5)) { PHASE_ENTER();
            REP(5) { unsigned* cnt = (unsigned*)(ws + WS_CTL) + WQ_WORD0 + 64 * (2 * L + 1 + 16 * _r);
            unsigned* grp = (unsigned*)(ws + WS_CTL) + WQ_WORD0 + 4096 + 64 * (8 * L + 32 * _r);
            unsigned* claimed = (unsigned*)(ws + WS_CTL) + WQ_WORD0 + 32768 + 64 * (L + 4 * _r);
            { const unsigned x = xb_xcc_id() & 7u;
              __syncthreads();
              if (F.tid == 0) { unsigned r = __hip_atomic_fetch_add(grp + 64 * x, 1u, __ATOMIC_RELAXED, __HIP_MEMORY_SCOPE_AGENT); unsigned got = 0xffffffffu;
                  if (r < 8u && __hip_atomic_exchange(claimed + 8 * x + r, 1u, __ATOMIC_RELAXED, __HIP_MEMORY_SCOPE_AGENT) == 0u) got = 8u * x + r;
                  misc[16] = got; }
              __syncthreads();
              const unsigned su = misc[16];
              if (su != 0xffffffffu) { UNIT_FRAME(Fu); gla_scan_unit(Fu, a, (int)(su >> 4), (int)(su & 7u), (int)((su >> 3) & 1u)); } }
            for (;;) { const int u = wq_pull(cnt, misc + 16, F.tid); if (u >= 64) break;
                UNIT_FRAME(Fu);
                __syncthreads(); if (F.tid == 0) misc[17] = __hip_atomic_exchange(claimed + u, 1u, __ATOMIC_RELAXED, __HIP_MEMORY_SCOPE_AGENT); __syncthreads();
                if (misc[17] == 0u) gla_scan_unit(Fu, a, u >> 4, u & 7, (u >> 3) & 1); }
            { const int g0 = (int)(xb_xcc_id() & 3u);
              for (int gi = 0; gi < 4; ++gi) { const int gq = (g0 + gi) & 3; unsigned* qcnt = (unsigned*)(ws + WS_CTL) + WQ_WORD0 + 12288 + 64 * (4 * L + gq + 32 * _r);
                  for (;;) { const int u = wq_pull(qcnt, misc + 16, F.tid); if (u >= 128) break;
                      UNIT_FRAME(Fu);
                      fa_chunk<0>(Fu, a, 127 - u, gq); } } } }
            SEAM(pb + 5); }
        if (HAS(6) && IN(pb + 6)) { PHASE_ENTER(); p_combine(F, a, L); SEAM(pb + 6); }
        if (HAS(7) && IN(pb + 7)) { PHASE_ENTER();
            pg8::Gemm g{(const bf16_t*)(ws + WS_A1), (const bf16_t*)(ws + WS_WPA) + (size_t)L * D * D, D, D, D};
            pg8::OrderAB S; S.mn.init(T, D, F.G, F.bid); S.A2 = (const bf16_t*)(ws + WS_A2); S.B2 = (const bf16_t*)(ws + WS_WPB) + (size_t)L * D * D;
            pg8::EpiGateAB E{(bf16_t*)(ws + WS_Y), (bf16_t*)(ws + WS_TMP), cols + C_GA, cols + C_GB};
            pg8::gemm_phase<pg8::EpiGateAB, pg8::OrderAB, false, true, true>(F.lds, g, S, E, F.tid);
            SEAM(pb + 7); }
        if (HAS(8) && IN(pb + 8)) { PHASE_ENTER(); }
        if (HAS(9) && IN(pb + 9)) { PHASE_ENTER();
            pg8::Gemm g{(const bf16_t*)(ws + WS_Y), (const bf16_t*)(ws + WS_WOUT) + (size_t)L * D * D, D, D, D};
            pg8::OrderMN S; S.init(T, D, F.G, F.bid); pg8::EpiResid E{L == 0 ? a.x : (const float*)nullptr, (const bf16_t*)(ws + WS_X), (bf16_t*)(ws + WS_X)};
            pg8::gemm_phase<pg8::EpiResid, pg8::OrderMN, false, false, true>(F.lds, g, S, E, F.tid);
            SEAM(pb + 9); }
    }
    if (HAS(13) && IN(N_PHASES - 1)) { FRESH(); const Args a = load_args(ap); p_rmsnorm<true, true>(F, a.ws + WS_X, a.final_w, a.out); }
#undef IN
#undef SEAM
}

extern "C" void kernel_launch(void* const* d_in, const int* in_sizes, int n_in, void* d_out, int out_size, void* d_ws, size_t ws_size, hipStream_t stream) {
    static int grid = 0;
    if (grid == 0) {
        if (n_in != 15 || ws_size < WS_END) { fprintf(stderr, "kernel_launch: unexpected inputs (n_in %d, ws %zu, need %zu)\n", n_in, ws_size, (size_t)WS_END); grid = -1; return; }
        int dev = 0, cus = 0;
        if (hipGetDevice(&dev) != hipSuccess || hipDeviceGetAttribute(&cus, hipDeviceAttributeMultiprocessorCount, dev) != hipSuccess) { grid = -1; return; }
        if (hipFuncSetAttribute((const void*)mk_fwd, hipFuncAttributeMaxDynamicSharedMemorySize, LDS_BYTES) != hipSuccess) { fprintf(stderr, "kernel_launch: hipFuncSetAttribute failed\n"); grid = -1; return; }
        int per_cu = 0;
        if (hipOccupancyMaxActiveBlocksPerMultiprocessor(&per_cu, (const void*)mk_fwd, NTHR, LDS_BYTES) != hipSuccess || per_cu < 1) fprintf(stderr, "kernel_launch: occupancy query reports %d\n", per_cu);
        (void)hipGetLastError();
        grid = cus;
    }
    if (grid < 0) return;
    (void)hipMemsetAsync((char*)d_ws + WS_CTL, 0, CTL_BYTES, stream);
    Args a{};
    a.x = (const float*)d_in[0]; a.norm_w = (const float*)d_in[1]; a.w_in = (const float*)d_in[2]; a.cmp_pe = (const float*)d_in[3]; a.cmp_w1 = (const float*)d_in[4];
    a.cmp_b1 = (const float*)d_in[5]; a.cmp_w2 = (const float*)d_in[6]; a.cmp_b2 = (const float*)d_in[7]; a.alpha_w = (const float*)d_in[8]; a.alpha_b = (const float*)d_in[9];
    a.gla_norm_w = (const float*)d_in[10]; a.p_a = (const float*)d_in[11]; a.p_b = (const float*)d_in[12]; a.w_out = (const float*)d_in[13]; a.final_w = (const float*)d_in[14];
    a.out = (float*)d_out; a.ws = (unsigned char*)d_ws;
#if MK_PER_PHASE
    for (int k = 0; k < N_PHASES; ++k) { a.ph_lo = k; a.ph_hi = k + 1; hipLaunchKernelGGL(mk_fwd, dim3(grid), dim3(NTHR), LDS_BYTES, stream, a, k); }
#else
    a.ph_lo = 0; a.ph_hi = N_PHASES; hipLaunchKernelGGL(mk_fwd, dim3(grid), dim3(NTHR), LDS_BYTES, stream, a, 0);
#endif
}
```

```cpp
#include <hip/hip_runtime.h>
#include <cstdio>
#include <cstdint>

#ifndef MK_PER_PHASE
#define MK_PER_PHASE 0
#endif

#define LAS __attribute__((address_space(3)))
#define GAS __attribute__((address_space(1)))
typedef unsigned short bf16_t;
typedef short bf16x8 __attribute__((ext_vector_type(8)));
typedef short s16x4 __attribute__((ext_vector_type(4)));
typedef float f32x4 __attribute__((ext_vector_type(4)));
typedef float f32x2 __attribute__((ext_vector_type(2)));
typedef unsigned u32x4 __attribute__((ext_vector_type(4)));
typedef unsigned u32x2 __attribute__((ext_vector_type(2)));
#define DI __device__ __forceinline__
#define MFMA16(a, b, c) __builtin_amdgcn_mfma_f32_16x16x32_bf16((a), (b), (c), 0, 0, 0)

constexpr int T = 8192, D = 2048, DEPTH = 4, NIN = 17472, NP = 17664;
constexpr int NCH = 128;
constexpr int C_QA = 0, C_KCMP = 2048, C_VCMP = 2560, C_KSEL = 3072, C_VSEL = 3584, C_KWIN = 4096, C_VWIN = 4608, C_ZA = 5120,
              C_QB = 7168, C_KB = 8192, C_VB = 9216, C_ZB = 11264, C_GA = 13312, C_GB = 15360, C_GBR = 17408, C_ALR = 17456;
constexpr float NORM_EPS = 1e-6f;
constexpr float ATT_C = 0.08838834764831845f * 1.4426950408889634f;

DI int map_col(int n) {
    if (n < 5120) return n;
    if (n < 5168) return C_GBR + (n - 5120);
    if (n < 11312) return n - 48;
    if (n < 11328) return C_ALR + (n - 11312);
    return n - 64;
}

constexpr size_t MiB = 1u << 20;
constexpr size_t al(size_t x) { return (x + MiB - 1) / MiB * MiB; }
constexpr size_t WS_CTL = 0, CTL_BYTES = MiB;
constexpr size_t WS_WIN = WS_CTL + CTL_BYTES;
constexpr size_t WS_WPA = WS_WIN + al((size_t)DEPTH * NP * D * 2);
constexpr size_t WS_WPB = WS_WPA + al((size_t)DEPTH * D * D * 2);
constexpr size_t WS_WOUT = WS_WPB + al((size_t)DEPTH * D * D * 2);
constexpr size_t WS_W1T = WS_WOUT + al((size_t)DEPTH * D * D * 2);
constexpr size_t WS_W2T = WS_W1T + al((size_t)DEPTH * 2 * 256 * 4096 * 2);
constexpr size_t WS_B1P = WS_W2T + al((size_t)DEPTH * 2 * 128 * 256 * 2);
constexpr size_t WS_X = WS_B1P + MiB;
constexpr size_t WS_H = WS_X + al((size_t)T * D * 4);
constexpr size_t WS_COLS = WS_H + al((size_t)T * D * 2);
constexpr size_t WS_CPART = WS_COLS + al((size_t)(T + 64) * NP * 2);
constexpr size_t WS_KC = WS_CPART + al((size_t)8 * 8 * 512 * 256 * 4);
constexpr size_t WS_VCT = WS_KC + MiB;
constexpr size_t WS_SELM = WS_VCT + MiB;
constexpr size_t WS_OCMP = WS_SELM + MiB;
constexpr size_t WS_OSEL = WS_OCMP + al((size_t)T * D * 2);
constexpr size_t WS_OWIN = WS_OSEL + al((size_t)T * D * 2);
constexpr size_t WS_VSELT = WS_OWIN + al((size_t)T * D * 2);
constexpr size_t WS_VWINT = WS_VSELT + al((size_t)4 * 128 * 128 * 64 * 2);
constexpr size_t WS_QDEC = WS_VWINT + al((size_t)4 * 128 * 128 * 64 * 2);
constexpr size_t WS_KST = WS_QDEC + al((size_t)T * 1024 * 2);
constexpr size_t WS_VT = WS_KST + al((size_t)T * 1024 * 2);
constexpr size_t WS_ATT = WS_VT + al((size_t)T * 2048 * 2);
constexpr size_t WS_DEC = WS_ATT + al((size_t)128 * 4 * 64 * 64 * 2);
constexpr size_t WS_OPART = WS_DEC + MiB;
constexpr size_t WS_A1 = WS_OPART + al((size_t)2 * T * 2048 * 4);
constexpr size_t WS_A2 = WS_A1 + al((size_t)T * D * 2);
constexpr size_t WS_TMP = WS_A2 + al((size_t)T * D * 2);
constexpr size_t WS_Y = WS_TMP + al((size_t)T * D * 4);
constexpr size_t WS_END = WS_Y + al((size_t)T * D * 2);

constexpr int LDS_MAIN = 131072;
constexpr int LDS_BYTES = 147456;
constexpr int LDS_MISC = LDS_BYTES - 256;
constexpr int NWAVES = 8, NTHR = 512;

DI float bf2f(unsigned short b) { return __uint_as_float(((unsigned)b) << 16); }
DI unsigned f2bf(float f) { unsigned u = __float_as_uint(f); return (u + 0x7fffu + ((u >> 16) & 1u)) >> 16; }
DI unsigned pk2_sw(float lo, float hi) { return f2bf(lo) | (f2bf(hi) << 16); }
typedef __bf16 bf16x2_t __attribute__((ext_vector_type(2)));
DI unsigned cvt_pk_bf16(float lo, float hi) { const f32x2 v = {lo, hi}; const bf16x2_t b = __builtin_convertvector(v, bf16x2_t); return __builtin_bit_cast(unsigned, b); }
DI unsigned pk2(float lo, float hi) { return cvt_pk_bf16(lo, hi); }
DI float lo_bf(unsigned w) { return __uint_as_float(w << 16); }
DI float hi_bf(unsigned w) { return __uint_as_float(w & 0xffff0000u); }
DI void unpack8(const u32x4& w, float (&f)[8]) { f[0] = lo_bf(w.x); f[1] = hi_bf(w.x); f[2] = lo_bf(w.y); f[3] = hi_bf(w.y); f[4] = lo_bf(w.z); f[5] = hi_bf(w.z); f[6] = lo_bf(w.w); f[7] = hi_bf(w.w); }
typedef _Float16 f16x2_t __attribute__((ext_vector_type(2)));
DI unsigned pk2h(float lo, float hi) { const f32x2 v = {lo, hi}; const f16x2_t h = __builtin_convertvector(v, f16x2_t); return __builtin_bit_cast(unsigned, h); }
DI float lo_h(unsigned w) { const f16x2_t h = __builtin_bit_cast(f16x2_t, w); return (float)h[0]; }
DI float hi_h(unsigned w) { const f16x2_t h = __builtin_bit_cast(f16x2_t, w); return (float)h[1]; }
DI void unpack8h(const u32x4& w, float (&f)[8]) { f[0] = lo_h(w.x); f[1] = hi_h(w.x); f[2] = lo_h(w.y); f[3] = hi_h(w.y); f[4] = lo_h(w.z); f[5] = hi_h(w.z); f[6] = lo_h(w.w); f[7] = hi_h(w.w); }
DI float sigmoidf_(float x) { return 1.f / (1.f + __expf(-x)); }
DI float siluf_(float x) { return x / (1.f + __expf(-x)); }
DI float shx(float v, int off, int lane) { return __int_as_float(__builtin_amdgcn_ds_bpermute((lane ^ off) << 2, __float_as_int(v))); }
DI int shxi(int v, int off, int lane) { return __builtin_amdgcn_ds_bpermute((lane ^ off) << 2, v); }
DI float wave_sum(float v, int lane) {
#pragma unroll
    for (int o = 1; o < 64; o <<= 1) v += shx(v, o, lane);
    return v;
}
#define LDS_WAIT() asm volatile("s_waitcnt lgkmcnt(0)" ::: "memory")
#define VM_WAIT() asm volatile("s_waitcnt vmcnt(0)" ::: "memory")

namespace pg8 {
constexpr int BM = 256, BK = 64, HALF = 128, HTB = HALF * BK * 2, STAGE_BYTES = 8 * HTB, NXCD = 8, WGM = 8;
__host__ __device__ __forceinline__ int lds_byte(int r, int c) { const int st = (r >> 4) * 2 + (c >> 5), rr = r & 15, cc = c & 31, ob = rr * 64 + cc * 2; return st * 1024 + (ob ^ (((ob >> 9) & 1) << 5)); }
__host__ __device__ __forceinline__ void stage_rc(int b, int& R, int& C) { const int st = b / 1024, sb = b % 1024, swz = sb ^ (((sb >> 9) & 1) << 5); R = (st >> 1) * 16 + swz / 64; C = (st & 1) * 32 + (swz % 64) / 2; }
__host__ __device__ __forceinline__ int perm32(int rho) { const int n = rho >> 4, i = rho & 15; return 8 * (i >> 2) + 4 * n + (i & 3); }

struct Unit { int pm, pn, pk, pz; };
struct Gemm { const bf16_t* A; const bf16_t* Bt; int lda, ldb, K; };

struct OrderMN {
    static constexpr bool SIGNAL = false;
    int nM, nN, nwg, G, c, rep;
    DI void init(int M, int N, int G_, int c_, int rep_ = 1) { nM = M / BM; nN = N / BM; nwg = nM * nN; G = G_; c = c_; rep = rep_; }
    DI bool next(int i, Unit& u) const {
        long L = (long)i * G + c; if (L >= (long)nwg * rep) return false;
        if (L >= nwg) L -= nwg;
        int wgid = (int)L; { const int q = nwg / NXCD, r = nwg % NXCD, xcd = wgid % NXCD, off = wgid / NXCD; wgid = (xcd < r ? xcd * (q + 1) : r * (q + 1) + (xcd - r) * q) + off; }
        const int nig = WGM * nN, gid = wgid / nig, fm = gid * WGM, gsz = (nM - fm) < WGM ? (nM - fm) : WGM;
        u.pm = fm + ((wgid % nig) % gsz); u.pn = (wgid % nig) / gsz; u.pk = 0; u.pz = 0; return true;
    }
    DI const char* a_ptr(const Gemm& g, const Unit& u) const { return (const char*)g.A + (size_t)u.pm * BM * g.lda * 2; }
    DI const char* b_ptr(const Gemm& g, const Unit& u) const { return (const char*)g.Bt + (size_t)u.pn * BM * g.ldb * 2; }
};
DI int in_col_tile(int p, int& early) {
    int i;
    if (p < 7) { early = 1; i = p; } else if (p < 35) { early = 0; i = p - 7; } else if (p < 41) { early = 1; i = p - 28; } else { early = 0; i = p - 13; }
    if (early) return i < 4 ? 8 + i : i < 12 ? 24 + i : 68;
    return i < 8 ? i : i < 24 ? 4 + i : 12 + i;
}
constexpr unsigned IN_EARLY_TILES = 13 * (T / 256);
struct OrderIn {
    static constexpr bool SIGNAL = true;
    OrderMN mn; unsigned* sig;
    DI bool next(int i, Unit& u) const { if (!mn.next(i, u)) return false; int e; const int pn = in_col_tile(u.pn, e); u.pn = pn;
        const int kind = (pn >= 36 && pn < 44) ? 1 : (pn == 14 || pn == 15) ? 2 : (pn == 18 || pn == 19) ? 3 : 0; u.pz = e | (kind << 1); return true; }
    DI const char* a_ptr(const Gemm& g, const Unit& u) const { return (u.pz >> 1) ? mn.b_ptr(g, u) : mn.a_ptr(g, u); }
    DI const char* b_ptr(const Gemm& g, const Unit& u) const { return (u.pz >> 1) ? mn.a_ptr(g, u) : mn.b_ptr(g, u); }
};
struct OrderCmp {
    static constexpr bool SIGNAL = false;
    int G, c;
    DI void init(int G_, int c_) { G = G_; c = c_; }
    DI bool next(int i, Unit& u) const { const int L = i * G + c; if (L >= 128) return false; u.pk = L & 7; u.pm = (L >> 3) & 1; u.pz = L >> 4; u.pn = 0; return true; }
    DI const char* a_ptr(const Gemm& g, const Unit& u) const { const int kv = u.pz >> 2, gg = u.pz & 3;
        return (const char*)g.A + ((size_t)(u.pm * BM * 16 + u.pk * 4) * NP + (kv ? C_VCMP : C_KCMP) + gg * 128) * 2; }
    DI const char* b_ptr(const Gemm& g, const Unit& u) const { const int kv = u.pz >> 2; return (const char*)g.Bt + ((size_t)kv * 256 * 4096 + u.pk * 512) * 2; }
};

template <class Epi, class Sched, bool IM2COL = false, bool ALIGN_EPI = false, bool SP2 = false>
DI void gemm_phase(LAS unsigned char* lds, const Gemm g, const Sched& S, const Epi& E, const int tid) {
    const int wid = __builtin_amdgcn_readfirstlane(tid >> 6), lane = tid & 63, wr = wid >> 2, wc = wid & 3, fr = lane & 15, fq = lane >> 4;
    const int nt = g.K / BK;
    unsigned voffA[2], voffB[2];
#pragma unroll
    for (int i = 0; i < 2; ++i) { int R, C; stage_rc(tid * 16 + i * 8192, R, C); const int Rb = Epi::PERM ? ((R >> 5) * 64 + perm32(R & 31)) : R;
        voffA[i] = (unsigned)(R * g.lda + C) * 2u; voffB[i] = (unsigned)(Rb * g.ldb + C) * 2u; }
    const size_t hstepA = (size_t)HALF * g.lda * 2, hstepB = (size_t)(Epi::PERM ? 32 : HALF) * g.ldb * 2;
    const unsigned ldsw = (unsigned)wid * 1024u;
    const int aoff = lds_byte(wr * 64 + fr, fq * 8), boff = lds_byte(wc * 32 + fr, fq * 8);
#define PG8_KA(kt) (IM2COL ? ((size_t)((kt) >> 1) * (NP * 2) + (size_t)((kt) & 1) * 128) : (size_t)(kt) * 128)
#define PG8_KB(kt) ((size_t)(kt) * 128)
#define PG8_SA(b, h) (((b) * 2 + (h)) * HTB)
#define PG8_SB(b, h) ((4 + (b) * 2 + (h)) * HTB)
#define PG8_STAGE(bufoff, gbase, voff) do { _Pragma("unroll") for (int _i = 0; _i < 2; ++_i) \
        __builtin_amdgcn_global_load_lds((const unsigned*)((const char*)(gbase) + (voff)[_i]), (LAS unsigned*)(lds + (bufoff) + ldsw + _i * 8192), 16, 0, 0); } while (0)
#define PG8_LDA(dst, b, h) do { _Pragma("unroll") for (int m = 0; m < 4; ++m) _Pragma("unroll") for (int k = 0; k < 2; ++k) dst[m][k] = *(const LAS bf16x8*)(lds + PG8_SA(b, h) + aoff + m * 2048 + k * 1024); } while (0)
#define PG8_LDB(dst, b, h) do { _Pragma("unroll") for (int n = 0; n < 2; ++n) _Pragma("unroll") for (int k = 0; k < 2; ++k) dst[n][k] = *(const LAS bf16x8*)(lds + PG8_SB(b, h) + boff + n * 2048 + k * 1024); } while (0)
#define PG8_MMA(ai, bj, At, Bt) do { __builtin_amdgcn_s_setprio(1); _Pragma("unroll") for (int m = 0; m < 4; ++m) _Pragma("unroll") for (int n = 0; n < 2; ++n) _Pragma("unroll") for (int k = 0; k < 2; ++k) \
        acc[ai][bj][m][n] = __builtin_amdgcn_mfma_f32_16x16x32_bf16(Bt[n][k], At[m][k], acc[ai][bj][m][n], 0, 0, 0); __builtin_amdgcn_s_setprio(0); } while (0)
#define PG8_WAIT_V(n) asm volatile("s_waitcnt vmcnt(" #n ")" ::: "memory")
#define PG8_WAIT_L(n) asm volatile("s_waitcnt lgkmcnt(" #n ")" ::: "memory")
#define PG8_BAR __builtin_amdgcn_s_barrier()
#define PG8_SCHED __builtin_amdgcn_sched_barrier(0)
    Unit cur, nxt; int ui = 0; int nsig = 0; (void)nsig;
    if (!S.next(0, cur)) return;
    f32x4 acc[2][2][4][2];
#pragma unroll
    for (int a = 0; a < 2; ++a)
#pragma unroll
        for (int b = 0; b < 2; ++b)
#pragma unroll
            for (int m = 0; m < 4; ++m)
#pragma unroll
                for (int n = 0; n < 2; ++n) acc[a][b][m][n] = (f32x4){0.f, 0.f, 0.f, 0.f};
    bf16x8 At[4][2], B0[2][2], B1[2][2];
    const char* cA = S.a_ptr(g, cur); const char* cB = S.b_ptr(g, cur);
    if constexpr (SP2) {
        PG8_STAGE(PG8_SB(0, 0), cB, voffB); PG8_STAGE(PG8_SB(0, 1), cB + hstepB, voffB); PG8_STAGE(PG8_SA(0, 0), cA, voffA); PG8_STAGE(PG8_SA(0, 1), cA + hstepA, voffA);
        if (wr == 1) PG8_BAR;
        PG8_WAIT_V(2); PG8_BAR;
        PG8_STAGE(PG8_SB(1, 0), cB + PG8_KB(1), voffB); PG8_STAGE(PG8_SA(1, 0), cA + PG8_KA(1), voffA); PG8_STAGE(PG8_SB(1, 1), cB + hstepB + PG8_KB(1), voffB);
        PG8_WAIT_V(6); PG8_BAR;
    } else {
    PG8_STAGE(PG8_SB(0, 0), cB, voffB); PG8_STAGE(PG8_SA(0, 0), cA, voffA); PG8_STAGE(PG8_SB(0, 1), cB + hstepB, voffB); PG8_STAGE(PG8_SA(0, 1), cA + hstepA, voffA);
    if (wr == 1) PG8_BAR;
    PG8_WAIT_V(4); PG8_BAR;
    PG8_STAGE(PG8_SB(1, 0), cB + PG8_KB(1), voffB); PG8_STAGE(PG8_SA(1, 0), cA + PG8_KA(1), voffA); PG8_STAGE(PG8_SB(1, 1), cB + hstepB + PG8_KB(1), voffB);
    PG8_WAIT_V(6); PG8_BAR;
    }
    for (;;) {
        const bool has_next = S.next(ui + 1, nxt);
        const char* nA = has_next ? S.a_ptr(g, nxt) : cA; const char* nB = has_next ? S.b_ptr(g, nxt) : cB;
        for (int t = 0; t < nt; t += 2) {
            const bool last = (t == nt - 2);
            const char* a1 = cA + PG8_KA(t + 1);
            const char* a2 = last ? nA : cA + PG8_KA(t + 2); const char* b2 = last ? nB : cB + PG8_KB(t + 2);
            const char* a3 = last ? nA + PG8_KA(1) : cA + PG8_KA(t + 3); const char* b3 = b2 + 128;
            if constexpr (SP2) {
            PG8_LDB(B0, 0, 0); PG8_LDB(B1, 0, 1); PG8_SCHED; PG8_LDA(At, 0, 0); PG8_STAGE(PG8_SA(1, 1), a1 + hstepA, voffA);
            PG8_WAIT_V(8); PG8_WAIT_L(0); PG8_BAR; PG8_MMA(0, 0, At, B0); PG8_MMA(0, 1, At, B1); PG8_BAR; PG8_SCHED;
            PG8_LDA(At, 0, 1); PG8_STAGE(PG8_SB(0, 0), b2, voffB); PG8_STAGE(PG8_SB(0, 1), b2 + hstepB, voffB); PG8_STAGE(PG8_SA(0, 0), a2, voffA);
            PG8_WAIT_V(8); PG8_WAIT_L(0); PG8_BAR; PG8_MMA(1, 0, At, B0); PG8_MMA(1, 1, At, B1); PG8_BAR; PG8_SCHED;
            PG8_LDB(B0, 1, 0); PG8_LDB(B1, 1, 1); PG8_SCHED; PG8_LDA(At, 1, 0); PG8_STAGE(PG8_SA(0, 1), a2 + hstepA, voffA);
            PG8_WAIT_V(8); PG8_WAIT_L(0); PG8_BAR; PG8_MMA(0, 0, At, B0); PG8_MMA(0, 1, At, B1); PG8_BAR; PG8_SCHED;
            PG8_LDA(At, 1, 1); PG8_STAGE(PG8_SB(1, 0), b3, voffB); PG8_STAGE(PG8_SB(1, 1), b3 + hstepB, voffB); PG8_STAGE(PG8_SA(1, 0), a3, voffA);
            PG8_WAIT_V(8); PG8_WAIT_L(0); PG8_BAR; PG8_MMA(1, 0, At, B0); PG8_MMA(1, 1, At, B1); PG8_BAR; PG8_SCHED;
            } else {
            PG8_LDB(B0, 0, 0); PG8_SCHED; PG8_LDA(At, 0, 0); PG8_STAGE(PG8_SA(1, 1), a1 + hstepA, voffA);
            PG8_WAIT_L(8); PG8_BAR; PG8_WAIT_L(0); PG8_MMA(0, 0, At, B0); PG8_BAR; PG8_SCHED;
            PG8_LDB(B1, 0, 1); PG8_STAGE(PG8_SB(0, 0), b2, voffB);
            PG8_BAR; PG8_WAIT_L(0); PG8_MMA(0, 1, At, B1); PG8_BAR;
            PG8_LDA(At, 0, 1); PG8_STAGE(PG8_SA(0, 0), a2, voffA);
            PG8_BAR; PG8_WAIT_L(0); PG8_MMA(1, 0, At, B0); PG8_BAR; PG8_SCHED;
            PG8_STAGE(PG8_SB(0, 1), b2 + hstepB, voffB);
            PG8_WAIT_V(6); PG8_BAR; PG8_MMA(1, 1, At, B1); PG8_BAR;
            PG8_LDB(B0, 1, 0); PG8_SCHED; PG8_LDA(At, 1, 0); PG8_STAGE(PG8_SA(0, 1), a2 + hstepA, voffA);
            PG8_WAIT_L(8); PG8_BAR; PG8_WAIT_L(0); PG8_MMA(0, 0, At, B0); PG8_BAR; PG8_SCHED;
            PG8_LDB(B1, 1, 1); PG8_STAGE(PG8_SB(1, 0), b3, voffB);
            PG8_BAR; PG8_WAIT_L(0); PG8_MMA(0, 1, At, B1); PG8_BAR;
            PG8_LDA(At, 1, 1); PG8_STAGE(PG8_SA(1, 0), a3, voffA);
            PG8_BAR; PG8_WAIT_L(0); PG8_MMA(1, 0, At, B0); PG8_BAR; PG8_SCHED;
            PG8_STAGE(PG8_SB(1, 1), b3 + hstepB, voffB);
            PG8_WAIT_V(6); PG8_BAR; PG8_MMA(1, 1, At, B1); PG8_BAR;
            }
        }
        if constexpr (ALIGN_EPI) { if (wr == 0) PG8_BAR; }
        E(acc, cur, wr, wc, fr, fq);
        if constexpr (Sched::SIGNAL) {
            nsig += cur.pz & 1;
            if ((cur.pz & 1) && !(has_next && (nxt.pz & 1))) { PG8_WAIT_V(0); PG8_BAR;
                if (tid == 0) { __builtin_amdgcn_fence(__ATOMIC_RELEASE, "agent"); PG8_WAIT_V(0); (void)__hip_atomic_fetch_add(S.sig, (unsigned)nsig, __ATOMIC_RELAXED, __HIP_MEMORY_SCOPE_AGENT); }
                nsig = 0; } }
        if (!has_next) break;
#pragma unroll
        for (int a = 0; a < 2; ++a)
#pragma unroll
            for (int b = 0; b < 2; ++b)
#pragma unroll
                for (int m = 0; m < 4; ++m)
#pragma unroll
                    for (int n = 0; n < 2; ++n) acc[a][b][m][n] = (f32x4){0.f, 0.f, 0.f, 0.f};
        cur = nxt; cA = nA; cB = nB; ++ui;
        if constexpr (ALIGN_EPI) { if (wr == 1) PG8_BAR; }
    }
    PG8_WAIT_V(0);
    if constexpr (!ALIGN_EPI) { if (wr == 0) PG8_BAR; }
    PG8_BAR;
#undef PG8_KA
#undef PG8_KB
#undef PG8_SA
#undef PG8_SB
#undef PG8_STAGE
#undef PG8_LDA
#undef PG8_LDB
#undef PG8_MMA
#undef PG8_WAIT_V
#undef PG8_WAIT_L
#undef PG8_BAR
#undef PG8_SCHED
}

struct EpiCols {
    static constexpr bool PERM = true;
    bf16_t* O; int ldc; bf16_t* vt; bf16_t* vselt; bf16_t* vwint;
    DI void operator()(const f32x4 (&acc)[2][2][4][2], const Unit& u, int wr, int wc, int fr, int fq) const {
        const int kind = u.pz >> 1;
        if (kind == 0) {
        const bool lo = fr < 8;
        bf16_t* base = O + (size_t)(u.pm * BM + wr * 64 + (fr & 7)) * ldc + u.pn * BM + wc * 64 + 8 * fq + (lo ? 0 : 32);
#pragma unroll
        for (int ai = 0; ai < 2; ++ai)
#pragma unroll
            for (int m = 0; m < 4; ++m) { bf16_t* rowp = base + (size_t)(ai * HALF + m * 16) * ldc;
                u32x4 w[2];
#pragma unroll
                for (int bj = 0; bj < 2; ++bj) { const f32x4 v0 = acc[ai][bj][m][0], v1 = acc[ai][bj][m][1];
                    w[bj].x = cvt_pk_bf16(v0[0], v0[1]); w[bj].y = cvt_pk_bf16(v0[2], v0[3]); w[bj].z = cvt_pk_bf16(v1[0], v1[1]); w[bj].w = cvt_pk_bf16(v1[2], v1[3]); }
                u32x4 snd, rcv;
#pragma unroll
                for (int e = 0; e < 4; ++e) { snd[e] = lo ? w[1][e] : w[0][e]; rcv[e] = (unsigned)__builtin_amdgcn_update_dpp(0, (int)snd[e], 0x128, 0xf, 0xf, false); }
                u32x4 sa, sb;
#pragma unroll
                for (int e = 0; e < 4; ++e) { sa[e] = lo ? w[0][e] : rcv[e]; sb[e] = lo ? rcv[e] : w[1][e]; }
                *(u32x4*)rowp = sa; *(u32x4*)(rowp + (size_t)8 * ldc) = sb; }
        } else {
        const int chunk = 4 * u.pm + wc, f0 = wr * 64 + fr;
        if (kind == 1) { bf16_t* base = vt + ((size_t)chunk * 2048 + (u.pn - 36) * BM + f0) * 64 + 8 * fq;
#pragma unroll
            for (int ai = 0; ai < 2; ++ai)
#pragma unroll
                for (int m = 0; m < 4; ++m)
#pragma unroll
                    for (int bj = 0; bj < 2; ++bj) { const f32x4 v0 = acc[ai][bj][m][0], v1 = acc[ai][bj][m][1];
                        u32x4 w; w.x = cvt_pk_bf16(v0[0], v0[1]); w.y = cvt_pk_bf16(v0[2], v0[3]); w.z = cvt_pk_bf16(v1[0], v1[1]); w.w = cvt_pk_bf16(v1[2], v1[3]);
                        *(u32x4*)(base + (size_t)(ai * HALF + m * 16) * 64 + 32 * bj) = w; }
        } else {
            bf16_t* arr = kind == 2 ? vselt : vwint; const int t0 = (u.pn - (kind == 2 ? 14 : 18)) * BM + f0;
            const int pos0 = 16 * (fq & 1) + 4 * (fq >> 1);
#pragma unroll
            for (int ai = 0; ai < 2; ++ai)
#pragma unroll
                for (int m = 0; m < 4; ++m) { const int fc = t0 + ai * HALF + m * 16, gg = fc >> 7, dim = fc & 127;
                    bf16_t* rowp = arr + ((size_t)(gg * 128 + chunk) * 128 + dim) * 64 + pos0;
#pragma unroll
                    for (int bj = 0; bj < 2; ++bj) { const f32x4 v0 = acc[ai][bj][m][0], v1 = acc[ai][bj][m][1];
                        u32x2 w0, w1; w0.x = cvt_pk_bf16(v0[0], v0[1]); w0.y = cvt_pk_bf16(v0[2], v0[3]); w1.x = cvt_pk_bf16(v1[0], v1[1]); w1.y = cvt_pk_bf16(v1[2], v1[3]);
                        *(u32x2*)(rowp + 32 * bj) = w0; *(u32x2*)(rowp + 32 * bj + 8) = w1; } }
        } }
    }
};
struct EpiPart {
    static constexpr bool PERM = false;
    float* P;
    DI void operator()(const f32x4 (&acc)[2][2][4][2], const Unit& u, int wr, int wc, int fr, int fq) const {
        float* base = P + ((size_t)(u.pk * 8 + u.pz) * 512 + u.pm * BM) * 256;
        const int row0 = wr * 64 + fr, col0 = wc * 32 + 4 * fq;
#pragma unroll
        for (int ai = 0; ai < 2; ++ai)
#pragma unroll
            for (int m = 0; m < 4; ++m) { float* rowp = base + (size_t)(row0 + ai * HALF + m * 16) * 256 + col0;
#pragma unroll
                for (int bj = 0; bj < 2; ++bj)
#pragma unroll
                    for (int n = 0; n < 2; ++n) *(f32x4*)(rowp + bj * HALF + n * 16) = acc[ai][bj][m][n]; }
    }
};
struct EpiGateTmp {
    static constexpr bool PERM = true;
    float* O; const bf16_t* gate;
    DI void operator()(const f32x4 (&acc)[2][2][4][2], const Unit& u, int wr, int wc, int fr, int fq) const {
        const int row0 = u.pm * BM + wr * 64 + fr, col0 = u.pn * BM + wc * 64 + 8 * fq;
#pragma unroll
        for (int ai = 0; ai < 2; ++ai)
#pragma unroll
            for (int m = 0; m < 4; ++m) { const int row = row0 + ai * HALF + m * 16;
#pragma unroll
                for (int bj = 0; bj < 2; ++bj) { const u32x4 gw = *(const u32x4*)(gate + (size_t)row * NP + col0 + bj * 32);
                    const f32x4 v0 = acc[ai][bj][m][0], v1 = acc[ai][bj][m][1]; f32x4 o0, o1;
                    o0[0] = v0[0] * sigmoidf_(lo_bf(gw.x)); o0[1] = v0[1] * sigmoidf_(hi_bf(gw.x)); o0[2] = v0[2] * sigmoidf_(lo_bf(gw.y)); o0[3] = v0[3] * sigmoidf_(hi_bf(gw.y));
                    o1[0] = v1[0] * sigmoidf_(lo_bf(gw.z)); o1[1] = v1[1] * sigmoidf_(hi_bf(gw.z)); o1[2] = v1[2] * sigmoidf_(lo_bf(gw.w)); o1[3] = v1[3] * sigmoidf_(hi_bf(gw.w));
                    float* op = O + (size_t)row * D + col0 + bj * 32; *(f32x4*)op = o0; *(f32x4*)(op + 4) = o1; }
                asm volatile("" ::: "memory"); }
    }
};
struct EpiGateAdd {
    static constexpr bool PERM = true;
    bf16_t* Y; const float* tmp; const bf16_t* gate;
    DI void operator()(const f32x4 (&acc)[2][2][4][2], const Unit& u, int wr, int wc, int fr, int fq) const {
        const int row0 = u.pm * BM + wr * 64 + fr, col0 = u.pn * BM + wc * 64 + 8 * fq;
#pragma unroll
        for (int ai = 0; ai < 2; ++ai)
#pragma unroll
            for (int m = 0; m < 4; ++m) { const int row = row0 + ai * HALF + m * 16;
#pragma unroll
                for (int bj = 0; bj < 2; ++bj) { const u32x4 gw = *(const u32x4*)(gate + (size_t)row * NP + col0 + bj * 32);
                    const float* tp = tmp + (size_t)row * D + col0 + bj * 32; const f32x4 t0 = *(const f32x4*)tp, t1 = *(const f32x4*)(tp + 4);
                    const f32x4 v0 = acc[ai][bj][m][0], v1 = acc[ai][bj][m][1]; f32x4 o0, o1;
                    o0[0] = t0[0] + v0[0] * sigmoidf_(lo_bf(gw.x)); o0[1] = t0[1] + v0[1] * sigmoidf_(hi_bf(gw.x)); o0[2] = t0[2] + v0[2] * sigmoidf_(lo_bf(gw.y)); o0[3] = t0[3] + v0[3] * sigmoidf_(hi_bf(gw.y));
                    o1[0] = t1[0] + v1[0] * sigmoidf_(lo_bf(gw.z)); o1[1] = t1[1] + v1[1] * sigmoidf_(hi_bf(gw.z)); o1[2] = t1[2] + v1[2] * sigmoidf_(lo_bf(gw.w)); o1[3] = t1[3] + v1[3] * sigmoidf_(hi_bf(gw.w));
                    u32x4 w; w.x = cvt_pk_bf16(o0[0], o0[1]); w.y = cvt_pk_bf16(o0[2], o0[3]); w.z = cvt_pk_bf16(o1[0], o1[1]); w.w = cvt_pk_bf16(o1[2], o1[3]);
                    *(u32x4*)(Y + (size_t)row * D + col0 + bj * 32) = w; }
                asm volatile("" ::: "memory"); }
    }
};
struct EpiResid {
    static constexpr bool PERM = true;
    const float* xf; const bf16_t* xb; bf16_t* xo;
    DI void operator()(const f32x4 (&acc)[2][2][4][2], const Unit& u, int wr, int wc, int fr, int fq) const {
        const int row0 = u.pm * BM + wr * 64 + fr, col0 = u.pn * BM + wc * 64 + 8 * fq;
#pragma unroll
        for (int ai = 0; ai < 2; ++ai) {
            if (xf) { f32x4 t[4][2][2];
#pragma unroll
                for (int m = 0; m < 4; ++m) { const size_t off = (size_t)(row0 + ai * HALF + m * 16) * D + col0;
#pragma unroll
                    for (int bj = 0; bj < 2; ++bj) { t[m][bj][0] = *(const f32x4*)(xf + off + bj * 32); t[m][bj][1] = *(const f32x4*)(xf + off + bj * 32 + 4); } }
#pragma unroll
                for (int m = 0; m < 4; ++m) { const size_t off = (size_t)(row0 + ai * HALF + m * 16) * D + col0;
#pragma unroll
                    for (int bj = 0; bj < 2; ++bj) { const f32x4 o0 = t[m][bj][0] + acc[ai][bj][m][0], o1 = t[m][bj][1] + acc[ai][bj][m][1];
                        u32x4 w; w.x = pk2h(o0[0], o0[1]); w.y = pk2h(o0[2], o0[3]); w.z = pk2h(o1[0], o1[1]); w.w = pk2h(o1[2], o1[3]);
                        *(u32x4*)(xo + off + bj * 32) = w; } }
            } else { u32x4 t[4][2];
#pragma unroll
                for (int m = 0; m < 4; ++m) { const size_t off = (size_t)(row0 + ai * HALF + m * 16) * D + col0;
#pragma unroll
                    for (int bj = 0; bj < 2; ++bj) t[m][bj] = *(const u32x4*)(xb + off + bj * 32); }
#pragma unroll
                for (int m = 0; m < 4; ++m) { const size_t off = (size_t)(row0 + ai * HALF + m * 16) * D + col0;
#pragma unroll
                    for (int bj = 0; bj < 2; ++bj) { const u32x4 x_ = t[m][bj]; const f32x4 v0 = acc[ai][bj][m][0], v1 = acc[ai][bj][m][1];
                        u32x4 w; w.x = pk2h(lo_h(x_.x) + v0[0], hi_h(x_.x) + v0[1]); w.y = pk2h(lo_h(x_.y) + v0[2], hi_h(x_.y) + v0[3]);
                        w.z = pk2h(lo_h(x_.z) + v1[0], hi_h(x_.z) + v1[1]); w.w = pk2h(lo_h(x_.w) + v1[2], hi_h(x_.w) + v1[3]);
                        *(u32x4*)(xo + off + bj * 32) = w; } } }
            asm volatile("" ::: "memory"); }
    }
};
struct OrderAB {
    static constexpr bool SIGNAL = false;
    OrderMN mn; const bf16_t* A2; const bf16_t* B2;
    DI bool next(int i, Unit& u) const { if (!mn.next(i >> 1, u)) return false; u.pz = i & 1; return true; }
    DI const char* a_ptr(const Gemm& g, const Unit& u) const { return (const char*)(u.pz ? A2 : g.A) + (size_t)u.pm * BM * g.lda * 2; }
    DI const char* b_ptr(const Gemm& g, const Unit& u) const { return (const char*)(u.pz ? B2 : g.Bt) + (size_t)u.pn * BM * g.ldb * 2; }
};
struct EpiGateAB {
    static constexpr bool PERM = true;
    bf16_t* Y; bf16_t* tmp; const bf16_t* gate_a; const bf16_t* gate_b;
    DI void operator()(const f32x4 (&acc)[2][2][4][2], const Unit& u, int wr, int wc, int fr, int fq) const {
        const int row0 = u.pm * BM + wr * 64 + fr, col0 = u.pn * BM + wc * 64 + 8 * fq;
        const bf16_t* gate = u.pz ? gate_b : gate_a; bf16_t* dst = u.pz ? Y : tmp;
#pragma unroll
        for (int ai = 0; ai < 2; ++ai) { u32x4 gw[4][2], tw[4][2];
#pragma unroll
            for (int m = 0; m < 4; ++m) { const int row = row0 + ai * HALF + m * 16;
#pragma unroll
                for (int bj = 0; bj < 2; ++bj) { gw[m][bj] = *(const u32x4*)(gate + (size_t)row * NP + col0 + bj * 32);
                    tw[m][bj] = (u32x4){0u, 0u, 0u, 0u}; if (u.pz) tw[m][bj] = *(const u32x4*)(tmp + (size_t)row * D + col0 + bj * 32); } }
#pragma unroll
            for (int m = 0; m < 4; ++m) { const int row = row0 + ai * HALF + m * 16;
#pragma unroll
                for (int bj = 0; bj < 2; ++bj) { const u32x4 g_ = gw[m][bj], t_ = tw[m][bj];
                    const f32x4 v0 = acc[ai][bj][m][0], v1 = acc[ai][bj][m][1]; f32x4 o0, o1;
                    o0[0] = lo_bf(t_.x) + v0[0] * sigmoidf_(lo_bf(g_.x)); o0[1] = hi_bf(t_.x) + v0[1] * sigmoidf_(hi_bf(g_.x)); o0[2] = lo_bf(t_.y) + v0[2] * sigmoidf_(lo_bf(g_.y)); o0[3] = hi_bf(t_.y) + v0[3] * sigmoidf_(hi_bf(g_.y));
                    o1[0] = lo_bf(t_.z) + v1[0] * sigmoidf_(lo_bf(g_.z)); o1[1] = hi_bf(t_.z) + v1[1] * sigmoidf_(hi_bf(g_.z)); o1[2] = lo_bf(t_.w) + v1[2] * sigmoidf_(lo_bf(g_.w)); o1[3] = hi_bf(t_.w) + v1[3] * sigmoidf_(hi_bf(g_.w));
                    u32x4 w; w.x = cvt_pk_bf16(o0[0], o0[1]); w.y = cvt_pk_bf16(o0[2], o0[3]); w.z = cvt_pk_bf16(o1[0], o1[1]); w.w = cvt_pk_bf16(o1[2], o1[3]);
                    *(u32x4*)(dst + (size_t)row * D + col0 + bj * 32) = w; } }
            asm volatile("" ::: "memory"); }
    }
};
}

#define XB_TMO      128
#define XB_XCNT(j)  (256  + 64 * (j))
#define XB_XSUB(j)  (1280 + 64 * (j))
#define XB_XGEN(j)  (2304 + 64 * (j))
#define XB_TOP      3328
#define XB_TOPGEN   3392
#define XCD_BAR_WORDS 3456
#define XB_SPIN_CAP (1u << 18)
__device__ __forceinline__ unsigned xb_ld(unsigned* p)              { return __hip_atomic_load(p, __ATOMIC_RELAXED, __HIP_MEMORY_SCOPE_AGENT); }
__device__ __forceinline__ unsigned xb_add(unsigned* p, unsigned v) { return __hip_atomic_fetch_add(p, v, __ATOMIC_RELAXED, __HIP_MEMORY_SCOPE_AGENT); }
__device__ __forceinline__ unsigned xb_xcc_id() { return (unsigned)__builtin_amdgcn_s_getreg((3 << 11) | 20) & 0xFu; }
#define XB_SPIN(cond, bar) do { unsigned _sp = 0; while (cond) { __builtin_amdgcn_s_sleep(1); \
    if ((++_sp & 255u) == 0u) { if (xb_ld(&(bar)[XB_TMO])) break; if (_sp > XB_SPIN_CAP) { atomicAdd(&(bar)[XB_TMO], 1u); break; } } } } while (0)
struct XcdBarrier { unsigned* bar; unsigned x; volatile LAS unsigned* st; };
__device__ __forceinline__ XcdBarrier xcd_barrier_post(unsigned* bar, volatile LAS unsigned* st) {
    XcdBarrier b; b.bar = bar; b.x = xb_xcc_id(); b.st = st;
    if (threadIdx.x == 0) (void)xb_add(&bar[XB_XCNT(b.x)], 1u);
    return b;
}
__device__ __forceinline__ void xcd_barrier_complete(unsigned* bar, unsigned x, unsigned& nloc, unsigned& nx) {
    const unsigned G = gridDim.x * gridDim.y * gridDim.z;
    unsigned sum, cnt, mine, sp = 0u;
    for (;;) {
        sum = 0u; cnt = 0u; mine = 0u;
#pragma unroll
        for (unsigned j = 0; j < 16; ++j) { const unsigned c = xb_ld(&bar[XB_XCNT(j)]); sum += c; cnt += (c > 0u) ? 1u : 0u; mine = (j == x) ? c : mine; }
        if (sum == G) break;
        __builtin_amdgcn_s_sleep(1);
        if ((++sp & 255u) == 0u) { if (xb_ld(&bar[XB_TMO])) break; if (sp > XB_SPIN_CAP) { atomicAdd(&bar[XB_TMO], 1u); break; } }
    }
    nloc = mine > 0u ? mine : 1u; nx = cnt > 0u ? cnt : 1u;
}
__device__ __forceinline__ void xcd_barrier(const XcdBarrier& b) {
    asm volatile("s_waitcnt vmcnt(0)" ::: "memory");
    __syncthreads();
    if (threadIdx.x == 0) {
        unsigned* bar = b.bar;
        __builtin_amdgcn_s_waitcnt(0);
        unsigned nloc = b.st[0], nx = b.st[1];
        if (nloc == 0u) { xcd_barrier_complete(bar, b.x, nloc, nx); b.st[0] = nloc; b.st[1] = nx; }
        const unsigned old = xb_add(&bar[XB_XSUB(b.x)], 1u);
        const unsigned gen = old / nloc;
        if (old + 1u == (gen + 1u) * nloc) {
            __builtin_amdgcn_fence(__ATOMIC_RELEASE, "agent");
            asm volatile("s_waitcnt vmcnt(0)" ::: "memory");
            const unsigned og = xb_add(&bar[XB_TOP], 1u);
            const unsigned tg = og / nx;
            if (og + 1u == (tg + 1u) * nx) xb_add(&bar[XB_TOPGEN], 1u);
            else XB_SPIN(xb_ld(&bar[XB_TOPGEN]) == tg, bar);
            __builtin_amdgcn_fence(__ATOMIC_ACQUIRE, "agent");
            xb_add(&bar[XB_XGEN(b.x)], 1u);
            asm volatile("s_waitcnt vmcnt(0)" ::: "memory");
        } else {
            XB_SPIN(xb_ld(&bar[XB_XGEN(b.x)]) == gen, bar);
            __builtin_amdgcn_fence(__ATOMIC_ACQUIRE, "agent");
            asm volatile("s_waitcnt vmcnt(0)" ::: "memory");
        }
    }
    __syncthreads();
}

struct Args {
    const float *x, *norm_w, *w_in, *cmp_pe, *cmp_w1, *cmp_b1, *cmp_w2, *cmp_b2, *alpha_w, *alpha_b, *gla_norm_w, *p_a, *p_b, *w_out, *final_w;
    float* out; unsigned char* ws; int ph_lo, ph_hi;
};
typedef const __attribute__((address_space(4))) Args* KArgsP;
DI Args load_args(KArgsP p) { Args a; a.x = p->x; a.norm_w = p->norm_w; a.w_in = p->w_in; a.cmp_pe = p->cmp_pe; a.cmp_w1 = p->cmp_w1; a.cmp_b1 = p->cmp_b1; a.cmp_w2 = p->cmp_w2; a.cmp_b2 = p->cmp_b2;
    a.alpha_w = p->alpha_w; a.alpha_b = p->alpha_b; a.gla_norm_w = p->gla_norm_w; a.p_a = p->p_a; a.p_b = p->p_b; a.w_out = p->w_out; a.final_w = p->final_w; a.out = p->out; a.ws = p->ws; a.ph_lo = 0; a.ph_hi = 0; return a; }
struct Frame {
    LAS unsigned char* lds; int tid, lane, wave, G, bid, gw, NGW;
};

struct CvItem { const float* W; bf16_t* WT; int K, N, item; bool map; };
DI void cv_load(f32x4 (&v)[16], const CvItem& c, int lane) {
    const int nblk = c.N / 64, kb = c.item / nblk, nb = c.item % nblk, k0 = 64 * kb, n0 = 64 * nb;
#pragma unroll
    for (int i = 0; i < 16; ++i) v[i] = *(const f32x4*)(c.W + (size_t)(k0 + 4 * i + (lane >> 4)) * c.N + n0 + 4 * (lane & 15));
}
DI void cv_store(const f32x4 (&v)[16], const CvItem& c, LAS float* scr, int lane) {
    const int nblk = c.N / 64, kb = c.item / nblk, nb = c.item % nblk, k0 = 64 * kb, n0 = 64 * nb;
#pragma unroll
    for (int i = 0; i < 16; ++i) { LAS float* d = scr + (4 * i + (lane >> 4)) * 65 + 4 * (lane & 15); d[0] = v[i].x; d[1] = v[i].y; d[2] = v[i].z; d[3] = v[i].w; }
    LDS_WAIT(); asm volatile("" ::: "memory");
    const int ch = lane & 7;
#pragma unroll
    for (int j = 0; j < 8; ++j) { const int n = (lane >> 3) + 8 * j; const LAS float* s = scr + (8 * ch) * 65 + n;
        u32x4 o; o.x = pk2(s[0 * 65], s[1 * 65]); o.y = pk2(s[2 * 65], s[3 * 65]); o.z = pk2(s[4 * 65], s[5 * 65]); o.w = pk2(s[6 * 65], s[7 * 65]);
        const int drow = c.map ? map_col(n0 + n) : (n0 + n);
        *(u32x4*)(c.WT + (size_t)drow * c.K + k0 + 8 * ch) = o; }
    LDS_WAIT(); asm volatile("" ::: "memory");
}
constexpr int CV_IN = (D / 64) * (NIN / 64), CV_SQ = (D / 64) * (D / 64), CV_W1 = (4096 / 64) * (256 / 64), CV_W2 = (256 / 64) * (128 / 64);
constexpr int CV_PER_L = CV_IN + 3 * CV_SQ + 2 * CV_W1 + 2 * CV_W2;
DI CvItem cv_item(const Args& a, int it) {
    unsigned char* ws = a.ws; const int l = it / CV_PER_L; int r = it % CV_PER_L; CvItem c;
    if (r < CV_IN) { c.W = a.w_in + (size_t)l * D * NIN; c.WT = (bf16_t*)(ws + WS_WIN) + (size_t)l * NP * D; c.K = D; c.N = NIN; c.item = r; c.map = true; return c; } r -= CV_IN;
    c.map = false;
    if (r < CV_SQ) { c.W = a.p_a + (size_t)l * D * D; c.WT = (bf16_t*)(ws + WS_WPA) + (size_t)l * D * D; c.K = D; c.N = D; c.item = r; return c; } r -= CV_SQ;
    if (r < CV_SQ) { c.W = a.p_b + (size_t)l * D * D; c.WT = (bf16_t*)(ws + WS_WPB) + (size_t)l * D * D; c.K = D; c.N = D; c.item = r; return c; } r -= CV_SQ;
    if (r < CV_SQ) { c.W = a.w_out + (size_t)l * D * D; c.WT = (bf16_t*)(ws + WS_WOUT) + (size_t)l * D * D; c.K = D; c.N = D; c.item = r; return c; } r -= CV_SQ;
    if (r < 2 * CV_W1) { const int kv = r / CV_W1; c.W = a.cmp_w1 + (size_t)(l * 2 + kv) * 4096 * 256; c.WT = (bf16_t*)(ws + WS_W1T) + (size_t)(l * 2 + kv) * 256 * 4096; c.K = 4096; c.N = 256; c.item = r % CV_W1; return c; } r -= 2 * CV_W1;
    { const int kv = r / CV_W2; c.W = a.cmp_w2 + (size_t)(l * 2 + kv) * 256 * 128; c.WT = (bf16_t*)(ws + WS_W2T) + (size_t)(l * 2 + kv) * 128 * 256; c.K = 256; c.N = 128; c.item = r % CV_W2; }
    return c;
}
DI void p_prologue(const Frame& F, const Args& a) {
    LAS float* scr = (LAS float*)(F.lds + F.wave * 16640);
    unsigned char* ws = a.ws;
    constexpr int TOT = DEPTH * CV_PER_L;
    f32x4 va[16], vb[16];
    int it = F.gw;
    if (it < TOT) { CvItem ca = cv_item(a, it); cv_load(va, ca, F.lane);
        for (;;) {
            const int itb = it + F.NGW; CvItem cb; const bool hb = itb < TOT; if (hb) { cb = cv_item(a, itb); cv_load(vb, cb, F.lane); }
            cv_store(va, ca, scr, F.lane);
            if (!hb) break;
            const int itc = itb + F.NGW; const bool hc = itc < TOT; if (hc) { ca = cv_item(a, itc); cv_load(va, ca, F.lane); }
            cv_store(vb, cb, scr, F.lane);
            if (!hc) break;
            it = itc;
        } }
    __syncthreads();
    LAS float* red = (LAS float*)F.lds;
    for (int job = F.bid; job < DEPTH * 2; job += F.G) {
        const float* w1 = a.cmp_w1 + (size_t)job * 4096 * 256; const float* pe = a.cmp_pe + (size_t)job * 4096;
        f32x4 s = {0.f, 0.f, 0.f, 0.f};
        for (int k = F.wave * 512; k < F.wave * 512 + 512; ++k) { const f32x4 w = *(const f32x4*)(w1 + (size_t)k * 256 + 4 * F.lane); s += w * pe[k]; }
        *(LAS f32x4*)(red + F.wave * 256 + 4 * F.lane) = s;
        __syncthreads();
        if (F.tid < 256) { float t = a.cmp_b1[job * 256 + F.tid];
#pragma unroll
            for (int w = 0; w < 8; ++w) t += red[w * 256 + F.tid];
            ((float*)(ws + WS_B1P))[job * 256 + F.tid] = t; }
        __syncthreads();
    }
}

template <bool OUT_F32, bool IN_BF16>
DI void p_rmsnorm(const Frame& F, const void* xin, const float* w, void* out) {
    f32x4 wv[4][2];
#pragma unroll
    for (int j = 0; j < 4; ++j) { wv[j][0] = *(const f32x4*)(w + 512 * j + 8 * F.lane); wv[j][1] = *(const f32x4*)(w + 512 * j + 8 * F.lane + 4); }
    for (int row = F.gw; row < T; row += F.NGW) {
        float v[4][8]; float s = 0.f;
        if (IN_BF16) { const bf16_t* xr = (const bf16_t*)xin + (size_t)row * D + 8 * F.lane; u32x4 q[4];
#pragma unroll
            for (int j = 0; j < 4; ++j) q[j] = *(const u32x4*)(xr + 512 * j);
#pragma unroll
            for (int j = 0; j < 4; ++j) unpack8h(q[j], v[j]);
        } else { const float* xr = (const float*)xin + (size_t)row * D + 8 * F.lane; f32x4 q[4][2];
#pragma unroll
            for (int j = 0; j < 4; ++j) { q[j][0] = *(const f32x4*)(xr + 512 * j); q[j][1] = *(const f32x4*)(xr + 512 * j + 4); }
#pragma unroll
            for (int j = 0; j < 4; ++j)
#pragma unroll
                for (int e = 0; e < 8; ++e) v[j][e] = q[j][e >> 2][e & 3]; }
#pragma unroll
        for (int j = 0; j < 4; ++j) s += ((v[j][0] * v[j][0] + v[j][1] * v[j][1]) + (v[j][2] * v[j][2] + v[j][3] * v[j][3])) + ((v[j][4] * v[j][4] + v[j][5] * v[j][5]) + (v[j][6] * v[j][6] + v[j][7] * v[j][7]));
        const float rs = rsqrtf(wave_sum(s, F.lane) * (1.f / D) + NORM_EPS);
        if (OUT_F32) { float* o = (float*)out + (size_t)row * D + 8 * F.lane;
#pragma unroll
            for (int j = 0; j < 4; ++j) { f32x4 y0, y1;
#pragma unroll
                for (int e = 0; e < 4; ++e) { y0[e] = v[j][e] * rs * wv[j][0][e]; y1[e] = v[j][4 + e] * rs * wv[j][1][e]; }
                *(f32x4*)(o + 512 * j) = y0; *(f32x4*)(o + 512 * j + 4) = y1; }
        } else { bf16_t* o = (bf16_t*)out + (size_t)row * D + 8 * F.lane;
#pragma unroll
            for (int j = 0; j < 4; ++j) { float y[8];
#pragma unroll
                for (int e = 0; e < 8; ++e) y[e] = v[j][e] * rs * wv[j][e >> 2][e & 3];
                u32x4 p; p.x = pk2(y[0], y[1]); p.y = pk2(y[2], y[3]); p.z = pk2(y[4], y[5]); p.w = pk2(y[6], y[7]); *(u32x4*)(o + 512 * j) = p; } }
    }
}

constexpr int KTILE = 16384, VTILE = 16384, ABUF = KTILE + VTILE;
DI void glds16(const void* gsrc, LAS unsigned char* dst) { unsigned keep; const unsigned lds_dst = (unsigned)(uintptr_t)dst;
    asm volatile("s_mov_b32 %0, m0\n\ts_mov_b32 m0, %2\n\ts_nop 0\n\tglobal_load_lds_dwordx4 %1, off\n\ts_mov_b32 m0, %0" : "=&s"(keep) : "v"(gsrc), "s"(lds_dst) : "memory"); }
DI void dma_k(LAS unsigned char* kb, const bf16_t* kbase, size_t kpitch, int w, int lane) {
#pragma unroll
    for (int i = 0; i < 2; ++i) { const int b = w + 8 * i, row = 4 * b + (lane >> 4), c = (lane & 15) ^ (row & 15);
        glds16(kbase + (size_t)row * kpitch + c * 8, kb + b * 1024); }
}
DI void dma_v(LAS unsigned char* vb, const bf16_t* vbase, size_t vpitch, int w, int lane) {
#pragma unroll
    for (int i = 0; i < 2; ++i) { const int b = w + 8 * i, row = 8 * b + (lane >> 3), c = (lane & 7) ^ ((row >> 1) & 7);
        glds16(vbase + (size_t)row * vpitch + c * 8, vb + b * 1024); }
}
#define VMCNT(n) asm volatile("s_waitcnt vmcnt(" #n ")" ::: "memory")
#define RAW_BARRIER() do { asm volatile("" ::: "memory"); __builtin_amdgcn_s_barrier(); asm volatile("" ::: "memory"); } while (0)

template <bool PERMK>
DI void transpose64x64(const bf16_t* src, size_t pitch, bf16_t* dst, LAS unsigned char* scr, int lane) {
    u32x4 v[8];
#pragma unroll
    for (int i = 0; i < 8; ++i) { const int id = i * 64 + lane, row = id >> 3, ch = id & 7; v[i] = *(const u32x4*)(src + (size_t)row * pitch + ch * 8); }
#pragma unroll
    for (int i = 0; i < 8; ++i) { const int id = i * 64 + lane, row = id >> 3, ch = id & 7;
        const int pos = PERMK ? ((row & 32) | (((row >> 2) & 3) << 3) | (((row >> 4) & 1) << 2) | (row & 3)) : row;
        LAS unsigned char* d = scr + (8 * ch) * 136 + pos * 2;
        *(LAS unsigned short*)(d + 0 * 136) = (unsigned short)(v[i].x & 0xffffu); *(LAS unsigned short*)(d + 1 * 136) = (unsigned short)(v[i].x >> 16);
        *(LAS unsigned short*)(d + 2 * 136) = (unsigned short)(v[i].y & 0xffffu); *(LAS unsigned short*)(d + 3 * 136) = (unsigned short)(v[i].y >> 16);
        *(LAS unsigned short*)(d + 4 * 136) = (unsigned short)(v[i].z & 0xffffu); *(LAS unsigned short*)(d + 5 * 136) = (unsigned short)(v[i].z >> 16);
        *(LAS unsigned short*)(d + 6 * 136) = (unsigned short)(v[i].w & 0xffffu); *(LAS unsigned short*)(d + 7 * 136) = (unsigned short)(v[i].w >> 16); }
    LDS_WAIT(); asm volatile("" ::: "memory");
#pragma unroll
    for (int i = 0; i < 8; ++i) { const int id = i * 64 + lane, col = id >> 3, tg = id & 7;
        const u32x2 lo = *(const LAS u32x2*)(scr + col * 136 + tg * 16), hi = *(const LAS u32x2*)(scr + col * 136 + tg * 16 + 8);
        u32x4 o; o.x = lo.x; o.y = lo.y; o.z = hi.x; o.w = hi.y;
        *(u32x4*)(dst + (size_t)col * 64 + 8 * tg) = o; }
    LDS_WAIT(); asm volatile("" ::: "memory");
}

DI void gla_g1_unit(const Frame& F, const Args& a, int layer, int n, int h) {
    const bf16_t* cols = (const bf16_t*)(a.ws + WS_COLS);
    LAS float* alr = (LAS float*)(F.lds); LAS float* part = (LAS float*)(F.lds + 4096);
    LAS unsigned char* QR = F.lds + 8192; LAS unsigned char* KR = F.lds + 8192 + 32768;
    __syncthreads();
#pragma unroll
    for (int hf = 0; hf < 2; ++hf) { dma_k(QR + hf * 16384, cols + (size_t)(64 * n) * NP + C_QB + h * 256 + hf * 128, NP, F.wave, F.lane);
        dma_k(KR + hf * 16384, cols + (size_t)(64 * n) * NP + C_KB + h * 256 + hf * 128, NP, F.wave, F.lane); }
    if (F.tid < 256) { const int t = F.tid >> 2, k4 = (F.tid & 3) * 4; const u32x2 w = *(const u32x2*)(cols + (size_t)(64 * n + t) * NP + C_ALR + k4);
        alr[t * 16 + k4 + 0] = lo_bf(w.x); alr[t * 16 + k4 + 1] = hi_bf(w.x); alr[t * 16 + k4 + 2] = lo_bf(w.y); alr[t * 16 + k4 + 3] = hi_bf(w.y); }
    __syncthreads();
    const int d = F.tid & 255, half = F.tid >> 8, col = h * 256 + d;
    float w[16];
#pragma unroll
    for (int k = 0; k < 16; ++k) w[k] = a.alpha_w[(size_t)(layer * 16 + k) * 1024 + col];
    const float b = a.alpha_b[layer * 1024 + col];
    float cum[32]; float run = 0.f;
#pragma unroll
    for (int i = 0; i < 32; ++i) { const int t = half * 32 + i; float ga = b;
#pragma unroll
        for (int k4 = 0; k4 < 4; ++k4) { const f32x4 av = *(const LAS f32x4*)(alr + t * 16 + 4 * k4); ga += av.x * w[4 * k4] + av.y * w[4 * k4 + 1] + av.z * w[4 * k4 + 2] + av.w * w[4 * k4 + 3]; }
        const float ls = fminf(ga, 0.f) - __logf(1.f + __expf(-fabsf(ga)));
        run += ls * 0.0625f; cum[i] = run; }
    part[half * 256 + d] = run;
    VMCNT(0);
    __syncthreads();
    const float p0 = part[d], last = p0 + part[256 + d], elast = __expf(last);
    if (half) {
#pragma unroll
        for (int i = 0; i < 32; ++i) cum[i] += p0; }
    bf16_t* kst = (bf16_t*)(a.ws + WS_KST);
    const int eoff = (d >> 7) * 16384 + (d & 7) * 2, ech = (d & 127) >> 3;
    unsigned ksw[16];
#pragma unroll
    for (int i = 0; i < 32; ++i) { const int t = half * 32 + i; const int off = eoff + t * 256 + ((ech ^ (t & 15)) << 4);
        const float qv = bf2f(*(const LAS unsigned short*)(QR + off)), kv = bf2f(*(const LAS unsigned short*)(KR + off));
        const float ec = __expf(cum[i]), kin = kv * __expf(-cum[i]);
        const unsigned qb = f2bf(qv * 0.0625f * ec), kib = f2bf(kin), ksb = f2bf(kin * elast);
        *(LAS unsigned short*)(QR + off) = (unsigned short)qb; *(LAS unsigned short*)(KR + off) = (unsigned short)kib;
        if (i & 1) ksw[i >> 1] |= ksb << 16; else ksw[i >> 1] = ksb; }
    { bf16_t* kp = kst + ((size_t)((n * 4 + h) * 256 + d)) * 64 + half * 32;
#pragma unroll
        for (int j = 0; j < 4; ++j) { u32x4 o; o.x = ksw[4 * j]; o.y = ksw[4 * j + 1]; o.z = ksw[4 * j + 2]; o.w = ksw[4 * j + 3]; *(u32x4*)(kp + 8 * j) = o; } }
    if (half == 0) ((float*)(a.ws + WS_DEC))[(n * 4 + h) * 256 + d] = elast;
    __syncthreads();
    { bf16_t* qdec = (bf16_t*)(a.ws + WS_QDEC);
#pragma unroll
        for (int i = 0; i < 4; ++i) { const int id = F.tid + 512 * i, t = id >> 5, c32 = id & 31, hf = c32 >> 4, c = c32 & 15;
            *(u32x4*)(qdec + (size_t)(64 * n + t) * 1024 + h * 256 + c32 * 8) = *(const LAS u32x4*)(QR + hf * 16384 + t * 256 + ((c ^ (t & 15)) << 4)); } }
    bf16_t* att = (bf16_t*)(a.ws + WS_ATT) + (size_t)(n * 4 + h) * 4096;
    const int fr = F.lane & 15, fq = F.lane >> 4, ms = F.wave >> 1;
#pragma unroll
    for (int z = 0; z < 2; ++z) { const int nt = 2 * (F.wave & 1) + z; f32x4 acc = {0.f, 0.f, 0.f, 0.f};
#pragma unroll
        for (int ks = 0; ks < 8; ++ks) { const int fo = (ks >> 2) * 16384 + (((4 * (ks & 3) + fq) ^ fr) << 4);
            const bf16x8 A = *(const LAS bf16x8*)(KR + fo + (16 * ms + fr) * 256);
            const bf16x8 B = *(const LAS bf16x8*)(QR + fo + (16 * nt + fr) * 256); acc = MFMA16(A, B, acc); }
        const int t = 16 * nt + fr, s0 = 16 * ms + 4 * fq;
        u32x2 o; o.x = pk2(s0 + 0 <= t ? acc[0] : 0.f, s0 + 1 <= t ? acc[1] : 0.f); o.y = pk2(s0 + 2 <= t ? acc[2] : 0.f, s0 + 3 <= t ? acc[3] : 0.f);
        *(u32x2*)(att + t * 64 + s0) = o; }
}

DI void transpose_unit(const Frame& F, const Args& a, int tu) {
    __syncthreads();
    const bf16_t* cols = (const bf16_t*)(a.ws + WS_COLS);
    LAS unsigned char* scr = F.lds + F.wave * 9216;
#pragma unroll 1
    for (int rep = 0; rep < 3; ++rep) { const int it = (tu * 3 + rep) * 8 + F.wave;
    if (it < 4096) { const int n = it >> 5, cg = it & 31;
        transpose64x64<false>(cols + (size_t)(64 * n) * NP + C_VB + 64 * cg, NP, (bf16_t*)(a.ws + WS_VT) + ((size_t)n * 2048 + 64 * cg) * 64, scr, F.lane); }
    else { const int r = (it - 4096) & 1023, win = (it - 4096) >> 10, j = r >> 3, g = (r >> 1) & 3, hf = r & 1;
        transpose64x64<true>(cols + (size_t)(64 * j) * NP + (win ? C_VWIN : C_VSEL) + 128 * g + 64 * hf, NP,
                             (bf16_t*)(a.ws + (win ? WS_VWINT : WS_VSELT)) + ((size_t)(g * 128 + j) * 128 + 64 * hf) * 64, scr, F.lane); } }
}

DI float gelu_tanh(float x) { const float u = 0.7978845608028654f * (x + 0.044715f * x * x * x); const float t = __expf(2.f * u); return 0.5f * x * (2.f - 2.f / (t + 1.f)); }
DI void mlp2_unit(const Frame& F, const Args& a, int layer, int pz, int rt) {
    const float* cpart = (const float*)(a.ws + WS_CPART);
    LAS unsigned char* hid = F.lds;
    const int kv = pz >> 2, g = pz & 3;
    __syncthreads();
    { const int r = F.tid >> 5, c0 = (F.tid & 31) * 8; f32x4 s0, s1;
        const float* bp = (const float*)(a.ws + WS_B1P) + (layer * 2 + kv) * 256 + c0;
        s0 = *(const f32x4*)bp; s1 = *(const f32x4*)(bp + 4);
#pragma unroll
        for (int pk = 0; pk < 8; ++pk) { const float* p = cpart + ((size_t)(pk * 8 + pz) * 512 + rt * 16 + r) * 256 + c0; s0 += *(const f32x4*)p; s1 += *(const f32x4*)(p + 4); }
        u32x4 o; o.x = pk2(gelu_tanh(s0.x), gelu_tanh(s0.y)); o.y = pk2(gelu_tanh(s0.z), gelu_tanh(s0.w)); o.z = pk2(gelu_tanh(s1.x), gelu_tanh(s1.y)); o.w = pk2(gelu_tanh(s1.z), gelu_tanh(s1.w));
        *(LAS u32x4*)(hid + r * 528 + c0 * 2) = o; }
    __syncthreads();
    const bf16_t* w2t = (const bf16_t*)(a.ws + WS_W2T) + (size_t)(layer * 2 + kv) * 128 * 256;
    const int fr = F.lane & 15, fq = F.lane >> 4, dt = F.wave;
    const float* b2 = a.cmp_b2 + (layer * 2 + kv) * 128;
    f32x4 acc = {0.f, 0.f, 0.f, 0.f};
#pragma unroll
    for (int ks = 0; ks < 8; ++ks) { const bf16x8 wf = *(const bf16x8*)(w2t + (16 * dt + fr) * 256 + 32 * ks + 8 * fq);
        const bf16x8 hf = *(const LAS bf16x8*)(hid + fr * 528 + (32 * ks + 8 * fq) * 2);
        acc = kv ? MFMA16(hf, wf, acc) : MFMA16(wf, hf, acc); }
    if (!kv) { const int n = 16 * rt + fr, dim = 16 * dt + 4 * fq; const f32x4 bb = *(const f32x4*)(b2 + dim); u32x2 o;
        if (n == 511) { o.x = 0u; o.y = 0u; } else { o.x = pk2(acc[0] + bb.x, acc[1] + bb.y); o.y = pk2(acc[2] + bb.z, acc[3] + bb.w); }
        *(u32x2*)((bf16_t*)(a.ws + WS_KC) + ((size_t)g * 512 + n) * 128 + dim) = o; }
    else { const int n0 = 16 * rt + 4 * fq, dim = 16 * dt + fr; const float bb = b2[dim]; u32x2 o;
        o.x = pk2(acc[0] + bb, acc[1] + bb); o.y = pk2(acc[2] + bb, (n0 + 3 == 511) ? 0.f : acc[3] + bb);
        const int pos = 64 * (rt >> 2) + 32 * ((rt & 3) >> 1) + 8 * fq + 4 * (rt & 1);
        *(u32x2*)((bf16_t*)(a.ws + WS_VCT) + ((size_t)g * 128 + dim) * 512 + pos) = o; }
}

template <int ACT>
DI void qk_tile(f32x4 (&s)[4][2], const LAS unsigned char* kb, const bf16x8 (&qf)[2][4], int fr, int fq) {
    const LAS unsigned char* kr = kb + fr * 256; const int x0 = (fq ^ fr) << 4, x1 = ((4 + fq) ^ fr) << 4, x2 = ((8 + fq) ^ fr) << 4, x3 = ((12 + fq) ^ fr) << 4;
    const f32x4 zero = {0.f, 0.f, 0.f, 0.f};
#pragma unroll
    for (int kt = 0; kt < 4; ++kt) { const LAS unsigned char* kn = kr + kt * 4096; bf16x8 kf[4];
        kf[0] = *(const LAS bf16x8*)(kn + x0); kf[1] = *(const LAS bf16x8*)(kn + x1); kf[2] = *(const LAS bf16x8*)(kn + x2); kf[3] = *(const LAS bf16x8*)(kn + x3);
        if (ACT & 1) { s[kt][0] = MFMA16(kf[0], qf[0][0], zero); } if (ACT & 2) { s[kt][1] = MFMA16(kf[0], qf[1][0], zero); }
#pragma unroll
        for (int ks = 1; ks < 4; ++ks) { if (ACT & 1) s[kt][0] = MFMA16(kf[ks], qf[0][ks], s[kt][0]); if (ACT & 2) s[kt][1] = MFMA16(kf[ks], qf[1][ks], s[kt][1]); }
    }
}
template <int ACT, bool WITH_L = true>
DI void pv_tile(f32x4 (&O)[8][2], f32x4 (&L)[2], const LAS unsigned char* vb, const bf16x8 (&pf)[2][2], int fr, int fq) {
    const LAS unsigned char* vr = vb + fr * 128; const int x = (fr >> 1) & 7, y0 = (fq ^ x) << 4, y1 = ((4 + fq) ^ x) << 4;
    const bf16x8 ones = {0x3f80, 0x3f80, 0x3f80, 0x3f80, 0x3f80, 0x3f80, 0x3f80, 0x3f80};
    if (WITH_L && (ACT & 1)) { L[0] = MFMA16(ones, pf[0][0], L[0]); L[0] = MFMA16(ones, pf[1][0], L[0]); }
    if (WITH_L && (ACT & 2)) { L[1] = MFMA16(ones, pf[0][1], L[1]); L[1] = MFMA16(ones, pf[1][1], L[1]); }
#pragma unroll
    for (int dt = 0; dt < 8; ++dt) {
        const bf16x8 v0 = *(const LAS bf16x8*)(vr + dt * 2048 + y0), v1 = *(const LAS bf16x8*)(vr + dt * 2048 + y1);
        if (ACT & 1) O[dt][0] = MFMA16(v0, pf[0][0], O[dt][0]); if (ACT & 2) O[dt][1] = MFMA16(v0, pf[0][1], O[dt][1]);
        if (ACT & 1) O[dt][0] = MFMA16(v1, pf[1][0], O[dt][0]); if (ACT & 2) O[dt][1] = MFMA16(v1, pf[1][1], O[dt][1]);
    }
}
DI float max3f(float a, float b, float c) { return fmaxf(fmaxf(a, b), c); }
DI bf16x8 pack_p(const f32x4& a, const f32x4& b) { u32x4 w; w.x = cvt_pk_bf16(a[0], a[1]); w.y = cvt_pk_bf16(a[2], a[3]); w.z = cvt_pk_bf16(b[0], b[1]); w.w = cvt_pk_bf16(b[2], b[3]); return __builtin_bit_cast(bf16x8, w); }
DI float quad_max(float v, int lane) {
    auto r = __builtin_amdgcn_permlane16_swap(__float_as_uint(v), __float_as_uint(v), false, false); v = fmaxf(__uint_as_float(r[0]), __uint_as_float(r[1]));
    r = __builtin_amdgcn_permlane32_swap(__float_as_uint(v), __float_as_uint(v), false, false); return fmaxf(__uint_as_float(r[0]), __uint_as_float(r[1])); }
DI float quad_sum(float v, int lane) {
    auto r = __builtin_amdgcn_permlane16_swap(__float_as_uint(v), __float_as_uint(v), false, false); v = __uint_as_float(r[0]) + __uint_as_float(r[1]);
    r = __builtin_amdgcn_permlane32_swap(__float_as_uint(v), __float_as_uint(v), false, false); return __uint_as_float(r[0]) + __uint_as_float(r[1]); }
constexpr float NEG_INF = -__builtin_inff();

template <int MODE, int ACT>
DI void fa_tile(f32x4 (&O)[8][2], f32x4 (&L)[2], float (&m)[2], const bf16x8 (&qf)[2][4], const LAS unsigned char* kb, const LAS unsigned char* vb,
                const bool (&bit)[2], const int (&tokl)[2], bool diag, bool left, int fr, int fq, int lane) {
    f32x4 s[4][2];
    qk_tile<ACT>(s, kb, qf, fr, fq);
    bf16x8 pf[2][2];
#pragma unroll
    for (int ct = 0; ct < 2; ++ct) {
        if (!((ACT >> ct) & 1)) continue;
        if (diag || left) {
            const int thr_hi = diag ? tokl[ct] : 63, thr_lo = left ? tokl[ct] : -1;
            int kq = 4 * fq; asm volatile("" : "+v"(kq));
#pragma unroll
            for (int kt = 0; kt < 4; ++kt)
#pragma unroll
                for (int r = 0; r < 4; ++r) { const int kl = 16 * kt + kq + r;
                    s[kt][ct][r] = (kl <= thr_hi && kl > thr_lo) ? s[kt][ct][r] : NEG_INF; } }
        float mx = max3f(s[0][ct][0], s[0][ct][1], s[0][ct][2]);
        mx = max3f(mx, s[0][ct][3], s[1][ct][0]); mx = max3f(mx, s[1][ct][1], s[1][ct][2]); mx = max3f(mx, s[1][ct][3], s[2][ct][0]); mx = max3f(mx, s[2][ct][1], s[2][ct][2]);
        mx = max3f(mx, s[2][ct][3], s[3][ct][0]); mx = max3f(mx, s[3][ct][1], s[3][ct][2]); mx = fmaxf(mx, s[3][ct][3]);
        mx = quad_max(mx, lane);
        if (MODE == 0 && !bit[ct]) mx = NEG_INF;
        if (__ballot((mx - m[ct]) * ATT_C > 8.f) != 0ull) {
            const float mn = fmaxf(m[ct], mx), alpha = __builtin_amdgcn_exp2f((m[ct] - mn) * ATT_C); m[ct] = mn; L[ct] *= alpha;
#pragma unroll
            for (int dt = 0; dt < 8; ++dt) O[dt][ct] *= alpha; }
        const float mc = (MODE == 0 && !bit[ct]) ? __builtin_inff() : m[ct] * ATT_C;
#pragma unroll
        for (int kt = 0; kt < 4; ++kt)
#pragma unroll
            for (int r = 0; r < 4; ++r) s[kt][ct][r] = __builtin_amdgcn_exp2f(s[kt][ct][r] * ATT_C - mc);
        pf[0][ct] = pack_p(s[0][ct], s[1][ct]); pf[1][ct] = pack_p(s[2][ct], s[3][ct]);
    }
    pv_tile<ACT>(O, L, vb, pf, fr, fq);
}

template <int MODE>
DI bool fa_rowmax(float (&m)[2], float (&mc)[2], float (&alpha)[2], f32x4 (&s)[4][2], const bool (&bit)[2], const int (&tokl)[2], bool diag, bool left, int fq, int lane) {
    bool need = false;
#pragma unroll
    for (int ct = 0; ct < 2; ++ct) {
        if (diag || left) {
            const int thr_hi = diag ? tokl[ct] : 63, thr_lo = left ? tokl[ct] : -1;
            int kq = 4 * fq; asm volatile("" : "+v"(kq));
#pragma unroll
            for (int kt = 0; kt < 4; ++kt)
#pragma unroll
                for (int r = 0; r < 4; ++r) { const int kl = 16 * kt + kq + r; s[kt][ct][r] = (kl <= thr_hi && kl > thr_lo) ? s[kt][ct][r] : NEG_INF; } }
        float mx = max3f(s[0][ct][0], s[0][ct][1], s[0][ct][2]);
        mx = max3f(mx, s[0][ct][3], s[1][ct][0]); mx = max3f(mx, s[1][ct][1], s[1][ct][2]); mx = max3f(mx, s[1][ct][3], s[2][ct][0]); mx = max3f(mx, s[2][ct][1], s[2][ct][2]);
        mx = max3f(mx, s[2][ct][3], s[3][ct][0]); mx = max3f(mx, s[3][ct][1], s[3][ct][2]); mx = fmaxf(mx, s[3][ct][3]);
        mx = quad_max(mx, lane);
        if (MODE == 0 && !bit[ct]) mx = NEG_INF;
        alpha[ct] = 1.f;
        if (__ballot((mx - m[ct]) * ATT_C > 8.f) != 0ull) { const float mn = fmaxf(m[ct], mx); alpha[ct] = __builtin_amdgcn_exp2f((m[ct] - mn) * ATT_C); m[ct] = mn; need = true; }
        mc[ct] = (MODE == 0 && !bit[ct]) ? __builtin_inff() : m[ct] * ATT_C;
    }
    return need;
}
template <bool HAS_PREV>
DI void fa_exp_pv(f32x4 (&s)[4][2], const float (&mc)[2], bf16x8 (&pfc)[2][2], f32x4 (&O)[8][2], f32x4 (&L)[2], const bf16x8 (&pfp)[2][2], const LAS unsigned char* vbp, int fr, int fq) {
#define FA_EXP1(e) do { if ((e) < 32) { const int _ct = (e) >> 4, _kt = ((e) >> 2) & 3, _r = (e) & 3; s[_kt][_ct][_r] = __builtin_amdgcn_exp2f(s[_kt][_ct][_r] * ATT_C - mc[_ct]); } \
        if ((e) == 8) pfc[0][0] = pack_p(s[0][0], s[1][0]); if ((e) == 16) pfc[1][0] = pack_p(s[2][0], s[3][0]); \
        if ((e) == 24) pfc[0][1] = pack_p(s[0][1], s[1][1]); if ((e) == 32) pfc[1][1] = pack_p(s[2][1], s[3][1]); } while (0)
    if (!HAS_PREV) {
#pragma unroll
        for (int e = 0; e <= 32; ++e) FA_EXP1(e);
    } else {
        const LAS unsigned char* vr = vbp + fr * 128; const int x = (fr >> 1) & 7, y0 = (fq ^ x) << 4, y1 = ((4 + fq) ^ x) << 4;
        const bf16x8 ones = {0x3f80, 0x3f80, 0x3f80, 0x3f80, 0x3f80, 0x3f80, 0x3f80, 0x3f80};
        bf16x8 vf[2][2];
        vf[0][0] = *(const LAS bf16x8*)(vr + y0); vf[0][1] = *(const LAS bf16x8*)(vr + y1);
#define FA_SLOT(mfma_stmt, e) do { mfma_stmt; FA_EXP1(e); __builtin_amdgcn_sched_barrier(0); } while (0)
        FA_SLOT(L[0] = MFMA16(ones, pfp[0][0], L[0]), 0); FA_SLOT(L[1] = MFMA16(ones, pfp[0][1], L[1]), 1);
        FA_SLOT(L[0] = MFMA16(ones, pfp[1][0], L[0]), 2); FA_SLOT(L[1] = MFMA16(ones, pfp[1][1], L[1]), 3);
#pragma unroll
        for (int dt = 0; dt < 8; ++dt) { const int cb = dt & 1, nb = cb ^ 1;
            if (dt < 7) { vf[nb][0] = *(const LAS bf16x8*)(vr + (dt + 1) * 2048 + y0); vf[nb][1] = *(const LAS bf16x8*)(vr + (dt + 1) * 2048 + y1); }
            FA_SLOT(O[dt][0] = MFMA16(vf[cb][0], pfp[0][0], O[dt][0]), 4 + 4 * dt); FA_SLOT(O[dt][1] = MFMA16(vf[cb][0], pfp[0][1], O[dt][1]), 5 + 4 * dt);
            FA_SLOT(O[dt][0] = MFMA16(vf[cb][1], pfp[1][0], O[dt][0]), 6 + 4 * dt); FA_SLOT(O[dt][1] = MFMA16(vf[cb][1], pfp[1][1], O[dt][1]), 7 + 4 * dt); }
#undef FA_SLOT
    }
#undef FA_EXP1
}

template <int MODE  >
DI void fa_chunk(const Frame& F, const Args& a, int c, int g) {
    const bf16_t* cols = (const bf16_t*)(a.ws + WS_COLS);
    const int fr = F.lane & 15, fq = F.lane >> 4, w = F.wave, tid = F.tid;
    LAS unsigned char* lds = F.lds;
    LAS int* list = (LAS int*)(lds + 4 * ABUF); LAS unsigned* maskw = (LAS unsigned*)(lds + 4 * ABUF + 1024);
    const bf16_t* kcol = cols + (MODE ? C_KWIN : C_KSEL) + 128 * g;
    const bf16_t* vT = (const bf16_t*)(a.ws + (MODE ? WS_VWINT : WS_VSELT)) + (size_t)g * 128 * 8192;
    __syncthreads();
    int ntile, j0 = 0;
    if (MODE == 0) {
        const unsigned* selm = (const unsigned*)(a.ws + WS_SELM);
        if (tid < 256) maskw[tid] = selm[((size_t)(64 * c + (tid >> 2)) * 4 + g) * 4 + (tid & 3)];
        __syncthreads();
        if (w == 0) { int base = 0;
#pragma unroll
            for (int hf = 0; hf < 2; ++hf) { const int j = hf * 64 + F.lane; unsigned orv = 0u;
                for (int tk = 0; tk < 64; ++tk) orv |= maskw[tk * 4 + (j >> 5)];
                const bool act = ((orv >> (j & 31)) & 1u) && (j <= c); const unsigned long long bl = __ballot(act);
                if (act) list[base + __popcll(bl & ((1ull << F.lane) - 1ull))] = j; base += __popcll(bl); }
            if (F.lane == 0) list[129] = base; }
        __syncthreads();
        ntile = list[129];
    } else { j0 = c > 8 ? c - 8 : 0; ntile = c - j0 + 1; }
    int tokl[2]; tokl[0] = 8 * w + (fr >> 2); tokl[1] = tokl[0] + 4;
    const int head = 4 * g + (fr & 3);
    bf16x8 qf[2][4];
#pragma unroll
    for (int ct = 0; ct < 2; ++ct)
#pragma unroll
        for (int ks = 0; ks < 4; ++ks) qf[ct][ks] = *(const bf16x8*)(cols + (size_t)(64 * c + tokl[ct]) * NP + C_QA + head * 128 + 32 * ks + 8 * fq);
    f32x4 O[8][2], L[2]; float m[2] = {-1e30f, -1e30f};
    L[0] = (f32x4){0.f, 0.f, 0.f, 0.f}; L[1] = L[0];
#pragma unroll
    for (int dt = 0; dt < 8; ++dt) { O[dt][0] = (f32x4){0.f, 0.f, 0.f, 0.f}; O[dt][1] = (f32x4){0.f, 0.f, 0.f, 0.f}; }
#define FA_TILE(t) (MODE ? j0 + (t) : list[(t)])
#define FA_ISSUE(t) do { const int _j = FA_TILE(t); LAS unsigned char* _b = lds + ((t) & 3) * ABUF; \
        dma_k(_b, kcol + (size_t)(64 * _j) * NP, NP, w, F.lane); dma_v(_b + KTILE, vT + (size_t)_j * 8192, 64, w, F.lane); } while (0)
    FA_ISSUE(0); if (ntile > 1) FA_ISSUE(1);
    f32x4 s[4][2]; bf16x8 pfp[2][2], pfc[2][2]; float mc[2], alpha[2]; bool bit[2] = {true, true};
    for (int t = 0; t < ntile; ++t) {
        if (t + 1 < ntile) VMCNT(4); else VMCNT(0);
        RAW_BARRIER();
        if (t + 2 < ntile) FA_ISSUE(t + 2);
        const int j = FA_TILE(t);
        qk_tile<3>(s, lds + (t & 3) * ABUF, qf, fr, fq);
        if (MODE == 0) {
#pragma unroll
            for (int ct = 0; ct < 2; ++ct) bit[ct] = (maskw[tokl[ct] * 4 + (j >> 5)] >> (j & 31)) & 1u; }
        const bool need = fa_rowmax<MODE>(m, mc, alpha, s, bit, tokl, j == c, (MODE == 1) && (j == c - 8), fq, F.lane);
        __builtin_amdgcn_sched_barrier(0);
        if (t > 0) fa_exp_pv<true>(s, mc, pfc, O, L, pfp, lds + ((t - 1) & 3) * ABUF + KTILE, fr, fq); else fa_exp_pv<false>(s, mc, pfc, O, L, pfp, lds, fr, fq);
        __builtin_amdgcn_sched_barrier(0);
        if (need) {
#pragma unroll
            for (int ct = 0; ct < 2; ++ct) { L[ct] *= alpha[ct];
#pragma unroll
                for (int dt = 0; dt < 8; ++dt) O[dt][ct] *= alpha[ct]; } }
#pragma unroll
        for (int ct = 0; ct < 2; ++ct) { pfp[0][ct] = pfc[0][ct]; pfp[1][ct] = pfc[1][ct]; }
    }
    pv_tile<3>(O, L, lds + ((ntile - 1) & 3) * ABUF + KTILE, pfp, fr, fq);
#undef FA_ISSUE
#undef FA_TILE
    bf16_t* out = (bf16_t*)(a.ws + (MODE ? WS_OWIN : WS_OSEL));
#pragma unroll
    for (int ct = 0; ct < 2; ++ct) { const float inv = 1.f / L[ct][0]; bf16_t* op = out + (size_t)(64 * c + tokl[ct]) * D + head * 128 + 4 * fq;
#pragma unroll
        for (int dt = 0; dt < 8; ++dt) { u32x2 o; o.x = pk2(O[dt][ct][0] * inv, O[dt][ct][1] * inv); o.y = pk2(O[dt][ct][2] * inv, O[dt][ct][3] * inv); *(u32x2*)(op + 16 * dt) = o; } }
}

DI void ca_chunk(const Frame& F, const Args& a, int c, int g) {
    const bf16_t* cols = (const bf16_t*)(a.ws + WS_COLS);
    const int fr = F.lane & 15, fq = F.lane >> 4, w = F.wave, tid = F.tid;
    LAS unsigned char* lds = F.lds;
    LAS float* pslc = (LAS float*)(lds + 2 * ABUF); LAS float* p3 = (LAS float*)(lds + 2 * ABUF + 32768);
    const bf16_t* kc = (const bf16_t*)(a.ws + WS_KC) + (size_t)g * 512 * 128;
    const bf16_t* vct = (const bf16_t*)(a.ws + WS_VCT) + (size_t)g * 128 * 512;
    const int ntile = ((4 * c + 2) >> 6) + 1;
    int tokl[2]; tokl[0] = 8 * w + (fr >> 2); tokl[1] = tokl[0] + 4;
    const int head = 4 * g + (fr & 3);
    int nlim[2];
#pragma unroll
    for (int ct = 0; ct < 2; ++ct) { const int t = 64 * c + tokl[ct]; nlim[ct] = t >= 31 ? ((t - 31) >> 4) : -1; }
    bf16x8 qf[2][4];
#pragma unroll
    for (int ct = 0; ct < 2; ++ct)
#pragma unroll
        for (int ks = 0; ks < 4; ++ks) qf[ct][ks] = *(const bf16x8*)(cols + (size_t)(64 * c + tokl[ct]) * NP + C_QA + head * 128 + 32 * ks + 8 * fq);
    float m[2] = {-1e30f, -1e30f}, l[2] = {0.f, 0.f};
    __syncthreads();
    dma_k(lds, kc, 128, w, F.lane);
    for (int jt = 0; jt < ntile; ++jt) {
        VMCNT(0); RAW_BARRIER();
        if (jt + 1 < ntile) dma_k(lds + ((jt + 1) & 1) * ABUF, kc + (size_t)(64 * (jt + 1)) * 128, 128, w, F.lane);
        const LAS unsigned char* kb = lds + (jt & 1) * ABUF;
        f32x4 s[4][2];
        qk_tile<3>(s, kb, qf, fr, fq);
        const bool edge = jt >= ntile - 2;
        int kq = 4 * fq; asm volatile("" : "+v"(kq));
#pragma unroll
        for (int ct = 0; ct < 2; ++ct) {
            float mx = NEG_INF;
#pragma unroll
            for (int kt = 0; kt < 4; ++kt)
#pragma unroll
                for (int r = 0; r < 4; ++r) { float v = s[kt][ct][r]; if (edge) { const int n = 64 * jt + 16 * kt + kq + r; v = (n <= nlim[ct]) ? v : NEG_INF; s[kt][ct][r] = v; } mx = fmaxf(mx, v); }
            mx = quad_max(mx, F.lane);
            if (__ballot((mx - m[ct]) * ATT_C > 8.f) != 0ull) { const float mn = fmaxf(m[ct], mx); l[ct] *= __builtin_amdgcn_exp2f((m[ct] - mn) * ATT_C); m[ct] = mn; }
            const float mc = m[ct] * ATT_C;
            float rs = 0.f;
#pragma unroll
            for (int kt = 0; kt < 4; ++kt)
#pragma unroll
                for (int r = 0; r < 4; ++r) rs += __builtin_amdgcn_exp2f(s[kt][ct][r] * ATT_C - mc);
            l[ct] += quad_sum(rs, F.lane);
        }
    }
    f32x4 O[8][2];
#pragma unroll
    for (int dt = 0; dt < 8; ++dt) { O[dt][0] = (f32x4){0.f, 0.f, 0.f, 0.f}; O[dt][1] = (f32x4){0.f, 0.f, 0.f, 0.f}; }
    float mc[2], inv[2];
#pragma unroll
    for (int ct = 0; ct < 2; ++ct) { mc[ct] = m[ct] * ATT_C; inv[ct] = l[ct] > 0.f ? 1.f / l[ct] : 0.f; }
    RAW_BARRIER();
    dma_k(lds, kc, 128, w, F.lane); dma_v(lds + KTILE, vct, 512, w, F.lane);
    for (int jt = 0; jt < ntile; ++jt) {
        VMCNT(0); RAW_BARRIER();
        if (jt + 1 < ntile) { LAS unsigned char* nb = lds + ((jt + 1) & 1) * ABUF; dma_k(nb, kc + (size_t)(64 * (jt + 1)) * 128, 128, w, F.lane); dma_v(nb + KTILE, vct + 64 * (jt + 1), 512, w, F.lane); }
        const LAS unsigned char* kb = lds + (jt & 1) * ABUF;
        f32x4 s[4][2];
        qk_tile<3>(s, kb, qf, fr, fq);
        const bool edge = jt >= ntile - 2;
        int kq = 4 * fq; asm volatile("" : "+v"(kq));
        bf16x8 pf[2][2];
#pragma unroll
        for (int ct = 0; ct < 2; ++ct) {
#pragma unroll
            for (int kt = 0; kt < 4; ++kt) {
#pragma unroll
                for (int r = 0; r < 4; ++r) { float p = __builtin_amdgcn_exp2f(s[kt][ct][r] * ATT_C - mc[ct]) * inv[ct];
                    if (edge) { const int n = 64 * jt + 16 * kt + kq + r; p = (n <= nlim[ct]) ? p : 0.f; }
                    s[kt][ct][r] = p; }
                float h3 = s[kt][ct][3], hs = (s[kt][ct][0] + s[kt][ct][1]) + (s[kt][ct][2] + h3);
                hs += shx(hs, 1, F.lane); hs += shx(hs, 2, F.lane); h3 += shx(h3, 1, F.lane); h3 += shx(h3, 2, F.lane);
                if ((fr & 3) == 0) { const int jj = 16 * jt + 4 * kt + fq; pslc[tokl[ct] * 128 + jj] = hs; p3[tokl[ct] * 128 + jj] = h3; }
            }
            pf[0][ct] = pack_p(s[0][ct], s[1][ct]); pf[1][ct] = pack_p(s[2][ct], s[3][ct]);
        }
        { f32x4 Ldummy[2]; pv_tile<3, false>(O, Ldummy, kb + KTILE, pf, fr, fq); }
    }
    bf16_t* out = (bf16_t*)(a.ws + WS_OCMP);
#pragma unroll
    for (int ct = 0; ct < 2; ++ct) { bf16_t* op = out + (size_t)(64 * c + tokl[ct]) * D + head * 128 + 4 * fq;
#pragma unroll
        for (int dt = 0; dt < 8; ++dt) { u32x2 o; o.x = pk2(O[dt][ct][0], O[dt][ct][1]); o.y = pk2(O[dt][ct][2], O[dt][ct][3]); *(u32x2*)(op + 16 * dt) = o; } }
    LDS_WAIT(); asm volatile("" ::: "memory");
    unsigned* selm = (unsigned*)(a.ws + WS_SELM);
    {
        int li = F.lane & 15, tq = F.lane >> 4; asm volatile("" : "+v"(li), "+v"(tq));
        unsigned mw[2][4];
        if (c <= 15) {
            const unsigned all = (c == 31) ? 0xffffffffu : ((2u << c) - 1u);
#pragma unroll
            for (int b = 0; b < 2; ++b) { mw[b][0] = all; mw[b][1] = 0u; mw[b][2] = 0u; mw[b][3] = 0u; }
        } else {
            unsigned long long key[2][8];
#pragma unroll
            for (int b = 0; b < 2; ++b) { const int tok = 8 * w + 4 * b + tq;
#pragma unroll
                for (int e = 0; e < 8; ++e) { const int jj = li + 16 * e; const bool ok = (jj >= 1) && (jj <= c - 2);
                    const float sc = ok ? pslc[tok * 128 + jj] + p3[tok * 128 + jj - 1] : 0.f;
                    key[b][e] = ok ? (((unsigned long long)__float_as_uint(sc) << 32) | (unsigned)(127 - jj)) : 0ull; }
#pragma unroll
                for (int q = 0; q < 4; ++q) mw[b][q] = 0u;
                { const int f0 = 0, f1 = c - 1, f2 = c;
#pragma unroll
                  for (int q = 0; q < 4; ++q) mw[b][q] |= ((f0 >> 5) == q ? 1u << (f0 & 31) : 0u) | ((f1 >> 5) == q ? 1u << (f1 & 31) : 0u) | ((f2 >> 5) == q ? 1u << (f2 & 31) : 0u); } }
#define ROR64(v, n) ((((unsigned long long)(unsigned)__builtin_amdgcn_update_dpp(0, (int)(unsigned)((v) >> 32), 0x120 + (n), 0xf, 0xf, false)) << 32) | (unsigned)__builtin_amdgcn_update_dpp(0, (int)(unsigned)(v), 0x120 + (n), 0xf, 0xf, false))
#pragma unroll 1
            for (int round = 0; round < 13; ++round) {
#pragma unroll
                for (int b = 0; b < 2; ++b) {
                    unsigned long long best = key[b][0];
#pragma unroll
                    for (int e = 1; e < 8; ++e) best = key[b][e] > best ? key[b][e] : best;
                    { unsigned long long o; o = ROR64(best, 1); best = o > best ? o : best; o = ROR64(best, 2); best = o > best ? o : best;
                      o = ROR64(best, 4); best = o > best ? o : best; o = ROR64(best, 8); best = o > best ? o : best; }
                    if (best != 0ull) { const int jb = 127 - (int)(unsigned)best;
#pragma unroll
                        for (int q = 0; q < 4; ++q) mw[b][q] |= ((jb >> 5) == q) ? (1u << (jb & 31)) : 0u;
#pragma unroll
                        for (int e = 0; e < 8; ++e) key[b][e] = (key[b][e] == best) ? 0ull : key[b][e]; }
                }
            }
#undef ROR64
        }
        if (li == 0) {
#pragma unroll
            for (int b = 0; b < 2; ++b) { const int tok = 8 * w + 4 * b + tq; u32x4 o; o.x = mw[b][0]; o.y = mw[b][1]; o.z = mw[b][2]; o.w = mw[b][3];
                *(u32x4*)(selm + ((size_t)(64 * c + tok) * 4 + g) * 4) = o; } }
    }
}

struct ScanRegs { bf16x8 ks[2]; bf16x8 at; f32x4 dc; };
DI void dma_v8(LAS unsigned char* vb, const bf16_t* vbase, int w, int lane) {
    const int row = 8 * w + (lane >> 3), c = (lane & 7) ^ ((row >> 1) & 7);
    glds16(vbase + (size_t)row * 64 + c * 8, vb + w * 1024);
}
constexpr int SC_SROW = 272, SC_SBUF = 64 * SC_SROW, SC_Q = 0, SC_V = 4 * 16384, SC_S = SC_V + 4 * 8192;
static_assert(SC_S + 2 * SC_SBUF <= LDS_MISC, "scan LDS map");
DI void scan_issue(ScanRegs& r, LAS unsigned char* lds, const Args& a, int n, int h, int sl, int kh, int w, int lane, int fr, int fq) {
    const bf16_t* qdec = (const bf16_t*)(a.ws + WS_QDEC); const bf16_t* kst = (const bf16_t*)(a.ws + WS_KST);
    const bf16_t* vt = (const bf16_t*)(a.ws + WS_VT); const bf16_t* att = (const bf16_t*)(a.ws + WS_ATT); const float* dec = (const float*)(a.ws + WS_DEC);
    dma_k(lds + SC_Q + (n & 3) * 16384, qdec + (size_t)(64 * n) * 1024 + h * 256 + kh * 128, 1024, w, lane);
    dma_v8(lds + SC_V + (n & 3) * 8192, vt + ((size_t)n * 2048 + h * 512 + 64 * sl) * 64, w, lane);
    { const bf16_t* kp = kst + ((size_t)(n * 4 + h) * 256 + kh * 128 + 16 * w + fr) * 64 + 8 * fq;
      asm volatile("global_load_dwordx4 %0, %1, off" : "=v"(r.ks[0]) : "v"(kp) : "memory");
      asm volatile("global_load_dwordx4 %0, %1, off offset:64" : "=v"(r.ks[1]) : "v"(kp) : "memory"); }
    { const bf16_t* ap_ = att + ((size_t)(n * 4 + h) * 64 + 16 * (w & 3) + fr) * 64 + 32 * kh + 8 * fq; asm volatile("global_load_dwordx4 %0, %1, off" : "=v"(r.at) : "v"(ap_) : "memory"); }
    { const float* dp = dec + (n * 4 + h) * 256 + kh * 128 + 16 * w + 4 * fq; asm volatile("global_load_dwordx4 %0, %1, off" : "=v"(r.dc) : "v"(dp) : "memory"); }
}
DI void scan_step(const ScanRegs& cur, f32x4 (&S)[4], LAS unsigned char* lds, bf16_t* opart, int n, int h, int sl, int kh, int w, int fr, int fq) {
    const LAS unsigned char* sc = lds + SC_S + (n & 1) * SC_SBUF; const LAS unsigned char* qb = lds + SC_Q + (n & 3) * 16384; const LAS unsigned char* vb = lds + SC_V + (n & 3) * 8192;
    const int tt = w & 3, vt0 = 2 * (w >> 2), xv = (fr >> 1) & 7;
    const LAS unsigned char* vr = vb + fr * 128; const int y0 = (fq ^ xv) << 4, y1 = ((4 + fq) ^ xv) << 4;
    bf16x8 qf[4], sf[2][4];
#pragma unroll
    for (int ks = 0; ks < 4; ++ks) qf[ks] = *(const LAS bf16x8*)(qb + (16 * tt + fr) * 256 + (((4 * ks + fq) ^ fr) << 4));
#pragma unroll
    for (int z = 0; z < 2; ++z)
#pragma unroll
        for (int ks = 0; ks < 4; ++ks) sf[z][ks] = *(const LAS bf16x8*)(sc + (16 * (vt0 + z) + fr) * SC_SROW + (32 * ks + 8 * fq) * 2);
    LDS_WAIT(); __builtin_amdgcn_sched_barrier(0);
    f32x4 acc[2];
#pragma unroll
    for (int z = 0; z < 2; ++z) { acc[z] = (f32x4){0.f, 0.f, 0.f, 0.f};
#pragma unroll
        for (int ks = 0; ks < 4; ++ks) acc[z] = MFMA16(sf[z][ks], qf[ks], acc[z]); }
    bf16x8 vf[4][2];
#pragma unroll
    for (int vt = 0; vt < 4; ++vt) { vf[vt][0] = *(const LAS bf16x8*)(vr + vt * 2048 + y0); vf[vt][1] = *(const LAS bf16x8*)(vr + vt * 2048 + y1); }
    LDS_WAIT(); __builtin_amdgcn_sched_barrier(0);
    { const bf16x8 va0 = vt0 ? (kh ? vf[2][1] : vf[2][0]) : (kh ? vf[0][1] : vf[0][0]), va1 = vt0 ? (kh ? vf[3][1] : vf[3][0]) : (kh ? vf[1][1] : vf[1][0]);
      acc[0] = MFMA16(va0, cur.at, acc[0]); acc[1] = MFMA16(va1, cur.at, acc[1]); }
    LAS unsigned char* sn = lds + SC_S + ((n + 1) & 1) * SC_SBUF;
#pragma unroll
    for (int vt = 0; vt < 4; ++vt) { S[vt] = S[vt] * cur.dc; S[vt] = MFMA16(cur.ks[0], vf[vt][0], S[vt]); S[vt] = MFMA16(cur.ks[1], vf[vt][1], S[vt]); }
#pragma unroll
    for (int z = 0; z < 2; ++z) { u32x2 o; o.x = pk2(acc[z][0], acc[z][1]); o.y = pk2(acc[z][2], acc[z][3]);
        *(u32x2*)(opart + (size_t)(64 * n + 16 * tt + fr) * 2048 + h * 512 + 64 * sl + 16 * (vt0 + z) + 4 * fq) = o; }
#pragma unroll
    for (int vt = 0; vt < 4; ++vt) { u32x2 o; o.x = pk2(S[vt][0], S[vt][1]); o.y = pk2(S[vt][2], S[vt][3]); *(LAS u32x2*)(sn + (16 * vt + fr) * SC_SROW + (16 * w + 4 * fq) * 2) = o; }
}
DI void gla_scan_unit(const Frame& F, const Args& a, int h, int sl, int kh) {
    LAS unsigned char* lds = F.lds;
    const int fr = F.lane & 15, fq = F.lane >> 4, w = F.wave;
    bf16_t* opart = (bf16_t*)(a.ws + WS_OPART) + (size_t)kh * T * 2048;
    __syncthreads();
    for (int i = F.tid; i < SC_SBUF / 4; i += NTHR) ((LAS unsigned*)(lds + SC_S))[i] = 0u;
    f32x4 S[4];
#pragma unroll
    for (int vt = 0; vt < 4; ++vt) S[vt] = (f32x4){0.f, 0.f, 0.f, 0.f};
    ScanRegs r0, r1, r2, r3;
    scan_issue(r0, lds, a, 0, h, sl, kh, w, F.lane, fr, fq); scan_issue(r1, lds, a, 1, h, sl, kh, w, F.lane, fr, fq); scan_issue(r2, lds, a, 2, h, sl, kh, w, F.lane, fr, fq);
#define SC_STEP(rn, rc, n) do { if ((n) < 3) asm volatile("s_waitcnt vmcnt(14)" ::: "memory"); else asm volatile("s_waitcnt vmcnt(20)" ::: "memory"); LDS_WAIT(); RAW_BARRIER(); \
        scan_issue(rn, lds, a, ((n) + 3 < NCH) ? (n) + 3 : NCH - 1, h, sl, kh, w, F.lane, fr, fq); scan_step(rc, S, lds, opart, (n), h, sl, kh, w, fr, fq); } while (0)
    for (int n = 0; n < NCH; n += 4) { SC_STEP(r3, r0, n); SC_STEP(r0, r1, n + 1); SC_STEP(r1, r2, n + 2); SC_STEP(r2, r3, n + 3); }
#undef SC_STEP
    VM_WAIT();
}

DI void p_combine(const Frame& F, const Args& a, int layer) {
    const bf16_t* cols = (const bf16_t*)(a.ws + WS_COLS);
    const bf16_t* ocmp = (const bf16_t*)(a.ws + WS_OCMP); const bf16_t* osel = (const bf16_t*)(a.ws + WS_OSEL); const bf16_t* owin = (const bf16_t*)(a.ws + WS_OWIN);
    const bf16_t* op0 = (const bf16_t*)(a.ws + WS_OPART); const bf16_t* op1 = op0 + (size_t)T * 2048;
    bf16_t* A1 = (bf16_t*)(a.ws + WS_A1); bf16_t* A2 = (bf16_t*)(a.ws + WS_A2);
    const int c8 = 8 * F.lane;
    f32x4 nw[2]; nw[0] = *(const f32x4*)(a.gla_norm_w + layer * 512 + c8); nw[1] = *(const f32x4*)(a.gla_norm_w + layer * 512 + c8 + 4);
    for (int row = F.gw; row < T; row += F.NGW) {
        const bf16_t* cr = cols + (size_t)row * NP; const size_t ro = (size_t)row * D;
#pragma unroll
        for (int j = 0; j < 4; ++j) { const int c0 = 512 * j + c8, head = 4 * j + (F.lane >> 4);
            const float g0 = sigmoidf_(bf2f(cr[C_GBR + head * 3 + 0])), g1 = sigmoidf_(bf2f(cr[C_GBR + head * 3 + 1])), g2 = sigmoidf_(bf2f(cr[C_GBR + head * 3 + 2]));
            float oc[8], os[8], ow[8], za[8], p0[8], p1[8], zb[8];
            unpack8(*(const u32x4*)(ocmp + ro + c0), oc); unpack8(*(const u32x4*)(osel + ro + c0), os); unpack8(*(const u32x4*)(owin + ro + c0), ow); unpack8(*(const u32x4*)(cr + C_ZA + c0), za);
            unpack8(*(const u32x4*)(op0 + ro + c0), p0); unpack8(*(const u32x4*)(op1 + ro + c0), p1); unpack8(*(const u32x4*)(cr + C_ZB + c0), zb);
            float r[8], o[8], ss = 0.f;
#pragma unroll
            for (int e = 0; e < 8; ++e) { r[e] = (g0 * oc[e] + g1 * os[e] + g2 * ow[e]) * siluf_(za[e]); o[e] = p0[e] + p1[e]; ss += o[e] * o[e]; }
            { u32x4 q; q.x = pk2(r[0], r[1]); q.y = pk2(r[2], r[3]); q.z = pk2(r[4], r[5]); q.w = pk2(r[6], r[7]); *(u32x4*)(A1 + ro + c0) = q; }
            const float rs = rsqrtf(wave_sum(ss, F.lane) * (1.f / 512.f) + NORM_EPS);
            float y[8];
#pragma unroll
            for (int e = 0; e < 8; ++e) y[e] = o[e] * rs * nw[e >> 2][e & 3] * siluf_(zb[e]);
            { u32x4 q; q.x = pk2(y[0], y[1]); q.y = pk2(y[2], y[3]); q.z = pk2(y[4], y[5]); q.w = pk2(y[6], y[7]); *(u32x4*)(A2 + ro + c0) = q; } }
    }
}

constexpr int PH_PER_LAYER = 10, N_PHASES = 2 + DEPTH * PH_PER_LAYER;
constexpr int WQ_WORD0 = 16384;
DI int wq_pull(unsigned* cnt, volatile LAS unsigned* slot, int tid) {
    __syncthreads();
    if (tid == 0) *slot = __hip_atomic_fetch_add(cnt, 1u, __ATOMIC_RELAXED, __HIP_MEMORY_SCOPE_AGENT);
    __syncthreads();
    return (int)*slot;
}
__global__ void __launch_bounds__(NTHR, 2) mk_fwd(Args a_in, int li) {
    KArgsP ap = (KArgsP)__builtin_amdgcn_kernarg_segment_ptr();
    const int ph_lo = a_in.ph_lo, ph_hi = a_in.ph_hi;
    extern __shared__ __attribute__((aligned(16))) unsigned char lds_raw[];
    Frame F;
    F.lds = (LAS unsigned char*)lds_raw;
    F.tid = threadIdx.x; F.lane = F.tid & 63; F.wave = __builtin_amdgcn_readfirstlane(F.tid >> 6);
    const int wave_s = F.wave;
    F.G = gridDim.x; F.bid = blockIdx.x; F.gw = F.bid * NWAVES + F.wave; F.NGW = F.G * NWAVES;
    volatile LAS unsigned* misc = (volatile LAS unsigned*)(F.lds + LDS_MISC);
    if (F.tid < 64) misc[F.tid] = 0u;
    __syncthreads();
    unsigned* ctl = (unsigned*)(a_in.ws + WS_CTL);
    XcdBarrier bar = xcd_barrier_post(ctl + (size_t)li * XCD_BAR_WORDS, misc);
#ifndef PHASE_SET
#define PHASE_SET 0xFFFF
#endif
#define HAS(k) ((PHASE_SET >> (k)) & 1)
#ifndef REPEAT_PHASE
#define REPEAT_PHASE -1
#endif
#define REP(k) for (int _r = 0; _r < ((REPEAT_PHASE == (k)) ? 2 : 1); ++_r)
#define IN(k) (ph_lo <= (k) && (k) < ph_hi)
#define SEAM(k) do { if (IN(k) && IN((k) + 1)) xcd_barrier(bar); } while (0)
#define FRESH() do { int _l = __builtin_amdgcn_mbcnt_hi(~0u, __builtin_amdgcn_mbcnt_lo(~0u, 0u)); asm volatile("" : "+v"(_l)); int _w = wave_s; asm volatile("" : "+s"(_w)); F.lane = _l; F.wave = _w; F.tid = _w * 64 + _l; F.gw = F.bid * NWAVES + F.wave; { KArgsP _k = (KArgsP)__builtin_amdgcn_kernarg_segment_ptr(); asm volatile("" : "+s"(_k)); ap = _k; } } while (0)
    if (HAS(12) && IN(0)) { FRESH(); const Args a = load_args(ap); REP(12) { p_prologue(F, a); } SEAM(0); }
#define PHASE_ENTER() FRESH(); const Args a = load_args(ap); unsigned char* ws = a.ws; bf16_t* cols = (bf16_t*)(ws + WS_COLS); (void)cols
#define UNIT_FRAME(Fu) Frame Fu = F; { int _l = F.lane; asm volatile("" : "+v"(_l)); Fu.lane = _l; Fu.tid = F.wave * 64 + _l; }
    for (int L = 0; L < DEPTH; ++L) {
        const int pb = 1 + PH_PER_LAYER * L;
        if (HAS(0) && IN(pb + 0)) { PHASE_ENTER();
            if (L == 0) p_rmsnorm<false, false>(F, a.x, a.norm_w, ws + WS_H); else p_rmsnorm<false, true>(F, ws + WS_X, a.norm_w + L * D, ws + WS_H);
            SEAM(pb + 0); }
        if (HAS(1) && IN(pb + 1)) { PHASE_ENTER();
            pg8::Gemm g{(const bf16_t*)(ws + WS_H), (const bf16_t*)(ws + WS_WIN) + (size_t)L * NP * D, D, D, D};
            pg8::OrderIn S; S.mn.init(T, NP, F.G, F.bid); S.sig = (unsigned*)(ws + WS_CTL) + WQ_WORD0 + 40960 + 64 * L; pg8::EpiCols E{cols, NP, (bf16_t*)(ws + WS_VT), (bf16_t*)(ws + WS_VSELT), (bf16_t*)(ws + WS_VWINT)};
            pg8::gemm_phase<pg8::EpiCols, pg8::OrderIn, false, true, true>(F.lds, g, S, E, F.tid); }
        if (HAS(2) && IN(pb + 2)) { PHASE_ENTER();
            unsigned* cnt = (unsigned*)(ws + WS_CTL) + WQ_WORD0 + 8192 + 64 * L;
            { unsigned* sig = (unsigned*)(ws + WS_CTL) + WQ_WORD0 + 40960 + 64 * L;
              if (F.tid == 0) { XB_SPIN(xb_ld(sig) < pg8::IN_EARLY_TILES, bar.bar); __builtin_amdgcn_fence(__ATOMIC_ACQUIRE, "agent"); asm volatile("s_waitcnt vmcnt(0)" ::: "memory"); }
              __syncthreads(); }
            for (;;) { const int u = wq_pull(cnt, misc + 16, F.tid); if (u >= 128 + 512) break;
                UNIT_FRAME(Fu);
                if (u < 128) { pg8::Gemm g{cols, (const bf16_t*)(ws + WS_W1T) + (size_t)L * 2 * 256 * 4096, 16 * NP, 4096, 512};
                    pg8::OrderCmp S; S.init(1 << 20, u); pg8::EpiPart E{(float*)(ws + WS_CPART)};
                    __syncthreads();
                    pg8::gemm_phase<pg8::EpiPart, pg8::OrderCmp, true, false, true>(Fu.lds, g, S, E, Fu.tid); }
                else { const int v = u - 128; gla_g1_unit(Fu, a, L, v >> 2, v & 3); } }
            SEAM(pb + 2); }
        if (HAS(3) && IN(pb + 3)) { PHASE_ENTER(); for (int u = F.bid; u < 256; u += F.G) mlp2_unit(F, a, L, u >> 5, u & 31); SEAM(pb + 3); }
        if (HAS(4) && IN(pb + 4)) { PHASE_ENTER();
            REP(4) { unsigned* cnt = (unsigned*)(ws + WS_CTL) + WQ_WORD0 + 64 * (2 * L + 16 * _r);
            for (;;) { const int u = wq_pull(cnt, misc + 16, F.tid); if (u >= 512 + 512) break;
                UNIT_FRAME(Fu);
                if (u < 512) ca_chunk(Fu, a, 127 - (u >> 2), u & 3);
                else { const int v = u - 512; fa_chunk<1>(Fu, a, 127 - (v >> 2), v & 3); } } }
            SEAM(pb + 4); }
        if (HAS(5) && IN(pb + 5)) { PHASE_ENTER();
            REP(5) { unsigned* cnt = (unsigned*)(ws + WS_CTL) + WQ_WORD0 + 64 * (2 * L + 1 + 16 * _r);
            unsigned* grp = (unsigned*)(ws + WS_CTL) + WQ_WORD0 + 4096 + 64 * (8 * L + 32 * _r);
            unsigned* claimed = (unsigned*)(ws + WS_CTL) + WQ_WORD0 + 32768 + 64 * (L + 4 * _r);
            { const unsigned x = xb_xcc_id() & 7u;
              __syncthreads();
              if (F.tid == 0) { unsigned r = __hip_atomic_fetch_add(grp + 64 * x, 1u, __ATOMIC_RELAXED, __HIP_MEMORY_SCOPE_AGENT); unsigned got = 0xffffffffu;
                  if (r < 8u && __hip_atomic_exchange(claimed + 8 * x + r, 1u, __ATOMIC_RELAXED, __HIP_MEMORY_SCOPE_AGENT) == 0u) got = 8u * x + r;
                  misc[16] = got; }
              __syncthreads();
              const unsigned su = misc[16];
              if (su != 0xffffffffu) { UNIT_FRAME(Fu); gla_scan_unit(Fu, a, (int)(su >> 4), (int)(su & 7u), (int)((su >> 3) & 1u)); } }
            for (;;) { const int u = wq_pull(cnt, misc + 16, F.tid); if (u >= 64) break;
                UNIT_FRAME(Fu);
                __syncthreads(); if (F.tid == 0) misc[17] = __hip_atomic_exchange(claimed + u, 1u, __ATOMIC_RELAXED, __HIP_MEMORY_SCOPE_AGENT); __syncthreads();
                if (misc[17] == 0u) gla_scan_unit(Fu, a, u >> 4, u & 7, (u >> 3) & 1); }
            { const int g0 = (int)(xb_xcc_id() & 3u);
              for (int gi = 0; gi < 4; ++gi) { const int gq = (g0 + gi) & 3; unsigned* qcnt = (unsigned*)(ws + WS_CTL) + WQ_WORD0 + 12288 + 64 * (4 * L + gq + 32 * _r);
                  for (;;) { const int u = wq_pull(qcnt, misc + 16, F.tid); if (u >= 128) break;
                      UNIT_FRAME(Fu);
                      fa_chunk<0>(Fu, a, 127 - u, gq); } } } }
            SEAM(pb + 5); }
        if (HAS(6) && IN(pb + 6)) { PHASE_ENTER(); p_combine(F, a, L); SEAM(pb + 6); }
        if (HAS(7) && IN(pb + 7)) { PHASE_ENTER();
            pg8::Gemm g{(const bf16_t*)(ws + WS_A1), (const bf16_t*)(ws + WS_WPA) + (size_t)L * D * D, D, D, D};
            pg8::OrderAB S; S.mn.init(T, D, F.G, F.bid); S.A2 = (const bf16_t*)(ws + WS_A2); S.B2 = (const bf16_t*)(ws + WS_WPB) + (size_t)L * D * D;
            pg8::EpiGateAB E{(bf16_t*)(ws + WS_Y), (bf16_t*)(ws + WS_TMP), cols + C_GA, cols + C_GB};
            pg8::gemm_phase<pg8::EpiGateAB, pg8::OrderAB, false, true, true>(F.lds, g, S, E, F.tid);
            SEAM(pb + 7); }
        if (HAS(8) && IN(pb + 8)) { PHASE_ENTER(); }
        if (HAS(9) && IN(pb + 9)) { PHASE_ENTER();
            pg8::Gemm g{(const bf16_t*)(ws + WS_Y), (const bf16_t*)(ws + WS_WOUT) + (size_t)L * D * D, D, D, D};
            pg8::OrderMN S; S.init(T, D, F.G, F.bid); pg8::EpiResid E{L == 0 ? a.x : (const float*)nullptr, (const bf16_t*)(ws + WS_X), (bf16_t*)(ws + WS_X)};
            pg8::gemm_phase<pg8::EpiResid, pg8::OrderMN, false, false, true>(F.lds, g, S, E, F.tid);
            SEAM(pb + 9); }
    }
    if (HAS(13) && IN(N_PHASES - 1)) { FRESH(); const Args a = load_args(ap); p_rmsnorm<true, true>(F, a.ws + WS_X, a.final_w, a.out); }
#undef IN
#undef SEAM
}

extern "C" void kernel_launch(void* const* d_in, const int* in_sizes, int n_in, void* d_out, int out_size, void* d_ws, size_t ws_size, hipStream_t stream) {
    static int grid = 0;
    if (grid == 0) {
        if (n_in != 15 || ws_size < WS_END) { fprintf(stderr, "kernel_launch: unexpected inputs (n_in %d, ws %zu, need %zu)\n", n_in, ws_size, (size_t)WS_END); grid = -1; return; }
        int dev = 0, cus = 0;
        if (hipGetDevice(&dev) != hipSuccess || hipDeviceGetAttribute(&cus, hipDeviceAttributeMultiprocessorCount, dev) != hipSuccess) { grid = -1; return; }
        if (hipFuncSetAttribute((const void*)mk_fwd, hipFuncAttributeMaxDynamicSharedMemorySize, LDS_BYTES) != hipSuccess) { fprintf(stderr, "kernel_launch: hipFuncSetAttribute failed\n"); grid = -1; return; }
        int per_cu = 0;
        if (hipOccupancyMaxActiveBlocksPerMultiprocessor(&per_cu, (const void*)mk_fwd, NTHR, LDS_BYTES) != hipSuccess || per_cu < 1) fprintf(stderr, "kernel_launch: occupancy query reports %d\n", per_cu);
        (void)hipGetLastError();
        grid = cus;
    }
    if (grid < 0) return;
    (void)hipMemsetAsync((char*)d_ws + WS_CTL, 0, CTL_BYTES, stream);
    Args a{};
    a.x = (const float*)d_in[0]; a.norm_w = (const float*)d_in[1]; a.w_in = (const float*)d_in[2]; a.cmp_pe = (const float*)d_in[3]; a.cmp_w1 = (const float*)d_in[4];
    a.cmp_b1 = (const float*)d_in[5]; a.cmp_w2 = (const float*)d_in[6]; a.cmp_b2 = (const float*)d_in[7]; a.alpha_w = (const float*)d_in[8]; a.alpha_b = (const float*)d_in[9];
    a.gla_norm_w = (const float*)d_in[10]; a.p_a = (const float*)d_in[11]; a.p_b = (const float*)d_in[12]; a.w_out = (const float*)d_in[13]; a.final_w = (const float*)d_in[14];
    a.out = (float*)d_out; a.ws = (unsigned char*)d_ws;
#if MK_PER_PHASE
    for (int k = 0; k < N_PHASES; ++k) { a.ph_lo = k; a.ph_hi = k + 1; hipLaunchKernelGGL(mk_fwd, dim3(grid), dim3(NTHR), LDS_BYTES, stream, a, k); }
#else
    a.ph_lo = 0; a.ph_hi = N_PHASES; hipLaunchKernelGGL(mk_fwd, dim3(grid), dim3(NTHR), LDS_BYTES, stream, a, 0);
#endif
}
```

```cpp
#include <hip/hip_runtime.h>
#include <cstdio>
#include <cstdint>

#ifndef MK_PER_PHASE
#define MK_PER_PHASE 0
#endif

#define LAS __attribute__((address_space(3)))
#define GAS __attribute__((address_space(1)))
typedef unsigned short bf16_t;
typedef short bf16x8 __attribute__((ext_vector_type(8)));
typedef short s16x4 __attribute__((ext_vector_type(4)));
typedef float f32x4 __attribute__((ext_vector_type(4)));
typedef float f32x2 __attribute__((ext_vector_type(2)));
typedef unsigned u32x4 __attribute__((ext_vector_type(4)));
typedef unsigned u32x2 __attribute__((ext_vector_type(2)));
#define DI __device__ __forceinline__
#define MFMA16(a, b, c) __builtin_amdgcn_mfma_f32_16x16x32_bf16((a), (b), (c), 0, 0, 0)

constexpr int T = 8192, D = 2048, DEPTH = 4, NIN = 17472, NP = 17664;
constexpr int NCH = 128;
constexpr int C_QA = 0, C_KCMP = 2048, C_VCMP = 2560, C_KSEL = 3072, C_VSEL = 3584, C_KWIN = 4096, C_VWIN = 4608, C_ZA = 5120,
              C_QB = 7168, C_KB = 8192, C_VB = 9216, C_ZB = 11264, C_GA = 13312, C_GB = 15360, C_GBR = 17408, C_ALR = 17456;
constexpr float NORM_EPS = 1e-6f;
constexpr float ATT_C = 0.08838834764831845f * 1.4426950408889634f;

DI int map_col(int n) {
    if (n < 5120) return n;
    if (n < 5168) return C_GBR + (n - 5120);
    if (n < 11312) return n - 48;
    if (n < 11328) return C_ALR + (n - 11312);
    return n - 64;
}

constexpr size_t MiB = 1u << 20;
constexpr size_t al(size_t x) { return (x + MiB - 1) / MiB * MiB; }
constexpr size_t WS_CTL = 0, CTL_BYTES = MiB;
constexpr size_t WS_WIN = WS_CTL + CTL_BYTES;
constexpr size_t WS_WPA = WS_WIN + al((size_t)DEPTH * NP * D * 2);
constexpr size_t WS_WPB = WS_WPA + al((size_t)DEPTH * D * D * 2);
constexpr size_t WS_WOUT = WS_WPB + al((size_t)DEPTH * D * D * 2);
constexpr size_t WS_W1T = WS_WOUT + al((size_t)DEPTH * D * D * 2);
constexpr size_t WS_W2T = WS_W1T + al((size_t)DEPTH * 2 * 256 * 4096 * 2);
constexpr size_t WS_B1P = WS_W2T + al((size_t)DEPTH * 2 * 128 * 256 * 2);
constexpr size_t WS_X = WS_B1P + MiB;
constexpr size_t WS_H = WS_X + al((size_t)T * D * 4);
constexpr size_t WS_COLS = WS_H + al((size_t)T * D * 2);
constexpr size_t WS_CPART = WS_COLS + al((size_t)(T + 64) * NP * 2);
constexpr size_t WS_KC = WS_CPART + al((size_t)8 * 8 * 512 * 256 * 4);
constexpr size_t WS_VCT = WS_KC + MiB;
constexpr size_t WS_SELM = WS_VCT + MiB;
constexpr size_t WS_OCMP = WS_SELM + MiB;
constexpr size_t WS_OSEL = WS_OCMP + al((size_t)T * D * 2);
constexpr size_t WS_OWIN = WS_OSEL + al((size_t)T * D * 2);
constexpr size_t WS_VSELT = WS_OWIN + al((size_t)T * D * 2);
constexpr size_t WS_VWINT = WS_VSELT + al((size_t)4 * 128 * 128 * 64 * 2);
constexpr size_t WS_QDEC = WS_VWINT + al((size_t)4 * 128 * 128 * 64 * 2);
constexpr size_t WS_KST = WS_QDEC + al((size_t)T * 1024 * 2);
constexpr size_t WS_VT = WS_KST + al((size_t)T * 1024 * 2);
constexpr size_t WS_ATT = WS_VT + al((size_t)T * 2048 * 2);
constexpr size_t WS_DEC = WS_ATT + al((size_t)128 * 4 * 64 * 64 * 2);
constexpr size_t WS_OPART = WS_DEC + MiB;
constexpr size_t WS_A1 = WS_OPART + al((size_t)2 * T * 2048 * 4);
constexpr size_t WS_A2 = WS_A1 + al((size_t)T * D * 2);
constexpr size_t WS_TMP = WS_A2 + al((size_t)T * D * 2);
constexpr size_t WS_Y = WS_TMP + al((size_t)T * D * 4);
constexpr size_t WS_END = WS_Y + al((size_t)T * D * 2);

constexpr int LDS_MAIN = 131072;
constexpr int LDS_BYTES = 147456;
constexpr int LDS_MISC = LDS_BYTES - 256;
constexpr int NWAVES = 8, NTHR = 512;

DI float bf2f(unsigned short b) { return __uint_as_float(((unsigned)b) << 16); }
DI unsigned f2bf(float f) { unsigned u = __float_as_uint(f); return (u + 0x7fffu + ((u >> 16) & 1u)) >> 16; }
DI unsigned pk2_sw(float lo, float hi) { return f2bf(lo) | (f2bf(hi) << 16); }
typedef __bf16 bf16x2_t __attribute__((ext_vector_type(2)));
DI unsigned cvt_pk_bf16(float lo, float hi) { const f32x2 v = {lo, hi}; const bf16x2_t b = __builtin_convertvector(v, bf16x2_t); return __builtin_bit_cast(unsigned, b); }
DI unsigned pk2(float lo, float hi) { return cvt_pk_bf16(lo, hi); }
DI float lo_bf(unsigned w) { return __uint_as_float(w << 16); }
DI float hi_bf(unsigned w) { return __uint_as_float(w & 0xffff0000u); }
DI void unpack8(const u32x4& w, float (&f)[8]) { f[0] = lo_bf(w.x); f[1] = hi_bf(w.x); f[2] = lo_bf(w.y); f[3] = hi_bf(w.y); f[4] = lo_bf(w.z); f[5] = hi_bf(w.z); f[6] = lo_bf(w.w); f[7] = hi_bf(w.w); }
typedef _Float16 f16x2_t __attribute__((ext_vector_type(2)));
DI unsigned pk2h(float lo, float hi) { const f32x2 v = {lo, hi}; const f16x2_t h = __builtin_convertvector(v, f16x2_t); return __builtin_bit_cast(unsigned, h); }
DI float lo_h(unsigned w) { const f16x2_t h = __builtin_bit_cast(f16x2_t, w); return (float)h[0]; }
DI float hi_h(unsigned w) { const f16x2_t h = __builtin_bit_cast(f16x2_t, w); return (float)h[1]; }
DI void unpack8h(const u32x4& w, float (&f)[8]) { f[0] = lo_h(w.x); f[1] = hi_h(w.x); f[2] = lo_h(w.y); f[3] = hi_h(w.y); f[4] = lo_h(w.z); f[5] = hi_h(w.z); f[6] = lo_h(w.w); f[7] = hi_h(w.w); }
DI float sigmoidf_(float x) { return 1.f / (1.f + __expf(-x)); }
DI float siluf_(float x) { return x / (1.f + __expf(-x)); }
DI float shx(float v, int off, int lane) { return __int_as_float(__builtin_amdgcn_ds_bpermute((lane ^ off) << 2, __float_as_int(v))); }
DI int shxi(int v, int off, int lane) { return __builtin_amdgcn_ds_bpermute((lane ^ off) << 2, v); }
DI float wave_sum(float v, int lane) {
#pragma unroll
    for (int o = 1; o < 64; o <<= 1) v += shx(v, o, lane);
    return v;
}
#define LDS_WAIT() asm volatile("s_waitcnt lgkmcnt(0)" ::: "memory")
#define VM_WAIT() asm volatile("s_waitcnt vmcnt(0)" ::: "memory")

namespace pg8 {
constexpr int BM = 256, BK = 64, HALF = 128, HTB = HALF * BK * 2, STAGE_BYTES = 8 * HTB, NXCD = 8, WGM = 8;
__host__ __device__ __forceinline__ int lds_byte(int r, int c) { const int st = (r >> 4) * 2 + (c >> 5), rr = r & 15, cc = c & 31, ob = rr * 64 + cc * 2; return st * 1024 + (ob ^ (((ob >> 9) & 1) << 5)); }
__host__ __device__ __forceinline__ void stage_rc(int b, int& R, int& C) { const int st = b / 1024, sb = b % 1024, swz = sb ^ (((sb >> 9) & 1) << 5); R = (st >> 1) * 16 + swz / 64; C = (st & 1) * 32 + (swz % 64) / 2; }
__host__ __device__ __forceinline__ int perm32(int rho) { const int n = rho >> 4, i = rho & 15; return 8 * (i >> 2) + 4 * n + (i & 3); }

struct Unit { int pm, pn, pk, pz; };
struct Gemm { const bf16_t* A; const bf16_t* Bt; int lda, ldb, K; };

struct OrderMN {
    static constexpr bool SIGNAL = false;
    int nM, nN, nwg, G, c, rep;
    DI void init(int M, int N, int G_, int c_, int rep_ = 1) { nM = M / BM; nN = N / BM; nwg = nM * nN; G = G_; c = c_; rep = rep_; }
    DI bool next(int i, Unit& u) const {
        long L = (long)i * G + c; if (L >= (long)nwg * rep) return false;
        if (L >= nwg) L -= nwg;
        int wgid = (int)L; { const int q = nwg / NXCD, r = nwg % NXCD, xcd = wgid % NXCD, off = wgid / NXCD; wgid = (xcd < r ? xcd * (q + 1) : r * (q + 1) + (xcd - r) * q) + off; }
        const int nig = WGM * nN, gid = wgid / nig, fm = gid * WGM, gsz = (nM - fm) < WGM ? (nM - fm) : WGM;
        u.pm = fm + ((wgid % nig) % gsz); u.pn = (wgid % nig) / gsz; u.pk = 0; u.pz = 0; return true;
    }
    DI const char* a_ptr(const Gemm& g, const Unit& u) const { return (const char*)g.A + (size_t)u.pm * BM * g.lda * 2; }
    DI const char* b_ptr(const Gemm& g, const Unit& u) const { return (const char*)g.Bt + (size_t)u.pn * BM * g.ldb * 2; }
};
DI int in_col_tile(int p, int& early) {
    int i;
    if (p < 7) { early = 1; i = p; } else if (p < 35) { early = 0; i = p - 7; } else if (p < 41) { early = 1; i = p - 28; } else { early = 0; i = p - 13; }
    if (early) return i < 4 ? 8 + i : i < 12 ? 24 + i : 68;
    return i < 8 ? i : i < 24 ? 4 + i : 12 + i;
}
constexpr unsigned IN_EARLY_TILES = 13 * (T / 256);
struct OrderIn {
    static constexpr bool SIGNAL = true;
    OrderMN mn; unsigned* sig;
    DI bool next(int i, Unit& u) const { if (!mn.next(i, u)) return false; int e; const int pn = in_col_tile(u.pn, e); u.pn = pn;
        const int kind = (pn >= 36 && pn < 44) ? 1 : (pn == 14 || pn == 15) ? 2 : (pn == 18 || pn == 19) ? 3 : 0; u.pz = e | (kind << 1); return true; }
    DI const char* a_ptr(const Gemm& g, const Unit& u) const { return (u.pz >> 1) ? mn.b_ptr(g, u) : mn.a_ptr(g, u); }
    DI const char* b_ptr(const Gemm& g, const Unit& u) const { return (u.pz >> 1) ? mn.a_ptr(g, u) : mn.b_ptr(g, u); }
};
struct OrderCmp {
    static constexpr bool SIGNAL = false;
    int G, c;
    DI void init(int G_, int c_) { G = G_; c = c_; }
    DI bool next(int i, Unit& u) const { const int L = i * G + c; if (L >= 128) return false; u.pk = L & 7; u.pm = (L >> 3) & 1; u.pz = L >> 4; u.pn = 0; return true; }
    DI const char* a_ptr(const Gemm& g, const Unit& u) const { const int kv = u.pz >> 2, gg = u.pz & 3;
        return (const char*)g.A + ((size_t)(u.pm * BM * 16 + u.pk * 4) * NP + (kv ? C_VCMP : C_KCMP) + gg * 128) * 2; }
    DI const char* b_ptr(const Gemm& g, const Unit& u) const { const int kv = u.pz >> 2; return (const char*)g.Bt + ((size_t)kv * 256 * 4096 + u.pk * 512) * 2; }
};

template <class Epi, class Sched, bool IM2COL = false, bool ALIGN_EPI = false, bool SP2 = false>
DI void gemm_phase(LAS unsigned char* lds, const Gemm g, const Sched& S, const Epi& E, const int tid) {
    const int wid = __builtin_amdgcn_readfirstlane(tid >> 6), lane = tid & 63, wr = wid >> 2, wc = wid & 3, fr = lane & 15, fq = lane >> 4;
    const int nt = g.K / BK;
    unsigned voffA[2], voffB[2];
#pragma unroll
    for (int i = 0; i < 2; ++i) { int R, C; stage_rc(tid * 16 + i * 8192, R, C); const int Rb = Epi::PERM ? ((R >> 5) * 64 + perm32(R & 31)) : R;
        voffA[i] = (unsigned)(R * g.lda + C) * 2u; voffB[i] = (unsigned)(Rb * g.ldb + C) * 2u; }
    const size_t hstepA = (size_t)HALF * g.lda * 2, hstepB = (size_t)(Epi::PERM ? 32 : HALF) * g.ldb * 2;
    const unsigned ldsw = (unsigned)wid * 1024u;
    const int aoff = lds_byte(wr * 64 + fr, fq * 8), boff = lds_byte(wc * 32 + fr, fq * 8);
#define PG8_KA(kt) (IM2COL ? ((size_t)((kt) >> 1) * (NP * 2) + (size_t)((kt) & 1) * 128) : (size_t)(kt) * 128)
#define PG8_KB(kt) ((size_t)(kt) * 128)
#define PG8_SA(b, h) (((b) * 2 + (h)) * HTB)
#define PG8_SB(b, h) ((4 + (b) * 2 + (h)) * HTB)
#define PG8_STAGE(bufoff, gbase, voff) do { _Pragma("unroll") for (int _i = 0; _i < 2; ++_i) \
        __builtin_amdgcn_global_load_lds((const unsigned*)((const char*)(gbase) + (voff)[_i]), (LAS unsigned*)(lds + (bufoff) + ldsw + _i * 8192), 16, 0, 0); } while (0)
#define PG8_LDA(dst, b, h) do { _Pragma("unroll") for (int m = 0; m < 4; ++m) _Pragma("unroll") for (int k = 0; k < 2; ++k) dst[m][k] = *(const LAS bf16x8*)(lds + PG8_SA(b, h) + aoff + m * 2048 + k * 1024); } while (0)
#define PG8_LDB(dst, b, h) do { _Pragma("unroll") for (int n = 0; n < 2; ++n) _Pragma("unroll") for (int k = 0; k < 2; ++k) dst[n][k] = *(const LAS bf16x8*)(lds + PG8_SB(b, h) + boff + n * 2048 + k * 1024); } while (0)
#define PG8_MMA(ai, bj, At, Bt) do { __builtin_amdgcn_s_setprio(1); _Pragma("unroll") for (int m = 0; m < 4; ++m) _Pragma("unroll") for (int n = 0; n < 2; ++n) _Pragma("unroll") for (int k = 0; k < 2; ++k) \
        acc[ai][bj][m][n] = __builtin_amdgcn_mfma_f32_16x16x32_bf16(Bt[n][k], At[m][k], acc[ai][bj][m][n], 0, 0, 0); __builtin_amdgcn_s_setprio(0); } while (0)
#define PG8_WAIT_V(n) asm volatile("s_waitcnt vmcnt(" #n ")" ::: "memory")
#define PG8_WAIT_L(n) asm volatile("s_waitcnt lgkmcnt(" #n ")" ::: "memory")
#define PG8_BAR __builtin_amdgcn_s_barrier()
#define PG8_SCHED __builtin_amdgcn_sched_barrier(0)
    Unit cur, nxt; int ui = 0; int nsig = 0; (void)nsig;
    if (!S.next(0, cur)) return;
    f32x4 acc[2][2][4][2];
#pragma unroll
    for (int a = 0; a < 2; ++a)
#pragma unroll
        for (int b = 0; b < 2; ++b)
#pragma unroll
            for (int m = 0; m < 4; ++m)
#pragma unroll
                for (int n = 0; n < 2; ++n) acc[a][b][m][n] = (f32x4){0.f, 0.f, 0.f, 0.f};
    bf16x8 At[4][2], B0[2][2], B1[2][2];
    const char* cA = S.a_ptr(g, cur); const char* cB = S.b_ptr(g, cur);
    if constexpr (SP2) {
        PG8_STAGE(PG8_SB(0, 0), cB, voffB); PG8_STAGE(PG8_SB(0, 1), cB + hstepB, voffB); PG8_STAGE(PG8_SA(0, 0), cA, voffA); PG8_STAGE(PG8_SA(0, 1), cA + hstepA, voffA);
        if (wr == 1) PG8_BAR;
        PG8_WAIT_V(2); PG8_BAR;
        PG8_STAGE(PG8_SB(1, 0), cB + PG8_KB(1), voffB); PG8_STAGE(PG8_SA(1, 0), cA + PG8_KA(1), voffA); PG8_STAGE(PG8_SB(1, 1), cB + hstepB + PG8_KB(1), voffB);
        PG8_WAIT_V(6); PG8_BAR;
    } else {
    PG8_STAGE(PG8_SB(0, 0), cB, voffB); PG8_STAGE(PG8_SA(0, 0), cA, voffA); PG8_STAGE(PG8_SB(0, 1), cB + hstepB, voffB); PG8_STAGE(PG8_SA(0, 1), cA + hstepA, voffA);
    if (wr == 1) PG8_BAR;
    PG8_WAIT_V(4); PG8_BAR;
    PG8_STAGE(PG8_SB(1, 0), cB + PG8_KB(1), voffB); PG8_STAGE(PG8_SA(1, 0), cA + PG8_KA(1), voffA); PG8_STAGE(PG8_SB(1, 1), cB + hstepB + PG8_KB(1), voffB);
    PG8_WAIT_V(6); PG8_BAR;
    }
    for (;;) {
        const bool has_next = S.next(ui + 1, nxt);
        const char* nA = has_next ? S.a_ptr(g, nxt) : cA; const char* nB = has_next ? S.b_ptr(g, nxt) : cB;
        for (int t = 0; t < nt; t += 2) {
            const bool last = (t == nt - 2);
            const char* a1 = cA + PG8_KA(t + 1);
            const char* a2 = last ? nA : cA + PG8_KA(t + 2); const char* b2 = last ? nB : cB + PG8_KB(t + 2);
            const char* a3 = last ? nA + PG8_KA(1) : cA + PG8_KA(t + 3); const char* b3 = b2 + 128;
            if constexpr (SP2) {
            PG8_LDB(B0, 0, 0); PG8_LDB(B1, 0, 1); PG8_SCHED; PG8_LDA(At, 0, 0); PG8_STAGE(PG8_SA(1, 1), a1 + hstepA, voffA);
            PG8_WAIT_V(8); PG8_WAIT_L(0); PG8_BAR; PG8_MMA(0, 0, At, B0); PG8_MMA(0, 1, At, B1); PG8_BAR; PG8_SCHED;
            PG8_LDA(At, 0, 1); PG8_STAGE(PG8_SB(0, 0), b2, voffB); PG8_STAGE(PG8_SB(0, 1), b2 + hstepB, voffB); PG8_STAGE(PG8_SA(0, 0), a2, voffA);
            PG8_WAIT_V(8); PG8_WAIT_L(0); PG8_BAR; PG8_MMA(1, 0, At, B0); PG8_MMA(1, 1, At, B1); PG8_BAR; PG8_SCHED;
            PG8_LDB(B0, 1, 0); PG8_LDB(B1, 1, 1); PG8_SCHED; PG8_LDA(At, 1, 0); PG8_STAGE(PG8_SA(0, 1), a2 + hstepA, voffA);
            PG8_WAIT_V(8); PG8_WAIT_L(0); PG8_BAR; PG8_MMA(0, 0, At, B0); PG8_MMA(0, 1, At, B1); PG8_BAR; PG8_SCHED;
            PG8_LDA(At, 1, 1); PG8_STAGE(PG8_SB(1, 0), b3, voffB); PG8_STAGE(PG8_SB(1, 1), b3 + hstepB, voffB); PG8_STAGE(PG8_SA(1, 0), a3, voffA);
            PG8_WAIT_V(8); PG8_WAIT_L(0); PG8_BAR; PG8_MMA(1, 0, At, B0); PG8_MMA(1, 1, At, B1); PG8_BAR; PG8_SCHED;
            } else {
            PG8_LDB(B0, 0, 0); PG8_SCHED; PG8_LDA(At, 0, 0); PG8_STAGE(PG8_SA(1, 1), a1 + hstepA, voffA);
            PG8_WAIT_L(8); PG8_BAR; PG8_WAIT_L(0); PG8_MMA(0, 0, At, B0); PG8_BAR; PG8_SCHED;
            PG8_LDB(B1, 0, 1); PG8_STAGE(PG8_SB(0, 0), b2, voffB);
            PG8_BAR; PG8_WAIT_L(0); PG8_MMA(0, 1, At, B1); PG8_BAR;
            PG8_LDA(At, 0, 1); PG8_STAGE(PG8_SA(0, 0), a2, voffA);
            PG8_BAR; PG8_WAIT_L(0); PG8_MMA(1, 0, At, B0); PG8_BAR; PG8_SCHED;
            PG8_STAGE(PG8_SB(0, 1), b2 + hstepB, voffB);
            PG8_WAIT_V(6); PG8_BAR; PG8_MMA(1, 1, At, B1); PG8_BAR;
            PG8_LDB(B0, 1, 0); PG8_SCHED; PG8_LDA(At, 1, 0); PG8_STAGE(PG8_SA(0, 1), a2 + hstepA, voffA);
            PG8_WAIT_L(8); PG8_BAR; PG8_WAIT_L(0); PG8_MMA(0, 0, At, B0); PG8_BAR; PG8_SCHED;
            PG8_LDB(B1, 1, 1); PG8_STAGE(PG8_SB(1, 0), b3, voffB);
            PG8_BAR; PG8_WAIT_L(0); PG8_MMA(0, 1, At, B1); PG8_BAR;
            PG8_LDA(At, 1, 1); PG8_STAGE(PG8_SA(1, 0), a3, voffA);
            PG8_BAR; PG8_WAIT_L(0); PG8_MMA(1, 0, At, B0); PG8_BAR; PG8_SCHED;
            PG8_STAGE(PG8_SB(1, 1), b3 + hstepB, voffB);
            PG8_WAIT_V(6); PG8_BAR; PG8_MMA(1, 1, At, B1); PG8_BAR;
            }
        }
        if constexpr (ALIGN_EPI) { if (wr == 0) PG8_BAR; }
        E(acc, cur, wr, wc, fr, fq);
        if constexpr (Sched::SIGNAL) {
            nsig += cur.pz & 1;
            if ((cur.pz & 1) && !(has_next && (nxt.pz & 1))) { PG8_WAIT_V(0); PG8_BAR;
                if (tid == 0) { __builtin_amdgcn_fence(__ATOMIC_RELEASE, "agent"); PG8_WAIT_V(0); (void)__hip_atomic_fetch_add(S.sig, (unsigned)nsig, __ATOMIC_RELAXED, __HIP_MEMORY_SCOPE_AGENT); }
                nsig = 0; } }
        if (!has_next) break;
#pragma unroll
        for (int a = 0; a < 2; ++a)
#pragma unroll
            for (int b = 0; b < 2; ++b)
#pragma unroll
                for (int m = 0; m < 4; ++m)
#pragma unroll
                    for (int n = 0; n < 2; ++n) acc[a][b][m][n] = (f32x4){0.f, 0.f, 0.f, 0.f};
        cur = nxt; cA = nA; cB = nB; ++ui;
        if constexpr (ALIGN_EPI) { if (wr == 1) PG8_BAR; }
    }
    PG8_WAIT_V(0);
    if constexpr (!ALIGN_EPI) { if (wr == 0) PG8_BAR; }
    PG8_BAR;
#undef PG8_KA
#undef PG8_KB
#undef PG8_SA
#undef PG8_SB
#undef PG8_STAGE
#undef PG8_LDA
#undef PG8_LDB
#undef PG8_MMA
#undef PG8_WAIT_V
#undef PG8_WAIT_L
#undef PG8_BAR
#undef PG8_SCHED
}

struct EpiCols {
    static constexpr bool PERM = true;
    bf16_t* O; int ldc; bf16_t* vt; bf16_t* vselt; bf16_t* vwint;
    DI void operator()(const f32x4 (&acc)[2][2][4][2], const Unit& u, int wr, int wc, int fr, int fq) const {
        const int kind = u.pz >> 1;
        const int chunk = 4 * u.pm + wc;
        if (kind <= 1) {
        const bool lo = fr < 8;
        const size_t pitch = kind ? (size_t)64 : (size_t)ldc;
        bf16_t* base = kind ? vt + ((size_t)chunk * 2048 + (u.pn - 36) * BM + wr * 64 + (fr & 7)) * 64 + 8 * fq + (lo ? 0 : 32)
                            : O + (size_t)(u.pm * BM + wr * 64 + (fr & 7)) * ldc + u.pn * BM + wc * 64 + 8 * fq + (lo ? 0 : 32);
#pragma unroll
        for (int ai = 0; ai < 2; ++ai)
#pragma unroll
            for (int m = 0; m < 4; ++m) { bf16_t* rowp = base + (size_t)(ai * HALF + m * 16) * pitch;
                u32x4 w[2];
#pragma unroll
                for (int bj = 0; bj < 2; ++bj) { const f32x4 v0 = acc[ai][bj][m][0], v1 = acc[ai][bj][m][1];
                    w[bj].x = cvt_pk_bf16(v0[0], v0[1]); w[bj].y = cvt_pk_bf16(v0[2], v0[3]); w[bj].z = cvt_pk_bf16(v1[0], v1[1]); w[bj].w = cvt_pk_bf16(v1[2], v1[3]); }
                u32x4 snd, rcv;
#pragma unroll
                for (int e = 0; e < 4; ++e) { snd[e] = lo ? w[1][e] : w[0][e]; rcv[e] = (unsigned)__builtin_amdgcn_update_dpp(0, (int)snd[e], 0x128, 0xf, 0xf, false); }
                u32x4 sa, sb;
#pragma unroll
                for (int e = 0; e < 4; ++e) { sa[e] = lo ? w[0][e] : rcv[e]; sb[e] = lo ? rcv[e] : w[1][e]; }
                *(u32x4*)rowp = sa; *(u32x4*)(rowp + 8 * pitch) = sb; }
        } else { const int f0 = wr * 64 + fr;
            bf16_t* arr = kind == 2 ? vselt : vwint; const int t0 = (u.pn - (kind == 2 ? 14 : 18)) * BM + f0;
            const int pos0 = 16 * (fq & 1) + 4 * (fq >> 1);
#pragma unroll
            for (int ai = 0; ai < 2; ++ai)
#pragma unroll
                for (int m = 0; m < 4; ++m) { const int fc = t0 + ai * HALF + m * 16, gg = fc >> 7, dim = fc & 127;
                    bf16_t* rowp = arr + ((size_t)(gg * 128 + chunk) * 128 + dim) * 64 + pos0;
#pragma unroll
                    for (int bj = 0; bj < 2; ++bj) { const f32x4 v0 = acc[ai][bj][m][0], v1 = acc[ai][bj][m][1];
                        u32x2 w0, w1; w0.x = cvt_pk_bf16(v0[0], v0[1]); w0.y = cvt_pk_bf16(v0[2], v0[3]); w1.x = cvt_pk_bf16(v1[0], v1[1]); w1.y = cvt_pk_bf16(v1[2], v1[3]);
                        *(u32x2*)(rowp + 32 * bj) = w0; *(u32x2*)(rowp + 32 * bj + 8) = w1; } }
        }
    }
};
struct EpiPart {
    static constexpr bool PERM = false;
    float* P;
    DI void operator()(const f32x4 (&acc)[2][2][4][2], const Unit& u, int wr, int wc, int fr, int fq) const {
        float* base = P + ((size_t)(u.pk * 8 + u.pz) * 512 + u.pm * BM) * 256;
        const int row0 = wr * 64 + fr, col0 = wc * 32 + 4 * fq;
#pragma unroll
        for (int ai = 0; ai < 2; ++ai)
#pragma unroll
            for (int m = 0; m < 4; ++m) { float* rowp = base + (size_t)(row0 + ai * HALF + m * 16) * 256 + col0;
#pragma unroll
                for (int bj = 0; bj < 2; ++bj)
#pragma unroll
                    for (int n = 0; n < 2; ++n) *(f32x4*)(rowp + bj * HALF + n * 16) = acc[ai][bj][m][n]; }
    }
};
struct EpiResid {
    static constexpr bool PERM = true;
    const float* xf; const bf16_t* xb; bf16_t* xo;
    DI void operator()(const f32x4 (&acc)[2][2][4][2], const Unit& u, int wr, int wc, int fr, int fq) const {
        const int row0 = u.pm * BM + wr * 64 + fr, col0 = u.pn * BM + wc * 64 + 8 * fq;
#pragma unroll
        for (int ai = 0; ai < 2; ++ai) {
            if (xf) { f32x4 t[4][2][2];
#pragma unroll
                for (int m = 0; m < 4; ++m) { const size_t off = (size_t)(row0 + ai * HALF + m * 16) * D + col0;
#pragma unroll
                    for (int bj = 0; bj < 2; ++bj) { t[m][bj][0] = *(const f32x4*)(xf + off + bj * 32); t[m][bj][1] = *(const f32x4*)(xf + off + bj * 32 + 4); } }
#pragma unroll
                for (int m = 0; m < 4; ++m) { const size_t off = (size_t)(row0 + ai * HALF + m * 16) * D + col0;
#pragma unroll
                    for (int bj = 0; bj < 2; ++bj) { const f32x4 o0 = t[m][bj][0] + acc[ai][bj][m][0], o1 = t[m][bj][1] + acc[ai][bj][m][1];
                        u32x4 w; w.x = pk2h(o0[0], o0[1]); w.y = pk2h(o0[2], o0[3]); w.z = pk2h(o1[0], o1[1]); w.w = pk2h(o1[2], o1[3]);
                        *(u32x4*)(xo + off + bj * 32) = w; } }
            } else { u32x4 t[4][2];
#pragma unroll
                for (int m = 0; m < 4; ++m) { const size_t off = (size_t)(row0 + ai * HALF + m * 16) * D + col0;
#pragma unroll
                    for (int bj = 0; bj < 2; ++bj) t[m][bj] = *(const u32x4*)(xb + off + bj * 32); }
#pragma unroll
                for (int m = 0; m < 4; ++m) { const size_t off = (size_t)(row0 + ai * HALF + m * 16) * D + col0;
#pragma unroll
                    for (int bj = 0; bj < 2; ++bj) { const u32x4 x_ = t[m][bj]; const f32x4 v0 = acc[ai][bj][m][0], v1 = acc[ai][bj][m][1];
                        u32x4 w; w.x = pk2h(lo_h(x_.x) + v0[0], hi_h(x_.x) + v0[1]); w.y = pk2h(lo_h(x_.y) + v0[2], hi_h(x_.y) + v0[3]);
                        w.z = pk2h(lo_h(x_.z) + v1[0], hi_h(x_.z) + v1[1]); w.w = pk2h(lo_h(x_.w) + v1[2], hi_h(x_.w) + v1[3]);
                        *(u32x4*)(xo + off + bj * 32) = w; } } }
            asm volatile("" ::: "memory"); }
    }
};
struct OrderAB {
    static constexpr bool SIGNAL = false;
    OrderMN mn; const bf16_t* A2; const bf16_t* B2;
    DI bool next(int i, Unit& u) const { if (!mn.next(i >> 1, u)) return false; u.pz = i & 1; return true; }
    DI const char* a_ptr(const Gemm& g, const Unit& u) const { return (const char*)(u.pz ? A2 : g.A) + (size_t)u.pm * BM * g.lda * 2; }
    DI const char* b_ptr(const Gemm& g, const Unit& u) const { return (const char*)(u.pz ? B2 : g.Bt) + (size_t)u.pn * BM * g.ldb * 2; }
};
struct EpiGateAB {
    static constexpr bool PERM = true;
    bf16_t* Y; bf16_t* tmp; const bf16_t* gate_a; const bf16_t* gate_b;
    DI void operator()(const f32x4 (&acc)[2][2][4][2], const Unit& u, int wr, int wc, int fr, int fq) const {
        const int row0 = u.pm * BM + wr * 64 + fr, col0 = u.pn * BM + wc * 64 + 8 * fq;
        const bf16_t* gate = u.pz ? gate_b : gate_a; bf16_t* dst = u.pz ? Y : tmp;
#pragma unroll
        for (int ai = 0; ai < 2; ++ai) { u32x4 gw[4][2], tw[4][2];
#pragma unroll
            for (int m = 0; m < 4; ++m) { const int row = row0 + ai * HALF + m * 16;
#pragma unroll
                for (int bj = 0; bj < 2; ++bj) { gw[m][bj] = *(const u32x4*)(gate + (size_t)row * NP + col0 + bj * 32);
                    tw[m][bj] = (u32x4){0u, 0u, 0u, 0u}; if (u.pz) tw[m][bj] = *(const u32x4*)(tmp + (size_t)row * D + col0 + bj * 32); } }
#pragma unroll
            for (int m = 0; m < 4; ++m) { const int row = row0 + ai * HALF + m * 16;
#pragma unroll
                for (int bj = 0; bj < 2; ++bj) { const u32x4 g_ = gw[m][bj], t_ = tw[m][bj];
                    const f32x4 v0 = acc[ai][bj][m][0], v1 = acc[ai][bj][m][1]; f32x4 o0, o1;
                    o0[0] = lo_bf(t_.x) + v0[0] * sigmoidf_(lo_bf(g_.x)); o0[1] = hi_bf(t_.x) + v0[1] * sigmoidf_(hi_bf(g_.x)); o0[2] = lo_bf(t_.y) + v0[2] * sigmoidf_(lo_bf(g_.y)); o0[3] = hi_bf(t_.y) + v0[3] * sigmoidf_(hi_bf(g_.y));
                    o1[0] = lo_bf(t_.z) + v1[0] * sigmoidf_(lo_bf(g_.z)); o1[1] = hi_bf(t_.z) + v1[1] * sigmoidf_(hi_bf(g_.z)); o1[2] = lo_bf(t_.w) + v1[2] * sigmoidf_(lo_bf(g_.w)); o1[3] = hi_bf(t_.w) + v1[3] * sigmoidf_(hi_bf(g_.w));
                    u32x4 w; w.x = cvt_pk_bf16(o0[0], o0[1]); w.y = cvt_pk_bf16(o0[2], o0[3]); w.z = cvt_pk_bf16(o1[0], o1[1]); w.w = cvt_pk_bf16(o1[2], o1[3]);
                    *(u32x4*)(dst + (size_t)row * D + col0 + bj * 32) = w; } }
            asm volatile("" ::: "memory"); }
    }
};
}

#define XB_TMO      128
#define XB_XCNT(j)  (256  + 64 * (j))
#define XB_XSUB(j)  (1280 + 64 * (j))
#define XB_XGEN(j)  (2304 + 64 * (j))
#define XB_TOP      3328
#define XB_TOPGEN   3392
#define XCD_BAR_WORDS 3456
#define XB_SPIN_CAP (1u << 18)
__device__ __forceinline__ unsigned xb_ld(unsigned* p)              { return __hip_atomic_load(p, __ATOMIC_RELAXED, __HIP_MEMORY_SCOPE_AGENT); }
__device__ __forceinline__ unsigned xb_add(unsigned* p, unsigned v) { return __hip_atomic_fetch_add(p, v, __ATOMIC_RELAXED, __HIP_MEMORY_SCOPE_AGENT); }
__device__ __forceinline__ unsigned xb_xcc_id() { return (unsigned)__builtin_amdgcn_s_getreg((3 << 11) | 20) & 0xFu; }
#define XB_SPIN(cond, bar) do { unsigned _sp = 0; while (cond) { __builtin_amdgcn_s_sleep(1); \
    if ((++_sp & 255u) == 0u) { if (xb_ld(&(bar)[XB_TMO])) break; if (_sp > XB_SPIN_CAP) { atomicAdd(&(bar)[XB_TMO], 1u); break; } } } } while (0)
struct XcdBarrier { unsigned* bar; unsigned x; volatile LAS unsigned* st; };
__device__ __forceinline__ XcdBarrier xcd_barrier_post(unsigned* bar, volatile LAS unsigned* st) {
    XcdBarrier b; b.bar = bar; b.x = xb_xcc_id(); b.st = st;
    if (threadIdx.x == 0) (void)xb_add(&bar[XB_XCNT(b.x)], 1u);
    return b;
}
__device__ __forceinline__ void xcd_barrier_complete(unsigned* bar, unsigned x, unsigned& nloc, unsigned& nx) {
    const unsigned G = gridDim.x * gridDim.y * gridDim.z;
    unsigned sum, cnt, mine, sp = 0u;
    for (;;) {
        sum = 0u; cnt = 0u; mine = 0u;
#pragma unroll
        for (unsigned j = 0; j < 16; ++j) { const unsigned c = xb_ld(&bar[XB_XCNT(j)]); sum += c; cnt += (c > 0u) ? 1u : 0u; mine = (j == x) ? c : mine; }
        if (sum == G) break;
        __builtin_amdgcn_s_sleep(1);
        if ((++sp & 255u) == 0u) { if (xb_ld(&bar[XB_TMO])) break; if (sp > XB_SPIN_CAP) { atomicAdd(&bar[XB_TMO], 1u); break; } }
    }
    nloc = mine > 0u ? mine : 1u; nx = cnt > 0u ? cnt : 1u;
}
__device__ __forceinline__ void xcd_barrier(const XcdBarrier& b) {
    asm volatile("s_waitcnt vmcnt(0)" ::: "memory");
    __syncthreads();
    if (threadIdx.x == 0) {
        unsigned* bar = b.bar;
        __builtin_amdgcn_s_waitcnt(0);
        unsigned nloc = b.st[0], nx = b.st[1];
        if (nloc == 0u) { xcd_barrier_complete(bar, b.x, nloc, nx); b.st[0] = nloc; b.st[1] = nx; }
        const unsigned old = xb_add(&bar[XB_XSUB(b.x)], 1u);
        const unsigned gen = old / nloc;
        if (old + 1u == (gen + 1u) * nloc) {
            __builtin_amdgcn_fence(__ATOMIC_RELEASE, "agent");
            asm volatile("s_waitcnt vmcnt(0)" ::: "memory");
            const unsigned og = xb_add(&bar[XB_TOP], 1u);
            const unsigned tg = og / nx;
            if (og + 1u == (tg + 1u) * nx) xb_add(&bar[XB_TOPGEN], 1u);
            else XB_SPIN(xb_ld(&bar[XB_TOPGEN]) == tg, bar);
            __builtin_amdgcn_fence(__ATOMIC_ACQUIRE, "agent");
            xb_add(&bar[XB_XGEN(b.x)], 1u);
            asm volatile("s_waitcnt vmcnt(0)" ::: "memory");
        } else {
            XB_SPIN(xb_ld(&bar[XB_XGEN(b.x)]) == gen, bar);
            __builtin_amdgcn_fence(__ATOMIC_ACQUIRE, "agent");
            asm volatile("s_waitcnt vmcnt(0)" ::: "memory");
        }
    }
    __syncthreads();
}

struct Args {
    const float *x, *norm_w, *w_in, *cmp_pe, *cmp_w1, *cmp_b1, *cmp_w2, *cmp_b2, *alpha_w, *alpha_b, *gla_norm_w, *p_a, *p_b, *w_out, *final_w;
    float* out; unsigned char* ws; int ph_lo, ph_hi;
};
typedef const __attribute__((address_space(4))) Args* KArgsP;
DI Args load_args(KArgsP p) { Args a; a.x = p->x; a.norm_w = p->norm_w; a.w_in = p->w_in; a.cmp_pe = p->cmp_pe; a.cmp_w1 = p->cmp_w1; a.cmp_b1 = p->cmp_b1; a.cmp_w2 = p->cmp_w2; a.cmp_b2 = p->cmp_b2;
    a.alpha_w = p->alpha_w; a.alpha_b = p->alpha_b; a.gla_norm_w = p->gla_norm_w; a.p_a = p->p_a; a.p_b = p->p_b; a.w_out = p->w_out; a.final_w = p->final_w; a.out = p->out; a.ws = p->ws; a.ph_lo = 0; a.ph_hi = 0; return a; }
struct Frame {
    LAS unsigned char* lds; int tid, lane, wave, G, bid, gw, NGW;
};

struct CvItem { const float* W; bf16_t* WT; int K, N, item; bool map; };
DI void cv_load(f32x4 (&v)[16], const CvItem& c, int lane) {
    const int nblk = c.N / 64, kb = c.item / nblk, nb = c.item % nblk, k0 = 64 * kb, n0 = 64 * nb;
#pragma unroll
    for (int i = 0; i < 16; ++i) v[i] = *(const f32x4*)(c.W + (size_t)(k0 + 4 * i + (lane >> 4)) * c.N + n0 + 4 * (lane & 15));
}
DI void cv_store(const f32x4 (&v)[16], const CvItem& c, LAS float* scr, int lane) {
    const int nblk = c.N / 64, kb = c.item / nblk, nb = c.item % nblk, k0 = 64 * kb, n0 = 64 * nb;
#pragma unroll
    for (int i = 0; i < 16; ++i) { LAS float* d = scr + (4 * i + (lane >> 4)) * 65 + 4 * (lane & 15); d[0] = v[i].x; d[1] = v[i].y; d[2] = v[i].z; d[3] = v[i].w; }
    LDS_WAIT(); asm volatile("" ::: "memory");
    const int ch = lane & 7;
#pragma unroll
    for (int j = 0; j < 8; ++j) { const int n = (lane >> 3) + 8 * j; const LAS float* s = scr + (8 * ch) * 65 + n;
        u32x4 o; o.x = pk2(s[0 * 65], s[1 * 65]); o.y = pk2(s[2 * 65], s[3 * 65]); o.z = pk2(s[4 * 65], s[5 * 65]); o.w = pk2(s[6 * 65], s[7 * 65]);
        const int drow = c.map ? map_col(n0 + n) : (n0 + n);
        *(u32x4*)(c.WT + (size_t)drow * c.K + k0 + 8 * ch) = o; }
    LDS_WAIT(); asm volatile("" ::: "memory");
}
constexpr int CV_IN = (D / 64) * (NIN / 64), CV_SQ = (D / 64) * (D / 64), CV_W1 = (4096 / 64) * (256 / 64), CV_W2 = (256 / 64) * (128 / 64);
constexpr int CV_PER_L = CV_IN + 3 * CV_SQ + 2 * CV_W1 + 2 * CV_W2;
DI CvItem cv_item(const Args& a, int it) {
    unsigned char* ws = a.ws; const int l = it / CV_PER_L; int r = it % CV_PER_L; CvItem c;
    if (r < CV_IN) { c.W = a.w_in + (size_t)l * D * NIN; c.WT = (bf16_t*)(ws + WS_WIN) + (size_t)l * NP * D; c.K = D; c.N = NIN; c.item = r; c.map = true; return c; } r -= CV_IN;
    c.map = false;
    if (r < CV_SQ) { c.W = a.p_a + (size_t)l * D * D; c.WT = (bf16_t*)(ws + WS_WPA) + (size_t)l * D * D; c.K = D; c.N = D; c.item = r; return c; } r -= CV_SQ;
    if (r < CV_SQ) { c.W = a.p_b + (size_t)l * D * D; c.WT = (bf16_t*)(ws + WS_WPB) + (size_t)l * D * D; c.K = D; c.N = D; c.item = r; return c; } r -= CV_SQ;
    if (r < CV_SQ) { c.W = a.w_out + (size_t)l * D * D; c.WT = (bf16_t*)(ws + WS_WOUT) + (size_t)l * D * D; c.K = D; c.N = D; c.item = r; return c; } r -= CV_SQ;
    if (r < 2 * CV_W1) { const int kv = r / CV_W1; c.W = a.cmp_w1 + (size_t)(l * 2 + kv) * 4096 * 256; c.WT = (bf16_t*)(ws + WS_W1T) + (size_t)(l * 2 + kv) * 256 * 4096; c.K = 4096; c.N = 256; c.item = r % CV_W1; return c; } r -= 2 * CV_W1;
    { const int kv = r / CV_W2; c.W = a.cmp_w2 + (size_t)(l * 2 + kv) * 256 * 128; c.WT = (bf16_t*)(ws + WS_W2T) + (size_t)(l * 2 + kv) * 128 * 256; c.K = 256; c.N = 128; c.item = r % CV_W2; }
    return c;
}
DI void p_prologue(const Frame& F, const Args& a) {
    LAS float* scr = (LAS float*)(F.lds + F.wave * 16640);
    unsigned char* ws = a.ws;
    constexpr int TOT = DEPTH * CV_PER_L;
    f32x4 va[16], vb[16];
    int it = F.gw;
    if (it < TOT) { CvItem ca = cv_item(a, it); cv_load(va, ca, F.lane);
        for (;;) {
            const int itb = it + F.NGW; CvItem cb; const bool hb = itb < TOT; if (hb) { cb = cv_item(a, itb); cv_load(vb, cb, F.lane); }
            cv_store(va, ca, scr, F.lane);
            if (!hb) break;
            const int itc = itb + F.NGW; const bool hc = itc < TOT; if (hc) { ca = cv_item(a, itc); cv_load(va, ca, F.lane); }
            cv_store(vb, cb, scr, F.lane);
            if (!hc) break;
            it = itc;
        } }
    __syncthreads();
    LAS float* red = (LAS float*)F.lds;
    for (int job = F.bid; job < DEPTH * 2; job += F.G) {
        const float* w1 = a.cmp_w1 + (size_t)job * 4096 * 256; const float* pe = a.cmp_pe + (size_t)job * 4096;
        f32x4 s = {0.f, 0.f, 0.f, 0.f};
        for (int k = F.wave * 512; k < F.wave * 512 + 512; ++k) { const f32x4 w = *(const f32x4*)(w1 + (size_t)k * 256 + 4 * F.lane); s += w * pe[k]; }
        *(LAS f32x4*)(red + F.wave * 256 + 4 * F.lane) = s;
        __syncthreads();
        if (F.tid < 256) { float t = a.cmp_b1[job * 256 + F.tid];
#pragma unroll
            for (int w = 0; w < 8; ++w) t += red[w * 256 + F.tid];
            ((float*)(ws + WS_B1P))[job * 256 + F.tid] = t; }
        __syncthreads();
    }
}

template <bool OUT_F32, bool IN_BF16>
DI void p_rmsnorm(const Frame& F, const void* xin, const float* w, void* out) {
    f32x4 wv[4][2];
#pragma unroll
    for (int j = 0; j < 4; ++j) { wv[j][0] = *(const f32x4*)(w + 512 * j + 8 * F.lane); wv[j][1] = *(const f32x4*)(w + 512 * j + 8 * F.lane + 4); }
    for (int row = F.gw; row < T; row += F.NGW) {
        float v[4][8]; float s = 0.f;
        if (IN_BF16) { const bf16_t* xr = (const bf16_t*)xin + (size_t)row * D + 8 * F.lane; u32x4 q[4];
#pragma unroll
            for (int j = 0; j < 4; ++j) q[j] = *(const u32x4*)(xr + 512 * j);
#pragma unroll
            for (int j = 0; j < 4; ++j) unpack8h(q[j], v[j]);
        } else { const float* xr = (const float*)xin + (size_t)row * D + 8 * F.lane; f32x4 q[4][2];
#pragma unroll
            for (int j = 0; j < 4; ++j) { q[j][0] = *(const f32x4*)(xr + 512 * j); q[j][1] = *(const f32x4*)(xr + 512 * j + 4); }
#pragma unroll
            for (int j = 0; j < 4; ++j)
#pragma unroll
                for (int e = 0; e < 8; ++e) v[j][e] = q[j][e >> 2][e & 3]; }
#pragma unroll
        for (int j = 0; j < 4; ++j) s += ((v[j][0] * v[j][0] + v[j][1] * v[j][1]) + (v[j][2] * v[j][2] + v[j][3] * v[j][3])) + ((v[j][4] * v[j][4] + v[j][5] * v[j][5]) + (v[j][6] * v[j][6] + v[j][7] * v[j][7]));
        const float rs = rsqrtf(wave_sum(s, F.lane) * (1.f / D) + NORM_EPS);
        if (OUT_F32) { float* o = (float*)out + (size_t)row * D + 8 * F.lane;
#pragma unroll
            for (int j = 0; j < 4; ++j) { f32x4 y0, y1;
#pragma unroll
                for (int e = 0; e < 4; ++e) { y0[e] = v[j][e] * rs * wv[j][0][e]; y1[e] = v[j][4 + e] * rs * wv[j][1][e]; }
                *(f32x4*)(o + 512 * j) = y0; *(f32x4*)(o + 512 * j + 4) = y1; }
        } else { bf16_t* o = (bf16_t*)out + (size_t)row * D + 8 * F.lane;
#pragma unroll
            for (int j = 0; j < 4; ++j) { float y[8];
#pragma unroll
                for (int e = 0; e < 8; ++e) y[e] = v[j][e] * rs * wv[j][e >> 2][e & 3];
                u32x4 p; p.x = pk2(y[0], y[1]); p.y = pk2(y[2], y[3]); p.z = pk2(y[4], y[5]); p.w = pk2(y[6], y[7]); *(u32x4*)(o + 512 * j) = p; } }
    }
}

constexpr int KTILE = 16384, VTILE = 16384, ABUF = KTILE + VTILE;
DI void glds16(const void* gsrc, LAS unsigned char* dst) { unsigned keep; const unsigned lds_dst = (unsigned)(uintptr_t)dst;
    asm volatile("s_mov_b32 %0, m0\n\ts_mov_b32 m0, %2\n\ts_nop 0\n\tglobal_load_lds_dwordx4 %1, off\n\ts_mov_b32 m0, %0" : "=&s"(keep) : "v"(gsrc), "s"(lds_dst) : "memory"); }
DI void dma_k(LAS unsigned char* kb, const bf16_t* kbase, size_t kpitch, int w, int lane) {
#pragma unroll
    for (int i = 0; i < 2; ++i) { const int b = w + 8 * i, row = 4 * b + (lane >> 4), c = (lane & 15) ^ (row & 15);
        glds16(kbase + (size_t)row * kpitch + c * 8, kb + b * 1024); }
}
DI void dma_v(LAS unsigned char* vb, const bf16_t* vbase, size_t vpitch, int w, int lane) {
#pragma unroll
    for (int i = 0; i < 2; ++i) { const int b = w + 8 * i, row = 8 * b + (lane >> 3), c = (lane & 7) ^ ((row >> 1) & 7);
        glds16(vbase + (size_t)row * vpitch + c * 8, vb + b * 1024); }
}
#define VMCNT(n) asm volatile("s_waitcnt vmcnt(" #n ")" ::: "memory")
#define RAW_BARRIER() do { asm volatile("" ::: "memory"); __builtin_amdgcn_s_barrier(); asm volatile("" ::: "memory"); } while (0)

DI void gla_g1_unit(const Frame& F, const Args& a, int layer, int n, int h) {
    const bf16_t* cols = (const bf16_t*)(a.ws + WS_COLS);
    LAS float* alr = (LAS float*)(F.lds); LAS float* part = (LAS float*)(F.lds + 4096);
    LAS unsigned char* QR = F.lds + 8192; LAS unsigned char* KR = F.lds + 8192 + 32768;
    __syncthreads();
#pragma unroll
    for (int hf = 0; hf < 2; ++hf) { dma_k(QR + hf * 16384, cols + (size_t)(64 * n) * NP + C_QB + h * 256 + hf * 128, NP, F.wave, F.lane);
        dma_k(KR + hf * 16384, cols + (size_t)(64 * n) * NP + C_KB + h * 256 + hf * 128, NP, F.wave, F.lane); }
    if (F.tid < 256) { const int t = F.tid >> 2, k4 = (F.tid & 3) * 4; const u32x2 w = *(const u32x2*)(cols + (size_t)(64 * n + t) * NP + C_ALR + k4);
        alr[t * 16 + k4 + 0] = lo_bf(w.x); alr[t * 16 + k4 + 1] = hi_bf(w.x); alr[t * 16 + k4 + 2] = lo_bf(w.y); alr[t * 16 + k4 + 3] = hi_bf(w.y); }
    __syncthreads();
    const int d = F.tid & 255, half = F.tid >> 8, col = h * 256 + d;
    float w[16];
#pragma unroll
    for (int k = 0; k < 16; ++k) w[k] = a.alpha_w[(size_t)(layer * 16 + k) * 1024 + col];
    const float b = a.alpha_b[layer * 1024 + col];
    float cum[32]; float run = 0.f;
#pragma unroll
    for (int i = 0; i < 32; ++i) { const int t = half * 32 + i; float ga = b;
#pragma unroll
        for (int k4 = 0; k4 < 4; ++k4) { const f32x4 av = *(const LAS f32x4*)(alr + t * 16 + 4 * k4); ga += av.x * w[4 * k4] + av.y * w[4 * k4 + 1] + av.z * w[4 * k4 + 2] + av.w * w[4 * k4 + 3]; }
        const float ls = fminf(ga, 0.f) - __logf(1.f + __expf(-fabsf(ga)));
        run += ls * 0.0625f; cum[i] = run; }
    part[half * 256 + d] = run;
    VMCNT(0);
    __syncthreads();
    const float p0 = part[d], last = p0 + part[256 + d], elast = __expf(last);
    if (half) {
#pragma unroll
        for (int i = 0; i < 32; ++i) cum[i] += p0; }
    bf16_t* kst = (bf16_t*)(a.ws + WS_KST);
    const int eoff = (d >> 7) * 16384 + (d & 7) * 2, ech = (d & 127) >> 3;
    unsigned ksw[16];
#pragma unroll
    for (int i = 0; i < 32; ++i) { const int t = half * 32 + i; const int off = eoff + t * 256 + ((ech ^ (t & 15)) << 4);
        const float qv = bf2f(*(const LAS unsigned short*)(QR + off)), kv = bf2f(*(const LAS unsigned short*)(KR + off));
        const float ec = __expf(cum[i]), kin = kv * __expf(-cum[i]);
        const unsigned qb = f2bf(qv * 0.0625f * ec), kib = f2bf(kin), ksb = f2bf(kin * elast);
        *(LAS unsigned short*)(QR + off) = (unsigned short)qb; *(LAS unsigned short*)(KR + off) = (unsigned short)kib;
        if (i & 1) ksw[i >> 1] |= ksb << 16; else ksw[i >> 1] = ksb; }
    { bf16_t* kp = kst + ((size_t)((n * 4 + h) * 256 + d)) * 64 + half * 32;
#pragma unroll
        for (int j = 0; j < 4; ++j) { u32x4 o; o.x = ksw[4 * j]; o.y = ksw[4 * j + 1]; o.z = ksw[4 * j + 2]; o.w = ksw[4 * j + 3]; *(u32x4*)(kp + 8 * j) = o; } }
    if (half == 0) ((float*)(a.ws + WS_DEC))[(n * 4 + h) * 256 + d] = elast;
    __syncthreads();
    { bf16_t* qdec = (bf16_t*)(a.ws + WS_QDEC);
#pragma unroll
        for (int i = 0; i < 4; ++i) { const int id = F.tid + 512 * i, t = id >> 5, c32 = id & 31, hf = c32 >> 4, c = c32 & 15;
            *(u32x4*)(qdec + (size_t)(64 * n + t) * 1024 + h * 256 + c32 * 8) = *(const LAS u32x4*)(QR + hf * 16384 + t * 256 + ((c ^ (t & 15)) << 4)); } }
    bf16_t* att = (bf16_t*)(a.ws + WS_ATT) + (size_t)(n * 4 + h) * 4096;
    const int fr = F.lane & 15, fq = F.lane >> 4, ms = F.wave >> 1;
#pragma unroll
    for (int z = 0; z < 2; ++z) { const int nt = 2 * (F.wave & 1) + z; f32x4 acc = {0.f, 0.f, 0.f, 0.f};
#pragma unroll
        for (int ks = 0; ks < 8; ++ks) { const int fo = (ks >> 2) * 16384 + (((4 * (ks & 3) + fq) ^ fr) << 4);
            const bf16x8 A = *(const LAS bf16x8*)(KR + fo + (16 * ms + fr) * 256);
            const bf16x8 B = *(const LAS bf16x8*)(QR + fo + (16 * nt + fr) * 256); acc = MFMA16(A, B, acc); }
        const int t = 16 * nt + fr, s0 = 16 * ms + 4 * fq;
        u32x2 o; o.x = pk2(s0 + 0 <= t ? acc[0] : 0.f, s0 + 1 <= t ? acc[1] : 0.f); o.y = pk2(s0 + 2 <= t ? acc[2] : 0.f, s0 + 3 <= t ? acc[3] : 0.f);
        *(u32x2*)(att + t * 64 + s0) = o; }
}

DI float gelu_tanh(float x) { const float u = 0.7978845608028654f * (x + 0.044715f * x * x * x); const float t = __expf(2.f * u); return 0.5f * x * (2.f - 2.f / (t + 1.f)); }
DI void mlp2_unit(const Frame& F, const Args& a, int layer, int pz, int rt) {
    const float* cpart = (const float*)(a.ws + WS_CPART);
    LAS unsigned char* hid = F.lds;
    const int kv = pz >> 2, g = pz & 3;
    __syncthreads();
    { const int r = F.tid >> 5, c0 = (F.tid & 31) * 8; f32x4 s0, s1;
        const float* bp = (const float*)(a.ws + WS_B1P) + (layer * 2 + kv) * 256 + c0;
        s0 = *(const f32x4*)bp; s1 = *(const f32x4*)(bp + 4);
#pragma unroll
        for (int pk = 0; pk < 8; ++pk) { const float* p = cpart + ((size_t)(pk * 8 + pz) * 512 + rt * 16 + r) * 256 + c0; s0 += *(const f32x4*)p; s1 += *(const f32x4*)(p + 4); }
        u32x4 o; o.x = pk2(gelu_tanh(s0.x), gelu_tanh(s0.y)); o.y = pk2(gelu_tanh(s0.z), gelu_tanh(s0.w)); o.z = pk2(gelu_tanh(s1.x), gelu_tanh(s1.y)); o.w = pk2(gelu_tanh(s1.z), gelu_tanh(s1.w));
        *(LAS u32x4*)(hid + r * 528 + c0 * 2) = o; }
    __syncthreads();
    const bf16_t* w2t = (const bf16_t*)(a.ws + WS_W2T) + (size_t)(layer * 2 + kv) * 128 * 256;
    const int fr = F.lane & 15, fq = F.lane >> 4, dt = F.wave;
    const float* b2 = a.cmp_b2 + (layer * 2 + kv) * 128;
    f32x4 acc = {0.f, 0.f, 0.f, 0.f};
#pragma unroll
    for (int ks = 0; ks < 8; ++ks) { const bf16x8 wf = *(const bf16x8*)(w2t + (16 * dt + fr) * 256 + 32 * ks + 8 * fq);
        const bf16x8 hf = *(const LAS bf16x8*)(hid + fr * 528 + (32 * ks + 8 * fq) * 2);
        acc = kv ? MFMA16(hf, wf, acc) : MFMA16(wf, hf, acc); }
    if (!kv) { const int n = 16 * rt + fr, dim = 16 * dt + 4 * fq; const f32x4 bb = *(const f32x4*)(b2 + dim); u32x2 o;
        if (n == 511) { o.x = 0u; o.y = 0u; } else { o.x = pk2(acc[0] + bb.x, acc[1] + bb.y); o.y = pk2(acc[2] + bb.z, acc[3] + bb.w); }
        *(u32x2*)((bf16_t*)(a.ws + WS_KC) + ((size_t)g * 512 + n) * 128 + dim) = o; }
    else { const int n0 = 16 * rt + 4 * fq, dim = 16 * dt + fr; const float bb = b2[dim]; u32x2 o;
        o.x = pk2(acc[0] + bb, acc[1] + bb); o.y = pk2(acc[2] + bb, (n0 + 3 == 511) ? 0.f : acc[3] + bb);
        const int pos = 64 * (rt >> 2) + 32 * ((rt & 3) >> 1) + 8 * fq + 4 * (rt & 1);
        *(u32x2*)((bf16_t*)(a.ws + WS_VCT) + ((size_t)g * 128 + dim) * 512 + pos) = o; }
}

template <int ACT>
DI void qk_tile(f32x4 (&s)[4][2], const LAS unsigned char* kb, const bf16x8 (&qf)[2][4], int fr, int fq) {
    const LAS unsigned char* kr = kb + fr * 256; const int x0 = (fq ^ fr) << 4, x1 = ((4 + fq) ^ fr) << 4, x2 = ((8 + fq) ^ fr) << 4, x3 = ((12 + fq) ^ fr) << 4;
    const f32x4 zero = {0.f, 0.f, 0.f, 0.f};
#pragma unroll
    for (int kt = 0; kt < 4; ++kt) { const LAS unsigned char* kn = kr + kt * 4096; bf16x8 kf[4];
        kf[0] = *(const LAS bf16x8*)(kn + x0); kf[1] = *(const LAS bf16x8*)(kn + x1); kf[2] = *(const LAS bf16x8*)(kn + x2); kf[3] = *(const LAS bf16x8*)(kn + x3);
        if (ACT & 1) { s[kt][0] = MFMA16(kf[0], qf[0][0], zero); } if (ACT & 2) { s[kt][1] = MFMA16(kf[0], qf[1][0], zero); }
#pragma unroll
        for (int ks = 1; ks < 4; ++ks) { if (ACT & 1) s[kt][0] = MFMA16(kf[ks], qf[0][ks], s[kt][0]); if (ACT & 2) s[kt][1] = MFMA16(kf[ks], qf[1][ks], s[kt][1]); }
    }
}
template <int ACT, bool WITH_L = true>
DI void pv_tile(f32x4 (&O)[8][2], f32x4 (&L)[2], const LAS unsigned char* vb, const bf16x8 (&pf)[2][2], int fr, int fq) {
    const LAS unsigned char* vr = vb + fr * 128; const int x = (fr >> 1) & 7, y0 = (fq ^ x) << 4, y1 = ((4 + fq) ^ x) << 4;
    const bf16x8 ones = {0x3f80, 0x3f80, 0x3f80, 0x3f80, 0x3f80, 0x3f80, 0x3f80, 0x3f80};
    if (WITH_L && (ACT & 1)) { L[0] = MFMA16(ones, pf[0][0], L[0]); L[0] = MFMA16(ones, pf[1][0], L[0]); }
    if (WITH_L && (ACT & 2)) { L[1] = MFMA16(ones, pf[0][1], L[1]); L[1] = MFMA16(ones, pf[1][1], L[1]); }
#pragma unroll
    for (int dt = 0; dt < 8; ++dt) {
        const bf16x8 v0 = *(const LAS bf16x8*)(vr + dt * 2048 + y0), v1 = *(const LAS bf16x8*)(vr + dt * 2048 + y1);
        if (ACT & 1) O[dt][0] = MFMA16(v0, pf[0][0], O[dt][0]); if (ACT & 2) O[dt][1] = MFMA16(v0, pf[0][1], O[dt][1]);
        if (ACT & 1) O[dt][0] = MFMA16(v1, pf[1][0], O[dt][0]); if (ACT & 2) O[dt][1] = MFMA16(v1, pf[1][1], O[dt][1]);
    }
}
DI float max3f(float a, float b, float c) { return fmaxf(fmaxf(a, b), c); }
DI bf16x8 pack_p(const f32x4& a, const f32x4& b) { u32x4 w; w.x = cvt_pk_bf16(a[0], a[1]); w.y = cvt_pk_bf16(a[2], a[3]); w.z = cvt_pk_bf16(b[0], b[1]); w.w = cvt_pk_bf16(b[2], b[3]); return __builtin_bit_cast(bf16x8, w); }
DI float quad_max(float v, int lane) {
    auto r = __builtin_amdgcn_permlane16_swap(__float_as_uint(v), __float_as_uint(v), false, false); v = fmaxf(__uint_as_float(r[0]), __uint_as_float(r[1]));
    r = __builtin_amdgcn_permlane32_swap(__float_as_uint(v), __float_as_uint(v), false, false); return fmaxf(__uint_as_float(r[0]), __uint_as_float(r[1])); }
DI float quad_sum(float v, int lane) {
    auto r = __builtin_amdgcn_permlane16_swap(__float_as_uint(v), __float_as_uint(v), false, false); v = __uint_as_float(r[0]) + __uint_as_float(r[1]);
    r = __builtin_amdgcn_permlane32_swap(__float_as_uint(v), __float_as_uint(v), false, false); return __uint_as_float(r[0]) + __uint_as_float(r[1]); }
constexpr float NEG_INF = -__builtin_inff();

template <int MODE, int ACT>
DI void fa_tile(f32x4 (&O)[8][2], f32x4 (&L)[2], float (&m)[2], const bf16x8 (&qf)[2][4], const LAS unsigned char* kb, const LAS unsigned char* vb,
                const bool (&bit)[2], const int (&tokl)[2], bool diag, bool left, int fr, int fq, int lane) {
    f32x4 s[4][2];
    qk_tile<ACT>(s, kb, qf, fr, fq);
    bf16x8 pf[2][2];
#pragma unroll
    for (int ct = 0; ct < 2; ++ct) {
        if (!((ACT >> ct) & 1)) continue;
        if (diag || left) {
            const int thr_hi = diag ? tokl[ct] : 63, thr_lo = left ? tokl[ct] : -1;
            int kq = 4 * fq; asm volatile("" : "+v"(kq));
#pragma unroll
            for (int kt = 0; kt < 4; ++kt)
#pragma unroll
                for (int r = 0; r < 4; ++r) { const int kl = 16 * kt + kq + r;
                    s[kt][ct][r] = (kl <= thr_hi && kl > thr_lo) ? s[kt][ct][r] : NEG_INF; } }
        float mx = max3f(s[0][ct][0], s[0][ct][1], s[0][ct][2]);
        mx = max3f(mx, s[0][ct][3], s[1][ct][0]); mx = max3f(mx, s[1][ct][1], s[1][ct][2]); mx = max3f(mx, s[1][ct][3], s[2][ct][0]); mx = max3f(mx, s[2][ct][1], s[2][ct][2]);
        mx = max3f(mx, s[2][ct][3], s[3][ct][0]); mx = max3f(mx, s[3][ct][1], s[3][ct][2]); mx = fmaxf(mx, s[3][ct][3]);
        mx = quad_max(mx, lane);
        if (MODE == 0 && !bit[ct]) mx = NEG_INF;
        if (__ballot((mx - m[ct]) * ATT_C > 8.f) != 0ull) {
            const float mn = fmaxf(m[ct], mx), alpha = __builtin_amdgcn_exp2f((m[ct] - mn) * ATT_C); m[ct] = mn; L[ct] *= alpha;
#pragma unroll
            for (int dt = 0; dt < 8; ++dt) O[dt][ct] *= alpha; }
        const float mc = (MODE == 0 && !bit[ct]) ? __builtin_inff() : m[ct] * ATT_C;
#pragma unroll
        for (int kt = 0; kt < 4; ++kt)
#pragma unroll
            for (int r = 0; r < 4; ++r) s[kt][ct][r] = __builtin_amdgcn_exp2f(s[kt][ct][r] * ATT_C - mc);
        pf[0][ct] = pack_p(s[0][ct], s[1][ct]); pf[1][ct] = pack_p(s[2][ct], s[3][ct]);
    }
    pv_tile<ACT>(O, L, vb, pf, fr, fq);
}

template <int MODE>
DI bool fa_rowmax(float (&m)[2], float (&mc)[2], float (&alpha)[2], f32x4 (&s)[4][2], const bool (&bit)[2], const int (&tokl)[2], bool diag, bool left, int fq, int lane) {
    bool need = false;
#pragma unroll
    for (int ct = 0; ct < 2; ++ct) {
        if (diag || left) {
            const int thr_hi = diag ? tokl[ct] : 63, thr_lo = left ? tokl[ct] : -1;
            int kq = 4 * fq; asm volatile("" : "+v"(kq));
#pragma unroll
            for (int kt = 0; kt < 4; ++kt)
#pragma unroll
                for (int r = 0; r < 4; ++r) { const int kl = 16 * kt + kq + r; s[kt][ct][r] = (kl <= thr_hi && kl > thr_lo) ? s[kt][ct][r] : NEG_INF; } }
        float mx = max3f(s[0][ct][0], s[0][ct][1], s[0][ct][2]);
        mx = max3f(mx, s[0][ct][3], s[1][ct][0]); mx = max3f(mx, s[1][ct][1], s[1][ct][2]); mx = max3f(mx, s[1][ct][3], s[2][ct][0]); mx = max3f(mx, s[2][ct][1], s[2][ct][2]);
        mx = max3f(mx, s[2][ct][3], s[3][ct][0]); mx = max3f(mx, s[3][ct][1], s[3][ct][2]); mx = fmaxf(mx, s[3][ct][3]);
        mx = quad_max(mx, lane);
        if (MODE == 0 && !bit[ct]) mx = NEG_INF;
        alpha[ct] = 1.f;
        if (__ballot((mx - m[ct]) * ATT_C > 8.f) != 0ull) { const float mn = fmaxf(m[ct], mx); alpha[ct] = __builtin_amdgcn_exp2f((m[ct] - mn) * ATT_C); m[ct] = mn; need = true; }
        mc[ct] = (MODE == 0 && !bit[ct]) ? __builtin_inff() : m[ct] * ATT_C;
    }
    return need;
}
template <bool HAS_PREV>
DI void fa_exp_pv(f32x4 (&s)[4][2], const float (&mc)[2], bf16x8 (&pfc)[2][2], f32x4 (&O)[8][2], f32x4 (&L)[2], const bf16x8 (&pfp)[2][2], const LAS unsigned char* vbp, int fr, int fq) {
#define FA_EXP1(e) do { if ((e) < 32) { const int _ct = (e) >> 4, _kt = ((e) >> 2) & 3, _r = (e) & 3; s[_kt][_ct][_r] = __builtin_amdgcn_exp2f(s[_kt][_ct][_r] * ATT_C - mc[_ct]); } \
        if ((e) == 8) pfc[0][0] = pack_p(s[0][0], s[1][0]); if ((e) == 16) pfc[1][0] = pack_p(s[2][0], s[3][0]); \
        if ((e) == 24) pfc[0][1] = pack_p(s[0][1], s[1][1]); if ((e) == 32) pfc[1][1] = pack_p(s[2][1], s[3][1]); } while (0)
    if (!HAS_PREV) {
#pragma unroll
        for (int e = 0; e <= 32; ++e) FA_EXP1(e);
    } else {
        const LAS unsigned char* vr = vbp + fr * 128; const int x = (fr >> 1) & 7, y0 = (fq ^ x) << 4, y1 = ((4 + fq) ^ x) << 4;
        const bf16x8 ones = {0x3f80, 0x3f80, 0x3f80, 0x3f80, 0x3f80, 0x3f80, 0x3f80, 0x3f80};
        bf16x8 vf[2][2];
        vf[0][0] = *(const LAS bf16x8*)(vr + y0); vf[0][1] = *(const LAS bf16x8*)(vr + y1);
#define FA_SLOT(mfma_stmt, e) do { mfma_stmt; FA_EXP1(e); __builtin_amdgcn_sched_barrier(0); } while (0)
        FA_SLOT(L[0] = MFMA16(ones, pfp[0][0], L[0]), 0); FA_SLOT(L[1] = MFMA16(ones, pfp[0][1], L[1]), 1);
        FA_SLOT(L[0] = MFMA16(ones, pfp[1][0], L[0]), 2); FA_SLOT(L[1] = MFMA16(ones, pfp[1][1], L[1]), 3);
#pragma unroll
        for (int dt = 0; dt < 8; ++dt) { const int cb = dt & 1, nb = cb ^ 1;
            if (dt < 7) { vf[nb][0] = *(const LAS bf16x8*)(vr + (dt + 1) * 2048 + y0); vf[nb][1] = *(const LAS bf16x8*)(vr + (dt + 1) * 2048 + y1); }
            FA_SLOT(O[dt][0] = MFMA16(vf[cb][0], pfp[0][0], O[dt][0]), 4 + 4 * dt); FA_SLOT(O[dt][1] = MFMA16(vf[cb][0], pfp[0][1], O[dt][1]), 5 + 4 * dt);
            FA_SLOT(O[dt][0] = MFMA16(vf[cb][1], pfp[1][0], O[dt][0]), 6 + 4 * dt); FA_SLOT(O[dt][1] = MFMA16(vf[cb][1], pfp[1][1], O[dt][1]), 7 + 4 * dt); }
#undef FA_SLOT
    }
#undef FA_EXP1
}

template <int MODE  >
DI void fa_chunk(const Frame& F, const Args& a, int c, int g) {
    const bf16_t* cols = (const bf16_t*)(a.ws + WS_COLS);
    const int fr = F.lane & 15, fq = F.lane >> 4, w = F.wave, tid = F.tid;
    LAS unsigned char* lds = F.lds;
    LAS int* list = (LAS int*)(lds + 4 * ABUF); LAS unsigned* maskw = (LAS unsigned*)(lds + 4 * ABUF + 1024);
    const bf16_t* kcol = cols + (MODE ? C_KWIN : C_KSEL) + 128 * g;
    const bf16_t* vT = (const bf16_t*)(a.ws + (MODE ? WS_VWINT : WS_VSELT)) + (size_t)g * 128 * 8192;
    __syncthreads();
    int ntile, j0 = 0;
    if (MODE == 0) {
        const unsigned* selm = (const unsigned*)(a.ws + WS_SELM);
        if (tid < 256) maskw[tid] = selm[((size_t)(64 * c + (tid >> 2)) * 4 + g) * 4 + (tid & 3)];
        __syncthreads();
        if (w == 0) { int base = 0;
#pragma unroll
            for (int hf = 0; hf < 2; ++hf) { const int j = hf * 64 + F.lane; unsigned orv = 0u;
                for (int tk = 0; tk < 64; ++tk) orv |= maskw[tk * 4 + (j >> 5)];
                const bool act = ((orv >> (j & 31)) & 1u) && (j <= c); const unsigned long long bl = __ballot(act);
                if (act) list[base + __popcll(bl & ((1ull << F.lane) - 1ull))] = j; base += __popcll(bl); }
            if (F.lane == 0) list[129] = base; }
        __syncthreads();
        ntile = list[129];
    } else { j0 = c > 8 ? c - 8 : 0; ntile = c - j0 + 1; }
    int tokl[2]; tokl[0] = 8 * w + (fr >> 2); tokl[1] = tokl[0] + 4;
    const int head = 4 * g + (fr & 3);
    bf16x8 qf[2][4];
#pragma unroll
    for (int ct = 0; ct < 2; ++ct)
#pragma unroll
        for (int ks = 0; ks < 4; ++ks) qf[ct][ks] = *(const bf16x8*)(cols + (size_t)(64 * c + tokl[ct]) * NP + C_QA + head * 128 + 32 * ks + 8 * fq);
    f32x4 O[8][2], L[2]; float m[2] = {-1e30f, -1e30f};
    L[0] = (f32x4){0.f, 0.f, 0.f, 0.f}; L[1] = L[0];
#pragma unroll
    for (int dt = 0; dt < 8; ++dt) { O[dt][0] = (f32x4){0.f, 0.f, 0.f, 0.f}; O[dt][1] = (f32x4){0.f, 0.f, 0.f, 0.f}; }
#define FA_TILE(t) (MODE ? j0 + (t) : list[(t)])
#define FA_ISSUE(t) do { const int _j = FA_TILE(t); LAS unsigned char* _b = lds + ((t) & 3) * ABUF; \
        dma_k(_b, kcol + (size_t)(64 * _j) * NP, NP, w, F.lane); dma_v(_b + KTILE, vT + (size_t)_j * 8192, 64, w, F.lane); } while (0)
    FA_ISSUE(0); if (ntile > 1) FA_ISSUE(1);
    f32x4 s[4][2]; bf16x8 pfp[2][2], pfc[2][2]; float mc[2], alpha[2]; bool bit[2] = {true, true};
    for (int t = 0; t < ntile; ++t) {
        if (t + 1 < ntile) VMCNT(4); else VMCNT(0);
        RAW_BARRIER();
        if (t + 2 < ntile) FA_ISSUE(t + 2);
        const int j = FA_TILE(t);
        qk_tile<3>(s, lds + (t & 3) * ABUF, qf, fr, fq);
        if (MODE == 0) {
#pragma unroll
            for (int ct = 0; ct < 2; ++ct) bit[ct] = (maskw[tokl[ct] * 4 + (j >> 5)] >> (j & 31)) & 1u; }
        const bool need = fa_rowmax<MODE>(m, mc, alpha, s, bit, tokl, j == c, (MODE == 1) && (j == c - 8), fq, F.lane);
        __builtin_amdgcn_sched_barrier(0);
        if (t > 0) fa_exp_pv<true>(s, mc, pfc, O, L, pfp, lds + ((t - 1) & 3) * ABUF + KTILE, fr, fq); else fa_exp_pv<false>(s, mc, pfc, O, L, pfp, lds, fr, fq);
        __builtin_amdgcn_sched_barrier(0);
        if (need) {
#pragma unroll
            for (int ct = 0; ct < 2; ++ct) { L[ct] *= alpha[ct];
#pragma unroll
                for (int dt = 0; dt < 8; ++dt) O[dt][ct] *= alpha[ct]; } }
#pragma unroll
        for (int ct = 0; ct < 2; ++ct) { pfp[0][ct] = pfc[0][ct]; pfp[1][ct] = pfc[1][ct]; }
    }
    pv_tile<3>(O, L, lds + ((ntile - 1) & 3) * ABUF + KTILE, pfp, fr, fq);
#undef FA_ISSUE
#undef FA_TILE
    bf16_t* out = (bf16_t*)(a.ws + (MODE ? WS_OWIN : WS_OSEL));
#pragma unroll
    for (int ct = 0; ct < 2; ++ct) { const float inv = 1.f / L[ct][0]; bf16_t* op = out + (size_t)(64 * c + tokl[ct]) * D + head * 128 + 4 * fq;
#pragma unroll
        for (int dt = 0; dt < 8; ++dt) { u32x2 o; o.x = pk2(O[dt][ct][0] * inv, O[dt][ct][1] * inv); o.y = pk2(O[dt][ct][2] * inv, O[dt][ct][3] * inv); *(u32x2*)(op + 16 * dt) = o; } }
}

DI void ca_chunk(const Frame& F, const Args& a, int c, int g) {
    const bf16_t* cols = (const bf16_t*)(a.ws + WS_COLS);
    const int fr = F.lane & 15, fq = F.lane >> 4, w = F.wave, tid = F.tid;
    LAS unsigned char* lds = F.lds;
    LAS float* pslc = (LAS float*)(lds + 2 * ABUF); LAS float* p3 = (LAS float*)(lds + 2 * ABUF + 32768);
    const bf16_t* kc = (const bf16_t*)(a.ws + WS_KC) + (size_t)g * 512 * 128;
    const bf16_t* vct = (const bf16_t*)(a.ws + WS_VCT) + (size_t)g * 128 * 512;
    const int ntile = ((4 * c + 2) >> 6) + 1;
    int tokl[2]; tokl[0] = 8 * w + (fr >> 2); tokl[1] = tokl[0] + 4;
    const int head = 4 * g + (fr & 3);
    int nlim[2];
#pragma unroll
    for (int ct = 0; ct < 2; ++ct) { const int t = 64 * c + tokl[ct]; nlim[ct] = t >= 31 ? ((t - 31) >> 4) : -1; }
    bf16x8 qf[2][4];
#pragma unroll
    for (int ct = 0; ct < 2; ++ct)
#pragma unroll
        for (int ks = 0; ks < 4; ++ks) qf[ct][ks] = *(const bf16x8*)(cols + (size_t)(64 * c + tokl[ct]) * NP + C_QA + head * 128 + 32 * ks + 8 * fq);
    float m[2] = {-1e30f, -1e30f}, l[2] = {0.f, 0.f};
    __syncthreads();
    dma_k(lds, kc, 128, w, F.lane);
    for (int jt = 0; jt < ntile; ++jt) {
        VMCNT(0); RAW_BARRIER();
        if (jt + 1 < ntile) dma_k(lds + ((jt + 1) & 1) * ABUF, kc + (size_t)(64 * (jt + 1)) * 128, 128, w, F.lane);
        const LAS unsigned char* kb = lds + (jt & 1) * ABUF;
        f32x4 s[4][2];
        qk_tile<3>(s, kb, qf, fr, fq);
        const bool edge = jt >= ntile - 2;
        int kq = 4 * fq; asm volatile("" : "+v"(kq));
#pragma unroll
        for (int ct = 0; ct < 2; ++ct) {
            float mx = NEG_INF;
#pragma unroll
            for (int kt = 0; kt < 4; ++kt)
#pragma unroll
                for (int r = 0; r < 4; ++r) { float v = s[kt][ct][r]; if (edge) { const int n = 64 * jt + 16 * kt + kq + r; v = (n <= nlim[ct]) ? v : NEG_INF; s[kt][ct][r] = v; } mx = fmaxf(mx, v); }
            mx = quad_max(mx, F.lane);
            if (__ballot((mx - m[ct]) * ATT_C > 8.f) != 0ull) { const float mn = fmaxf(m[ct], mx); l[ct] *= __builtin_amdgcn_exp2f((m[ct] - mn) * ATT_C); m[ct] = mn; }
            const float mc = m[ct] * ATT_C;
            float rs = 0.f;
#pragma unroll
            for (int kt = 0; kt < 4; ++kt)
#pragma unroll
                for (int r = 0; r < 4; ++r) rs += __builtin_amdgcn_exp2f(s[kt][ct][r] * ATT_C - mc);
            l[ct] += quad_sum(rs, F.lane);
        }
    }
    f32x4 O[8][2];
#pragma unroll
    for (int dt = 0; dt < 8; ++dt) { O[dt][0] = (f32x4){0.f, 0.f, 0.f, 0.f}; O[dt][1] = (f32x4){0.f, 0.f, 0.f, 0.f}; }
    float mc[2], inv[2];
#pragma unroll
    for (int ct = 0; ct < 2; ++ct) { mc[ct] = m[ct] * ATT_C; inv[ct] = l[ct] > 0.f ? 1.f / l[ct] : 0.f; }
    RAW_BARRIER();
    dma_k(lds, kc, 128, w, F.lane); dma_v(lds + KTILE, vct, 512, w, F.lane);
    for (int jt = 0; jt < ntile; ++jt) {
        VMCNT(0); RAW_BARRIER();
        if (jt + 1 < ntile) { LAS unsigned char* nb = lds + ((jt + 1) & 1) * ABUF; dma_k(nb, kc + (size_t)(64 * (jt + 1)) * 128, 128, w, F.lane); dma_v(nb + KTILE, vct + 64 * (jt + 1), 512, w, F.lane); }
        const LAS unsigned char* kb = lds + (jt & 1) * ABUF;
        f32x4 s[4][2];
        qk_tile<3>(s, kb, qf, fr, fq);
        const bool edge = jt >= ntile - 2;
        int kq = 4 * fq; asm volatile("" : "+v"(kq));
        bf16x8 pf[2][2];
#pragma unroll
        for (int ct = 0; ct < 2; ++ct) {
#pragma unroll
            for (int kt = 0; kt < 4; ++kt) {
#pragma unroll
                for (int r = 0; r < 4; ++r) { float p = __builtin_amdgcn_exp2f(s[kt][ct][r] * ATT_C - mc[ct]) * inv[ct];
                    if (edge) { const int n = 64 * jt + 16 * kt + kq + r; p = (n <= nlim[ct]) ? p : 0.f; }
                    s[kt][ct][r] = p; }
                float h3 = s[kt][ct][3], hs = (s[kt][ct][0] + s[kt][ct][1]) + (s[kt][ct][2] + h3);
                hs += shx(hs, 1, F.lane); hs += shx(hs, 2, F.lane); h3 += shx(h3, 1, F.lane); h3 += shx(h3, 2, F.lane);
                if ((fr & 3) == 0) { const int jj = 16 * jt + 4 * kt + fq; pslc[tokl[ct] * 128 + jj] = hs; p3[tokl[ct] * 128 + jj] = h3; }
            }
            pf[0][ct] = pack_p(s[0][ct], s[1][ct]); pf[1][ct] = pack_p(s[2][ct], s[3][ct]);
        }
        { f32x4 Ldummy[2]; pv_tile<3, false>(O, Ldummy, kb + KTILE, pf, fr, fq); }
    }
    bf16_t* out = (bf16_t*)(a.ws + WS_OCMP);
#pragma unroll
    for (int ct = 0; ct < 2; ++ct) { bf16_t* op = out + (size_t)(64 * c + tokl[ct]) * D + head * 128 + 4 * fq;
#pragma unroll
        for (int dt = 0; dt < 8; ++dt) { u32x2 o; o.x = pk2(O[dt][ct][0], O[dt][ct][1]); o.y = pk2(O[dt][ct][2], O[dt][ct][3]); *(u32x2*)(op + 16 * dt) = o; } }
    LDS_WAIT(); asm volatile("" ::: "memory");
    unsigned* selm = (unsigned*)(a.ws + WS_SELM);
    {
        int li = F.lane & 15, tq = F.lane >> 4; asm volatile("" : "+v"(li), "+v"(tq));
        unsigned mw[2][4];
        if (c <= 15) {
            const unsigned all = (c == 31) ? 0xffffffffu : ((2u << c) - 1u);
#pragma unroll
            for (int b = 0; b < 2; ++b) { mw[b][0] = all; mw[b][1] = 0u; mw[b][2] = 0u; mw[b][3] = 0u; }
        } else {
            unsigned long long key[2][8];
#pragma unroll
            for (int b = 0; b < 2; ++b) { const int tok = 8 * w + 4 * b + tq;
#pragma unroll
                for (int e = 0; e < 8; ++e) { const int jj = li + 16 * e; const bool ok = (jj >= 1) && (jj <= c - 2);
                    const float sc = ok ? pslc[tok * 128 + jj] + p3[tok * 128 + jj - 1] : 0.f;
                    key[b][e] = ok ? (((unsigned long long)__float_as_uint(sc) << 32) | (unsigned)(127 - jj)) : 0ull; }
#pragma unroll
                for (int q = 0; q < 4; ++q) mw[b][q] = 0u;
                { const int f0 = 0, f1 = c - 1, f2 = c;
#pragma unroll
                  for (int q = 0; q < 4; ++q) mw[b][q] |= ((f0 >> 5) == q ? 1u << (f0 & 31) : 0u) | ((f1 >> 5) == q ? 1u << (f1 & 31) : 0u) | ((f2 >> 5) == q ? 1u << (f2 & 31) : 0u); } }
#define ROR64(v, n) ((((unsigned long long)(unsigned)__builtin_amdgcn_update_dpp(0, (int)(unsigned)((v) >> 32), 0x120 + (n), 0xf, 0xf, false)) << 32) | (unsigned)__builtin_amdgcn_update_dpp(0, (int)(unsigned)(v), 0x120 + (n), 0xf, 0xf, false))
#pragma unroll 1
            for (int round = 0; round < 13; ++round) {
#pragma unroll
                for (int b = 0; b < 2; ++b) {
                    unsigned long long best = key[b][0];
#pragma unroll
                    for (int e = 1; e < 8; ++e) best = key[b][e] > best ? key[b][e] : best;
                    { unsigned long long o; o = ROR64(best, 1); best = o > best ? o : best; o = ROR64(best, 2); best = o > best ? o : best;
                      o = ROR64(best, 4); best = o > best ? o : best; o = ROR64(best, 8); best = o > best ? o : best; }
                    if (best != 0ull) { const int jb = 127 - (int)(unsigned)best;
#pragma unroll
                        for (int q = 0; q < 4; ++q) mw[b][q] |= ((jb >> 5) == q) ? (1u << (jb & 31)) : 0u;
#pragma unroll
                        for (int e = 0; e < 8; ++e) key[b][e] = (key[b][e] == best) ? 0ull : key[b][e]; }
                }
            }
#undef ROR64
        }
        if (li == 0) {
#pragma unroll
            for (int b = 0; b < 2; ++b) { const int tok = 8 * w + 4 * b + tq; u32x4 o; o.x = mw[b][0]; o.y = mw[b][1]; o.z = mw[b][2]; o.w = mw[b][3];
                *(u32x4*)(selm + ((size_t)(64 * c + tok) * 4 + g) * 4) = o; } }
    }
}

struct ScanRegs { bf16x8 ks[2]; bf16x8 at; f32x4 dc; };
DI void dma_v8(LAS unsigned char* vb, const bf16_t* vbase, int w, int lane) {
    const int row = 8 * w + (lane >> 3), c = (lane & 7) ^ ((row >> 1) & 7);
    glds16(vbase + (size_t)row * 64 + c * 8, vb + w * 1024);
}
constexpr int SC_SROW = 272, SC_SBUF = 64 * SC_SROW, SC_Q = 0, SC_V = 4 * 16384, SC_S = SC_V + 4 * 8192;
static_assert(SC_S + 2 * SC_SBUF <= LDS_MISC, "scan LDS map");
DI void scan_issue(ScanRegs& r, LAS unsigned char* lds, const Args& a, int n, int h, int sl, int kh, int w, int lane, int fr, int fq) {
    const bf16_t* qdec = (const bf16_t*)(a.ws + WS_QDEC); const bf16_t* kst = (const bf16_t*)(a.ws + WS_KST);
    const bf16_t* vt = (const bf16_t*)(a.ws + WS_VT); const bf16_t* att = (const bf16_t*)(a.ws + WS_ATT); const float* dec = (const float*)(a.ws + WS_DEC);
    dma_k(lds + SC_Q + (n & 3) * 16384, qdec + (size_t)(64 * n) * 1024 + h * 256 + kh * 128, 1024, w, lane);
    dma_v8(lds + SC_V + (n & 3) * 8192, vt + ((size_t)n * 2048 + h * 512 + 64 * sl) * 64, w, lane);
    { const bf16_t* kp = kst + ((size_t)(n * 4 + h) * 256 + kh * 128 + 16 * w + fr) * 64 + 8 * fq;
      asm volatile("global_load_dwordx4 %0, %1, off" : "=v"(r.ks[0]) : "v"(kp) : "memory");
      asm volatile("global_load_dwordx4 %0, %1, off offset:64" : "=v"(r.ks[1]) : "v"(kp) : "memory"); }
    { const bf16_t* ap_ = att + ((size_t)(n * 4 + h) * 64 + 16 * (w & 3) + fr) * 64 + 32 * kh + 8 * fq; asm volatile("global_load_dwordx4 %0, %1, off" : "=v"(r.at) : "v"(ap_) : "memory"); }
    { const float* dp = dec + (n * 4 + h) * 256 + kh * 128 + 16 * w + 4 * fq; asm volatile("global_load_dwordx4 %0, %1, off" : "=v"(r.dc) : "v"(dp) : "memory"); }
}
DI void scan_step(const ScanRegs& cur, f32x4 (&S)[4], LAS unsigned char* lds, bf16_t* opart, int n, int h, int sl, int kh, int w, int fr, int fq) {
    const LAS unsigned char* sc = lds + SC_S + (n & 1) * SC_SBUF; const LAS unsigned char* qb = lds + SC_Q + (n & 3) * 16384; const LAS unsigned char* vb = lds + SC_V + (n & 3) * 8192;
    const int tt = w & 3, vt0 = 2 * (w >> 2), xv = (fr >> 1) & 7;
    const LAS unsigned char* vr = vb + fr * 128; const int y0 = (fq ^ xv) << 4, y1 = ((4 + fq) ^ xv) << 4;
    bf16x8 qf[4], sf[2][4];
#pragma unroll
    for (int ks = 0; ks < 4; ++ks) qf[ks] = *(const LAS bf16x8*)(qb + (16 * tt + fr) * 256 + (((4 * ks + fq) ^ fr) << 4));
#pragma unroll
    for (int z = 0; z < 2; ++z)
#pragma unroll
        for (int ks = 0; ks < 4; ++ks) sf[z][ks] = *(const LAS bf16x8*)(sc + (16 * (vt0 + z) + fr) * SC_SROW + (32 * ks + 8 * fq) * 2);
    LDS_WAIT(); __builtin_amdgcn_sched_barrier(0);
    f32x4 acc[2];
#pragma unroll
    for (int z = 0; z < 2; ++z) { acc[z] = (f32x4){0.f, 0.f, 0.f, 0.f};
#pragma unroll
        for (int ks = 0; ks < 4; ++ks) acc[z] = MFMA16(sf[z][ks], qf[ks], acc[z]); }
    bf16x8 vf[4][2];
#pragma unroll
    for (int vt = 0; vt < 4; ++vt) { vf[vt][0] = *(const LAS bf16x8*)(vr + vt * 2048 + y0); vf[vt][1] = *(const LAS bf16x8*)(vr + vt * 2048 + y1); }
    LDS_WAIT(); __builtin_amdgcn_sched_barrier(0);
    { const bf16x8 va0 = vt0 ? (kh ? vf[2][1] : vf[2][0]) : (kh ? vf[0][1] : vf[0][0]), va1 = vt0 ? (kh ? vf[3][1] : vf[3][0]) : (kh ? vf[1][1] : vf[1][0]);
      acc[0] = MFMA16(va0, cur.at, acc[0]); acc[1] = MFMA16(va1, cur.at, acc[1]); }
    LAS unsigned char* sn = lds + SC_S + ((n + 1) & 1) * SC_SBUF;
#pragma unroll
    for (int vt = 0; vt < 4; ++vt) { S[vt] = S[vt] * cur.dc; S[vt] = MFMA16(cur.ks[0], vf[vt][0], S[vt]); S[vt] = MFMA16(cur.ks[1], vf[vt][1], S[vt]); }
#pragma unroll
    for (int z = 0; z < 2; ++z) { u32x2 o; o.x = pk2(acc[z][0], acc[z][1]); o.y = pk2(acc[z][2], acc[z][3]);
        *(u32x2*)(opart + (size_t)(64 * n + 16 * tt + fr) * 2048 + h * 512 + 64 * sl + 16 * (vt0 + z) + 4 * fq) = o; }
#pragma unroll
    for (int vt = 0; vt < 4; ++vt) { u32x2 o; o.x = pk2(S[vt][0], S[vt][1]); o.y = pk2(S[vt][2], S[vt][3]); *(LAS u32x2*)(sn + (16 * vt + fr) * SC_SROW + (16 * w + 4 * fq) * 2) = o; }
}
DI void gla_scan_unit(const Frame& F, const Args& a, int h, int sl, int kh) {
    LAS unsigned char* lds = F.lds;
    const int fr = F.lane & 15, fq = F.lane >> 4, w = F.wave;
    bf16_t* opart = (bf16_t*)(a.ws + WS_OPART) + (size_t)kh * T * 2048;
    __syncthreads();
    for (int i = F.tid; i < SC_SBUF / 4; i += NTHR) ((LAS unsigned*)(lds + SC_S))[i] = 0u;
    f32x4 S[4];
#pragma unroll
    for (int vt = 0; vt < 4; ++vt) S[vt] = (f32x4){0.f, 0.f, 0.f, 0.f};
    ScanRegs r0, r1, r2, r3;
    scan_issue(r0, lds, a, 0, h, sl, kh, w, F.lane, fr, fq); scan_issue(r1, lds, a, 1, h, sl, kh, w, F.lane, fr, fq); scan_issue(r2, lds, a, 2, h, sl, kh, w, F.lane, fr, fq);
#define SC_STEP(rn, rc, n) do { if ((n) < 3) asm volatile("s_waitcnt vmcnt(14)" ::: "memory"); else asm volatile("s_waitcnt vmcnt(20)" ::: "memory"); LDS_WAIT(); RAW_BARRIER(); \
        scan_issue(rn, lds, a, ((n) + 3 < NCH) ? (n) + 3 : NCH - 1, h, sl, kh, w, F.lane, fr, fq); scan_step(rc, S, lds, opart, (n), h, sl, kh, w, fr, fq); } while (0)
    for (int n = 0; n < NCH; n += 4) { SC_STEP(r3, r0, n); SC_STEP(r0, r1, n + 1); SC_STEP(r1, r2, n + 2); SC_STEP(r2, r3, n + 3); }
#undef SC_STEP
    VM_WAIT();
}

DI void p_combine(const Frame& F, const Args& a, int layer) {
    const bf16_t* cols = (const bf16_t*)(a.ws + WS_COLS);
    const bf16_t* ocmp = (const bf16_t*)(a.ws + WS_OCMP); const bf16_t* osel = (const bf16_t*)(a.ws + WS_OSEL); const bf16_t* owin = (const bf16_t*)(a.ws + WS_OWIN);
    const bf16_t* op0 = (const bf16_t*)(a.ws + WS_OPART); const bf16_t* op1 = op0 + (size_t)T * 2048;
    bf16_t* A1 = (bf16_t*)(a.ws + WS_A1); bf16_t* A2 = (bf16_t*)(a.ws + WS_A2);
    const int c8 = 8 * F.lane;
    f32x4 nw[2]; nw[0] = *(const f32x4*)(a.gla_norm_w + layer * 512 + c8); nw[1] = *(const f32x4*)(a.gla_norm_w + layer * 512 + c8 + 4);
    for (int row = F.gw; row < T; row += F.NGW) {
        const bf16_t* cr = cols + (size_t)row * NP; const size_t ro = (size_t)row * D;
#pragma unroll
        for (int j = 0; j < 4; ++j) { const int c0 = 512 * j + c8, head = 4 * j + (F.lane >> 4);
            const float g0 = sigmoidf_(bf2f(cr[C_GBR + head * 3 + 0])), g1 = sigmoidf_(bf2f(cr[C_GBR + head * 3 + 1])), g2 = sigmoidf_(bf2f(cr[C_GBR + head * 3 + 2]));
            float oc[8], os[8], ow[8], za[8], p0[8], p1[8], zb[8];
            unpack8(*(const u32x4*)(ocmp + ro + c0), oc); unpack8(*(const u32x4*)(osel + ro + c0), os); unpack8(*(const u32x4*)(owin + ro + c0), ow); unpack8(*(const u32x4*)(cr + C_ZA + c0), za);
            unpack8(*(const u32x4*)(op0 + ro + c0), p0); unpack8(*(const u32x4*)(op1 + ro + c0), p1); unpack8(*(const u32x4*)(cr + C_ZB + c0), zb);
            float r[8], o[8], ss = 0.f;
#pragma unroll
            for (int e = 0; e < 8; ++e) { r[e] = (g0 * oc[e] + g1 * os[e] + g2 * ow[e]) * siluf_(za[e]); o[e] = p0[e] + p1[e]; ss += o[e] * o[e]; }
            { u32x4 q; q.x = pk2(r[0], r[1]); q.y = pk2(r[2], r[3]); q.z = pk2(r[4], r[5]); q.w = pk2(r[6], r[7]); *(u32x4*)(A1 + ro + c0) = q; }
            const float rs = rsqrtf(wave_sum(ss, F.lane) * (1.f / 512.f) + NORM_EPS);
            float y[8];
#pragma unroll
            for (int e = 0; e < 8; ++e) y[e] = o[e] * rs * nw[e >> 2][e & 3] * siluf_(zb[e]);
            { u32x4 q; q.x = pk2(y[0], y[1]); q.y = pk2(y[2], y[3]); q.z = pk2(y[4], y[5]); q.w = pk2(y[6], y[7]); *(u32x4*)(A2 + ro + c0) = q; } }
    }
}

constexpr int PH_PER_LAYER = 10, N_PHASES = 2 + DEPTH * PH_PER_LAYER;
constexpr int WQ_WORD0 = 16384;
DI int wq_pull(unsigned* cnt, volatile LAS unsigned* slot, int tid) {
    __syncthreads();
    if (tid == 0) *slot = __hip_atomic_fetch_add(cnt, 1u, __ATOMIC_RELAXED, __HIP_MEMORY_SCOPE_AGENT);
    __syncthreads();
    return (int)*slot;
}
__global__ void __launch_bounds__(NTHR, 2) mk_fwd(Args a_in, int li) {
    KArgsP ap = (KArgsP)__builtin_amdgcn_kernarg_segment_ptr();
    const int ph_lo = a_in.ph_lo, ph_hi = a_in.ph_hi;
    extern __shared__ __attribute__((aligned(16))) unsigned char lds_raw[];
    Frame F;
    F.lds = (LAS unsigned char*)lds_raw;
    F.tid = threadIdx.x; F.lane = F.tid & 63; F.wave = __builtin_amdgcn_readfirstlane(F.tid >> 6);
    const int wave_s = F.wave;
    F.G = gridDim.x; F.bid = blockIdx.x; F.gw = F.bid * NWAVES + F.wave; F.NGW = F.G * NWAVES;
    volatile LAS unsigned* misc = (volatile LAS unsigned*)(F.lds + LDS_MISC);
    if (F.tid < 64) misc[F.tid] = 0u;
    __syncthreads();
    unsigned* ctl = (unsigned*)(a_in.ws + WS_CTL);
    XcdBarrier bar = xcd_barrier_post(ctl + (size_t)li * XCD_BAR_WORDS, misc);
#ifndef PHASE_SET
#define PHASE_SET 0xFFFF
#endif
#define HAS(k) ((PHASE_SET >> (k)) & 1)
#ifndef REPEAT_PHASE
#define REPEAT_PHASE -1
#endif
#define REP(k) for (int _r = 0; _r < ((REPEAT_PHASE == (k)) ? 2 : 1); ++_r)
#define IN(k) (ph_lo <= (k) && (k) < ph_hi)
#define SEAM(k) do { if (IN(k) && IN((k) + 1)) xcd_barrier(bar); } while (0)
#define FRESH() do { int _l = __builtin_amdgcn_mbcnt_hi(~0u, __builtin_amdgcn_mbcnt_lo(~0u, 0u)); asm volatile("" : "+v"(_l)); int _w = wave_s; asm volatile("" : "+s"(_w)); F.lane = _l; F.wave = _w; F.tid = _w * 64 + _l; F.gw = F.bid * NWAVES + F.wave; { KArgsP _k = (KArgsP)__builtin_amdgcn_kernarg_segment_ptr(); asm volatile("" : "+s"(_k)); ap = _k; } } while (0)
    if (HAS(12) && IN(0)) { FRESH(); const Args a = load_args(ap); REP(12) { p_prologue(F, a); } SEAM(0); }
#define PHASE_ENTER() FRESH(); const Args a = load_args(ap); unsigned char* ws = a.ws; bf16_t* cols = (bf16_t*)(ws + WS_COLS); (void)cols
#define UNIT_FRAME(Fu) Frame Fu = F; { int _l = F.lane; asm volatile("" : "+v"(_l)); Fu.lane = _l; Fu.tid = F.wave * 64 + _l; }
    for (int L = 0; L < DEPTH; ++L) {
        const int pb = 1 + PH_PER_LAYER * L;
        if (HAS(0) && IN(pb + 0)) { PHASE_ENTER();
            if (L == 0) p_rmsnorm<false, false>(F, a.x, a.norm_w, ws + WS_H); else p_rmsnorm<false, true>(F, ws + WS_X, a.norm_w + L * D, ws + WS_H);
            SEAM(pb + 0); }
        if (HAS(1) && IN(pb + 1)) { PHASE_ENTER();
            pg8::Gemm g{(const bf16_t*)(ws + WS_H), (const bf16_t*)(ws + WS_WIN) + (size_t)L * NP * D, D, D, D};
            pg8::OrderIn S; S.mn.init(T, NP, F.G, F.bid); S.sig = (unsigned*)(ws + WS_CTL) + WQ_WORD0 + 40960 + 64 * L; pg8::EpiCols E{cols, NP, (bf16_t*)(ws + WS_VT), (bf16_t*)(ws + WS_VSELT), (bf16_t*)(ws + WS_VWINT)};
            pg8::gemm_phase<pg8::EpiCols, pg8::OrderIn, false, true, true>(F.lds, g, S, E, F.tid); }
        if (HAS(2) && IN(pb + 2)) { PHASE_ENTER();
            unsigned* cnt = (unsigned*)(ws + WS_CTL) + WQ_WORD0 + 8192 + 64 * L;
            { unsigned* sig = (unsigned*)(ws + WS_CTL) + WQ_WORD0 + 40960 + 64 * L;
              if (F.tid == 0) { XB_SPIN(xb_ld(sig) < pg8::IN_EARLY_TILES, bar.bar); __builtin_amdgcn_fence(__ATOMIC_ACQUIRE, "agent"); asm volatile("s_waitcnt vmcnt(0)" ::: "memory"); }
              __syncthreads(); }
            for (;;) { const int u = wq_pull(cnt, misc + 16, F.tid); if (u >= 128 + 512) break;
                UNIT_FRAME(Fu);
                if (u < 128) { pg8::Gemm g{cols, (const bf16_t*)(ws + WS_W1T) + (size_t)L * 2 * 256 * 4096, 16 * NP, 4096, 512};
                    pg8::OrderCmp S; S.init(1 << 20, u); pg8::EpiPart E{(float*)(ws + WS_CPART)};
                    __syncthreads();
                    pg8::gemm_phase<pg8::EpiPart, pg8::OrderCmp, true, false, true>(Fu.lds, g, S, E, Fu.tid); }
                else { const int v = u - 128; gla_g1_unit(Fu, a, L, v >> 2, v & 3); } }
            SEAM(pb + 2); }
        if (HAS(3) && IN(pb + 3)) { PHASE_ENTER(); for (int u = F.bid; u < 256; u += F.G) mlp2_unit(F, a, L, u >> 5, u & 31); SEAM(pb + 3); }
        if (HAS(4) && IN(pb + 4)) { PHASE_ENTER();
            REP(4) { unsigned* cnt = (unsigned*)(ws + WS_CTL) + WQ_WORD0 + 64 * (2 * L + 16 * _r);
            for (;;) { const int u = wq_pull(cnt, misc + 16, F.tid); if (u >= 512 + 512) break;
                UNIT_FRAME(Fu);
                if (u < 512) ca_chunk(Fu, a, 127 - (u >> 2), u & 3);
                else { const int v = u - 512; fa_chunk<1>(Fu, a, 127 - (v >> 2), v & 3); } } }
            SEAM(pb + 4); }
        if (HAS(5) && IN(pb + 5)) { PHASE_ENTER();
            REP(5) { unsigned* cnt = (unsigned*)(ws + WS_CTL) + WQ_WORD0 + 64 * (2 * L + 1 + 16 * _r);
            unsigned* grp = (unsigned*)(ws + WS_CTL) + WQ_WORD0 + 4096 + 64 * (8 * L + 32 * _r);
            unsigned* claimed = (unsigned*)(ws + WS_CTL) + WQ_WORD0 + 32768 + 64 * (L + 4 * _r);
            { const unsigned x = xb_xcc_id() & 7u;
              __syncthreads();
              if (F.tid == 0) { unsigned r = __hip_atomic_fetch_add(grp + 64 * x, 1u, __ATOMIC_RELAXED, __HIP_MEMORY_SCOPE_AGENT); unsigned got = 0xffffffffu;
                  if (r < 8u && __hip_atomic_exchange(claimed + 8 * x + r, 1u, __ATOMIC_RELAXED, __HIP_MEMORY_SCOPE_AGENT) == 0u) got = 8u * x + r;
                  misc[16] = got; }
              __syncthreads();
              const unsigned su = misc[16];
              if (su != 0xffffffffu) { UNIT_FRAME(Fu); gla_scan_unit(Fu, a, (int)(su >> 4), (int)(su & 7u), (int)((su >> 3) & 1u)); } }
            for (;;) { const int u = wq_pull(cnt, misc + 16, F.tid); if (u >= 64) break;
                UNIT_FRAME(Fu);
                __syncthreads(); if (F.tid == 0) misc[17] = __hip_atomic_exchange(claimed + u, 1u, __ATOMIC_RELAXED, __HIP_MEMORY_SCOPE_AGENT); __syncthreads();
                if (misc[17] == 0u) gla_scan_unit(Fu, a, u >> 4, u & 7, (u >> 3) & 1); }
            { const int g0 = (int)(xb_xcc_id() & 3u);
              for (int gi = 0; gi < 4; ++gi) { const int gq = (g0 + gi) & 3; unsigned* qcnt = (unsigned*)(ws + WS_CTL) + WQ_WORD0 + 12288 + 64 * (4 * L + gq + 32 * _r);
                  for (;;) { const int u = wq_pull(qcnt, misc + 16, F.tid); if (u >= 128) break;
                      UNIT_FRAME(Fu);
                      fa_chunk<0>(Fu, a, 127 - u, gq); } } } }
            SEAM(pb + 5); }
        if (HAS(6) && IN(pb + 6)) { PHASE_ENTER(); p_combine(F, a, L); SEAM(pb + 6); }
        if (HAS(7) && IN(pb + 7)) { PHASE_ENTER();
            pg8::Gemm g{(const bf16_t*)(ws + WS_A1), (const bf16_t*)(ws + WS_WPA) + (size_t)L * D * D, D, D, D};
            pg8::OrderAB S; S.mn.init(T, D, F.G, F.bid); S.A2 = (const bf16_t*)(ws + WS_A2); S.B2 = (const bf16_t*)(ws + WS_WPB) + (size_t)L * D * D;
            pg8::EpiGateAB E{(bf16_t*)(ws + WS_Y), (bf16_t*)(ws + WS_TMP), cols + C_GA, cols + C_GB};
            pg8::gemm_phase<pg8::EpiGateAB, pg8::OrderAB, false, true, true>(F.lds, g, S, E, F.tid);
            SEAM(pb + 7); }
        if (HAS(8) && IN(pb + 8)) { PHASE_ENTER(); }
        if (HAS(9) && IN(pb + 9)) { PHASE_ENTER();
            pg8::Gemm g{(const bf16_t*)(ws + WS_Y), (const bf16_t*)(ws + WS_WOUT) + (size_t)L * D * D, D, D, D};
            pg8::OrderMN S; S.init(T, D, F.G, F.bid); pg8::EpiResid E{L == 0 ? a.x : (const float*)nullptr, (const bf16_t*)(ws + WS_X), (bf16_t*)(ws + WS_X)};
            pg8::gemm_phase<pg8::EpiResid, pg8::OrderMN, false, false, true>(F.lds, g, S, E, F.tid);
            SEAM(pb + 9); }
    }
    if (HAS(13) && IN(N_PHASES - 1)) { FRESH(); const Args a = load_args(ap); p_rmsnorm<true, true>(F, a.ws + WS_X, a.final_w, a.out); }
#undef IN
#undef SEAM
}

extern "C" void kernel_launch(void* const* d_in, const int* in_sizes, int n_in, void* d_out, int out_size, void* d_ws, size_t ws_size, hipStream_t stream) {
    static int grid = 0;
    if (grid == 0) {
        if (n_in != 15 || ws_size < WS_END) { fprintf(stderr, "kernel_launch: unexpected inputs (n_in %d, ws %zu, need %zu)\n", n_in, ws_size, (size_t)WS_END); grid = -1; return; }
        int dev = 0, cus = 0;
        if (hipGetDevice(&dev) != hipSuccess || hipDeviceGetAttribute(&cus, hipDeviceAttributeMultiprocessorCount, dev) != hipSuccess) { grid = -1; return; }
        if (hipFuncSetAttribute((const void*)mk_fwd, hipFuncAttributeMaxDynamicSharedMemorySize, LDS_BYTES) != hipSuccess) { fprintf(stderr, "kernel_launch: hipFuncSetAttribute failed\n"); grid = -1; return; }
        int per_cu = 0;
        if (hipOccupancyMaxActiveBlocksPerMultiprocessor(&per_cu, (const void*)mk_fwd, NTHR, LDS_BYTES) != hipSuccess || per_cu < 1) fprintf(stderr, "kernel_launch: occupancy query reports %d\n", per_cu);
        (void)hipGetLastError();
        grid = cus;
    }
    if (grid < 0) return;
    (void)hipMemsetAsync((char*)d_ws + WS_CTL, 0, CTL_BYTES, stream);
    Args a{};
    a.x = (const float*)d_in[0]; a.norm_w = (const float*)d_in[1]; a.w_in = (const float*)d_in[2]; a.cmp_pe = (const float*)d_in[3]; a.cmp_w1 = (const float*)d_in[4];
    a.cmp_b1 = (const float*)d_in[5]; a.cmp_w2 = (const float*)d_in[6]; a.cmp_b2 = (const float*)d_in[7]; a.alpha_w = (const float*)d_in[8]; a.alpha_b = (const float*)d_in[9];
    a.gla_norm_w = (const float*)d_in[10]; a.p_a = (const float*)d_in[11]; a.p_b = (const float*)d_in[12]; a.w_out = (const float*)d_in[13]; a.final_w = (const float*)d_in[14];
    a.out = (float*)d_out; a.ws = (unsigned char*)d_ws;
#if MK_PER_PHASE
    for (int k = 0; k < N_PHASES; ++k) { a.ph_lo = k; a.ph_hi = k + 1; hipLaunchKernelGGL(mk_fwd, dim3(grid), dim3(NTHR), LDS_BYTES, stream, a, k); }
#else
    a.ph_lo = 0; a.ph_hi = N_PHASES; hipLaunchKernelGGL(mk_fwd, dim3(grid), dim3(NTHR), LDS_BYTES, stream, a, 0);
#endif
}
```
